# Optimizing an MI355X kernel written in HIP

```python
import jax, jax.numpy as jnp
from jax import lax
import numpy as np

D_MODEL = 2048
BATCH = 4
SEQ = 4096
DEPTH = 2

GRID_W = 64
CTX_LEN = 256
HEAD_DIM = 128
F_GROUPS = 4
F_W = F_GROUPS * HEAD_DIM
NA_HEADS = 8
NA_W = NA_HEADS * HEAD_DIM
NA_KH = 8
NA_KW = 16
C_GROUPS = 4
C_W = C_GROUPS * HEAD_DIM
CHUNK = 128
D_FF = 5632
CONV_W = 3
EPS = 1e-6
NEG_INF = -1e30

OFF_F = 0
OFF_Q = OFF_F + F_W
OFF_K = OFF_Q + NA_W
OFF_V = OFF_K + NA_W
OFF_C = OFF_V + NA_W
OFF_GATE = OFF_C + 2 * C_W
IN_W = OFF_GATE + 3 * D_MODEL

kernel_name = "hybrid_fourier_natten_gmlp_dit_block"


def rms_norm(x, w):
    x32 = x.astype(jnp.float32)
    y = x32 * lax.rsqrt(jnp.mean(x32 * x32, axis=-1, keepdims=True) + EPS)
    return (y * w.astype(jnp.float32)).astype(x.dtype)


def modulate(h, shift, scale):
    return h * (1 + scale) + shift


def split_proj(p):
    return (p[..., OFF_F:OFF_Q], p[..., OFF_Q:OFF_K], p[..., OFF_K:OFF_V],
            p[..., OFF_V:OFF_C], p[..., OFF_C:OFF_GATE], p[..., OFF_GATE:])


def fourier_mix(xf):
    b, n, _ = xf.shape
    xg = xf.astype(jnp.float32).reshape(b, n, F_GROUPS, HEAD_DIM)
    y = jnp.fft.fftn(xg, axes=(1, 3), norm="ortho").real
    return y.reshape(b, n, F_W).astype(xf.dtype)


def spatial_gating(z, norm_w, ws, bs):
    b, n, _ = z.shape
    z = jax.nn.gelu(z, approximate=False)
    u, v = jnp.split(z, 2, axis=-1)
    v32 = v.astype(jnp.float32).reshape(b, n, C_GROUPS, HEAD_DIM)
    v32 = (v32 - v32.mean(-1, keepdims=True)) * lax.rsqrt(v32.var(-1, keepdims=True) + EPS)
    vn = (v32.reshape(b, n, C_W) * norm_w.astype(jnp.float32)).astype(z.dtype)
    vc = vn.reshape(b, n // CHUNK, CHUNK, C_GROUPS, HEAD_DIM)
    sp = jnp.einsum('gij,bcjgd->bcigd', ws, vc) + bs.T[:, :, None]
    return u * sp.reshape(b, n, C_W)


def depthwise_conv(x, w, bias):
    n = x.shape[1]
    pad = CONV_W // 2
    xp = jnp.pad(x, ((0, 0), (pad, pad), (0, 0)))
    y = bias
    for tap in range(CONV_W):
        y = y + xp[:, tap:tap + n] * w[tap]
    return y


def conv_ffn(h, w_up, conv_w, conv_b, w_down):
    a, gv = jnp.split(h @ w_up, 2, axis=-1)
    a = depthwise_conv(a, conv_w, conv_b)
    return (jax.nn.silu(a) * gv) @ w_down


def context_attention(q, k, v):
    b, l, _ = q.shape
    qh = q.reshape(b, l, NA_HEADS, HEAD_DIM)
    kh = k.reshape(b, l, NA_HEADS, HEAD_DIM)
    vh = v.reshape(b, l, NA_HEADS, HEAD_DIM)
    s = jnp.einsum('bqhd,bkhd->bhqk', qh, kh, preferred_element_type=jnp.float32) * (HEAD_DIM ** -0.5)
    p = jax.nn.softmax(s, axis=-1).astype(v.dtype)
    return jnp.einsum('bhqk,bkhd->bqhd', p, vh).reshape(b, l, NA_W)


def neighborhood_attention(q, k, v, k_ctx, v_ctx, rpb):
    b, s, _ = q.shape
    rows = s // GRID_W
    kh = min(NA_KH, rows)
    scale = HEAD_DIM ** -0.5
    qg = q.reshape(b, rows, GRID_W, NA_HEADS, HEAD_DIM)
    kg = k.reshape(b, rows, GRID_W, NA_HEADS, HEAD_DIM)
    vg = v.reshape(b, rows, GRID_W, NA_HEADS, HEAD_DIM)
    kc = k_ctx.reshape(b, -1, NA_HEADS, HEAD_DIM)
    vc = v_ctx.reshape(b, -1, NA_HEADS, HEAD_DIM)
    cols = np.arange(GRID_W)
    c_start = np.clip(cols - NA_KW // 2, 0, GRID_W - NA_KW)
    col_in = (cols[None, :] >= c_start[:, None]) & (cols[None, :] < c_start[:, None] + NA_KW)
    dc_idx = np.clip(cols[None, :] - cols[:, None] + NA_KW - 1, 0, 2 * NA_KW - 2)

    def row_block(r):
        r_start = jnp.clip(r - kh // 2, 0, rows - kh)
        k_blk = lax.dynamic_slice_in_dim(kg, r_start, kh, axis=1)
        v_blk = lax.dynamic_slice_in_dim(vg, r_start, kh, axis=1)
        q_row = lax.dynamic_index_in_dim(qg, r, axis=1, keepdims=False)
        s_win = jnp.einsum('bqhd,bkwhd->bhqkw', q_row, k_blk,
                           preferred_element_type=jnp.float32) * scale
        dr_idx = r_start + jnp.arange(kh) - r + NA_KH - 1
        bias = rpb[:, dr_idx[None, :, None], dc_idx[:, None, :]]
        s_win = jnp.where(col_in[:, None, :], s_win + bias.astype(jnp.float32), NEG_INF)
        s_ctx = jnp.einsum('bqhd,blhd->bhql', q_row, kc,
                           preferred_element_type=jnp.float32) * scale
        scores = jnp.concatenate([s_win.reshape(b, NA_HEADS, GRID_W, kh * GRID_W), s_ctx], axis=-1)
        p = jax.nn.softmax(scores, axis=-1).astype(v.dtype)
        p_win = p[..., :kh * GRID_W].reshape(b, NA_HEADS, GRID_W, kh, GRID_W)
        p_ctx = p[..., kh * GRID_W:]
        return (jnp.einsum('bhqkw,bkwhd->bqhd', p_win, v_blk)
                + jnp.einsum('bhql,blhd->bqhd', p_ctx, vc))

    out = lax.map(row_block, jnp.arange(rows))
    return jnp.moveaxis(out, 0, 1).reshape(b, s, NA_W)


def gated_merge(f, att, z, gates, norm_w, ws, bs, w_f_out, w_na_out, w_c_out, w_o):
    a_f = fourier_mix(f) @ w_f_out
    a_na = att @ w_na_out
    a_c = spatial_gating(z, norm_w, ws, bs) @ w_c_out
    g_f, g_na, g_c = jnp.split(jax.nn.sigmoid(gates), 3, axis=-1)
    return (g_f * a_f + g_na * a_na + g_c * a_c) @ w_o


def setup_inputs(seed: int = 0) -> dict:
    key = jax.random.key(seed)
    ks = jax.random.split(key, 24)
    f32 = jnp.float32
    nrm = lambda k, shape, s: jax.random.normal(k, shape, f32) * s
    d = D_MODEL
    return {
        "x": nrm(ks[0], (BATCH, SEQ, d), 1.0),
        "c": nrm(ks[1], (BATCH, d), 1.0),
        "ctx": nrm(ks[2], (BATCH, CTX_LEN, d), 1.0),
        "c_ctx": nrm(ks[3], (d,), 1.0),
        "ada_w": nrm(ks[4], (DEPTH, d, 6 * d), 0.5 * d ** -0.5),
        "ada_b": nrm(ks[5], (DEPTH, 6 * d), 0.01),
        "norm1_w": 1.0 + nrm(ks[6], (DEPTH, d), 0.02),
        "norm2_w": 1.0 + nrm(ks[7], (DEPTH, d), 0.02),
        "w_in": nrm(ks[8], (DEPTH, d, IN_W), d ** -0.5),
        "na_rpb": nrm(ks[9], (DEPTH, NA_HEADS, 2 * NA_KH - 1, 2 * NA_KW - 1), 0.1),
        "gmlp_norm_w": 1.0 + nrm(ks[10], (DEPTH, C_W), 0.02),
        "gmlp_ws": nrm(ks[11], (DEPTH, C_GROUPS, CHUNK, CHUNK), CHUNK ** -0.5),
        "gmlp_bs": 1.0 + nrm(ks[12], (DEPTH, C_GROUPS, CHUNK), 0.02),
        "w_f_out": nrm(ks[13], (DEPTH, F_W, d), F_W ** -0.5),
        "w_na_out": nrm(ks[14], (DEPTH, NA_W, d), NA_W ** -0.5),
        "w_c_out": nrm(ks[15], (DEPTH, C_W, d), C_W ** -0.5),
        "w_o": nrm(ks[16], (DEPTH, d, d), d ** -0.5),
        "ffn_up": nrm(ks[17], (DEPTH, d, 2 * D_FF), d ** -0.5),
        "ffn_conv_w": nrm(ks[18], (DEPTH, CONV_W, D_FF), CONV_W ** -0.5),
        "ffn_conv_b": nrm(ks[19], (DEPTH, D_FF), 0.01),
        "ffn_down": nrm(ks[20], (DEPTH, D_FF, d), D_FF ** -0.5),
        "final_norm_w": 1.0 + nrm(ks[21], (d,), 0.02),
    }


def reference(x, c, ctx, c_ctx, ada_w, ada_b, norm1_w, norm2_w, w_in, na_rpb, gmlp_norm_w,
              gmlp_ws, gmlp_bs, w_f_out, w_na_out, w_c_out, w_o, ffn_up, ffn_conv_w, ffn_conv_b,
              ffn_down, final_norm_w):
    xc = ctx
    silu_c = jax.nn.silu(c)
    silu_cc = jax.nn.silu(c_ctx)
    for l in range(DEPTH):
        last = l == DEPTH - 1
        mod_lat = (silu_c @ ada_w[l] + ada_b[l])[:, None, :]
        mod_ctx = silu_cc @ ada_w[l] + ada_b[l]
        sh1, sc1, g1, sh2, sc2, g2 = jnp.split(mod_lat, 6, axis=-1)
        csh1, csc1, cg1, csh2, csc2, cg2 = jnp.split(mod_ctx, 6, axis=-1)
        mix_w = (gmlp_norm_w[l], gmlp_ws[l], gmlp_bs[l], w_f_out[l], w_na_out[l], w_c_out[l], w_o[l])
        ffn_w = (ffn_up[l], ffn_conv_w[l], ffn_conv_b[l], ffn_down[l])

        hc = modulate(rms_norm(xc, norm1_w[l]), csh1, csc1)
        if last:
            k_ctx, v_ctx = jnp.split(hc @ w_in[l][:, OFF_K:OFF_C], 2, axis=-1)
        else:
            f_c, q_c, k_ctx, v_ctx, z_c, gate_c = split_proj(hc @ w_in[l])
            att_c = context_attention(q_c, k_ctx, v_ctx)
            xc = xc + cg1 * gated_merge(f_c, att_c, z_c, gate_c, *mix_w)
            hc2 = modulate(rms_norm(xc, norm2_w[l]), csh2, csc2)
            xc = xc + cg2 * conv_ffn(hc2, *ffn_w)

        h = modulate(rms_norm(x, norm1_w[l]), sh1, sc1)
        f, q, k, v, z, gate = split_proj(h @ w_in[l])
        att = neighborhood_attention(q, k, v, k_ctx, v_ctx, na_rpb[l])
        x = x + g1 * gated_merge(f, att, z, gate, *mix_w)
        h2 = modulate(rms_norm(x, norm2_w[l]), sh2, sc2)
        x = x + g2 * conv_ffn(h2, *ffn_w)
    return rms_norm(x, final_norm_w)
```

```cpp
#include <hip/hip_runtime.h>
#include <hip/hip_cooperative_groups.h>
#include <cstdio>
#include <cstdint>
namespace cg = cooperative_groups;

#define LAS __attribute__((address_space(3)))
typedef unsigned short bf16_t;
typedef short bf16x8 __attribute__((ext_vector_type(8)));
typedef float f32x4 __attribute__((ext_vector_type(4)));
typedef float f32x2 __attribute__((ext_vector_type(2)));
typedef unsigned u32x4 __attribute__((ext_vector_type(4)));
typedef unsigned u32x2 __attribute__((ext_vector_type(2)));

constexpr int DM = 2048, MLAT = 16384, MT = 17408;
constexpr int INW = 10752, DFF = 5632, UPW = 11264;
constexpr int OFF_Q = 512, OFF_K = 1536, OFF_V = 2560, OFF_C = 3584, OFF_G = 4608;
constexpr float EPS = 1e-6f;
constexpr size_t MiB = 1u << 20;
constexpr size_t WS_CTL = 0;
constexpr size_t CTL_ZERO_BYTES = 1 * MiB;
constexpr size_t WS_MODS = 4096;
constexpr size_t WS_DFTD = 1 * MiB;
constexpr size_t WS_XC = 2 * MiB;
constexpr size_t WS_WIN = 10 * MiB;
constexpr size_t WS_WBR = 52 * MiB;
constexpr size_t WS_WO = 60 * MiB;
constexpr size_t WS_WUP = 68 * MiB;
constexpr size_t WS_WDN = 112 * MiB;
constexpr size_t WS_XN = 134 * MiB;
constexpr size_t WS_BIG = 202 * MiB;
constexpr size_t WS_HMID = 576 * MiB;
constexpr size_t WS_DFT = WS_HMID;
constexpr size_t WS_PQT = WS_HMID + 64 * MiB;
constexpr size_t WS_VT = WS_HMID + 96 * MiB;
constexpr size_t WS_DFTC = WS_HMID + 128 * MiB;
constexpr size_t WS_PQTC = WS_HMID + 132 * MiB;
constexpr size_t WS_VTC = WS_HMID + 164 * MiB;
constexpr size_t WS_TMP = WS_HMID;
constexpr size_t WS_END = 763 * MiB;
constexpr int LDS_BYTES = 147456;

#define LDS_WAIT() asm volatile("s_waitcnt lgkmcnt(0)" ::: "memory")
__device__ __forceinline__ unsigned cvt_pk_bf16(float lo, float hi) { unsigned r; asm volatile("v_cvt_pk_bf16_f32 %0, %1, %2" : "=v"(r) : "v"(lo), "v"(hi)); return r; }
__device__ __forceinline__ int fresh_lane() { unsigned z; asm volatile("v_mov_b32 %0, 0" : "=v"(z)); return (int)__builtin_amdgcn_mbcnt_hi(~0u, __builtin_amdgcn_mbcnt_lo(~0u, z)); }
__device__ __forceinline__ float bf2f(unsigned short b) { return __uint_as_float((unsigned)b << 16); }
__device__ __forceinline__ float bflo(unsigned w) { return __uint_as_float(w << 16); }
__device__ __forceinline__ float bfhi(unsigned w) { return __uint_as_float(w & 0xffff0000u); }
__device__ __forceinline__ float shx(float v, int o, int lane) { return __int_as_float(__builtin_amdgcn_ds_bpermute((lane ^ o) << 2, __float_as_int(v))); }
__device__ __forceinline__ float wave_sum(float v, int lane) {
#pragma unroll
    for (int o = 1; o < 64; o <<= 1) v += shx(v, o, lane);
    return v;
}
__device__ __forceinline__ float fsigmoid(float x) { return __builtin_amdgcn_rcpf(1.0f + __builtin_amdgcn_exp2f(-1.44269504089f * x)); }
__device__ __forceinline__ float fsilu(float x) { return x * fsigmoid(x); }
__device__ __forceinline__ f32x2 gelu_pk(f32x2 v) {
    const f32x2 av = __builtin_elementwise_abs(v), d = av * 0.2316418882f + 1.0f;
    f32x2 t; t.x = __builtin_amdgcn_rcpf(d.x); t.y = __builtin_amdgcn_rcpf(d.y);
    f32x2 q = t * 0.5307027145f + (-0.7265760135f); q = q * t + 0.7107068705f; q = q * t + (-0.142248368f); q = q * t + 0.127414796f; q = q * t;
    const f32x2 s = (v * v) * (-0.72134752044f);
    f32x2 e; e.x = __builtin_amdgcn_exp2f(s.x); e.y = __builtin_amdgcn_exp2f(s.y);
    const f32x2 m = v * (q * e), r = v - m;
    f32x2 o; o.x = v.x < 0.f ? m.x : r.x; o.y = v.y < 0.f ? m.y : r.y; return o;
}

namespace pg8 {
constexpr int BM = 256, BK = 64, HALF = 128, HTB = HALF * BK * 2, STAGE_BYTES = 8 * HTB, NXCD = 8, WGM = 8;
__host__ __device__ __forceinline__ int lds_byte(int r, int c) { const int st = (r >> 4) * 2 + (c >> 5), rr = r & 15, cc = c & 31, ob = rr * 64 + cc * 2; return st * 1024 + (ob ^ (((ob >> 9) & 1) << 5)); }
__host__ __device__ __forceinline__ void stage_rc(int b, int& R, int& C) { const int st = b / 1024, sb = b % 1024, swz = sb ^ (((sb >> 9) & 1) << 5); R = (st >> 1) * 16 + swz / 64; C = (st & 1) * 32 + (swz % 64) / 2; }
__host__ __device__ __forceinline__ int perm32(int rho) { const int n = rho >> 4, i = rho & 15; return 8 * (i >> 2) + 4 * n + (i & 3); }

struct Unit { const char* A; const char* B; int nt, pm, pn, aux; };

struct StaticOrder {
    int nM, nN, nwg, G, c;
    __device__ void init(int nM_, int nN_, int G_, int c_) { nM = nM_; nN = nN_; nwg = nM * nN; G = G_; c = c_; }
    __device__ bool next(int i, int& pm, int& pn) const {
        const long L = (long)i * G + c; if (L >= nwg) return false;
        int wgid = (int)L; { const int q = nwg / NXCD, r = nwg % NXCD, xcd = wgid % NXCD, off = wgid / NXCD; wgid = (xcd < r ? xcd * (q + 1) : r * (q + 1) + (xcd - r) * q) + off; }
        const int nig = WGM * nN, gid = wgid / nig, fm = gid * WGM, gsz = (nM - fm) < WGM ? (nM - fm) : WGM;
        pm = fm + ((wgid % nig) % gsz); pn = (wgid % nig) / gsz; return true;
    }
};

template <class Epi, class Sched>
__device__ __forceinline__ void gemm_phase(LAS unsigned char* lds, const int tid, const int lda, const int ldb, const Sched& S, const Epi& E) {
    const int wid = __builtin_amdgcn_readfirstlane(tid >> 6), lane = tid & 63, wr = wid >> 2, wc = wid & 3, fr = lane & 15, fq = lane >> 4;
    unsigned voffA[2], voffB[2];
#pragma unroll
    for (int i = 0; i < 2; ++i) { int R, C; stage_rc(tid * 16 + i * 8192, R, C); const int Rb = Epi::PERM ? ((R & ~31) + perm32(R & 31)) : R;
        voffA[i] = (unsigned)(R * lda + C) * 2u; voffB[i] = (unsigned)(Rb * ldb + C) * 2u; }
    const size_t kstep = (size_t)(BK * 2);
    const size_t hstepA = (size_t)HALF * lda * 2, hstepB = (size_t)HALF * ldb * 2;
    const unsigned ldsw = (unsigned)wid * 1024u;
    const int aoff = lds_byte(wr * 64 + fr, fq * 8), boff = lds_byte(wc * 32 + fr, fq * 8);
#define PG8_SA(b, h) (((b) * 2 + (h)) * HTB)
#define PG8_SB(b, h) ((4 + (b) * 2 + (h)) * HTB)
#define PG8_STAGE(bufoff, gbase, voff) do { _Pragma("unroll") for (int _i = 0; _i < 2; ++_i) \
        __builtin_amdgcn_global_load_lds((const unsigned*)((const char*)(gbase) + (voff)[_i]), (LAS unsigned*)(lds + (bufoff) + ldsw + _i * 8192), 16, 0, 0); } while (0)
#define PG8_LDA(dst, b, h) do { _Pragma("unroll") for (int m = 0; m < 4; ++m) _Pragma("unroll") for (int k = 0; k < 2; ++k) dst[m][k] = *(const LAS bf16x8*)(lds + PG8_SA(b, h) + aoff + m * 2048 + k * 1024); } while (0)
#define PG8_LDB(dst, b, h) do { _Pragma("unroll") for (int n = 0; n < 2; ++n) _Pragma("unroll") for (int k = 0; k < 2; ++k) dst[n][k] = *(const LAS bf16x8*)(lds + PG8_SB(b, h) + boff + n * 2048 + k * 1024); } while (0)
#define PG8_MMA(ai, bj, At, Bt) do { __builtin_amdgcn_s_setprio(1); _Pragma("unroll") for (int m = 0; m < 4; ++m) _Pragma("unroll") for (int n = 0; n < 2; ++n) _Pragma("unroll") for (int k = 0; k < 2; ++k) \
        acc[ai][bj][m][n] = __builtin_amdgcn_mfma_f32_16x16x32_bf16(Bt[n][k], At[m][k], acc[ai][bj][m][n], 0, 0, 0); __builtin_amdgcn_s_setprio(0); } while (0)
#define PG8_WAIT_V(n) asm volatile("s_waitcnt vmcnt(" #n ")" ::: "memory")
#define PG8_WAIT_L(n) asm volatile("s_waitcnt lgkmcnt(" #n ")" ::: "memory")
#define PG8_BAR __builtin_amdgcn_s_barrier()
#define PG8_SCHED __builtin_amdgcn_sched_barrier(0)
    Unit cur, nxt; int ui = 0;
    if (!S.next(0, cur)) return;
    f32x4 acc[2][2][4][2];
#pragma unroll
    for (int a = 0; a < 2; ++a)
#pragma unroll
        for (int b = 0; b < 2; ++b)
#pragma unroll
            for (int m = 0; m < 4; ++m)
#pragma unroll
                for (int n = 0; n < 2; ++n) acc[a][b][m][n] = (f32x4){0.f, 0.f, 0.f, 0.f};
    bf16x8 At[4][2], B0[2][2], B1[2][2];
    const char* cA = cur.A; const char* cB = cur.B;
    {
        PG8_STAGE(PG8_SB(0, 0), cB, voffB); PG8_STAGE(PG8_SB(0, 1), cB + hstepB, voffB); PG8_STAGE(PG8_SA(0, 0), cA, voffA); PG8_STAGE(PG8_SA(0, 1), cA + hstepA, voffA);
        if (wr == 1) PG8_BAR;
        PG8_WAIT_V(2); PG8_BAR;
        PG8_STAGE(PG8_SB(1, 0), cB + kstep, voffB); PG8_STAGE(PG8_SA(1, 0), cA + kstep, voffA); PG8_STAGE(PG8_SB(1, 1), cB + hstepB + kstep, voffB);
        PG8_WAIT_V(6); PG8_BAR;
    }
    for (;;) {
        const bool has_next = S.next(ui + 1, nxt);
        const char* nA = has_next ? nxt.A : cA; const char* nB = has_next ? nxt.B : cB;
        const int nt = cur.nt;
        for (int t = 0; t < nt; t += 2) {
            const bool last = (t == nt - 2);
            const char* a1 = cA + (size_t)(t + 1) * kstep;
            const char* a2 = last ? nA : cA + (size_t)(t + 2) * kstep; const char* b2 = last ? nB : cB + (size_t)(t + 2) * kstep;
            const char* a3 = a2 + kstep; const char* b3 = b2 + kstep;
            PG8_LDB(B0, 0, 0); PG8_LDB(B1, 0, 1); PG8_SCHED; PG8_LDA(At, 0, 0); PG8_STAGE(PG8_SA(1, 1), a1 + hstepA, voffA);
            PG8_WAIT_V(8); PG8_WAIT_L(0); PG8_BAR; PG8_MMA(0, 0, At, B0); PG8_MMA(0, 1, At, B1); PG8_BAR; PG8_SCHED;
            PG8_LDA(At, 0, 1); PG8_STAGE(PG8_SB(0, 0), b2, voffB); PG8_STAGE(PG8_SB(0, 1), b2 + hstepB, voffB); PG8_STAGE(PG8_SA(0, 0), a2, voffA);
            PG8_WAIT_V(8); PG8_WAIT_L(0); PG8_BAR; PG8_MMA(1, 0, At, B0); PG8_MMA(1, 1, At, B1); PG8_BAR; PG8_SCHED;
            PG8_LDB(B0, 1, 0); PG8_LDB(B1, 1, 1); PG8_SCHED; PG8_LDA(At, 1, 0); PG8_STAGE(PG8_SA(0, 1), a2 + hstepA, voffA);
            PG8_WAIT_V(8); PG8_WAIT_L(0); PG8_BAR; PG8_MMA(0, 0, At, B0); PG8_MMA(0, 1, At, B1); PG8_BAR; PG8_SCHED;
            PG8_LDA(At, 1, 1); PG8_STAGE(PG8_SB(1, 0), b3, voffB); PG8_STAGE(PG8_SB(1, 1), b3 + hstepB, voffB); PG8_STAGE(PG8_SA(1, 0), a3, voffA);
            PG8_WAIT_V(8); PG8_WAIT_L(0); PG8_BAR; PG8_MMA(1, 0, At, B0); PG8_MMA(1, 1, At, B1); PG8_BAR; PG8_SCHED;
        }
        if (wr == 0) PG8_BAR;
        E(acc, cur, wr, wc);
        if (!has_next) break;
#pragma unroll
        for (int a = 0; a < 2; ++a)
#pragma unroll
            for (int b = 0; b < 2; ++b)
#pragma unroll
                for (int m = 0; m < 4; ++m)
#pragma unroll
                    for (int n = 0; n < 2; ++n) acc[a][b][m][n] = (f32x4){0.f, 0.f, 0.f, 0.f};
        cur = nxt; cA = nA; cB = nB; ++ui;
        if (wr == 1) PG8_BAR;
    }
    PG8_WAIT_V(0);
    PG8_BAR;
#undef PG8_SA
#undef PG8_SB
#undef PG8_STAGE
#undef PG8_LDA
#undef PG8_LDB
#undef PG8_MMA
#undef PG8_WAIT_V
#undef PG8_WAIT_L
#undef PG8_BAR
#undef PG8_SCHED
}
}
using pg8::Unit;
typedef const f32x4 (&AccRef)[2][2][4][2];

struct SchedGrid {
    pg8::StaticOrder so; const char* A; const char* B; size_t tsA, tsB; int nt, nextra, ex_pm0, ex_pn0, ex_w;
    __device__ __forceinline__ bool next(int i, Unit& u) const {
        int pm, pn;
        if (!so.next(i, pm, pn)) { const long e = (long)i * so.G + so.c - so.nwg; if (e >= nextra) return false; pm = ex_pm0 + (int)e / ex_w; pn = ex_pn0 + (int)e % ex_w; }
        u.A = A + (size_t)pm * tsA; u.B = B + (size_t)pn * tsB; u.nt = nt; u.pm = pm; u.pn = pn; u.aux = 0; return true;
    }
};
struct SchedBranch {
    pg8::StaticOrder so; const char* proj; const char* wbr;
    __device__ __forceinline__ bool next(int i, Unit& u) const {
        int pm, pn; if (!so.next(i / 3, pm, pn)) return false;
        const int br = i % 3; const int acol = br == 0 ? 0 : (br == 1 ? OFF_Q : OFF_C), koff = br == 0 ? 0 : (br == 1 ? 512 : 1536);
        u.A = proj + ((size_t)pm * 256 * INW + acol) * 2; u.B = wbr + ((size_t)pn * 256 * DM + koff) * 2; u.nt = br == 1 ? 16 : 8; u.pm = pm; u.pn = pn; u.aux = br; return true;
    }
};
struct SchedF1 {
    const char* dftd; const char* proj; int G, c, nctx;
    __device__ __forceinline__ bool next(int i, Unit& u) const {
        const int L = i * G + c; { const char* ap = dftd; asm volatile("" : "+s"(ap)); u.A = ap; } u.nt = 2; u.pm = 0;
        if (L < 256) { const int b = L >> 6, g = (L >> 4) & 3, pn = L & 15; u.B = proj + ((size_t)(b * 4096 + pn * 256) * INW + g * 128) * 2; u.pn = pn; u.aux = b * 4 + g; return true; }
        const int e = L - 256; if (e >= nctx) return false;
        const int b = e >> 2, g = e & 3; u.B = proj + ((size_t)(MLAT + b * 256) * INW + g * 128) * 2; u.pn = 0; u.aux = 16 + b * 4 + g; return true;
    }
};
struct SchedF2 {
    const char* dft; const char* pqt; const char* dftc; const char* pqtc; int G, c, nctx;
    __device__ __forceinline__ bool next(int i, Unit& u) const {
        const int L = i * G + c;
        if (L < 128) { const int b = L >> 5, pm = (L >> 1) & 15, pn = L & 1; u.A = dft + (size_t)pm * 256 * 8192 * 2; u.B = pqt + (size_t)(b * 512 + pn * 256) * 8192 * 2; u.nt = 128; u.pm = pm; u.pn = pn; u.aux = b; return true; }
        const int e = L - 128; if (e >= nctx) return false;
        const int b = e >> 1, pn = e & 1; u.A = dftc; u.B = pqtc + (size_t)(b * 512 + pn * 256) * 8192 * 2; u.nt = 8; u.pm = 0; u.pn = pn; u.aux = 4 + b; return true;
    }
};

struct EpiInProj {
    static constexpr bool PERM = true;
    bf16_t* proj; bf16_t* vt; bf16_t* vtc;
    __device__ __forceinline__ void operator()(AccRef acc, const Unit& u, int wr, int wc) const {
        const int ln_ = fresh_lane(), fr = ln_ & 15, fq = ln_ >> 4;
        const int pm = u.pm, pn = u.pn; const int row0 = pm * 256 + wr * 64 + fr, col0 = pn * 256 + wc * 32 + 8 * fq;
        if (pn >= 10 && pn < 14) {
            const int vc0 = col0 - OFF_V;
#pragma unroll
            for (int ai = 0; ai < 2; ++ai)
#pragma unroll
                for (int m = 0; m < 4; ++m) {
                    const int row = row0 + ai * 128 + m * 16; bf16_t* dst; size_t stride;
                    if (pm < 64) { const int b = pm >> 4; dst = vt + (size_t)b * 1024 * 4096 + (row - b * 4096); stride = 4096; }
                    else { const int b = pm - 64; dst = vtc + (size_t)b * 1024 * 256 + (row - MLAT - b * 256); stride = 256; }
#pragma unroll
                    for (int bj = 0; bj < 2; ++bj)
#pragma unroll
                        for (int n = 0; n < 2; ++n) { const f32x4 v = acc[ai][bj][m][n]; const unsigned w0 = cvt_pk_bf16(v[0], v[1]), w1 = cvt_pk_bf16(v[2], v[3]);
                            bf16_t* d = dst + (size_t)(vc0 + bj * 128 + n * 4) * stride;
                            d[0] = (bf16_t)(w0 & 0xffffu); d[stride] = (bf16_t)(w0 >> 16); d[2 * stride] = (bf16_t)(w1 & 0xffffu); d[3 * stride] = (bf16_t)(w1 >> 16); }
                }
            return;
        }
        const int act = pn < 14 ? 0 : (pn < 18 ? 1 : 2); const float sc = (pn >= 2 && pn < 6) ? 0.08838834764831845f : 1.0f;
#pragma unroll
        for (int ai = 0; ai < 2; ++ai)
#pragma unroll
            for (int m = 0; m < 4; ++m) { bf16_t* rowp = proj + (size_t)(row0 + ai * 128 + m * 16) * INW + col0;
#pragma unroll
                for (int bj = 0; bj < 2; ++bj) { f32x4 v0 = acc[ai][bj][m][0], v1 = acc[ai][bj][m][1];
                    if (act == 1) { f32x2 a = gelu_pk((f32x2){v0[0], v0[1]}), b = gelu_pk((f32x2){v0[2], v0[3]}), c = gelu_pk((f32x2){v1[0], v1[1]}), d = gelu_pk((f32x2){v1[2], v1[3]});
                        v0 = (f32x4){a.x, a.y, b.x, b.y}; v1 = (f32x4){c.x, c.y, d.x, d.y}; }
                    else if (act == 2) { v0 = (f32x4){fsigmoid(v0[0]), fsigmoid(v0[1]), fsigmoid(v0[2]), fsigmoid(v0[3])}; v1 = (f32x4){fsigmoid(v1[0]), fsigmoid(v1[1]), fsigmoid(v1[2]), fsigmoid(v1[3])}; }
                    else { v0 = v0 * sc; v1 = v1 * sc; }
                    u32x4 w; w.x = cvt_pk_bf16(v0[0], v0[1]); w.y = cvt_pk_bf16(v0[2], v0[3]); w.z = cvt_pk_bf16(v1[0], v1[1]); w.w = cvt_pk_bf16(v1[2], v1[3]);
                    *(u32x4*)(rowp + bj * 128) = w; } }
    }
};
struct EpiPlain {
    static constexpr bool PERM = true;
    bf16_t* out; int ld;
    __device__ __forceinline__ void operator()(AccRef acc, const Unit& u, int wr, int wc) const {
        const int ln_ = fresh_lane(), fr = ln_ & 15, fq = ln_ >> 4;
        const int row0 = u.pm * 256 + wr * 64 + fr, col0 = u.pn * 256 + wc * 32 + 8 * fq;
#pragma unroll
        for (int ai = 0; ai < 2; ++ai)
#pragma unroll
            for (int m = 0; m < 4; ++m) { bf16_t* rowp = out + (size_t)(row0 + ai * 128 + m * 16) * ld + col0;
#pragma unroll
                for (int bj = 0; bj < 2; ++bj) { const f32x4 v0 = acc[ai][bj][m][0], v1 = acc[ai][bj][m][1];
                    u32x4 w; w.x = cvt_pk_bf16(v0[0], v0[1]); w.y = cvt_pk_bf16(v0[2], v0[3]); w.z = cvt_pk_bf16(v1[0], v1[1]); w.w = cvt_pk_bf16(v1[2], v1[3]);
                    *(u32x4*)(rowp + bj * 128) = w; } }
    }
};
struct EpiF1 {
    static constexpr bool PERM = true;
    bf16_t* pqt; bf16_t* pqtc;
    __device__ __forceinline__ void operator()(AccRef acc, const Unit& u, int wr, int wc) const {
        const int ln_ = fresh_lane(), fr = ln_ & 15, fq = ln_ >> 4;
        const int aux = u.aux; const bool isc = aux >= 16; const int bg = aux & 15, b = bg >> 2, g = bg & 3;
        bf16_t* base = (isc ? pqtc : pqt) + (size_t)(b * 512 + g * 128) * 8192; const int half = isc ? 256 : 4096;
        const int n0 = u.pn * 256 + wc * 32 + 8 * fq;
#pragma unroll
        for (int ai = 0; ai < 2; ++ai)
#pragma unroll
            for (int m = 0; m < 4; ++m) { bf16_t* rowp = base + (size_t)(wr * 64 + m * 16 + fr) * 8192 + ai * half + n0;
#pragma unroll
                for (int bj = 0; bj < 2; ++bj) { const f32x4 v0 = acc[ai][bj][m][0], v1 = acc[ai][bj][m][1];
                    u32x4 w; w.x = cvt_pk_bf16(v0[0], v0[1]); w.y = cvt_pk_bf16(v0[2], v0[3]); w.z = cvt_pk_bf16(v1[0], v1[1]); w.w = cvt_pk_bf16(v1[2], v1[3]);
                    *(u32x4*)(rowp + bj * 128) = w; } }
    }
};
struct EpiF2 {
    static constexpr bool PERM = true;
    bf16_t* proj;
    __device__ __forceinline__ void operator()(AccRef acc, const Unit& u, int wr, int wc) const {
        const int ln_ = fresh_lane(), fr = ln_ & 15, fq = ln_ >> 4;
        const int aux = u.aux; const bool isc = aux >= 4; const int rowbase = isc ? MLAT + (aux - 4) * 256 : aux * 4096;
        const float sc = isc ? 0.005524271728019903f : 0.0013810679320049757f;
        const int row0 = rowbase + u.pm * 256 + wr * 64 + fr, col0 = u.pn * 256 + wc * 32 + 8 * fq;
#pragma unroll
        for (int ai = 0; ai < 2; ++ai)
#pragma unroll
            for (int m = 0; m < 4; ++m) { bf16_t* rowp = proj + (size_t)(row0 + ai * 128 + m * 16) * INW + col0;
#pragma unroll
                for (int bj = 0; bj < 2; ++bj) { const f32x4 v0 = acc[ai][bj][m][0] * sc, v1 = acc[ai][bj][m][1] * sc;
                    u32x4 w; w.x = cvt_pk_bf16(v0[0], v0[1]); w.y = cvt_pk_bf16(v0[2], v0[3]); w.z = cvt_pk_bf16(v1[0], v1[1]); w.w = cvt_pk_bf16(v1[2], v1[3]);
                    *(u32x4*)(rowp + bj * 128) = w; } }
    }
};
struct EpiBranch {
    static constexpr bool PERM = false;
    const bf16_t* proj; float* tmp; bf16_t* merged;
    __device__ __forceinline__ void operator()(AccRef acc, const Unit& u, int wr, int wc) const {
        const int ln_ = fresh_lane(), fr = ln_ & 15, fq = ln_ >> 4;
        const int br = u.aux; const int col0 = u.pn * 256 + wc * 32 + 4 * fq;
#pragma unroll
        for (int ai = 0; ai < 2; ++ai)
#pragma unroll
            for (int m = 0; m < 4; ++m) { const size_t row = (size_t)(u.pm * 256 + ai * 128 + wr * 64 + m * 16 + fr);
#pragma unroll
                for (int bj = 0; bj < 2; ++bj)
#pragma unroll
                    for (int n = 0; n < 2; ++n) { const int col = col0 + bj * 128 + n * 16;
                        const u32x2 gw = *(const u32x2*)(proj + row * INW + OFF_G + br * DM + col);
                        f32x4 v = acc[ai][bj][m][n] * (f32x4){bflo(gw.x), bfhi(gw.x), bflo(gw.y), bfhi(gw.y)};
                        float* tp = tmp + row * DM + col;
                        if (br == 0) { *(f32x4*)tp = v; }
                        else if (br == 1) { *(f32x4*)tp = *(const f32x4*)tp + v; }
                        else { v = v + *(const f32x4*)tp; u32x2 w; w.x = cvt_pk_bf16(v[0], v[1]); w.y = cvt_pk_bf16(v[2], v[3]); *(u32x2*)(merged + row * DM + col) = w; } } }
    }
};
struct EpiResid {
    static constexpr bool PERM = false;
    const float* src_lat; const float* src_ctx; float* dst_lat; float* dst_ctx; const float* gate;
    __device__ __forceinline__ void operator()(AccRef acc, const Unit& u, int wr, int wc) const {
        const int ln_ = fresh_lane(), fr = ln_ & 15, fq = ln_ >> 4;
        const int pm = u.pm; const int b = pm < 64 ? (pm >> 4) : 4; const float* g = gate + (size_t)b * 12288; const int col0 = u.pn * 256 + wc * 32 + 4 * fq;
        const float* s0 = pm < 64 ? src_lat + (size_t)pm * 256 * DM : src_ctx + (size_t)(pm - 64) * 256 * DM;
        float* d0 = pm < 64 ? dst_lat + (size_t)pm * 256 * DM : dst_ctx + (size_t)(pm - 64) * 256 * DM;
        f32x4 gv[2][2];
#pragma unroll
        for (int bj = 0; bj < 2; ++bj)
#pragma unroll
            for (int n = 0; n < 2; ++n) gv[bj][n] = *(const f32x4*)(g + col0 + bj * 128 + n * 16);
#pragma unroll
        for (int ai = 0; ai < 2; ++ai)
#pragma unroll
            for (int m = 0; m < 4; ++m) { const size_t ro = (size_t)(ai * 128 + wr * 64 + m * 16 + fr) * DM;
#pragma unroll
                for (int bj = 0; bj < 2; ++bj)
#pragma unroll
                    for (int n = 0; n < 2; ++n) { const int col = col0 + bj * 128 + n * 16;
                        *(f32x4*)(d0 + ro + col) = *(const f32x4*)(s0 + ro + col) + gv[bj][n] * acc[ai][bj][m][n]; } }
    }
};

struct Args { const float* in[22]; float* out; unsigned char* ws; int ph_lo, ph_hi; };

__device__ __forceinline__ void transpose_item(const float* W, int N, bf16_t* WT, int ldk, int koff, LAS float* scr, int item, int lane) {
    const int nblk = N / 32, kb = item / nblk, nb = item % nblk, k0 = 64 * kb, n0 = 32 * nb;
#pragma unroll 8
    for (int i = 0; i < 32; ++i) { const int kk = 2 * i + (lane >> 5); scr[kk * 33 + (lane & 31)] = W[(size_t)(k0 + kk) * N + n0 + (lane & 31)]; }
    LDS_WAIT(); asm volatile("" ::: "memory");
    const int c = lane & 7;
#pragma unroll
    for (int j = 0; j < 4; ++j) { const int n = (lane >> 3) + 8 * j; const LAS float* s = scr + (8 * c) * 33 + n;
        u32x4 o; o.x = cvt_pk_bf16(s[0 * 33], s[1 * 33]); o.y = cvt_pk_bf16(s[2 * 33], s[3 * 33]); o.z = cvt_pk_bf16(s[4 * 33], s[5 * 33]); o.w = cvt_pk_bf16(s[6 * 33], s[7 * 33]);
        *(u32x4*)(WT + (size_t)(n0 + n) * ldk + koff + k0 + 8 * c) = o; }
    LDS_WAIT(); asm volatile("" ::: "memory");
}
__device__ __forceinline__ void convert_weights(const Args& a, int l, LAS float* scr, int gw, int NGW, int lane) {
    unsigned char* ws = a.ws;
    const float* w_in = a.in[8] + (size_t)l * DM * INW; const float* w_f = a.in[13] + (size_t)l * 512 * DM; const float* w_na = a.in[14] + (size_t)l * 1024 * DM;
    const float* w_c = a.in[15] + (size_t)l * 512 * DM; const float* w_o = a.in[16] + (size_t)l * DM * DM; const float* w_up = a.in[17] + (size_t)l * DM * UPW; const float* w_dn = a.in[20] + (size_t)l * DFF * DM;
    constexpr int I_IN = 32 * 336, I_F = 8 * 64, I_NA = 16 * 64, I_C = 8 * 64, I_O = 32 * 64, I_UP = 32 * 352, I_DN = 88 * 64;
    constexpr int NITEMS = I_IN + I_F + I_NA + I_C + I_O + I_UP + I_DN;
    for (int it = gw; it < NITEMS; it += NGW) {
        int r = it;
        if (r < I_IN) { transpose_item(w_in, INW, (bf16_t*)(ws + WS_WIN), DM, 0, scr, r, lane); continue; } r -= I_IN;
        if (r < I_F) { transpose_item(w_f, DM, (bf16_t*)(ws + WS_WBR), DM, 0, scr, r, lane); continue; } r -= I_F;
        if (r < I_NA) { transpose_item(w_na, DM, (bf16_t*)(ws + WS_WBR), DM, 512, scr, r, lane); continue; } r -= I_NA;
        if (r < I_C) { transpose_item(w_c, DM, (bf16_t*)(ws + WS_WBR), DM, 1536, scr, r, lane); continue; } r -= I_C;
        if (r < I_O) { transpose_item(w_o, DM, (bf16_t*)(ws + WS_WO), DM, 0, scr, r, lane); continue; } r -= I_O;
        if (r < I_UP) { transpose_item(w_up, UPW, (bf16_t*)(ws + WS_WUP), DM, 0, scr, r, lane); continue; } r -= I_UP;
        transpose_item(w_dn, DM, (bf16_t*)(ws + WS_WDN), DFF, 0, scr, r, lane);
    }
}
__device__ __forceinline__ void dft_tables(unsigned char* ws, const LAS float* lut, int gw, int NGW, int lane) {
    bf16_t* dft = (bf16_t*)(ws + WS_DFT); bf16_t* dftc = (bf16_t*)(ws + WS_DFTC);
    for (int it = gw; it < 4096 + 256; it += NGW) {
        if (it < 4096) { const int k = it;
            for (int i = 0; i < 16; ++i) { const int n0 = (i * 64 + lane) * 8; const int nn = n0 & 4095, sh = n0 >= 4096 ? 1024 : 0; float v[8];
#pragma unroll
                for (int e = 0; e < 8; ++e) v[e] = lut[((k * (nn + e)) + sh) & 4095];
                u32x4 w; w.x = cvt_pk_bf16(v[0], v[1]); w.y = cvt_pk_bf16(v[2], v[3]); w.z = cvt_pk_bf16(v[4], v[5]); w.w = cvt_pk_bf16(v[6], v[7]);
                *(u32x4*)(dft + (size_t)k * 8192 + n0) = w; }
        } else { const int k = it - 4096; const int n0 = lane * 8; const int nn = n0 & 255, sh = n0 >= 256 ? 1024 : 0; float v[8];
#pragma unroll
            for (int e = 0; e < 8; ++e) v[e] = lut[((((k * (nn + e)) & 255) * 16) + sh) & 4095];
            u32x4 w; w.x = cvt_pk_bf16(v[0], v[1]); w.y = cvt_pk_bf16(v[2], v[3]); w.z = cvt_pk_bf16(v[4], v[5]); w.w = cvt_pk_bf16(v[6], v[7]);
            *(u32x4*)(dftc + (size_t)k * 8192 + n0) = w; }
    }
}
__device__ __forceinline__ void mods_items(const Args& a, int gw, int NGW, int lane) {
    float* mods = (float*)(a.ws + WS_MODS);
    for (int it = gw; it < 768; it += NGW) {
        const int l = it / 384, rem = it % 384, cch = rem >> 3, kp = rem & 7; const int col = cch * 256 + lane * 4, k0 = kp * 256;
        float sv[5][4];
#pragma unroll
        for (int r = 0; r < 5; ++r)
#pragma unroll
            for (int i = 0; i < 4; ++i) { const int k = k0 + lane + 64 * i; const float cv = r < 4 ? a.in[1][r * DM + k] : a.in[3][k]; sv[r][i] = fsilu(cv); }
        f32x4 acc[5];
#pragma unroll
        for (int r = 0; r < 5; ++r) acc[r] = (f32x4){0.f, 0.f, 0.f, 0.f};
        const float* wbase = a.in[4] + ((size_t)l * DM + k0) * 12288 + col;
#pragma unroll
        for (int i = 0; i < 4; ++i) {
#pragma unroll 8
            for (int ll = 0; ll < 64; ++ll) { const f32x4 w = *(const f32x4*)(wbase + (size_t)(i * 64 + ll) * 12288);
#pragma unroll
                for (int r = 0; r < 5; ++r) { const float s = __int_as_float(__builtin_amdgcn_readlane(__float_as_int(sv[r][i]), ll)); acc[r] += w * s; } }
        }
        if (kp == 0) { const f32x4 bv = *(const f32x4*)(a.in[5] + (size_t)l * 12288 + col);
#pragma unroll
            for (int r = 0; r < 5; ++r) acc[r] += bv; }
#pragma unroll
        for (int r = 0; r < 5; ++r) { float* d = mods + ((size_t)l * 5 + r) * 12288 + col; atomicAdd(d, acc[r][0]); atomicAdd(d + 1, acc[r][1]); atomicAdd(d + 2, acc[r][2]); atomicAdd(d + 3, acc[r][3]); }
    }
}
__device__ __forceinline__ void norm_rows(const float* xlat, const float* xctx, const float* w, const float* mods_l, int shoff, int scoff, bf16_t* XN, int nrows, int gw, int NGW, int lane) {
    for (int row = gw; row < nrows; row += NGW) {
        const float* xr = row < MLAT ? xlat + (size_t)row * DM : xctx + (size_t)(row - MLAT) * DM; const int b = row < MLAT ? (row >> 12) : 4;
        const float* sh = mods_l + (size_t)b * 12288 + shoff; const float* sc = mods_l + (size_t)b * 12288 + scoff;
        f32x4 v[8]; float ss = 0.f;
#pragma unroll
        for (int j = 0; j < 8; ++j) { v[j] = *(const f32x4*)(xr + 4 * lane + 256 * j); ss += (v[j][0] * v[j][0] + v[j][1] * v[j][1]) + (v[j][2] * v[j][2] + v[j][3] * v[j][3]); }
        const float rstd = rsqrtf(wave_sum(ss, lane) * (1.0f / DM) + EPS);
#pragma unroll
        for (int j = 0; j < 8; ++j) { const int col = 4 * lane + 256 * j; const f32x4 wv = *(const f32x4*)(w + col), scv = *(const f32x4*)(sc + col), shv = *(const f32x4*)(sh + col);
            const f32x4 o = (v[j] * rstd * wv) * (scv + 1.0f) + shv; u32x2 pk; pk.x = cvt_pk_bf16(o[0], o[1]); pk.y = cvt_pk_bf16(o[2], o[3]);
            *(u32x2*)(XN + (size_t)row * DM + col) = pk; }
    }
}
__device__ __forceinline__ void final_norm(float* x, const float* w, int gw, int NGW, int lane) {
    for (int row = gw; row < MLAT; row += NGW) { float* xr = x + (size_t)row * DM; f32x4 v[8]; float ss = 0.f;
#pragma unroll
        for (int j = 0; j < 8; ++j) { v[j] = *(const f32x4*)(xr + 4 * lane + 256 * j); ss += (v[j][0] * v[j][0] + v[j][1] * v[j][1]) + (v[j][2] * v[j][2] + v[j][3] * v[j][3]); }
        const float rstd = rsqrtf(wave_sum(ss, lane) * (1.0f / DM) + EPS);
#pragma unroll
        for (int j = 0; j < 8; ++j) { const int col = 4 * lane + 256 * j; *(f32x4*)(xr + col) = v[j] * rstd * *(const f32x4*)(w + col); } }
}
__device__ __forceinline__ void sgu_unit(bf16_t* proj, int row0, int g, const float* nw, const float* wsg, const float* bsg, LAS unsigned char* lds, int tid) {
    LAS bf16_t* vnt = (LAS bf16_t*)lds;
    const int lane = tid & 63, wid = tid >> 6, fr = lane & 15, fq = lane >> 4;
    {
        const int j = tid >> 2, q = tid & 3; const bf16_t* src = proj + (size_t)(row0 + j) * INW + OFF_C + 512 + g * 128 + q * 32;
        float v[32];
#pragma unroll
        for (int i = 0; i < 4; ++i) { const u32x4 w = *(const u32x4*)(src + 8 * i);
            v[8 * i + 0] = bflo(w.x); v[8 * i + 1] = bfhi(w.x); v[8 * i + 2] = bflo(w.y); v[8 * i + 3] = bfhi(w.y); v[8 * i + 4] = bflo(w.z); v[8 * i + 5] = bfhi(w.z); v[8 * i + 6] = bflo(w.w); v[8 * i + 7] = bfhi(w.w); }
        float s = 0.f;
#pragma unroll
        for (int e = 0; e < 32; ++e) s += v[e];
        s += shx(s, 1, lane); s += shx(s, 2, lane); const float mean = s * (1.0f / 128.0f);
        float qv = 0.f;
#pragma unroll
        for (int e = 0; e < 32; ++e) { v[e] -= mean; qv += v[e] * v[e]; }
        qv += shx(qv, 1, lane); qv += shx(qv, 2, lane); const float rstd = rsqrtf(qv * (1.0f / 128.0f) + EPS);
#pragma unroll
        for (int e = 0; e < 32; e += 2) { const int d = q * 32 + e; const unsigned w = cvt_pk_bf16(v[e] * rstd * nw[g * 128 + d], v[e + 1] * rstd * nw[g * 128 + d + 1]);
            vnt[d * 136 + j] = (bf16_t)(w & 0xffffu); vnt[(d + 1) * 136 + j] = (bf16_t)(w >> 16); }
    }
    __syncthreads();
    {
        const int i = 16 * wid + fr;
        bf16x8 wf[4];
#pragma unroll
        for (int ks = 0; ks < 4; ++ks) { const float* wp = wsg + (size_t)i * 128 + 32 * ks + 8 * fq; const f32x4 a = *(const f32x4*)wp, b = *(const f32x4*)(wp + 4);
            u32x4 w; w.x = cvt_pk_bf16(a[0], a[1]); w.y = cvt_pk_bf16(a[2], a[3]); w.z = cvt_pk_bf16(b[0], b[1]); w.w = cvt_pk_bf16(b[2], b[3]); wf[ks] = __builtin_bit_cast(bf16x8, w); }
        const float bias = bsg[i];
        bf16_t* up = proj + (size_t)(row0 + i) * INW + OFF_C + g * 128 + 4 * fq;
#pragma unroll
        for (int nt = 0; nt < 8; ++nt) { f32x4 acc = (f32x4){0.f, 0.f, 0.f, 0.f};
#pragma unroll
            for (int ks = 0; ks < 4; ++ks) { const bf16x8 af = *(const LAS bf16x8*)((const LAS unsigned char*)vnt + (16 * nt + fr) * 272 + (32 * ks + 8 * fq) * 2);
                acc = __builtin_amdgcn_mfma_f32_16x16x32_bf16(af, wf[ks], acc, 0, 0, 0); }
            const u32x2 uw = *(const u32x2*)(up + 16 * nt); u32x2 o;
            o.x = cvt_pk_bf16(bflo(uw.x) * (acc[0] + bias), bfhi(uw.x) * (acc[1] + bias)); o.y = cvt_pk_bf16(bflo(uw.y) * (acc[2] + bias), bfhi(uw.y) * (acc[3] + bias));
            *(u32x2*)(up + 16 * nt) = o; }
    }
    __syncthreads();
}
template <bool LAT>
__device__ __forceinline__ void attn_task(bf16_t* proj, const bf16_t* vt, const bf16_t* vtc, const float* rpb, int t, int lane) {
    constexpr int NCH = LAT ? 16 : 8, WCH = LAT ? 8 : 0;
    const int fr = lane & 15, fq = lane >> 4;
    int b, h, r = 0, cgp = 0, qrow;
    if (LAT) { cgp = t & 3; r = (t >> 2) & 63; h = (t >> 8) & 7; b = t >> 11; qrow = b * 4096 + r * 64 + cgp * 16 + fr; }
    else { const int qg = t & 15; h = (t >> 4) & 7; b = t >> 7; qrow = MLAT + b * 256 + qg * 16 + fr; }
    bf16_t* qp = proj + (size_t)qrow * INW + OFF_Q + h * 128;
    bf16x8 qf[4];
#pragma unroll
    for (int ks = 0; ks < 4; ++ks) qf[ks] = *(const bf16x8*)(qp + ks * 32 + fq * 8);
    const int rs = r < 4 ? 0 : (r > 60 ? 56 : r - 4);
    const int cb = cgp == 0 ? 0 : (cgp == 1 ? 8 : (cgp == 2 ? 24 : 32));
    float S[NCH][8];
    const int kap = 8 * (fr >> 2) + (fr & 3);
#pragma unroll
    for (int c = 0; c < NCH; ++c) {
#pragma unroll
        for (int tt = 0; tt < 2; ++tt) {
            const int krow = (c < WCH) ? (b * 4096 + (rs + c) * 64 + cb + kap + 4 * tt) : (MLAT + b * 256 + 32 * (c - WCH) + kap + 4 * tt);
            const bf16_t* kp = proj + (size_t)krow * INW + OFF_K + h * 128 + fq * 8;
            f32x4 acc = (f32x4){0.f, 0.f, 0.f, 0.f};
#pragma unroll
            for (int ks = 0; ks < 4; ++ks) { const bf16x8 kf = *(const bf16x8*)(kp + ks * 32); acc = __builtin_amdgcn_mfma_f32_16x16x32_bf16(kf, qf[ks], acc, 0, 0, 0); }
            S[c][4 * tt + 0] = acc[0]; S[c][4 * tt + 1] = acc[1]; S[c][4 * tt + 2] = acc[2]; S[c][4 * tt + 3] = acc[3];
        }
    }
    if (LAT) {
        const int qc = cgp * 16 + fr; const int cs = qc < 8 ? 0 : (qc > 56 ? 48 : qc - 8);
#pragma unroll
        for (int c = 0; c < WCH; ++c) { const int dr = rs + c - r + 7; const float* rp = rpb + (h * 15 + dr) * 31;
#pragma unroll
            for (int jj = 0; jj < 8; ++jj) { const int kc = cb + 8 * fq + jj; const bool valid = (kc >= cs) && (kc < cs + 16); int dc = kc - qc + 15; dc = dc < 0 ? 0 : (dc > 30 ? 30 : dc);
                const float bias = rp[dc]; S[c][jj] = valid ? S[c][jj] + bias : -1e30f; } }
    }
    float mx = -3.0e38f;
#pragma unroll
    for (int c = 0; c < NCH; ++c)
#pragma unroll
        for (int jj = 0; jj < 8; ++jj) mx = fmaxf(mx, S[c][jj]);
    mx = fmaxf(mx, shx(mx, 16, lane)); mx = fmaxf(mx, shx(mx, 32, lane));
    float sum = 0.f; bf16x8 pf[NCH];
#pragma unroll
    for (int c = 0; c < NCH; ++c) { float p[8];
#pragma unroll
        for (int jj = 0; jj < 8; ++jj) { p[jj] = __builtin_amdgcn_exp2f((S[c][jj] - mx) * 1.44269504089f); sum += p[jj]; }
        u32x4 w; w.x = cvt_pk_bf16(p[0], p[1]); w.y = cvt_pk_bf16(p[2], p[3]); w.z = cvt_pk_bf16(p[4], p[5]); w.w = cvt_pk_bf16(p[6], p[7]); pf[c] = __builtin_bit_cast(bf16x8, w); }
    sum += shx(sum, 16, lane); sum += shx(sum, 32, lane);
    const float inv = 1.0f / sum;
    const bf16_t* vlat = vt + ((size_t)(b * 1024 + h * 128 + fr)) * 4096 + cb + 8 * fq;
    const bf16_t* vctx = vtc + ((size_t)(b * 1024 + h * 128 + fr)) * 256 + 8 * fq;
#pragma unroll
    for (int dt = 0; dt < 8; ++dt) { f32x4 acc = (f32x4){0.f, 0.f, 0.f, 0.f};
#pragma unroll
        for (int c = 0; c < NCH; ++c) { const bf16_t* vp = (c < WCH) ? (vlat + (size_t)dt * 16 * 4096 + (rs + c) * 64) : (vctx + (size_t)dt * 16 * 256 + 32 * (c - WCH));
            const bf16x8 vf = *(const bf16x8*)vp; acc = __builtin_amdgcn_mfma_f32_16x16x32_bf16(vf, pf[c], acc, 0, 0, 0); }
        u32x2 o; o.x = cvt_pk_bf16(acc[0] * inv, acc[1] * inv); o.y = cvt_pk_bf16(acc[2] * inv, acc[3] * inv);
        *(u32x2*)(qp + dt * 16 + 4 * fq) = o; }
}
__device__ __forceinline__ void conv_items(const bf16_t* up, bf16_t* hmid, const float* cw, const float* cbias, int nrows, int gtid, int NT) {
    const int nitems = (nrows / 16) * 704;
    for (int it = gtid; it < nitems; it += NT) {
        const int cg8 = it % 704, rb = it / 704; const int row0 = rb * 16, ch = cg8 * 8;
        const int seqlen = row0 < MLAT ? 4096 : 256; const int ts = (row0 < MLAT ? row0 : row0 - MLAT) & (seqlen - 1);
        float w0[8], w1[8], w2[8], bb[8];
#pragma unroll
        for (int e = 0; e < 8; ++e) { w0[e] = cw[ch + e]; w1[e] = cw[DFF + ch + e]; w2[e] = cw[2 * DFF + ch + e]; bb[e] = cbias[ch + e]; }
        const bf16_t* ap = up + (size_t)row0 * UPW + ch; const bf16_t* gp = ap + DFF; bf16_t* hp = hmid + (size_t)row0 * DFF + ch;
        u32x4 prev = (u32x4){0u, 0u, 0u, 0u}; if (ts > 0) prev = *(const u32x4*)(ap - UPW);
        u32x4 cur = *(const u32x4*)ap;
        for (int i = 0; i < 16; ++i) {
            u32x4 nxt = (u32x4){0u, 0u, 0u, 0u}; if (i < 15 || ts + 16 < seqlen) nxt = *(const u32x4*)(ap + (size_t)(i + 1) * UPW);
            const u32x4 gw = *(const u32x4*)(gp + (size_t)i * UPW);
            float o[8];
#pragma unroll
            for (int e = 0; e < 4; ++e) {
                const float y0 = bb[2 * e] + w0[2 * e] * bflo(prev[e]) + w1[2 * e] * bflo(cur[e]) + w2[2 * e] * bflo(nxt[e]);
                const float y1 = bb[2 * e + 1] + w0[2 * e + 1] * bfhi(prev[e]) + w1[2 * e + 1] * bfhi(cur[e]) + w2[2 * e + 1] * bfhi(nxt[e]);
                o[2 * e] = fsilu(y0) * bflo(gw[e]); o[2 * e + 1] = fsilu(y1) * bfhi(gw[e]); }
            u32x4 w; w.x = cvt_pk_bf16(o[0], o[1]); w.y = cvt_pk_bf16(o[2], o[3]); w.z = cvt_pk_bf16(o[4], o[5]); w.w = cvt_pk_bf16(o[6], o[7]);
            *(u32x4*)(hp + (size_t)i * DFF) = w;
            prev = cur; cur = nxt;
        }
    }
}

constexpr int NPHASE = 22;
__global__ void __launch_bounds__(512, 2) mega(Args a) {
    extern __shared__ __attribute__((aligned(16))) unsigned char lds_raw[];
    LAS unsigned char* lds = (LAS unsigned char*)lds_raw;
    cg::grid_group grid = cg::this_grid();
    const int G = gridDim.x, cu = blockIdx.x, NGW = G * 8, wave = __builtin_amdgcn_readfirstlane((int)threadIdx.x >> 6);
    unsigned char* ws = a.ws;
    unsigned* ctl = (unsigned*)(ws + WS_CTL);
    bf16_t* PROJ = (bf16_t*)(ws + WS_BIG); bf16_t* XN = (bf16_t*)(ws + WS_XN); bf16_t* HMID = (bf16_t*)(ws + WS_HMID);
    float* XC = (float*)(ws + WS_XC); float* mods = (float*)(ws + WS_MODS);
    bf16_t* VT = (bf16_t*)(ws + WS_VT); bf16_t* VTC = (bf16_t*)(ws + WS_VTC);

    for (int p = a.ph_lo; p < a.ph_hi; ++p) {
        if (p > a.ph_lo) grid.sync();
        const int lane = fresh_lane();
        const int tid = wave * 64 + lane, gw = cu * 8 + wave;
        if (p == 0) {
            LAS float* lut = (LAS float*)(lds + 72 * 1024);
            for (int i = tid; i < 4096; i += 512) lut[i] = cospif((float)i * (1.0f / 2048.0f));
            __syncthreads();
            if (cu == 0) { bf16_t* dd = (bf16_t*)(ws + WS_DFTD);
                for (int e = tid; e < 256 * 128; e += 512) { const int row = e >> 7, d = e & 127, j = row & 127; const float ang = (float)((j * d) & 127) * (1.0f / 64.0f);
                    const float v = row < 128 ? cospif(ang) : sinpif(ang); dd[e] = (bf16_t)(cvt_pk_bf16(v, 0.f) & 0xffffu); } }
            mods_items(a, gw, NGW, lane);
            convert_weights(a, 0, (LAS float*)(lds + wave * 8704), gw, NGW, lane);
            dft_tables(ws, lut, gw, NGW, lane);
            continue;
        }
        if (p == NPHASE - 1) { final_norm(a.out, a.in[21], gw, NGW, lane); continue; }
        const int l = (p - 1) / 10, s = (p - 1) % 10;
        const float* mods_l = mods + (size_t)l * 5 * 12288;
        const float* xlat = (l == 0) ? a.in[0] : a.out; const float* xctx = (l == 0) ? a.in[2] : XC;
        const int nMall = (l == 0) ? 68 : 64;
        switch (s) {
        case 0: {
            if (l == 1) { LAS float* lut = (LAS float*)(lds + 72 * 1024);
                for (int i = tid; i < 4096; i += 512) lut[i] = cospif((float)i * (1.0f / 2048.0f));
                __syncthreads();
                convert_weights(a, 1, (LAS float*)(lds + wave * 8704), gw, NGW, lane);
                dft_tables(ws, lut, gw, NGW, lane); }
            norm_rows(xlat, xctx, a.in[6] + (size_t)l * DM, mods_l, 0, 2048, XN, MT, gw, NGW, lane);
        } break;
        case 1: {
            SchedGrid S; S.so.init(nMall, 42, G, cu); S.A = (const char*)XN; S.B = (const char*)(ws + WS_WIN); S.tsA = (size_t)256 * DM * 2; S.tsB = (size_t)256 * DM * 2; S.nt = 32;
            S.nextra = (l == 0) ? 0 : 32; S.ex_pm0 = 64; S.ex_pn0 = 6; S.ex_w = 8;
            EpiInProj E{PROJ, VT, VTC};
            pg8::gemm_phase<EpiInProj, SchedGrid>(lds, tid, DM, DM, S, E);
        } break;
        case 2: {
            SchedF1 S{(const char*)(ws + WS_DFTD), (const char*)PROJ, G, cu, (l == 0) ? 16 : 0};
            EpiF1 E{(bf16_t*)(ws + WS_PQT), (bf16_t*)(ws + WS_PQTC)};
            pg8::gemm_phase<EpiF1, SchedF1>(lds, tid, 128, INW, S, E);
            __syncthreads();
            const int tid2 = wave * 64 + fresh_lane();
            const int nun = 512 + ((l == 0) ? 32 : 0);
            for (int u = cu; u < nun; u += G) { int row0, g;
                if (u < 512) { const int b = u >> 7, ch = (u >> 2) & 31; g = u & 3; row0 = b * 4096 + ch * 128; }
                else { const int e = u - 512; const int b = e >> 3, ch = (e >> 2) & 1; g = e & 3; row0 = MLAT + b * 256 + ch * 128; }
                sgu_unit(PROJ, row0, g, a.in[10] + (size_t)l * 512, a.in[11] + ((size_t)l * 4 + g) * 128 * 128, a.in[12] + ((size_t)l * 4 + g) * 128, lds, tid2); }
        } break;
        case 3: {
            SchedF2 S{(const char*)(ws + WS_DFT), (const char*)(ws + WS_PQT), (const char*)(ws + WS_DFTC), (const char*)(ws + WS_PQTC), G, cu, (l == 0) ? 8 : 0};
            EpiF2 E{PROJ};
            pg8::gemm_phase<EpiF2, SchedF2>(lds, tid, 8192, 8192, S, E);
            const int lane2 = fresh_lane();
            const int ntask = 8192 + ((l == 0) ? 512 : 0); unsigned* cnt = ctl + 64 * l; const float* rpb = a.in[9] + (size_t)l * 8 * 15 * 31;
            for (;;) { int t = 0; if (lane2 == 0) t = (int)atomicAdd(cnt, 1u); t = __builtin_amdgcn_readfirstlane(t); if (t >= ntask) break;
                if (t < 8192) attn_task<true>(PROJ, VT, VTC, rpb, t, lane2); else attn_task<false>(PROJ, VT, VTC, rpb, t - 8192, lane2); }
        } break;
        case 4: {
            SchedBranch S; S.so.init(nMall, 8, G, cu); S.proj = (const char*)PROJ; S.wbr = (const char*)(ws + WS_WBR);
            EpiBranch E{PROJ, (float*)(ws + WS_TMP), XN};
            pg8::gemm_phase<EpiBranch, SchedBranch>(lds, tid, INW, DM, S, E);
        } break;
        case 5: {
            SchedGrid S; S.so.init(nMall, 8, G, cu); S.A = (const char*)XN; S.B = (const char*)(ws + WS_WO); S.tsA = (size_t)256 * DM * 2; S.tsB = (size_t)256 * DM * 2; S.nt = 32; S.nextra = 0; S.ex_pm0 = 0; S.ex_pn0 = 0; S.ex_w = 1;
            EpiResid E{xlat, xctx, a.out, XC, mods_l + 4096};
            pg8::gemm_phase<EpiResid, SchedGrid>(lds, tid, DM, DM, S, E);
        } break;
        case 6: {
            norm_rows(a.out, XC, a.in[7] + (size_t)l * DM, mods_l, 6144, 8192, XN, nMall * 256, gw, NGW, lane);
        } break;
        case 7: {
            SchedGrid S; S.so.init(nMall, 44, G, cu); S.A = (const char*)XN; S.B = (const char*)(ws + WS_WUP); S.tsA = (size_t)256 * DM * 2; S.tsB = (size_t)256 * DM * 2; S.nt = 32; S.nextra = 0; S.ex_pm0 = 0; S.ex_pn0 = 0; S.ex_w = 1;
            EpiPlain E{PROJ, UPW};
            pg8::gemm_phase<EpiPlain, SchedGrid>(lds, tid, DM, DM, S, E);
        } break;
        case 8: {
            conv_items(PROJ, HMID, a.in[18] + (size_t)l * 3 * DFF, a.in[19] + (size_t)l * DFF, nMall * 256, cu * 512 + tid, G * 512);
        } break;
        case 9: {
            SchedGrid S; S.so.init(nMall, 8, G, cu); S.A = (const char*)HMID; S.B = (const char*)(ws + WS_WDN); S.tsA = (size_t)256 * DFF * 2; S.tsB = (size_t)256 * DFF * 2; S.nt = 88; S.nextra = 0; S.ex_pm0 = 0; S.ex_pn0 = 0; S.ex_w = 1;
            EpiResid E{a.out, XC, a.out, XC, mods_l + 10240};
            pg8::gemm_phase<EpiResid, SchedGrid>(lds, tid, DFF, DFF, S, E);
        } break;
        }
    }
}

extern "C" void kernel_launch(void* const* d_in, const int* in_sizes, int n_in, void* d_out, int out_size, void* d_ws, size_t ws_size, hipStream_t stream) {
    static int grid = 0;
    if (grid == 0) {
        if (n_in != 22 || ws_size < WS_END) { fprintf(stderr, "kernel_launch: unexpected n_in %d / ws_size %zu (need %zu)\n", n_in, ws_size, (size_t)WS_END); grid = -1; return; }
        int dev = 0, cus = 0, per_cu = 0;
        hipGetDevice(&dev); hipDeviceGetAttribute(&cus, hipDeviceAttributeMultiprocessorCount, dev);
        if (hipFuncSetAttribute((const void*)mega, hipFuncAttributeMaxDynamicSharedMemorySize, LDS_BYTES) != hipSuccess) { fprintf(stderr, "kernel_launch: hipFuncSetAttribute failed\n"); grid = -1; return; }
        hipOccupancyMaxActiveBlocksPerMultiprocessor(&per_cu, (const void*)mega, 512, LDS_BYTES);
        (void)hipGetLastError();
        if (per_cu < 1) fprintf(stderr, "kernel_launch: occupancy query says %d blocks/CU\n", per_cu);
        grid = cus > 0 ? cus : 256;
    }
    if (grid < 0) return;
    hipMemsetAsync((char*)d_ws + WS_CTL, 0, CTL_ZERO_BYTES, stream);
    Args a{};
    for (int i = 0; i < 22; ++i) a.in[i] = (const float*)d_in[i];
    a.out = (float*)d_out; a.ws = (unsigned char*)d_ws; a.ph_lo = 0; a.ph_hi = NPHASE;
    void* args[] = {&a};
    hipError_t e = hipLaunchCooperativeKernel((const void*)mega, dim3(grid), dim3(512), args, LDS_BYTES, stream);
    if (e != hipSuccess) fprintf(stderr, "kernel_launch: cooperative launch failed: %s (grid %d)\n", hipGetErrorString(e), grid);
}
```

```cpp
#include <hip/hip_runtime.h>
#include <hip/hip_cooperative_groups.h>
#include <cstdio>
#include <cstdint>
namespace cg = cooperative_groups;

#define LAS __attribute__((address_space(3)))
typedef unsigned short bf16_t;
typedef short bf16x8 __attribute__((ext_vector_type(8)));
typedef float f32x4 __attribute__((ext_vector_type(4)));
typedef float f32x2 __attribute__((ext_vector_type(2)));
typedef unsigned u32x4 __attribute__((ext_vector_type(4)));
typedef unsigned u32x2 __attribute__((ext_vector_type(2)));

constexpr int DM = 2048, MLAT = 16384, MT = 17408;
constexpr int INW = 10752, DFF = 5632, UPW = 11264;
constexpr int OFF_Q = 512, OFF_K = 1536, OFF_V = 2560, OFF_C = 3584, OFF_G = 4608;
constexpr float EPS = 1e-6f;
constexpr size_t MiB = 1u << 20;
constexpr size_t WS_CTL = 0;
constexpr size_t CTL_ZERO_BYTES = 1 * MiB;
constexpr size_t WS_MODS = 4096;
constexpr size_t WS_BAR = 512 * 1024;
constexpr size_t WS_DFTD = 1 * MiB;
constexpr size_t WS_XC = 2 * MiB;
constexpr size_t WS_WIN = 10 * MiB;
constexpr size_t WS_WBR = 52 * MiB;
constexpr size_t WS_WO = 60 * MiB;
constexpr size_t WS_WUP = 68 * MiB;
constexpr size_t WS_WDN = 112 * MiB;
constexpr size_t WS_XN = 134 * MiB;
constexpr size_t WS_BIG = 202 * MiB;
constexpr size_t WS_HMID = 576 * MiB;
constexpr size_t WS_DFT = WS_HMID;
constexpr size_t WS_PQT = WS_HMID + 64 * MiB;
constexpr size_t WS_VT = WS_HMID + 96 * MiB;
constexpr size_t WS_DFTC = WS_HMID + 128 * MiB;
constexpr size_t WS_PQTC = WS_HMID + 132 * MiB;
constexpr size_t WS_VTC = WS_HMID + 164 * MiB;
constexpr size_t WS_TMP = WS_HMID;
constexpr size_t WS_END = 763 * MiB;
constexpr int LDS_BYTES = 147456;

#define LDS_WAIT() asm volatile("s_waitcnt lgkmcnt(0)" ::: "memory")
__device__ __forceinline__ unsigned cvt_pk_bf16(float lo, float hi) { unsigned r; asm volatile("v_cvt_pk_bf16_f32 %0, %1, %2" : "=v"(r) : "v"(lo), "v"(hi)); return r; }
__device__ __forceinline__ int fresh_lane() { unsigned z; asm volatile("v_mov_b32 %0, 0" : "=v"(z)); return (int)__builtin_amdgcn_mbcnt_hi(~0u, __builtin_amdgcn_mbcnt_lo(~0u, z)); }
__device__ __forceinline__ float bf2f(unsigned short b) { return __uint_as_float((unsigned)b << 16); }
__device__ __forceinline__ float bflo(unsigned w) { return __uint_as_float(w << 16); }
__device__ __forceinline__ float bfhi(unsigned w) { return __uint_as_float(w & 0xffff0000u); }
__device__ __forceinline__ float shx(float v, int o, int lane) { return __int_as_float(__builtin_amdgcn_ds_bpermute((lane ^ o) << 2, __float_as_int(v))); }
__device__ __forceinline__ float wave_sum(float v, int lane) {
#pragma unroll
    for (int o = 1; o < 64; o <<= 1) v += shx(v, o, lane);
    return v;
}
__device__ __forceinline__ float fsigmoid(float x) { return __builtin_amdgcn_rcpf(1.0f + __builtin_amdgcn_exp2f(-1.44269504089f * x)); }
__device__ __forceinline__ float fsilu(float x) { return x * fsigmoid(x); }
__device__ __forceinline__ f32x2 gelu_pk(f32x2 v) {
    const f32x2 av = __builtin_elementwise_abs(v), d = av * 0.2316418882f + 1.0f;
    f32x2 t; t.x = __builtin_amdgcn_rcpf(d.x); t.y = __builtin_amdgcn_rcpf(d.y);
    f32x2 q = t * 0.5307027145f + (-0.7265760135f); q = q * t + 0.7107068705f; q = q * t + (-0.142248368f); q = q * t + 0.127414796f; q = q * t;
    const f32x2 s = (v * v) * (-0.72134752044f);
    f32x2 e; e.x = __builtin_amdgcn_exp2f(s.x); e.y = __builtin_amdgcn_exp2f(s.y);
    const f32x2 m = v * (q * e), r = v - m;
    f32x2 o; o.x = v.x < 0.f ? m.x : r.x; o.y = v.y < 0.f ? m.y : r.y; return o;
}

namespace pg8 {
constexpr int BM = 256, BK = 64, HALF = 128, HTB = HALF * BK * 2, STAGE_BYTES = 8 * HTB, NXCD = 8, WGM = 8;
__host__ __device__ __forceinline__ int lds_byte(int r, int c) { const int st = (r >> 4) * 2 + (c >> 5), rr = r & 15, cc = c & 31, ob = rr * 64 + cc * 2; return st * 1024 + (ob ^ (((ob >> 9) & 1) << 5)); }
__host__ __device__ __forceinline__ void stage_rc(int b, int& R, int& C) { const int st = b / 1024, sb = b % 1024, swz = sb ^ (((sb >> 9) & 1) << 5); R = (st >> 1) * 16 + swz / 64; C = (st & 1) * 32 + (swz % 64) / 2; }
__host__ __device__ __forceinline__ int perm32(int rho) { const int n = rho >> 4, i = rho & 15; return 8 * (i >> 2) + 4 * n + (i & 3); }

struct Unit { const char* A; const char* B; int nt, pm, pn, aux; };

struct StaticOrder {
    int nM, nN, nwg, G, c;
    __device__ void init(int nM_, int nN_, int G_, int c_) { nM = nM_; nN = nN_; nwg = nM * nN; G = G_; c = c_; }
    __device__ bool next(int i, int& pm, int& pn) const {
        const long L = (long)i * G + c; if (L >= nwg) return false;
        int wgid = (int)L; { const int q = nwg / NXCD, r = nwg % NXCD, xcd = wgid % NXCD, off = wgid / NXCD; wgid = (xcd < r ? xcd * (q + 1) : r * (q + 1) + (xcd - r) * q) + off; }
        const int nig = WGM * nN, gid = wgid / nig, fm = gid * WGM, gsz = (nM - fm) < WGM ? (nM - fm) : WGM;
        pm = fm + ((wgid % nig) % gsz); pn = (wgid % nig) / gsz; return true;
    }
};

template <class Epi, class Sched>
__device__ __forceinline__ void gemm_phase(LAS unsigned char* lds, const int tid, const int lda, const int ldb, const Sched& S, const Epi& E) {
    const int wid = __builtin_amdgcn_readfirstlane(tid >> 6), lane = tid & 63, wr = wid >> 2, wc = wid & 3, fr = lane & 15, fq = lane >> 4;
    unsigned voffA[2], voffB[2];
#pragma unroll
    for (int i = 0; i < 2; ++i) { int R, C; stage_rc(tid * 16 + i * 8192, R, C); const int Rb = Epi::PERM ? ((R & ~31) + perm32(R & 31)) : R;
        voffA[i] = (unsigned)(R * lda + C) * 2u; voffB[i] = (unsigned)(Rb * ldb + C) * 2u; }
    const size_t kstep = (size_t)(BK * 2);
    const size_t hstepA = (size_t)HALF * lda * 2, hstepB = (size_t)HALF * ldb * 2;
    const unsigned ldsw = (unsigned)wid * 1024u;
    const int aoff = lds_byte(wr * 64 + fr, fq * 8), boff = lds_byte(wc * 32 + fr, fq * 8);
#define PG8_SA(b, h) (((b) * 2 + (h)) * HTB)
#define PG8_SB(b, h) ((4 + (b) * 2 + (h)) * HTB)
#define PG8_STAGE(bufoff, gbase, voff) do { _Pragma("unroll") for (int _i = 0; _i < 2; ++_i) \
        __builtin_amdgcn_global_load_lds((const unsigned*)((const char*)(gbase) + (voff)[_i]), (LAS unsigned*)(lds + (bufoff) + ldsw + _i * 8192), 16, 0, 0); } while (0)
#define PG8_LDA(dst, b, h) do { _Pragma("unroll") for (int m = 0; m < 4; ++m) _Pragma("unroll") for (int k = 0; k < 2; ++k) dst[m][k] = *(const LAS bf16x8*)(lds + PG8_SA(b, h) + aoff + m * 2048 + k * 1024); } while (0)
#define PG8_LDB(dst, b, h) do { _Pragma("unroll") for (int n = 0; n < 2; ++n) _Pragma("unroll") for (int k = 0; k < 2; ++k) dst[n][k] = *(const LAS bf16x8*)(lds + PG8_SB(b, h) + boff + n * 2048 + k * 1024); } while (0)
#define PG8_MMA(ai, bj, At, Bt) do { __builtin_amdgcn_s_setprio(1); _Pragma("unroll") for (int m = 0; m < 4; ++m) _Pragma("unroll") for (int n = 0; n < 2; ++n) _Pragma("unroll") for (int k = 0; k < 2; ++k) \
        acc[ai][bj][m][n] = __builtin_amdgcn_mfma_f32_16x16x32_bf16(Bt[n][k], At[m][k], acc[ai][bj][m][n], 0, 0, 0); __builtin_amdgcn_s_setprio(0); } while (0)
#define PG8_WAIT_V(n) asm volatile("s_waitcnt vmcnt(" #n ")" ::: "memory")
#define PG8_WAIT_L(n) asm volatile("s_waitcnt lgkmcnt(" #n ")" ::: "memory")
#define PG8_BAR __builtin_amdgcn_s_barrier()
#define PG8_SCHED __builtin_amdgcn_sched_barrier(0)
    Unit cur, nxt; int ui = 0;
    if (!S.next(0, cur)) return;
    f32x4 acc[2][2][4][2];
#pragma unroll
    for (int a = 0; a < 2; ++a)
#pragma unroll
        for (int b = 0; b < 2; ++b)
#pragma unroll
            for (int m = 0; m < 4; ++m)
#pragma unroll
                for (int n = 0; n < 2; ++n) acc[a][b][m][n] = (f32x4){0.f, 0.f, 0.f, 0.f};
    bf16x8 At[4][2], B0[2][2], B1[2][2];
    const char* cA = cur.A; const char* cB = cur.B;
    {
        PG8_STAGE(PG8_SB(0, 0), cB, voffB); PG8_STAGE(PG8_SB(0, 1), cB + hstepB, voffB); PG8_STAGE(PG8_SA(0, 0), cA, voffA); PG8_STAGE(PG8_SA(0, 1), cA + hstepA, voffA);
        if (wr == 1) PG8_BAR;
        PG8_WAIT_V(2); PG8_BAR;
        PG8_STAGE(PG8_SB(1, 0), cB + kstep, voffB); PG8_STAGE(PG8_SA(1, 0), cA + kstep, voffA); PG8_STAGE(PG8_SB(1, 1), cB + hstepB + kstep, voffB);
        PG8_WAIT_V(6); PG8_BAR;
    }
    for (;;) {
        const bool has_next = S.next(ui + 1, nxt);
        const char* nA = has_next ? nxt.A : cA; const char* nB = has_next ? nxt.B : cB;
        const int nt = cur.nt;
        for (int t = 0; t < nt; t += 2) {
            const bool last = (t == nt - 2);
            const char* a1 = cA + (size_t)(t + 1) * kstep;
            const char* a2 = last ? nA : cA + (size_t)(t + 2) * kstep; const char* b2 = last ? nB : cB + (size_t)(t + 2) * kstep;
            const char* a3 = a2 + kstep; const char* b3 = b2 + kstep;
            PG8_LDB(B0, 0, 0); PG8_LDB(B1, 0, 1); PG8_SCHED; PG8_LDA(At, 0, 0); PG8_STAGE(PG8_SA(1, 1), a1 + hstepA, voffA);
            PG8_WAIT_V(8); PG8_WAIT_L(0); PG8_BAR; PG8_MMA(0, 0, At, B0); PG8_MMA(0, 1, At, B1); PG8_BAR; PG8_SCHED;
            PG8_LDA(At, 0, 1); PG8_STAGE(PG8_SB(0, 0), b2, voffB); PG8_STAGE(PG8_SB(0, 1), b2 + hstepB, voffB); PG8_STAGE(PG8_SA(0, 0), a2, voffA);
            PG8_WAIT_V(8); PG8_WAIT_L(0); PG8_BAR; PG8_MMA(1, 0, At, B0); PG8_MMA(1, 1, At, B1); PG8_BAR; PG8_SCHED;
            PG8_LDB(B0, 1, 0); PG8_LDB(B1, 1, 1); PG8_SCHED; PG8_LDA(At, 1, 0); PG8_STAGE(PG8_SA(0, 1), a2 + hstepA, voffA);
            PG8_WAIT_V(8); PG8_WAIT_L(0); PG8_BAR; PG8_MMA(0, 0, At, B0); PG8_MMA(0, 1, At, B1); PG8_BAR; PG8_SCHED;
            PG8_LDA(At, 1, 1); PG8_STAGE(PG8_SB(1, 0), b3, voffB); PG8_STAGE(PG8_SB(1, 1), b3 + hstepB, voffB); PG8_STAGE(PG8_SA(1, 0), a3, voffA);
            PG8_WAIT_V(8); PG8_WAIT_L(0); PG8_BAR; PG8_MMA(1, 0, At, B0); PG8_MMA(1, 1, At, B1); PG8_BAR; PG8_SCHED;
        }
        if (wr == 0) PG8_BAR;
        E(acc, cur, wr, wc);
        if (!has_next) break;
#pragma unroll
        for (int a = 0; a < 2; ++a)
#pragma unroll
            for (int b = 0; b < 2; ++b)
#pragma unroll
                for (int m = 0; m < 4; ++m)
#pragma unroll
                    for (int n = 0; n < 2; ++n) acc[a][b][m][n] = (f32x4){0.f, 0.f, 0.f, 0.f};
        cur = nxt; cA = nA; cB = nB; ++ui;
        if (wr == 1) PG8_BAR;
    }
    PG8_WAIT_V(0);
    PG8_BAR;
#undef PG8_SA
#undef PG8_SB
#undef PG8_STAGE
#undef PG8_LDA
#undef PG8_LDB
#undef PG8_MMA
#undef PG8_WAIT_V
#undef PG8_WAIT_L
#undef PG8_BAR
#undef PG8_SCHED
}
}
using pg8::Unit;
typedef const f32x4 (&AccRef)[2][2][4][2];

struct SchedGrid {
    pg8::StaticOrder so; const char* A; const char* B; size_t tsA, tsB; int nt, nextra, ex_pm0, ex_pn0, ex_w;
    __device__ __forceinline__ bool next(int i, Unit& u) const {
        int pm, pn;
        if (!so.next(i, pm, pn)) { const long e = (long)i * so.G + so.c - so.nwg; if (e >= nextra) return false; pm = ex_pm0 + (int)e / ex_w; pn = ex_pn0 + (int)e % ex_w; }
        u.A = A + (size_t)pm * tsA; u.B = B + (size_t)pn * tsB; u.nt = nt; u.pm = pm; u.pn = pn; u.aux = 0; return true;
    }
};
struct SchedBranch {
    pg8::StaticOrder so; const char* proj; const char* wbr;
    __device__ __forceinline__ bool next(int i, Unit& u) const {
        int pm, pn; if (!so.next(i / 3, pm, pn)) return false;
        const int br = i % 3; const int acol = br == 0 ? 0 : (br == 1 ? OFF_Q : OFF_C), koff = br == 0 ? 0 : (br == 1 ? 512 : 1536);
        u.A = proj + ((size_t)pm * 256 * INW + acol) * 2; u.B = wbr + ((size_t)pn * 256 * DM + koff) * 2; u.nt = br == 1 ? 16 : 8; u.pm = pm; u.pn = pn; u.aux = br; return true;
    }
};
struct SchedF1 {
    const char* dftd; const char* proj; int G, c, nctx;
    __device__ __forceinline__ bool next(int i, Unit& u) const {
        const int L = i * G + c; { const char* ap = dftd; asm volatile("" : "+s"(ap)); u.A = ap; } u.nt = 2; u.pm = 0;
        if (L < 256) { const int b = L >> 6, g = (L >> 4) & 3, pn = L & 15; u.B = proj + ((size_t)(b * 4096 + pn * 256) * INW + g * 128) * 2; u.pn = pn; u.aux = b * 4 + g; return true; }
        const int e = L - 256; if (e >= nctx) return false;
        const int b = e >> 2, g = e & 3; u.B = proj + ((size_t)(MLAT + b * 256) * INW + g * 128) * 2; u.pn = 0; u.aux = 16 + b * 4 + g; return true;
    }
};
struct SchedF2 {
    const char* dft; const char* pqt; const char* dftc; const char* pqtc; int G, c, nctx;
    __device__ __forceinline__ bool next(int i, Unit& u) const {
        const int L = i * G + c;
        if (L < 128) { const int b = L >> 5, pm = (L >> 1) & 15, pn = L & 1; u.A = dft + (size_t)pm * 256 * 8192 * 2; u.B = pqt + (size_t)(b * 512 + pn * 256) * 8192 * 2; u.nt = 128; u.pm = pm; u.pn = pn; u.aux = b; return true; }
        const int e = L - 128; if (e >= nctx) return false;
        const int b = e >> 1, pn = e & 1; u.A = dftc; u.B = pqtc + (size_t)(b * 512 + pn * 256) * 8192 * 2; u.nt = 8; u.pm = 0; u.pn = pn; u.aux = 4 + b; return true;
    }
};

struct EpiInProj {
    static constexpr bool PERM = true;
    bf16_t* proj; bf16_t* vt; bf16_t* vtc;
    __device__ __forceinline__ void operator()(AccRef acc, const Unit& u, int wr, int wc) const {
        const int ln_ = fresh_lane(), fr = ln_ & 15, fq = ln_ >> 4;
        const int pm = u.pm, pn = u.pn; const int row0 = pm * 256 + wr * 64 + fr, col0 = pn * 256 + wc * 32 + 8 * fq;
        if (pn >= 10 && pn < 14) {
            const int vc0 = col0 - OFF_V;
#pragma unroll
            for (int ai = 0; ai < 2; ++ai)
#pragma unroll
                for (int m = 0; m < 4; ++m) {
                    const int row = row0 + ai * 128 + m * 16; bf16_t* dst; size_t stride;
                    if (pm < 64) { const int b = pm >> 4; dst = vt + (size_t)b * 1024 * 4096 + (row - b * 4096); stride = 4096; }
                    else { const int b = pm - 64; dst = vtc + (size_t)b * 1024 * 256 + (row - MLAT - b * 256); stride = 256; }
#pragma unroll
                    for (int bj = 0; bj < 2; ++bj)
#pragma unroll
                        for (int n = 0; n < 2; ++n) { const f32x4 v = acc[ai][bj][m][n]; const unsigned w0 = cvt_pk_bf16(v[0], v[1]), w1 = cvt_pk_bf16(v[2], v[3]);
                            bf16_t* d = dst + (size_t)(vc0 + bj * 128 + n * 4) * stride;
                            d[0] = (bf16_t)(w0 & 0xffffu); d[stride] = (bf16_t)(w0 >> 16); d[2 * stride] = (bf16_t)(w1 & 0xffffu); d[3 * stride] = (bf16_t)(w1 >> 16); }
                }
            return;
        }
        const int act = pn < 14 ? 0 : (pn < 18 ? 1 : 2); const float sc = (pn >= 2 && pn < 6) ? 0.08838834764831845f : 1.0f;
#pragma unroll
        for (int ai = 0; ai < 2; ++ai)
#pragma unroll
            for (int m = 0; m < 4; ++m) { bf16_t* rowp = proj + (size_t)(row0 + ai * 128 + m * 16) * INW + col0;
#pragma unroll
                for (int bj = 0; bj < 2; ++bj) { f32x4 v0 = acc[ai][bj][m][0], v1 = acc[ai][bj][m][1];
                    if (act == 1) { f32x2 a = gelu_pk((f32x2){v0[0], v0[1]}), b = gelu_pk((f32x2){v0[2], v0[3]}), c = gelu_pk((f32x2){v1[0], v1[1]}), d = gelu_pk((f32x2){v1[2], v1[3]});
                        v0 = (f32x4){a.x, a.y, b.x, b.y}; v1 = (f32x4){c.x, c.y, d.x, d.y}; }
                    else if (act == 2) { v0 = (f32x4){fsigmoid(v0[0]), fsigmoid(v0[1]), fsigmoid(v0[2]), fsigmoid(v0[3])}; v1 = (f32x4){fsigmoid(v1[0]), fsigmoid(v1[1]), fsigmoid(v1[2]), fsigmoid(v1[3])}; }
                    else { v0 = v0 * sc; v1 = v1 * sc; }
                    u32x4 w; w.x = cvt_pk_bf16(v0[0], v0[1]); w.y = cvt_pk_bf16(v0[2], v0[3]); w.z = cvt_pk_bf16(v1[0], v1[1]); w.w = cvt_pk_bf16(v1[2], v1[3]);
                    *(u32x4*)(rowp + bj * 128) = w; } }
    }
};
struct EpiPlain {
    static constexpr bool PERM = true;
    bf16_t* out; int ld;
    __device__ __forceinline__ void operator()(AccRef acc, const Unit& u, int wr, int wc) const {
        const int ln_ = fresh_lane(), fr = ln_ & 15, fq = ln_ >> 4;
        const int row0 = u.pm * 256 + wr * 64 + fr, col0 = u.pn * 256 + wc * 32 + 8 * fq;
#pragma unroll
        for (int ai = 0; ai < 2; ++ai)
#pragma unroll
            for (int m = 0; m < 4; ++m) { bf16_t* rowp = out + (size_t)(row0 + ai * 128 + m * 16) * ld + col0;
#pragma unroll
                for (int bj = 0; bj < 2; ++bj) { const f32x4 v0 = acc[ai][bj][m][0], v1 = acc[ai][bj][m][1];
                    u32x4 w; w.x = cvt_pk_bf16(v0[0], v0[1]); w.y = cvt_pk_bf16(v0[2], v0[3]); w.z = cvt_pk_bf16(v1[0], v1[1]); w.w = cvt_pk_bf16(v1[2], v1[3]);
                    *(u32x4*)(rowp + bj * 128) = w; } }
    }
};
struct EpiF1 {
    static constexpr bool PERM = true;
    bf16_t* pqt; bf16_t* pqtc;
    __device__ __forceinline__ void operator()(AccRef acc, const Unit& u, int wr, int wc) const {
        const int ln_ = fresh_lane(), fr = ln_ & 15, fq = ln_ >> 4;
        const int aux = u.aux; const bool isc = aux >= 16; const int bg = aux & 15, b = bg >> 2, g = bg & 3;
        bf16_t* base = (isc ? pqtc : pqt) + (size_t)(b * 512 + g * 128) * 8192; const int half = isc ? 256 : 4096;
        const int n0 = u.pn * 256 + wc * 32 + 8 * fq;
#pragma unroll
        for (int ai = 0; ai < 2; ++ai)
#pragma unroll
            for (int m = 0; m < 4; ++m) { bf16_t* rowp = base + (size_t)(wr * 64 + m * 16 + fr) * 8192 + ai * half + n0;
#pragma unroll
                for (int bj = 0; bj < 2; ++bj) { const f32x4 v0 = acc[ai][bj][m][0], v1 = acc[ai][bj][m][1];
                    u32x4 w; w.x = cvt_pk_bf16(v0[0], v0[1]); w.y = cvt_pk_bf16(v0[2], v0[3]); w.z = cvt_pk_bf16(v1[0], v1[1]); w.w = cvt_pk_bf16(v1[2], v1[3]);
                    *(u32x4*)(rowp + bj * 128) = w; } }
    }
};
struct EpiF2 {
    static constexpr bool PERM = true;
    bf16_t* proj;
    __device__ __forceinline__ void operator()(AccRef acc, const Unit& u, int wr, int wc) const {
        const int ln_ = fresh_lane(), fr = ln_ & 15, fq = ln_ >> 4;
        const int aux = u.aux; const bool isc = aux >= 4; const int rowbase = isc ? MLAT + (aux - 4) * 256 : aux * 4096;
        const float sc = isc ? 0.005524271728019903f : 0.0013810679320049757f;
        const int row0 = rowbase + u.pm * 256 + wr * 64 + fr, col0 = u.pn * 256 + wc * 32 + 8 * fq;
#pragma unroll
        for (int ai = 0; ai < 2; ++ai)
#pragma unroll
            for (int m = 0; m < 4; ++m) { bf16_t* rowp = proj + (size_t)(row0 + ai * 128 + m * 16) * INW + col0;
#pragma unroll
                for (int bj = 0; bj < 2; ++bj) { const f32x4 v0 = acc[ai][bj][m][0] * sc, v1 = acc[ai][bj][m][1] * sc;
                    u32x4 w; w.x = cvt_pk_bf16(v0[0], v0[1]); w.y = cvt_pk_bf16(v0[2], v0[3]); w.z = cvt_pk_bf16(v1[0], v1[1]); w.w = cvt_pk_bf16(v1[2], v1[3]);
                    *(u32x4*)(rowp + bj * 128) = w; } }
    }
};
struct EpiBranch {
    static constexpr bool PERM = false;
    const bf16_t* proj; float* tmp; bf16_t* merged;
    __device__ __forceinline__ void operator()(AccRef acc, const Unit& u, int wr, int wc) const {
        const int ln_ = fresh_lane(), fr = ln_ & 15, fq = ln_ >> 4;
        const int br = u.aux; const int col0 = u.pn * 256 + wc * 32 + 4 * fq;
#pragma unroll
        for (int ai = 0; ai < 2; ++ai)
#pragma unroll
            for (int m = 0; m < 4; ++m) { const size_t row = (size_t)(u.pm * 256 + ai * 128 + wr * 64 + m * 16 + fr);
#pragma unroll
                for (int bj = 0; bj < 2; ++bj)
#pragma unroll
                    for (int n = 0; n < 2; ++n) { const int col = col0 + bj * 128 + n * 16;
                        const u32x2 gw = *(const u32x2*)(proj + row * INW + OFF_G + br * DM + col);
                        f32x4 v = acc[ai][bj][m][n] * (f32x4){bflo(gw.x), bfhi(gw.x), bflo(gw.y), bfhi(gw.y)};
                        float* tp = tmp + row * DM + col;
                        if (br == 0) { *(f32x4*)tp = v; }
                        else if (br == 1) { *(f32x4*)tp = *(const f32x4*)tp + v; }
                        else { v = v + *(const f32x4*)tp; u32x2 w; w.x = cvt_pk_bf16(v[0], v[1]); w.y = cvt_pk_bf16(v[2], v[3]); *(u32x2*)(merged + row * DM + col) = w; } } }
    }
};
struct EpiResid {
    static constexpr bool PERM = false;
    const float* src_lat; const float* src_ctx; float* dst_lat; float* dst_ctx; const float* gate;
    __device__ __forceinline__ void operator()(AccRef acc, const Unit& u, int wr, int wc) const {
        const int ln_ = fresh_lane(), fr = ln_ & 15, fq = ln_ >> 4;
        const int pm = u.pm; const int b = pm < 64 ? (pm >> 4) : 4; const float* g = gate + (size_t)b * 12288; const int col0 = u.pn * 256 + wc * 32 + 4 * fq;
        const float* s0 = pm < 64 ? src_lat + (size_t)pm * 256 * DM : src_ctx + (size_t)(pm - 64) * 256 * DM;
        float* d0 = pm < 64 ? dst_lat + (size_t)pm * 256 * DM : dst_ctx + (size_t)(pm - 64) * 256 * DM;
        f32x4 gv[2][2];
#pragma unroll
        for (int bj = 0; bj < 2; ++bj)
#pragma unroll
            for (int n = 0; n < 2; ++n) gv[bj][n] = *(const f32x4*)(g + col0 + bj * 128 + n * 16);
#pragma unroll
        for (int ai = 0; ai < 2; ++ai)
#pragma unroll
            for (int m = 0; m < 4; ++m) { const size_t ro = (size_t)(ai * 128 + wr * 64 + m * 16 + fr) * DM;
#pragma unroll
                for (int bj = 0; bj < 2; ++bj)
#pragma unroll
                    for (int n = 0; n < 2; ++n) { const int col = col0 + bj * 128 + n * 16;
                        *(f32x4*)(d0 + ro + col) = *(const f32x4*)(s0 + ro + col) + gv[bj][n] * acc[ai][bj][m][n]; } }
    }
};

struct Args { const float* in[22]; float* out; unsigned char* ws; int ph_lo, ph_hi; };

__device__ __forceinline__ void transpose_item(const float* W, int N, bf16_t* WT, int ldk, int koff, LAS float* scr, int item, int lane) {
    const int nblk = N / 32, kb = item / nblk, nb = item % nblk, k0 = 64 * kb, n0 = 32 * nb;
#pragma unroll 8
    for (int i = 0; i < 32; ++i) { const int kk = 2 * i + (lane >> 5); scr[kk * 33 + (lane & 31)] = W[(size_t)(k0 + kk) * N + n0 + (lane & 31)]; }
    LDS_WAIT(); asm volatile("" ::: "memory");
    const int c = lane & 7;
#pragma unroll
    for (int j = 0; j < 4; ++j) { const int n = (lane >> 3) + 8 * j; const LAS float* s = scr + (8 * c) * 33 + n;
        u32x4 o; o.x = cvt_pk_bf16(s[0 * 33], s[1 * 33]); o.y = cvt_pk_bf16(s[2 * 33], s[3 * 33]); o.z = cvt_pk_bf16(s[4 * 33], s[5 * 33]); o.w = cvt_pk_bf16(s[6 * 33], s[7 * 33]);
        *(u32x4*)(WT + (size_t)(n0 + n) * ldk + koff + k0 + 8 * c) = o; }
    LDS_WAIT(); asm volatile("" ::: "memory");
}
__device__ __forceinline__ void convert_weights(const Args& a, int l, LAS float* scr, int gw, int NGW, int lane) {
    unsigned char* ws = a.ws;
    const float* w_in = a.in[8] + (size_t)l * DM * INW; const float* w_f = a.in[13] + (size_t)l * 512 * DM; const float* w_na = a.in[14] + (size_t)l * 1024 * DM;
    const float* w_c = a.in[15] + (size_t)l * 512 * DM; const float* w_o = a.in[16] + (size_t)l * DM * DM; const float* w_up = a.in[17] + (size_t)l * DM * UPW; const float* w_dn = a.in[20] + (size_t)l * DFF * DM;
    constexpr int I_IN = 32 * 336, I_F = 8 * 64, I_NA = 16 * 64, I_C = 8 * 64, I_O = 32 * 64, I_UP = 32 * 352, I_DN = 88 * 64;
    constexpr int NITEMS = I_IN + I_F + I_NA + I_C + I_O + I_UP + I_DN;
    for (int it = gw; it < NITEMS; it += NGW) {
        int r = it;
        if (r < I_IN) { transpose_item(w_in, INW, (bf16_t*)(ws + WS_WIN), DM, 0, scr, r, lane); continue; } r -= I_IN;
        if (r < I_F) { transpose_item(w_f, DM, (bf16_t*)(ws + WS_WBR), DM, 0, scr, r, lane); continue; } r -= I_F;
        if (r < I_NA) { transpose_item(w_na, DM, (bf16_t*)(ws + WS_WBR), DM, 512, scr, r, lane); continue; } r -= I_NA;
        if (r < I_C) { transpose_item(w_c, DM, (bf16_t*)(ws + WS_WBR), DM, 1536, scr, r, lane); continue; } r -= I_C;
        if (r < I_O) { transpose_item(w_o, DM, (bf16_t*)(ws + WS_WO), DM, 0, scr, r, lane); continue; } r -= I_O;
        if (r < I_UP) { transpose_item(w_up, UPW, (bf16_t*)(ws + WS_WUP), DM, 0, scr, r, lane); continue; } r -= I_UP;
        transpose_item(w_dn, DM, (bf16_t*)(ws + WS_WDN), DFF, 0, scr, r, lane);
    }
}
__device__ __forceinline__ void dft_tables(unsigned char* ws, const LAS float* lut, int gw, int NGW, int lane) {
    bf16_t* dft = (bf16_t*)(ws + WS_DFT); bf16_t* dftc = (bf16_t*)(ws + WS_DFTC);
    for (int it = gw; it < 4096 + 256; it += NGW) {
        if (it < 4096) { const int k = it;
            for (int i = 0; i < 16; ++i) { const int n0 = (i * 64 + lane) * 8; const int nn = n0 & 4095, sh = n0 >= 4096 ? 1024 : 0; float v[8];
#pragma unroll
                for (int e = 0; e < 8; ++e) v[e] = lut[((k * (nn + e)) + sh) & 4095];
                u32x4 w; w.x = cvt_pk_bf16(v[0], v[1]); w.y = cvt_pk_bf16(v[2], v[3]); w.z = cvt_pk_bf16(v[4], v[5]); w.w = cvt_pk_bf16(v[6], v[7]);
                *(u32x4*)(dft + (size_t)k * 8192 + n0) = w; }
        } else { const int k = it - 4096; const int n0 = lane * 8; const int nn = n0 & 255, sh = n0 >= 256 ? 1024 : 0; float v[8];
#pragma unroll
            for (int e = 0; e < 8; ++e) v[e] = lut[((((k * (nn + e)) & 255) * 16) + sh) & 4095];
            u32x4 w; w.x = cvt_pk_bf16(v[0], v[1]); w.y = cvt_pk_bf16(v[2], v[3]); w.z = cvt_pk_bf16(v[4], v[5]); w.w = cvt_pk_bf16(v[6], v[7]);
            *(u32x4*)(dftc + (size_t)k * 8192 + n0) = w; }
    }
}
__device__ __forceinline__ void mods_items(const Args& a, int gw, int NGW, int lane) {
    float* mods = (float*)(a.ws + WS_MODS);
    for (int it = gw; it < 768; it += NGW) {
        const int l = it / 384, rem = it % 384, cch = rem >> 3, kp = rem & 7; const int col = cch * 256 + lane * 4, k0 = kp * 256;
        float sv[5][4];
#pragma unroll
        for (int r = 0; r < 5; ++r)
#pragma unroll
            for (int i = 0; i < 4; ++i) { const int k = k0 + lane + 64 * i; const float cv = r < 4 ? a.in[1][r * DM + k] : a.in[3][k]; sv[r][i] = fsilu(cv); }
        f32x4 acc[5];
#pragma unroll
        for (int r = 0; r < 5; ++r) acc[r] = (f32x4){0.f, 0.f, 0.f, 0.f};
        const float* wbase = a.in[4] + ((size_t)l * DM + k0) * 12288 + col;
#pragma unroll
        for (int i = 0; i < 4; ++i) {
#pragma unroll 8
            for (int ll = 0; ll < 64; ++ll) { const f32x4 w = *(const f32x4*)(wbase + (size_t)(i * 64 + ll) * 12288);
#pragma unroll
                for (int r = 0; r < 5; ++r) { const float s = __int_as_float(__builtin_amdgcn_readlane(__float_as_int(sv[r][i]), ll)); acc[r] += w * s; } }
        }
        if (kp == 0) { const f32x4 bv = *(const f32x4*)(a.in[5] + (size_t)l * 12288 + col);
#pragma unroll
            for (int r = 0; r < 5; ++r) acc[r] += bv; }
#pragma unroll
        for (int r = 0; r < 5; ++r) { float* d = mods + ((size_t)l * 5 + r) * 12288 + col; atomicAdd(d, acc[r][0]); atomicAdd(d + 1, acc[r][1]); atomicAdd(d + 2, acc[r][2]); atomicAdd(d + 3, acc[r][3]); }
    }
}
__device__ __forceinline__ void norm_rows(const float* xlat, const float* xctx, const float* w, const float* mods_l, int shoff, int scoff, bf16_t* XN, int nrows, int gw, int NGW, int lane) {
    for (int row = gw; row < nrows; row += NGW) {
        const float* xr = row < MLAT ? xlat + (size_t)row * DM : xctx + (size_t)(row - MLAT) * DM; const int b = row < MLAT ? (row >> 12) : 4;
        const float* sh = mods_l + (size_t)b * 12288 + shoff; const float* sc = mods_l + (size_t)b * 12288 + scoff;
        f32x4 v[8]; float ss = 0.f;
#pragma unroll
        for (int j = 0; j < 8; ++j) { v[j] = *(const f32x4*)(xr + 4 * lane + 256 * j); ss += (v[j][0] * v[j][0] + v[j][1] * v[j][1]) + (v[j][2] * v[j][2] + v[j][3] * v[j][3]); }
        const float rstd = rsqrtf(wave_sum(ss, lane) * (1.0f / DM) + EPS);
#pragma unroll
        for (int j = 0; j < 8; ++j) { const int col = 4 * lane + 256 * j; const f32x4 wv = *(const f32x4*)(w + col), scv = *(const f32x4*)(sc + col), shv = *(const f32x4*)(sh + col);
            const f32x4 o = (v[j] * rstd * wv) * (scv + 1.0f) + shv; u32x2 pk; pk.x = cvt_pk_bf16(o[0], o[1]); pk.y = cvt_pk_bf16(o[2], o[3]);
            *(u32x2*)(XN + (size_t)row * DM + col) = pk; }
    }
}
__device__ __forceinline__ void final_norm(float* x, const float* w, int gw, int NGW, int lane) {
    for (int row = gw; row < MLAT; row += NGW) { float* xr = x + (size_t)row * DM; f32x4 v[8]; float ss = 0.f;
#pragma unroll
        for (int j = 0; j < 8; ++j) { v[j] = *(const f32x4*)(xr + 4 * lane + 256 * j); ss += (v[j][0] * v[j][0] + v[j][1] * v[j][1]) + (v[j][2] * v[j][2] + v[j][3] * v[j][3]); }
        const float rstd = rsqrtf(wave_sum(ss, lane) * (1.0f / DM) + EPS);
#pragma unroll
        for (int j = 0; j < 8; ++j) { const int col = 4 * lane + 256 * j; *(f32x4*)(xr + col) = v[j] * rstd * *(const f32x4*)(w + col); } }
}
__device__ __forceinline__ void sgu_unit(bf16_t* proj, int row0, int g, const float* nw, const float* wsg, const float* bsg, LAS unsigned char* lds, int tid) {
    LAS bf16_t* vnt = (LAS bf16_t*)lds;
    const int lane = tid & 63, wid = tid >> 6, fr = lane & 15, fq = lane >> 4;
    {
        const int j = tid >> 2, q = tid & 3; const bf16_t* src = proj + (size_t)(row0 + j) * INW + OFF_C + 512 + g * 128 + q * 32;
        float v[32];
#pragma unroll
        for (int i = 0; i < 4; ++i) { const u32x4 w = *(const u32x4*)(src + 8 * i);
            v[8 * i + 0] = bflo(w.x); v[8 * i + 1] = bfhi(w.x); v[8 * i + 2] = bflo(w.y); v[8 * i + 3] = bfhi(w.y); v[8 * i + 4] = bflo(w.z); v[8 * i + 5] = bfhi(w.z); v[8 * i + 6] = bflo(w.w); v[8 * i + 7] = bfhi(w.w); }
        float s = 0.f;
#pragma unroll
        for (int e = 0; e < 32; ++e) s += v[e];
        s += shx(s, 1, lane); s += shx(s, 2, lane); const float mean = s * (1.0f / 128.0f);
        float qv = 0.f;
#pragma unroll
        for (int e = 0; e < 32; ++e) { v[e] -= mean; qv += v[e] * v[e]; }
        qv += shx(qv, 1, lane); qv += shx(qv, 2, lane); const float rstd = rsqrtf(qv * (1.0f / 128.0f) + EPS);
#pragma unroll
        for (int e = 0; e < 32; e += 2) { const int d = q * 32 + e; const unsigned w = cvt_pk_bf16(v[e] * rstd * nw[g * 128 + d], v[e + 1] * rstd * nw[g * 128 + d + 1]);
            vnt[d * 136 + j] = (bf16_t)(w & 0xffffu); vnt[(d + 1) * 136 + j] = (bf16_t)(w >> 16); }
    }
    __syncthreads();
    {
        const int i = 16 * wid + fr;
        bf16x8 wf[4];
#pragma unroll
        for (int ks = 0; ks < 4; ++ks) { const float* wp = wsg + (size_t)i * 128 + 32 * ks + 8 * fq; const f32x4 a = *(const f32x4*)wp, b = *(const f32x4*)(wp + 4);
            u32x4 w; w.x = cvt_pk_bf16(a[0], a[1]); w.y = cvt_pk_bf16(a[2], a[3]); w.z = cvt_pk_bf16(b[0], b[1]); w.w = cvt_pk_bf16(b[2], b[3]); wf[ks] = __builtin_bit_cast(bf16x8, w); }
        const float bias = bsg[i];
        bf16_t* up = proj + (size_t)(row0 + i) * INW + OFF_C + g * 128 + 4 * fq;
#pragma unroll
        for (int nt = 0; nt < 8; ++nt) { f32x4 acc = (f32x4){0.f, 0.f, 0.f, 0.f};
#pragma unroll
            for (int ks = 0; ks < 4; ++ks) { const bf16x8 af = *(const LAS bf16x8*)((const LAS unsigned char*)vnt + (16 * nt + fr) * 272 + (32 * ks + 8 * fq) * 2);
                acc = __builtin_amdgcn_mfma_f32_16x16x32_bf16(af, wf[ks], acc, 0, 0, 0); }
            const u32x2 uw = *(const u32x2*)(up + 16 * nt); u32x2 o;
            o.x = cvt_pk_bf16(bflo(uw.x) * (acc[0] + bias), bfhi(uw.x) * (acc[1] + bias)); o.y = cvt_pk_bf16(bflo(uw.y) * (acc[2] + bias), bfhi(uw.y) * (acc[3] + bias));
            *(u32x2*)(up + 16 * nt) = o; }
    }
    __syncthreads();
}
template <bool LAT>
__device__ __forceinline__ void attn_task(bf16_t* proj, const bf16_t* vt, const bf16_t* vtc, const float* rpb, int t, int lane) {
    constexpr int NCH = LAT ? 16 : 8, WCH = LAT ? 8 : 0;
    const int fr = lane & 15, fq = lane >> 4;
    int b, h, r = 0, cgp = 0, qrow;
    if (LAT) { cgp = t & 3; r = (t >> 2) & 63; h = (t >> 8) & 7; b = t >> 11; qrow = b * 4096 + r * 64 + cgp * 16 + fr; }
    else { const int qg = t & 15; h = (t >> 4) & 7; b = t >> 7; qrow = MLAT + b * 256 + qg * 16 + fr; }
    bf16_t* qp = proj + (size_t)qrow * INW + OFF_Q + h * 128;
    bf16x8 qf[4];
#pragma unroll
    for (int ks = 0; ks < 4; ++ks) qf[ks] = *(const bf16x8*)(qp + ks * 32 + fq * 8);
    const int rs = r < 4 ? 0 : (r > 60 ? 56 : r - 4);
    const int cb = cgp == 0 ? 0 : (cgp == 1 ? 8 : (cgp == 2 ? 24 : 32));
    float S[NCH][8];
    const int kap = 8 * (fr >> 2) + (fr & 3);
    const bf16_t* kbase = proj + OFF_K + h * 128 + fq * 8;
    bf16x8 kf[2][8];
#define ATT_LOADK(buf, c) do { _Pragma("unroll") for (int tt = 0; tt < 2; ++tt) { \
        const int krow = ((c) < WCH) ? (b * 4096 + (rs + (c)) * 64 + cb + kap + 4 * tt) : (MLAT + b * 256 + 32 * ((c) - WCH) + kap + 4 * tt); \
        const bf16_t* kp = kbase + (size_t)krow * INW; \
        _Pragma("unroll") for (int ks = 0; ks < 4; ++ks) kf[buf][tt * 4 + ks] = *(const bf16x8*)(kp + ks * 32); } } while (0)
    ATT_LOADK(0, 0);
#pragma unroll
    for (int c = 0; c < NCH; ++c) {
        if (c + 1 < NCH) ATT_LOADK((c + 1) & 1, c + 1);
        __builtin_amdgcn_sched_barrier(0);
#pragma unroll
        for (int tt = 0; tt < 2; ++tt) {
            f32x4 acc = (f32x4){0.f, 0.f, 0.f, 0.f};
#pragma unroll
            for (int ks = 0; ks < 4; ++ks) acc = __builtin_amdgcn_mfma_f32_16x16x32_bf16(kf[c & 1][tt * 4 + ks], qf[ks], acc, 0, 0, 0);
            S[c][4 * tt + 0] = acc[0]; S[c][4 * tt + 1] = acc[1]; S[c][4 * tt + 2] = acc[2]; S[c][4 * tt + 3] = acc[3];
        }
        __builtin_amdgcn_sched_barrier(0);
    }
#undef ATT_LOADK
    if (LAT) {
        const int qc = cgp * 16 + fr; const int cs = qc < 8 ? 0 : (qc > 56 ? 48 : qc - 8);
#pragma unroll
        for (int c = 0; c < WCH; ++c) { const int dr = rs + c - r + 7; const float* rp = rpb + (h * 15 + dr) * 31;
#pragma unroll
            for (int jj = 0; jj < 8; ++jj) { const int kc = cb + 8 * fq + jj; const bool valid = (kc >= cs) && (kc < cs + 16); int dc = kc - qc + 15; dc = dc < 0 ? 0 : (dc > 30 ? 30 : dc);
                const float bias = rp[dc]; S[c][jj] = valid ? S[c][jj] + bias : -1e30f; } }
    }
    float mx = -3.0e38f;
#pragma unroll
    for (int c = 0; c < NCH; ++c)
#pragma unroll
        for (int jj = 0; jj < 8; ++jj) mx = fmaxf(mx, S[c][jj]);
    mx = fmaxf(mx, shx(mx, 16, lane)); mx = fmaxf(mx, shx(mx, 32, lane));
    float sum = 0.f; bf16x8 pf[NCH];
#pragma unroll
    for (int c = 0; c < NCH; ++c) { float p[8];
#pragma unroll
        for (int jj = 0; jj < 8; ++jj) { p[jj] = __builtin_amdgcn_exp2f((S[c][jj] - mx) * 1.44269504089f); sum += p[jj]; }
        u32x4 w; w.x = cvt_pk_bf16(p[0], p[1]); w.y = cvt_pk_bf16(p[2], p[3]); w.z = cvt_pk_bf16(p[4], p[5]); w.w = cvt_pk_bf16(p[6], p[7]); pf[c] = __builtin_bit_cast(bf16x8, w); }
    sum += shx(sum, 16, lane); sum += shx(sum, 32, lane);
    const float inv = 1.0f / sum;
    const bf16_t* vlat = vt + ((size_t)(b * 1024 + h * 128 + fr)) * 4096 + cb + 8 * fq;
    const bf16_t* vctx = vtc + ((size_t)(b * 1024 + h * 128 + fr)) * 256 + 8 * fq;
    constexpr int NBH = NCH / 8, NQ = 8 * NBH;
    bf16x8 vf[2][8];
#define ATT_LOADV(buf, q) do { const int dt_ = (q) / NBH, hb_ = (q) % NBH; _Pragma("unroll") for (int i = 0; i < 8; ++i) { const int c_ = hb_ * 8 + i; \
        const bf16_t* vp = (c_ < WCH) ? (vlat + (size_t)dt_ * 16 * 4096 + (rs + c_) * 64) : (vctx + (size_t)dt_ * 16 * 256 + 32 * (c_ - WCH)); \
        vf[buf][i] = *(const bf16x8*)vp; } } while (0)
    ATT_LOADV(0, 0);
    f32x4 oacc = (f32x4){0.f, 0.f, 0.f, 0.f};
#pragma unroll
    for (int q = 0; q < NQ; ++q) {
        if (q + 1 < NQ) ATT_LOADV((q + 1) & 1, q + 1);
        __builtin_amdgcn_sched_barrier(0);
        const int dt = q / NBH, hb = q % NBH;
        if (hb == 0) oacc = (f32x4){0.f, 0.f, 0.f, 0.f};
#pragma unroll
        for (int i = 0; i < 8; ++i) oacc = __builtin_amdgcn_mfma_f32_16x16x32_bf16(vf[q & 1][i], pf[hb * 8 + i], oacc, 0, 0, 0);
        if (hb == NBH - 1) { u32x2 o; o.x = cvt_pk_bf16(oacc[0] * inv, oacc[1] * inv); o.y = cvt_pk_bf16(oacc[2] * inv, oacc[3] * inv);
            *(u32x2*)(qp + dt * 16 + 4 * fq) = o; }
        __builtin_amdgcn_sched_barrier(0);
    }
#undef ATT_LOADV
}
__device__ __forceinline__ void conv_items(const bf16_t* up, bf16_t* hmid, const float* cw, const float* cbias, int nrows, int gtid, int NT) {
    const int nitems = (nrows / 16) * 704;
    for (int it = gtid; it < nitems; it += NT) {
        const int cg8 = it % 704, rb = it / 704; const int row0 = rb * 16, ch = cg8 * 8;
        const int seqlen = row0 < MLAT ? 4096 : 256; const int ts = (row0 < MLAT ? row0 : row0 - MLAT) & (seqlen - 1);
        float w0[8], w1[8], w2[8], bb[8];
#pragma unroll
        for (int e = 0; e < 8; ++e) { w0[e] = cw[ch + e]; w1[e] = cw[DFF + ch + e]; w2[e] = cw[2 * DFF + ch + e]; bb[e] = cbias[ch + e]; }
        const bf16_t* ap = up + (size_t)row0 * UPW + ch; const bf16_t* gp = ap + DFF; bf16_t* hp = hmid + (size_t)row0 * DFF + ch;
        u32x4 prev = (u32x4){0u, 0u, 0u, 0u}; if (ts > 0) prev = *(const u32x4*)(ap - UPW);
        u32x4 cur = *(const u32x4*)ap;
        for (int i = 0; i < 16; ++i) {
            u32x4 nxt = (u32x4){0u, 0u, 0u, 0u}; if (i < 15 || ts + 16 < seqlen) nxt = *(const u32x4*)(ap + (size_t)(i + 1) * UPW);
            const u32x4 gw = *(const u32x4*)(gp + (size_t)i * UPW);
            float o[8];
#pragma unroll
            for (int e = 0; e < 4; ++e) {
                const float y0 = bb[2 * e] + w0[2 * e] * bflo(prev[e]) + w1[2 * e] * bflo(cur[e]) + w2[2 * e] * bflo(nxt[e]);
                const float y1 = bb[2 * e + 1] + w0[2 * e + 1] * bfhi(prev[e]) + w1[2 * e + 1] * bfhi(cur[e]) + w2[2 * e + 1] * bfhi(nxt[e]);
                o[2 * e] = fsilu(y0) * bflo(gw[e]); o[2 * e + 1] = fsilu(y1) * bfhi(gw[e]); }
            u32x4 w; w.x = cvt_pk_bf16(o[0], o[1]); w.y = cvt_pk_bf16(o[2], o[3]); w.z = cvt_pk_bf16(o[4], o[5]); w.w = cvt_pk_bf16(o[6], o[7]);
            *(u32x4*)(hp + (size_t)i * DFF) = w;
            prev = cur; cur = nxt;
        }
    }
}


#define XB_TMO      128
#define XB_XCNT(j)  (256  + 64 * (j))
#define XB_XSUB(j)  (1280 + 64 * (j))
#define XB_XGEN(j)  (2304 + 64 * (j))
#define XB_TOP      3328
#define XB_TOPGEN   3392
#define XCD_BAR_WORDS 3456
#define XB_SPIN_CAP (1u << 18)
__device__ __forceinline__ unsigned xb_ld(unsigned* p)              { return __hip_atomic_load(p, __ATOMIC_RELAXED, __HIP_MEMORY_SCOPE_AGENT); }
__device__ __forceinline__ unsigned xb_add(unsigned* p, unsigned v) { return __hip_atomic_fetch_add(p, v, __ATOMIC_RELAXED, __HIP_MEMORY_SCOPE_AGENT); }
__device__ __forceinline__ unsigned xb_xcc_id() { return (unsigned)__builtin_amdgcn_s_getreg((3 << 11) | 20) & 0xFu; }
#define XB_SPIN(cond, bar) do { unsigned _sp = 0; while (cond) { __builtin_amdgcn_s_sleep(1); \
    if ((++_sp & 255u) == 0u) { if (xb_ld(&(bar)[XB_TMO])) break; if (_sp > XB_SPIN_CAP) { atomicAdd(&(bar)[XB_TMO], 1u); break; } } } } while (0)
struct XcdBarrier { unsigned* bar; unsigned x; volatile LAS unsigned* st; };
__device__ __forceinline__ XcdBarrier xcd_barrier_post(unsigned* bar, volatile LAS unsigned* st) {
    XcdBarrier b; b.bar = bar; b.x = xb_xcc_id(); b.st = st;
    if (threadIdx.x == 0) (void)xb_add(&bar[XB_XCNT(b.x)], 1u);
    return b;
}
__device__ __forceinline__ void xcd_barrier_complete(unsigned* bar, unsigned x, unsigned& nloc, unsigned& nx) {
    const unsigned G = gridDim.x * gridDim.y * gridDim.z;
    unsigned sum, cnt, mine, sp = 0u;
    for (;;) {
        sum = 0u; cnt = 0u; mine = 0u;
#pragma unroll
        for (unsigned j = 0; j < 16; ++j) { const unsigned c = xb_ld(&bar[XB_XCNT(j)]); sum += c; cnt += (c > 0u) ? 1u : 0u; mine = (j == x) ? c : mine; }
        if (sum == G) break;
        __builtin_amdgcn_s_sleep(1);
        if ((++sp & 255u) == 0u) { if (xb_ld(&bar[XB_TMO])) break; if (sp > XB_SPIN_CAP) { atomicAdd(&bar[XB_TMO], 1u); break; } }
    }
    nloc = mine > 0u ? mine : 1u; nx = cnt > 0u ? cnt : 1u;
}
__device__ __forceinline__ void xcd_barrier(const XcdBarrier& b) {
    asm volatile("s_waitcnt vmcnt(0)" ::: "memory");
    __syncthreads();
    if (threadIdx.x == 0) {
        unsigned* bar = b.bar;
        __builtin_amdgcn_s_waitcnt(0);
        unsigned nloc = b.st[0], nx = b.st[1];
        if (nloc == 0u) { xcd_barrier_complete(bar, b.x, nloc, nx); b.st[0] = nloc; b.st[1] = nx; }
        const unsigned old = xb_add(&bar[XB_XSUB(b.x)], 1u);
        const unsigned gen = old / nloc;
        if (old + 1u == (gen + 1u) * nloc) {
            __builtin_amdgcn_fence(__ATOMIC_RELEASE, "agent");
            asm volatile("s_waitcnt vmcnt(0)" ::: "memory");
            const unsigned og = xb_add(&bar[XB_TOP], 1u);
            const unsigned tg = og / nx;
            if (og + 1u == (tg + 1u) * nx) xb_add(&bar[XB_TOPGEN], 1u);
            else XB_SPIN(xb_ld(&bar[XB_TOPGEN]) == tg, bar);
            __builtin_amdgcn_fence(__ATOMIC_ACQUIRE, "agent");
            xb_add(&bar[XB_XGEN(b.x)], 1u);
            asm volatile("s_waitcnt vmcnt(0)" ::: "memory");
        } else {
            XB_SPIN(xb_ld(&bar[XB_XGEN(b.x)]) == gen, bar);
            __builtin_amdgcn_fence(__ATOMIC_ACQUIRE, "agent");
            asm volatile("s_waitcnt vmcnt(0)" ::: "memory");
        }
    }
    __syncthreads();
}
constexpr int NPHASE = 22;
__global__ void __launch_bounds__(512, 2) mega(Args a) {
    extern __shared__ __attribute__((aligned(16))) unsigned char lds_raw[];
    LAS unsigned char* lds = (LAS unsigned char*)lds_raw;
    cg::grid_group grid = cg::this_grid();
    const int G = gridDim.x, cu = blockIdx.x, NGW = G * 8, wave = __builtin_amdgcn_readfirstlane((int)threadIdx.x >> 6);
    unsigned char* ws = a.ws;
    unsigned* ctl = (unsigned*)(ws + WS_CTL);
    bf16_t* PROJ = (bf16_t*)(ws + WS_BIG); bf16_t* XN = (bf16_t*)(ws + WS_XN); bf16_t* HMID = (bf16_t*)(ws + WS_HMID);
    float* XC = (float*)(ws + WS_XC); float* mods = (float*)(ws + WS_MODS);
    bf16_t* VT = (bf16_t*)(ws + WS_VT); bf16_t* VTC = (bf16_t*)(ws + WS_VTC);

    volatile LAS unsigned* xst = (volatile LAS unsigned*)(lds + 143360);
    if (threadIdx.x < 4) xst[threadIdx.x] = 0u;
    __syncthreads();
    const XcdBarrier xbar = xcd_barrier_post((unsigned*)(ws + WS_BAR), xst);

    for (int p = a.ph_lo; p < a.ph_hi; ++p) {
        if (p > a.ph_lo) { if (p == 1) grid.sync(); else xcd_barrier(xbar); }
        const int lane = fresh_lane();
        const int tid = wave * 64 + lane, gw = cu * 8 + wave;
        if (p == 0) {
            LAS float* lut = (LAS float*)(lds + 72 * 1024);
            for (int i = tid; i < 4096; i += 512) lut[i] = cospif((float)i * (1.0f / 2048.0f));
            __syncthreads();
            if (cu == 0) { bf16_t* dd = (bf16_t*)(ws + WS_DFTD);
                for (int e = tid; e < 256 * 128; e += 512) { const int row = e >> 7, d = e & 127, j = row & 127; const float ang = (float)((j * d) & 127) * (1.0f / 64.0f);
                    const float v = row < 128 ? cospif(ang) : sinpif(ang); dd[e] = (bf16_t)(cvt_pk_bf16(v, 0.f) & 0xffffu); } }
            mods_items(a, gw, NGW, lane);
            convert_weights(a, 0, (LAS float*)(lds + wave * 8704), gw, NGW, lane);
            dft_tables(ws, lut, gw, NGW, lane);
            continue;
        }
        if (p == NPHASE - 1) { final_norm(a.out, a.in[21], gw, NGW, lane); continue; }
        const int l = (p - 1) / 10, s = (p - 1) % 10;
        const float* mods_l = mods + (size_t)l * 5 * 12288;
        const float* xlat = (l == 0) ? a.in[0] : a.out; const float* xctx = (l == 0) ? a.in[2] : XC;
        const int nMall = (l == 0) ? 68 : 64;
        switch (s) {
        case 0: {
            if (l == 1) { LAS float* lut = (LAS float*)(lds + 72 * 1024);
                for (int i = tid; i < 4096; i += 512) lut[i] = cospif((float)i * (1.0f / 2048.0f));
                __syncthreads();
                convert_weights(a, 1, (LAS float*)(lds + wave * 8704), gw, NGW, lane);
                dft_tables(ws, lut, gw, NGW, lane); }
            norm_rows(xlat, xctx, a.in[6] + (size_t)l * DM, mods_l, 0, 2048, XN, MT, gw, NGW, lane);
        } break;
        case 1: {
            SchedGrid S; S.so.init(nMall, 42, G, cu); S.A = (const char*)XN; S.B = (const char*)(ws + WS_WIN); S.tsA = (size_t)256 * DM * 2; S.tsB = (size_t)256 * DM * 2; S.nt = 32;
            S.nextra = (l == 0) ? 0 : 32; S.ex_pm0 = 64; S.ex_pn0 = 6; S.ex_w = 8;
            EpiInProj E{PROJ, VT, VTC};
            pg8::gemm_phase<EpiInProj, SchedGrid>(lds, tid, DM, DM, S, E);
        } break;
        case 2: {
            SchedF1 S{(const char*)(ws + WS_DFTD), (const char*)PROJ, G, cu, (l == 0) ? 16 : 0};
            EpiF1 E{(bf16_t*)(ws + WS_PQT), (bf16_t*)(ws + WS_PQTC)};
            pg8::gemm_phase<EpiF1, SchedF1>(lds, tid, 128, INW, S, E);
            __syncthreads();
            const int tid2 = wave * 64 + fresh_lane();
            const int nun = 512 + ((l == 0) ? 32 : 0);
            for (int u = cu; u < nun; u += G) { int row0, g;
                if (u < 512) { const int b = u >> 7, ch = (u >> 2) & 31; g = u & 3; row0 = b * 4096 + ch * 128; }
                else { const int e = u - 512; const int b = e >> 3, ch = (e >> 2) & 1; g = e & 3; row0 = MLAT + b * 256 + ch * 128; }
                sgu_unit(PROJ, row0, g, a.in[10] + (size_t)l * 512, a.in[11] + ((size_t)l * 4 + g) * 128 * 128, a.in[12] + ((size_t)l * 4 + g) * 128, lds, tid2); }
        } break;
        case 3: {
            SchedF2 S{(const char*)(ws + WS_DFT), (const char*)(ws + WS_PQT), (const char*)(ws + WS_DFTC), (const char*)(ws + WS_PQTC), G, cu, (l == 0) ? 8 : 0};
            EpiF2 E{PROJ};
            pg8::gemm_phase<EpiF2, SchedF2>(lds, tid, 8192, 8192, S, E);
            const int lane2 = fresh_lane();
            const int ntask = 8192 + ((l == 0) ? 512 : 0); unsigned* cnt = ctl + 64 * l; const float* rpb = a.in[9] + (size_t)l * 8 * 15 * 31;
            for (;;) { int t = 0; if (lane2 == 0) t = (int)atomicAdd(cnt, 1u); t = __builtin_amdgcn_readfirstlane(t); if (t >= ntask) break;
                if (t < 8192) attn_task<true>(PROJ, VT, VTC, rpb, t, lane2); else attn_task<false>(PROJ, VT, VTC, rpb, t - 8192, lane2); }
        } break;
        case 4: {
            SchedBranch S; S.so.init(nMall, 8, G, cu); S.proj = (const char*)PROJ; S.wbr = (const char*)(ws + WS_WBR);
            EpiBranch E{PROJ, (float*)(ws + WS_TMP), XN};
            pg8::gemm_phase<EpiBranch, SchedBranch>(lds, tid, INW, DM, S, E);
        } break;
        case 5: {
            SchedGrid S; S.so.init(nMall, 8, G, cu); S.A = (const char*)XN; S.B = (const char*)(ws + WS_WO); S.tsA = (size_t)256 * DM * 2; S.tsB = (size_t)256 * DM * 2; S.nt = 32; S.nextra = 0; S.ex_pm0 = 0; S.ex_pn0 = 0; S.ex_w = 1;
            EpiResid E{xlat, xctx, a.out, XC, mods_l + 4096};
            pg8::gemm_phase<EpiResid, SchedGrid>(lds, tid, DM, DM, S, E);
        } break;
        case 6: {
            norm_rows(a.out, XC, a.in[7] + (size_t)l * DM, mods_l, 6144, 8192, XN, nMall * 256, gw, NGW, lane);
        } break;
        case 7: {
            SchedGrid S; S.so.init(nMall, 44, G, cu); S.A = (const char*)XN; S.B = (const char*)(ws + WS_WUP); S.tsA = (size_t)256 * DM * 2; S.tsB = (size_t)256 * DM * 2; S.nt = 32; S.nextra = 0; S.ex_pm0 = 0; S.ex_pn0 = 0; S.ex_w = 1;
            EpiPlain E{PROJ, UPW};
            pg8::gemm_phase<EpiPlain, SchedGrid>(lds, tid, DM, DM, S, E);
        } break;
        case 8: {
            conv_items(PROJ, HMID, a.in[18] + (size_t)l * 3 * DFF, a.in[19] + (size_t)l * DFF, nMall * 256, cu * 512 + tid, G * 512);
        } break;
        case 9: {
            SchedGrid S; S.so.init(nMall, 8, G, cu); S.A = (const char*)HMID; S.B = (const char*)(ws + WS_WDN); S.tsA = (size_t)256 * DFF * 2; S.tsB = (size_t)256 * DFF * 2; S.nt = 88; S.nextra = 0; S.ex_pm0 = 0; S.ex_pn0 = 0; S.ex_w = 1;
            EpiResid E{a.out, XC, a.out, XC, mods_l + 10240};
            pg8::gemm_phase<EpiResid, SchedGrid>(lds, tid, DFF, DFF, S, E);
        } break;
        }
    }
}

extern "C" void kernel_launch(void* const* d_in, const int* in_sizes, int n_in, void* d_out, int out_size, void* d_ws, size_t ws_size, hipStream_t stream) {
    static int grid = 0;
    if (grid == 0) {
        if (n_in != 22 || ws_size < WS_END) { fprintf(stderr, "kernel_launch: unexpected n_in %d / ws_size %zu (need %zu)\n", n_in, ws_size, (size_t)WS_END); grid = -1; return; }
        int dev = 0, cus = 0, per_cu = 0;
        hipGetDevice(&dev); hipDeviceGetAttribute(&cus, hipDeviceAttributeMultiprocessorCount, dev);
        if (hipFuncSetAttribute((const void*)mega, hipFuncAttributeMaxDynamicSharedMemorySize, LDS_BYTES) != hipSuccess) { fprintf(stderr, "kernel_launch: hipFuncSetAttribute failed\n"); grid = -1; return; }
        hipOccupancyMaxActiveBlocksPerMultiprocessor(&per_cu, (const void*)mega, 512, LDS_BYTES);
        (void)hipGetLastError();
        if (per_cu < 1) fprintf(stderr, "kernel_launch: occupancy query says %d blocks/CU\n", per_cu);
        grid = cus > 0 ? cus : 256;
    }
    if (grid < 0) return;
    hipMemsetAsync((char*)d_ws + WS_CTL, 0, CTL_ZERO_BYTES, stream);
    Args a{};
    for (int i = 0; i < 22; ++i) a.in[i] = (const float*)d_in[i];
    a.out = (float*)d_out; a.ws = (unsigned char*)d_ws; a.ph_lo = 0; a.ph_hi = NPHASE;
    void* args[] = {&a};
    hipError_t e = hipLaunchCooperativeKernel((const void*)mega, dim3(grid), dim3(512), args, LDS_BYTES, stream);
    if (e != hipSuccess) fprintf(stderr, "kernel_launch: cooperative launch failed: %s (grid %d)\n", hipGetErrorString(e), grid);
}
```

```cpp
#include <hip/hip_runtime.h>
#include <hip/hip_cooperative_groups.h>
#include <cstdio>
#include <cstdint>
namespace cg = cooperative_groups;

#define LAS __attribute__((address_space(3)))
typedef unsigned short bf16_t;
typedef short bf16x8 __attribute__((ext_vector_type(8)));
typedef float f32x4 __attribute__((ext_vector_type(4)));
typedef float f32x2 __attribute__((ext_vector_type(2)));
typedef unsigned u32x4 __attribute__((ext_vector_type(4)));
typedef unsigned u32x2 __attribute__((ext_vector_type(2)));

constexpr int DM = 2048, MLAT = 16384, MT = 17408;
constexpr int INW = 10752, DFF = 5632, UPW = 11264;
constexpr int OFF_Q = 512, OFF_K = 1536, OFF_V = 2560, OFF_C = 3584, OFF_G = 4608;
constexpr float EPS = 1e-6f;
constexpr size_t MiB = 1u << 20;
constexpr size_t WS_CTL = 0;
constexpr size_t CTL_ZERO_BYTES = 1 * MiB;
constexpr size_t WS_MODS = 4096;
constexpr size_t WS_BAR = 512 * 1024;
constexpr size_t WS_DFTD = 1 * MiB;
constexpr size_t WS_XC = 2 * MiB;
constexpr size_t WS_WIN = 10 * MiB;
constexpr size_t WS_WBR = 52 * MiB;
constexpr size_t WS_WO = 60 * MiB;
constexpr size_t WS_WUP = 68 * MiB;
constexpr size_t WS_WDN = 112 * MiB;
constexpr size_t WS_XN = 134 * MiB;
constexpr size_t WS_BIG = 202 * MiB;
constexpr size_t WS_HMID = 576 * MiB;
constexpr size_t WS_ZBUF = WS_HMID;
constexpr size_t WS_TT = WS_HMID + 32 * MiB;
constexpr size_t WS_MA = WS_HMID + 36 * MiB;
constexpr size_t WS_U = WS_HMID + 64 * MiB;
constexpr size_t WS_VT = WS_HMID + 96 * MiB;
constexpr size_t WS_DFTC = WS_HMID + 128 * MiB;
constexpr size_t WS_PQTC = WS_HMID + 132 * MiB;
constexpr size_t WS_VTC = WS_HMID + 164 * MiB;
constexpr size_t WS_TMP = WS_HMID;
constexpr size_t WS_END = 763 * MiB;
constexpr int LDS_BYTES = 147456;

#define LDS_WAIT() asm volatile("s_waitcnt lgkmcnt(0)" ::: "memory")
__device__ __forceinline__ unsigned cvt_pk_bf16(float lo, float hi) { unsigned r; asm volatile("v_cvt_pk_bf16_f32 %0, %1, %2" : "=v"(r) : "v"(lo), "v"(hi)); return r; }
__device__ __forceinline__ int fresh_lane() { unsigned z; asm volatile("v_mov_b32 %0, 0" : "=v"(z)); return (int)__builtin_amdgcn_mbcnt_hi(~0u, __builtin_amdgcn_mbcnt_lo(~0u, z)); }
__device__ __forceinline__ float bf2f(unsigned short b) { return __uint_as_float((unsigned)b << 16); }
__device__ __forceinline__ float bflo(unsigned w) { return __uint_as_float(w << 16); }
__device__ __forceinline__ float bfhi(unsigned w) { return __uint_as_float(w & 0xffff0000u); }
__device__ __forceinline__ float shx(float v, int o, int lane) { return __int_as_float(__builtin_amdgcn_ds_bpermute((lane ^ o) << 2, __float_as_int(v))); }
__device__ __forceinline__ float wave_sum(float v, int lane) {
#pragma unroll
    for (int o = 1; o < 64; o <<= 1) v += shx(v, o, lane);
    return v;
}
__device__ __forceinline__ float fsigmoid(float x) { return __builtin_amdgcn_rcpf(1.0f + __builtin_amdgcn_exp2f(-1.44269504089f * x)); }
__device__ __forceinline__ float fsilu(float x) { return x * fsigmoid(x); }
__device__ __forceinline__ f32x2 gelu_pk(f32x2 v) {
    const f32x2 av = __builtin_elementwise_abs(v), d = av * 0.2316418882f + 1.0f;
    f32x2 t; t.x = __builtin_amdgcn_rcpf(d.x); t.y = __builtin_amdgcn_rcpf(d.y);
    f32x2 q = t * 0.5307027145f + (-0.7265760135f); q = q * t + 0.7107068705f; q = q * t + (-0.142248368f); q = q * t + 0.127414796f; q = q * t;
    const f32x2 s = (v * v) * (-0.72134752044f);
    f32x2 e; e.x = __builtin_amdgcn_exp2f(s.x); e.y = __builtin_amdgcn_exp2f(s.y);
    const f32x2 m = v * (q * e), r = v - m;
    f32x2 o; o.x = v.x < 0.f ? m.x : r.x; o.y = v.y < 0.f ? m.y : r.y; return o;
}

namespace pg8 {
constexpr int BM = 256, BK = 64, HALF = 128, HTB = HALF * BK * 2, STAGE_BYTES = 8 * HTB, NXCD = 8, WGM = 8;
__host__ __device__ __forceinline__ int lds_byte(int r, int c) { const int st = (r >> 4) * 2 + (c >> 5), rr = r & 15, cc = c & 31, ob = rr * 64 + cc * 2; return st * 1024 + (ob ^ (((ob >> 9) & 1) << 5)); }
__host__ __device__ __forceinline__ void stage_rc(int b, int& R, int& C) { const int st = b / 1024, sb = b % 1024, swz = sb ^ (((sb >> 9) & 1) << 5); R = (st >> 1) * 16 + swz / 64; C = (st & 1) * 32 + (swz % 64) / 2; }
__host__ __device__ __forceinline__ int perm32(int rho) { const int n = rho >> 4, i = rho & 15; return 8 * (i >> 2) + 4 * n + (i & 3); }

struct Unit { const char* A; const char* B; int nt, pm, pn, aux; };

struct StaticOrder {
    int nM, nN, nwg, G, c;
    __device__ void init(int nM_, int nN_, int G_, int c_) { nM = nM_; nN = nN_; nwg = nM * nN; G = G_; c = c_; }
    __device__ bool next(int i, int& pm, int& pn) const {
        const long L = (long)i * G + c; if (L >= nwg) return false;
        int wgid = (int)L; { const int q = nwg / NXCD, r = nwg % NXCD, xcd = wgid % NXCD, off = wgid / NXCD; wgid = (xcd < r ? xcd * (q + 1) : r * (q + 1) + (xcd - r) * q) + off; }
        const int nig = WGM * nN, gid = wgid / nig, fm = gid * WGM, gsz = (nM - fm) < WGM ? (nM - fm) : WGM;
        pm = fm + ((wgid % nig) % gsz); pn = (wgid % nig) / gsz; return true;
    }
};

template <class Epi, class Sched>
__device__ __forceinline__ void gemm_phase(LAS unsigned char* lds, const int tid, const int lda, const int ldb, const Sched& S, const Epi& E) {
    const int wid = __builtin_amdgcn_readfirstlane(tid >> 6), lane = tid & 63, wr = wid >> 2, wc = wid & 3, fr = lane & 15, fq = lane >> 4;
    unsigned voffA[2], voffB[2];
#pragma unroll
    for (int i = 0; i < 2; ++i) { int R, C; stage_rc(tid * 16 + i * 8192, R, C); const int Rb = Epi::PERM ? ((R & ~31) + perm32(R & 31)) : R;
        voffA[i] = (unsigned)(R * lda + C) * 2u; voffB[i] = (unsigned)(Sched::brow(Rb) * ldb + C) * 2u; }
    const size_t kstep = (size_t)(BK * 2);
    const size_t hstepA = (size_t)HALF * lda * 2, hstepB = (size_t)Sched::BH * ldb * 2;
    const unsigned ldsw = (unsigned)wid * 1024u;
    const int aoff = lds_byte(wr * 64 + fr, fq * 8), boff = lds_byte(wc * 32 + fr, fq * 8);
#define PG8_SA(b, h) (((b) * 2 + (h)) * HTB)
#define PG8_SB(b, h) ((4 + (b) * 2 + (h)) * HTB)
#define PG8_STAGE(bufoff, gbase, voff) do { _Pragma("unroll") for (int _i = 0; _i < 2; ++_i) \
        __builtin_amdgcn_global_load_lds((const unsigned*)((const char*)(gbase) + (voff)[_i]), (LAS unsigned*)(lds + (bufoff) + ldsw + _i * 8192), 16, 0, 0); } while (0)
#define PG8_LDA(dst, b, h) do { _Pragma("unroll") for (int m = 0; m < 4; ++m) _Pragma("unroll") for (int k = 0; k < 2; ++k) dst[m][k] = *(const LAS bf16x8*)(lds + PG8_SA(b, h) + aoff + m * 2048 + k * 1024); } while (0)
#define PG8_LDB(dst, b, h) do { _Pragma("unroll") for (int n = 0; n < 2; ++n) _Pragma("unroll") for (int k = 0; k < 2; ++k) dst[n][k] = *(const LAS bf16x8*)(lds + PG8_SB(b, h) + boff + n * 2048 + k * 1024); } while (0)
#define PG8_MMA(ai, bj, At, Bt) do { __builtin_amdgcn_s_setprio(1); _Pragma("unroll") for (int m = 0; m < 4; ++m) _Pragma("unroll") for (int n = 0; n < 2; ++n) _Pragma("unroll") for (int k = 0; k < 2; ++k) \
        acc[ai][bj][m][n] = __builtin_amdgcn_mfma_f32_16x16x32_bf16(Bt[n][k], At[m][k], acc[ai][bj][m][n], 0, 0, 0); __builtin_amdgcn_s_setprio(0); } while (0)
#define PG8_WAIT_V(n) asm volatile("s_waitcnt vmcnt(" #n ")" ::: "memory")
#define PG8_WAIT_L(n) asm volatile("s_waitcnt lgkmcnt(" #n ")" ::: "memory")
#define PG8_BAR __builtin_amdgcn_s_barrier()
#define PG8_SCHED __builtin_amdgcn_sched_barrier(0)
    Unit cur, nxt; int ui = 0;
    if (!S.next(0, cur)) return;
    f32x4 acc[2][2][4][2];
#pragma unroll
    for (int a = 0; a < 2; ++a)
#pragma unroll
        for (int b = 0; b < 2; ++b)
#pragma unroll
            for (int m = 0; m < 4; ++m)
#pragma unroll
                for (int n = 0; n < 2; ++n) acc[a][b][m][n] = (f32x4){0.f, 0.f, 0.f, 0.f};
    bf16x8 At[4][2], B0[2][2], B1[2][2];
    const char* cA = cur.A; const char* cB = cur.B;
    {
        PG8_STAGE(PG8_SB(0, 0), cB, voffB); PG8_STAGE(PG8_SB(0, 1), cB + hstepB, voffB); PG8_STAGE(PG8_SA(0, 0), cA, voffA); PG8_STAGE(PG8_SA(0, 1), cA + hstepA, voffA);
        if (wr == 1) PG8_BAR;
        PG8_WAIT_V(2); PG8_BAR;
        PG8_STAGE(PG8_SB(1, 0), cB + kstep, voffB); PG8_STAGE(PG8_SA(1, 0), cA + kstep, voffA); PG8_STAGE(PG8_SB(1, 1), cB + hstepB + kstep, voffB);
        PG8_WAIT_V(6); PG8_BAR;
    }
    for (;;) {
        const bool has_next = S.next(ui + 1, nxt);
        const char* nA = has_next ? nxt.A : cA; const char* nB = has_next ? nxt.B : cB;
        const int nt = cur.nt;
        for (int t = 0; t < nt; t += 2) {
            const bool last = (t == nt - 2);
            const char* a1 = cA + (size_t)(t + 1) * kstep;
            const char* a2 = last ? nA : cA + (size_t)(t + 2) * kstep; const char* b2 = last ? nB : cB + (size_t)(t + 2) * kstep;
            const char* a3 = a2 + kstep; const char* b3 = b2 + kstep;
            PG8_LDB(B0, 0, 0); PG8_LDB(B1, 0, 1); PG8_SCHED; PG8_LDA(At, 0, 0); PG8_STAGE(PG8_SA(1, 1), a1 + hstepA, voffA);
            PG8_WAIT_V(8); PG8_WAIT_L(0); PG8_BAR; PG8_MMA(0, 0, At, B0); PG8_MMA(0, 1, At, B1); PG8_BAR; PG8_SCHED;
            PG8_LDA(At, 0, 1); PG8_STAGE(PG8_SB(0, 0), b2, voffB); PG8_STAGE(PG8_SB(0, 1), b2 + hstepB, voffB); PG8_STAGE(PG8_SA(0, 0), a2, voffA);
            PG8_WAIT_V(8); PG8_WAIT_L(0); PG8_BAR; PG8_MMA(1, 0, At, B0); PG8_MMA(1, 1, At, B1); PG8_BAR; PG8_SCHED;
            PG8_LDB(B0, 1, 0); PG8_LDB(B1, 1, 1); PG8_SCHED; PG8_LDA(At, 1, 0); PG8_STAGE(PG8_SA(0, 1), a2 + hstepA, voffA);
            PG8_WAIT_V(8); PG8_WAIT_L(0); PG8_BAR; PG8_MMA(0, 0, At, B0); PG8_MMA(0, 1, At, B1); PG8_BAR; PG8_SCHED;
            PG8_LDA(At, 1, 1); PG8_STAGE(PG8_SB(1, 0), b3, voffB); PG8_STAGE(PG8_SB(1, 1), b3 + hstepB, voffB); PG8_STAGE(PG8_SA(1, 0), a3, voffA);
            PG8_WAIT_V(8); PG8_WAIT_L(0); PG8_BAR; PG8_MMA(1, 0, At, B0); PG8_MMA(1, 1, At, B1); PG8_BAR; PG8_SCHED;
        }
        if (wr == 0) PG8_BAR;
        E(acc, cur, wr, wc);
        if (!has_next) break;
        if (!Epi::CHAIN || cur.aux == 2) {
#pragma unroll
        for (int a = 0; a < 2; ++a)
#pragma unroll
            for (int b = 0; b < 2; ++b)
#pragma unroll
                for (int m = 0; m < 4; ++m)
#pragma unroll
                    for (int n = 0; n < 2; ++n) acc[a][b][m][n] = (f32x4){0.f, 0.f, 0.f, 0.f};
        }
        cur = nxt; cA = nA; cB = nB; ++ui;
        if (wr == 1) PG8_BAR;
    }
    PG8_WAIT_V(0);
    PG8_BAR;
#undef PG8_SA
#undef PG8_SB
#undef PG8_STAGE
#undef PG8_LDA
#undef PG8_LDB
#undef PG8_MMA
#undef PG8_WAIT_V
#undef PG8_WAIT_L
#undef PG8_BAR
#undef PG8_SCHED
}
}
using pg8::Unit;
typedef const f32x4 (&AccRef)[2][2][4][2];

struct SchedGrid {
    static __device__ __forceinline__ int brow(int r) { return r; } static constexpr int BH = 128;
    pg8::StaticOrder so; const char* A; const char* B; size_t tsA, tsB; int nt, nextra, ex_pm0, ex_pn0, ex_w, ex_ks;
    __device__ __forceinline__ bool next(int i, Unit& u) const {
        int pm, pn; int kp = 0, ntu = nt, aux = 0;
        if (!so.next(i, pm, pn)) { const long e = (long)i * so.G + so.c - so.nwg; if (e >= nextra) return false; const int te = (int)e / ex_ks; kp = (int)e % ex_ks; ntu = nt / ex_ks; aux = ex_ks > 1 ? 1 : 0;
            pm = ex_pm0 + te / ex_w; pn = ex_pn0 + te % ex_w; }
        u.A = A + (size_t)pm * tsA + (size_t)kp * ntu * 128; u.B = B + (size_t)pn * tsB + (size_t)kp * ntu * 128; u.nt = ntu; u.pm = pm; u.pn = pn; u.aux = aux; return true;
    }
};
struct SchedBranch {
    static __device__ __forceinline__ int brow(int r) { return r; } static constexpr int BH = 128;
    pg8::StaticOrder so; const char* proj; const char* wbr;
    __device__ __forceinline__ bool next(int i, Unit& u) const {
        int pm, pn; if (!so.next(i / 3, pm, pn)) return false;
        const int br = i % 3; const int acol = br == 0 ? 0 : (br == 1 ? OFF_Q : OFF_C), koff = br == 0 ? 0 : (br == 1 ? 512 : 1536);
        u.A = proj + ((size_t)pm * 256 * INW + acol) * 2; u.B = wbr + ((size_t)pn * 256 * DM + koff) * 2; u.nt = br == 1 ? 16 : 8; u.pm = pm; u.pn = pn; u.aux = br; return true;
    }
};
struct SchedF1L {
    static __device__ __forceinline__ int brow(int r) { return (r >> 6) + 64 * (r & 63); } static constexpr int BH = 2;
    const char* dftd; const char* proj; int G, c;
    __device__ __forceinline__ bool next(int i, Unit& u) const {
        const int L = i * G + c; if (L >= 256) return false;
        { const char* ap = dftd; asm volatile("" : "+s"(ap)); u.A = ap; } u.nt = 2; u.pm = 0;
        const int b = L >> 6, g = (L >> 4) & 3, pn = L & 15; u.B = proj + ((size_t)(b * 4096 + 4 * pn) * INW + g * 128) * 2; u.pn = pn; u.aux = b * 4 + g; return true;
    }
};
struct SchedF1 {
    static __device__ __forceinline__ int brow(int r) { return r; } static constexpr int BH = 128;
    const char* dftd; const char* proj; int G, c, nctx;
    __device__ __forceinline__ bool next(int i, Unit& u) const {
        const int e = i * G + c; if (e >= nctx) return false;
        { const char* ap = dftd; asm volatile("" : "+s"(ap)); u.A = ap; } u.nt = 2; u.pm = 0;
        const int b = e >> 2, g = e & 3; u.B = proj + ((size_t)(MLAT + b * 256) * INW + g * 128) * 2; u.pn = 0; u.aux = 16 + b * 4 + g; return true;
    }
};
struct SchedF2 {
    static __device__ __forceinline__ int brow(int r) { return r; } static constexpr int BH = 128;
    const char* dftc; const char* pqtc; int G, c, nctx;
    __device__ __forceinline__ bool next(int i, Unit& u) const {
        const int e = i * G + c; if (e >= nctx) return false;
        const int b = e >> 1, pn = e & 1; { const char* ap = dftc; asm volatile("" : "+s"(ap)); u.A = ap; } u.B = pqtc + (size_t)(b * 512 + pn * 256) * 8192 * 2; u.nt = 8; u.pm = 0; u.pn = pn; u.aux = 4 + b; return true;
    }
};
struct SchedFA {
    static __device__ __forceinline__ int brow(int r) { return r; } static constexpr int BH = 128;
    const char* ma; const char* ub; int G, c;
    __device__ __forceinline__ bool next(int i, Unit& u) const {
        const int L = i * G + c; if (L >= 512) return false;
        { const char* ap = ma; asm volatile("" : "+s"(ap)); u.A = ap; } u.B = ub + (size_t)L * 256 * 128 * 2; u.nt = 2; u.pm = 0; u.pn = L; u.aux = 0; return true;
    }
};
struct SchedFB {
    static __device__ __forceinline__ int brow(int r) { return r; } static constexpr int BH = 128;
    const char* tt; const char* zb; int G, c;
    __device__ __forceinline__ bool next(int i, Unit& u) const {
        const int L = i * G + c; if (L >= 512) return false;
        const int k2 = L >> 3, pn = L & 7; u.A = tt + (size_t)k2 * 256 * 128 * 2; u.B = zb + ((size_t)k2 * 2048 + pn * 256) * 128 * 2; u.nt = 2; u.pm = 0; u.pn = pn; u.aux = k2; return true;
    }
};

struct EpiInProj {
    static constexpr bool PERM = true, CHAIN = false;
    bf16_t* proj; bf16_t* vt; bf16_t* vtc;
    __device__ __forceinline__ void operator()(AccRef acc, const Unit& u, int wr, int wc) const {
        const int ln_ = fresh_lane(), fr = ln_ & 15, fq = ln_ >> 4;
        const int pm = u.pm, pn = u.pn; const int row0 = pm * 256 + wr * 64 + fr, col0 = pn * 256 + wc * 32 + 8 * fq;
        if (pn >= 10 && pn < 14) {
            const int vc0 = col0 - OFF_V;
#pragma unroll
            for (int ai = 0; ai < 2; ++ai)
#pragma unroll
                for (int m = 0; m < 4; ++m) {
                    const int row = row0 + ai * 128 + m * 16; bf16_t* dst; size_t stride;
                    if (pm < 64) { const int b = pm >> 4; dst = vt + (size_t)b * 1024 * 4096 + (row - b * 4096); stride = 4096; }
                    else { const int b = pm - 64; dst = vtc + (size_t)b * 1024 * 256 + (row - MLAT - b * 256); stride = 256; }
#pragma unroll
                    for (int bj = 0; bj < 2; ++bj)
#pragma unroll
                        for (int n = 0; n < 2; ++n) { const f32x4 v = acc[ai][bj][m][n]; const unsigned w0 = cvt_pk_bf16(v[0], v[1]), w1 = cvt_pk_bf16(v[2], v[3]);
                            bf16_t* d = dst + (size_t)(vc0 + bj * 128 + n * 4) * stride;
                            d[0] = (bf16_t)(w0 & 0xffffu); d[stride] = (bf16_t)(w0 >> 16); d[2 * stride] = (bf16_t)(w1 & 0xffffu); d[3 * stride] = (bf16_t)(w1 >> 16); }
                }
            return;
        }
        const int act = pn < 14 ? 0 : (pn < 18 ? 1 : 2); const float sc = (pn >= 2 && pn < 6) ? 0.08838834764831845f : 1.0f;
#pragma unroll
        for (int ai = 0; ai < 2; ++ai)
#pragma unroll
            for (int m = 0; m < 4; ++m) { bf16_t* rowp = proj + (size_t)(row0 + ai * 128 + m * 16) * INW + col0;
#pragma unroll
                for (int bj = 0; bj < 2; ++bj) { f32x4 v0 = acc[ai][bj][m][0], v1 = acc[ai][bj][m][1];
                    if (act == 1) { f32x2 a = gelu_pk((f32x2){v0[0], v0[1]}), b = gelu_pk((f32x2){v0[2], v0[3]}), c = gelu_pk((f32x2){v1[0], v1[1]}), d = gelu_pk((f32x2){v1[2], v1[3]});
                        v0 = (f32x4){a.x, a.y, b.x, b.y}; v1 = (f32x4){c.x, c.y, d.x, d.y}; }
                    else if (act == 2) { v0 = (f32x4){fsigmoid(v0[0]), fsigmoid(v0[1]), fsigmoid(v0[2]), fsigmoid(v0[3])}; v1 = (f32x4){fsigmoid(v1[0]), fsigmoid(v1[1]), fsigmoid(v1[2]), fsigmoid(v1[3])}; }
                    else { v0 = v0 * sc; v1 = v1 * sc; }
                    u32x4 w; w.x = cvt_pk_bf16(v0[0], v0[1]); w.y = cvt_pk_bf16(v0[2], v0[3]); w.z = cvt_pk_bf16(v1[0], v1[1]); w.w = cvt_pk_bf16(v1[2], v1[3]);
                    *(u32x4*)(rowp + bj * 128) = w; } }
    }
};
struct EpiPlain {
    static constexpr bool PERM = true, CHAIN = false;
    bf16_t* out; int ld;
    __device__ __forceinline__ void operator()(AccRef acc, const Unit& u, int wr, int wc) const {
        const int ln_ = fresh_lane(), fr = ln_ & 15, fq = ln_ >> 4;
        const int row0 = u.pm * 256 + wr * 64 + fr, col0 = u.pn * 256 + wc * 32 + 8 * fq;
#pragma unroll
        for (int ai = 0; ai < 2; ++ai)
#pragma unroll
            for (int m = 0; m < 4; ++m) { bf16_t* rowp = out + (size_t)(row0 + ai * 128 + m * 16) * ld + col0;
#pragma unroll
                for (int bj = 0; bj < 2; ++bj) { const f32x4 v0 = acc[ai][bj][m][0], v1 = acc[ai][bj][m][1];
                    u32x4 w; w.x = cvt_pk_bf16(v0[0], v0[1]); w.y = cvt_pk_bf16(v0[2], v0[3]); w.z = cvt_pk_bf16(v1[0], v1[1]); w.w = cvt_pk_bf16(v1[2], v1[3]);
                    *(u32x4*)(rowp + bj * 128) = w; } }
    }
};
struct EpiF1 {
    static constexpr bool PERM = true, CHAIN = false;
    bf16_t* pqt; bf16_t* pqtc;
    __device__ __forceinline__ void operator()(AccRef acc, const Unit& u, int wr, int wc) const {
        const int ln_ = fresh_lane(), fr = ln_ & 15, fq = ln_ >> 4;
        const int aux = u.aux; const bool isc = aux >= 16; const int bg = aux & 15, b = bg >> 2, g = bg & 3;
        bf16_t* base = (isc ? pqtc : pqt) + (size_t)(b * 512 + g * 128) * 8192; const int half = isc ? 256 : 4096;
        const int n0 = u.pn * 256 + wc * 32 + 8 * fq;
#pragma unroll
        for (int ai = 0; ai < 2; ++ai)
#pragma unroll
            for (int m = 0; m < 4; ++m) { bf16_t* rowp = base + (size_t)(wr * 64 + m * 16 + fr) * 8192 + ai * half + n0;
#pragma unroll
                for (int bj = 0; bj < 2; ++bj) { const f32x4 v0 = acc[ai][bj][m][0], v1 = acc[ai][bj][m][1];
                    u32x4 w; w.x = cvt_pk_bf16(v0[0], v0[1]); w.y = cvt_pk_bf16(v0[2], v0[3]); w.z = cvt_pk_bf16(v1[0], v1[1]); w.w = cvt_pk_bf16(v1[2], v1[3]);
                    *(u32x4*)(rowp + bj * 128) = w; } }
    }
};
struct EpiF1L {
    static constexpr bool PERM = true, CHAIN = false;
    bf16_t* ub;
    __device__ __forceinline__ void operator()(AccRef acc, const Unit& u, int wr, int wc) const {
        const int ln_ = fresh_lane(), fr = ln_ & 15, fq = ln_ >> 4;
        const int b = u.aux >> 2, g = u.aux & 3;
#pragma unroll
        for (int ai = 0; ai < 2; ++ai)
#pragma unroll
            for (int m = 0; m < 4; ++m) { const int ch = b * 512 + g * 128 + wr * 64 + m * 16 + fr;
#pragma unroll
                for (int bj = 0; bj < 2; ++bj) { const int n1 = 4 * u.pn + 2 * bj + (wc >> 1), n2 = 32 * (wc & 1) + 8 * fq;
                    const f32x4 v0 = acc[ai][bj][m][0], v1 = acc[ai][bj][m][1];
                    u32x4 w; w.x = cvt_pk_bf16(v0[0], v0[1]); w.y = cvt_pk_bf16(v0[2], v0[3]); w.z = cvt_pk_bf16(v1[0], v1[1]); w.w = cvt_pk_bf16(v1[2], v1[3]);
                    *(u32x4*)(ub + ((size_t)ch * 64 + n1) * 128 + ai * 64 + n2) = w; } }
    }
};
struct EpiFA {
    static constexpr bool PERM = true, CHAIN = false;
    bf16_t* zb;
    __device__ __forceinline__ void operator()(AccRef acc, const Unit& u, int wr, int wc) const {
        if (wr != 0) return;
        const int ln_ = fresh_lane(), fr = ln_ & 15, fq = ln_ >> 4;
#pragma unroll
        for (int ai = 0; ai < 2; ++ai)
#pragma unroll
            for (int m = 0; m < 4; ++m) { const int k2 = m * 16 + fr;
#pragma unroll
                for (int bj = 0; bj < 2; ++bj) { const int bc = u.pn * 4 + 2 * bj + (wc >> 1), n1 = 32 * (wc & 1) + 8 * fq;
                    const f32x4 v0 = acc[ai][bj][m][0], v1 = acc[ai][bj][m][1];
                    u32x4 w; w.x = cvt_pk_bf16(v0[0], v0[1]); w.y = cvt_pk_bf16(v0[2], v0[3]); w.z = cvt_pk_bf16(v1[0], v1[1]); w.w = cvt_pk_bf16(v1[2], v1[3]);
                    *(u32x4*)(zb + ((size_t)k2 * 2048 + bc) * 128 + ai * 64 + n1) = w; } }
    }
};
struct EpiFB {
    static constexpr bool PERM = true, CHAIN = false;
    bf16_t* proj;
    __device__ __forceinline__ void operator()(AccRef acc, const Unit& u, int wr, int wc) const {
        if (wr != 0) return;
        const int ln_ = fresh_lane(), fr = ln_ & 15, fq = ln_ >> 4;
        const float sc = 0.0013810679320049757f; const int k2 = u.aux;
#pragma unroll
        for (int m = 0; m < 4; ++m) { const int k = 64 * (m * 16 + fr) + k2;
#pragma unroll
            for (int bj = 0; bj < 2; ++bj) { const int ncol = u.pn * 256 + 128 * bj + 32 * wc + 8 * fq; const int b = ncol >> 9, ch = ncol & 511;
                const f32x4 v0 = acc[0][bj][m][0] * sc, v1 = acc[0][bj][m][1] * sc;
                u32x4 w; w.x = cvt_pk_bf16(v0[0], v0[1]); w.y = cvt_pk_bf16(v0[2], v0[3]); w.z = cvt_pk_bf16(v1[0], v1[1]); w.w = cvt_pk_bf16(v1[2], v1[3]);
                *(u32x4*)(proj + (size_t)(b * 4096 + k) * INW + ch) = w; } }
    }
};
struct EpiF2 {
    static constexpr bool PERM = true, CHAIN = false;
    bf16_t* proj;
    __device__ __forceinline__ void operator()(AccRef acc, const Unit& u, int wr, int wc) const {
        const int ln_ = fresh_lane(), fr = ln_ & 15, fq = ln_ >> 4;
        const int aux = u.aux; const bool isc = aux >= 4; const int rowbase = isc ? MLAT + (aux - 4) * 256 : aux * 4096;
        const float sc = isc ? 0.005524271728019903f : 0.0013810679320049757f;
        const int row0 = rowbase + u.pm * 256 + wr * 64 + fr, col0 = u.pn * 256 + wc * 32 + 8 * fq;
#pragma unroll
        for (int ai = 0; ai < 2; ++ai)
#pragma unroll
            for (int m = 0; m < 4; ++m) { bf16_t* rowp = proj + (size_t)(row0 + ai * 128 + m * 16) * INW + col0;
#pragma unroll
                for (int bj = 0; bj < 2; ++bj) { const f32x4 v0 = acc[ai][bj][m][0] * sc, v1 = acc[ai][bj][m][1] * sc;
                    u32x4 w; w.x = cvt_pk_bf16(v0[0], v0[1]); w.y = cvt_pk_bf16(v0[2], v0[3]); w.z = cvt_pk_bf16(v1[0], v1[1]); w.w = cvt_pk_bf16(v1[2], v1[3]);
                    *(u32x4*)(rowp + bj * 128) = w; } }
    }
};
typedef f32x4 (&AccMut)[2][2][4][2];
struct EpiBranch {
    static constexpr bool PERM = false, CHAIN = true;
    const bf16_t* proj; bf16_t* merged;
    __device__ __forceinline__ void operator()(AccMut acc, const Unit& u, int wr, int wc) const {
        const int ln_ = fresh_lane(), fr = ln_ & 15, fq = ln_ >> 4;
        const int br = u.aux; const int col0 = u.pn * 256 + wc * 32 + 4 * fq;
#pragma unroll
        for (int ai = 0; ai < 2; ++ai)
#pragma unroll
            for (int m = 0; m < 4; ++m) { const size_t row = (size_t)(u.pm * 256 + ai * 128 + wr * 64 + m * 16 + fr);
#pragma unroll
                for (int bj = 0; bj < 2; ++bj)
#pragma unroll
                    for (int n = 0; n < 2; ++n) { const int col = col0 + bj * 128 + n * 16;
                        const bf16_t* gp = proj + row * INW + OFF_G + br * DM + col;
                        const u32x2 gw = *(const u32x2*)gp; const f32x4 g = (f32x4){bflo(gw.x), bfhi(gw.x), bflo(gw.y), bfhi(gw.y)};
                        if (br < 2) { const u32x2 hw = *(const u32x2*)(gp + DM);
                            const f32x4 r = (f32x4){__builtin_amdgcn_rcpf(fmaxf(bflo(hw.x), 1e-30f)), __builtin_amdgcn_rcpf(fmaxf(bfhi(hw.x), 1e-30f)), __builtin_amdgcn_rcpf(fmaxf(bflo(hw.y), 1e-30f)), __builtin_amdgcn_rcpf(fmaxf(bfhi(hw.y), 1e-30f))};
                            acc[ai][bj][m][n] = acc[ai][bj][m][n] * (g * r); }
                        else { const f32x4 v = acc[ai][bj][m][n] * g; u32x2 w; w.x = cvt_pk_bf16(v[0], v[1]); w.y = cvt_pk_bf16(v[2], v[3]); *(u32x2*)(merged + row * DM + col) = w; } } }
    }
};
struct EpiResid {
    static constexpr bool PERM = false, CHAIN = false;
    const float* src_lat; const float* src_ctx; float* dst_lat; float* dst_ctx; const float* gate;
    __device__ __forceinline__ void operator()(AccRef acc, const Unit& u, int wr, int wc) const {
        const int ln_ = fresh_lane(), fr = ln_ & 15, fq = ln_ >> 4;
        const int pm = u.pm; const int b = pm < 64 ? (pm >> 4) : 4; const float* g = gate + (size_t)b * 12288; const int col0 = u.pn * 256 + wc * 32 + 4 * fq;
        const float* s0 = pm < 64 ? src_lat + (size_t)pm * 256 * DM : src_ctx + (size_t)(pm - 64) * 256 * DM;
        float* d0 = pm < 64 ? dst_lat + (size_t)pm * 256 * DM : dst_ctx + (size_t)(pm - 64) * 256 * DM;
        f32x4 gv[2][2];
#pragma unroll
        for (int bj = 0; bj < 2; ++bj)
#pragma unroll
            for (int n = 0; n < 2; ++n) gv[bj][n] = *(const f32x4*)(g + col0 + bj * 128 + n * 16);
#pragma unroll
        for (int ai = 0; ai < 2; ++ai)
#pragma unroll
            for (int m = 0; m < 4; ++m) { const size_t ro = (size_t)(ai * 128 + wr * 64 + m * 16 + fr) * DM;
#pragma unroll
                for (int bj = 0; bj < 2; ++bj)
#pragma unroll
                    for (int n = 0; n < 2; ++n) { const int col = col0 + bj * 128 + n * 16;
                        if (u.aux) { const f32x4 v = gv[bj][n] * acc[ai][bj][m][n]; float* d = d0 + ro + col;
                            unsafeAtomicAdd(d, v[0]); unsafeAtomicAdd(d + 1, v[1]); unsafeAtomicAdd(d + 2, v[2]); unsafeAtomicAdd(d + 3, v[3]); }
                        else *(f32x4*)(d0 + ro + col) = *(const f32x4*)(s0 + ro + col) + gv[bj][n] * acc[ai][bj][m][n]; } }
    }
};

struct Args { const float* in[22]; float* out; unsigned char* ws; int ph_lo, ph_hi; };

__device__ __forceinline__ void transpose_item(const float* W, int N, bf16_t* WT, int ldk, int koff, LAS float* scr, int item, int lane) {
    const int nblk = N / 32, kb = item / nblk, nb = item % nblk, k0 = 64 * kb, n0 = 32 * nb;
#pragma unroll 8
    for (int i = 0; i < 32; ++i) { const int kk = 2 * i + (lane >> 5); scr[kk * 33 + (lane & 31)] = W[(size_t)(k0 + kk) * N + n0 + (lane & 31)]; }
    LDS_WAIT(); asm volatile("" ::: "memory");
    const int c = lane & 7;
#pragma unroll
    for (int j = 0; j < 4; ++j) { const int n = (lane >> 3) + 8 * j; const LAS float* s = scr + (8 * c) * 33 + n;
        u32x4 o; o.x = cvt_pk_bf16(s[0 * 33], s[1 * 33]); o.y = cvt_pk_bf16(s[2 * 33], s[3 * 33]); o.z = cvt_pk_bf16(s[4 * 33], s[5 * 33]); o.w = cvt_pk_bf16(s[6 * 33], s[7 * 33]);
        *(u32x4*)(WT + (size_t)(n0 + n) * ldk + koff + k0 + 8 * c) = o; }
    LDS_WAIT(); asm volatile("" ::: "memory");
}
template <class AR>
__device__ __forceinline__ void convert_weights(const AR& a, int l, LAS float* scr, int gw, int NGW, int lane) {
    unsigned char* ws = a.ws;
    const float* w_in = a.in[8] + (size_t)l * DM * INW; const float* w_f = a.in[13] + (size_t)l * 512 * DM; const float* w_na = a.in[14] + (size_t)l * 1024 * DM;
    const float* w_c = a.in[15] + (size_t)l * 512 * DM; const float* w_o = a.in[16] + (size_t)l * DM * DM; const float* w_up = a.in[17] + (size_t)l * DM * UPW; const float* w_dn = a.in[20] + (size_t)l * DFF * DM;
    constexpr int I_IN = 32 * 336, I_F = 8 * 64, I_NA = 16 * 64, I_C = 8 * 64, I_O = 32 * 64, I_UP = 32 * 352, I_DN = 88 * 64;
    constexpr int NITEMS = I_IN + I_F + I_NA + I_C + I_O + I_UP + I_DN;
    for (int it = gw; it < NITEMS; it += NGW) {
        int r = it;
        if (r < I_IN) { transpose_item(w_in, INW, (bf16_t*)(ws + WS_WIN), DM, 0, scr, r, lane); continue; } r -= I_IN;
        if (r < I_F) { transpose_item(w_f, DM, (bf16_t*)(ws + WS_WBR), DM, 0, scr, r, lane); continue; } r -= I_F;
        if (r < I_NA) { transpose_item(w_na, DM, (bf16_t*)(ws + WS_WBR), DM, 512, scr, r, lane); continue; } r -= I_NA;
        if (r < I_C) { transpose_item(w_c, DM, (bf16_t*)(ws + WS_WBR), DM, 1536, scr, r, lane); continue; } r -= I_C;
        if (r < I_O) { transpose_item(w_o, DM, (bf16_t*)(ws + WS_WO), DM, 0, scr, r, lane); continue; } r -= I_O;
        if (r < I_UP) { transpose_item(w_up, UPW, (bf16_t*)(ws + WS_WUP), DM, 0, scr, r, lane); continue; } r -= I_UP;
        transpose_item(w_dn, DM, (bf16_t*)(ws + WS_WDN), DFF, 0, scr, r, lane);
    }
}
__device__ __forceinline__ void dft_tables(unsigned char* ws, const LAS float* lut, int gw, int NGW, int lane) {
    bf16_t* tt = (bf16_t*)(ws + WS_TT); bf16_t* ma = (bf16_t*)(ws + WS_MA); bf16_t* dftc = (bf16_t*)(ws + WS_DFTC);
    const int half = lane >> 5, x0 = (lane & 31) * 2;
    for (int it = gw; it < 16384 + 256 + 256; it += NGW) {
        if (it < 16384) { const int k2 = it >> 8, k1 = it & 255; float v0 = 0.f, v1 = 0.f;
            if (k1 < 64) { const int k = 64 * k1 + k2, sh = half ? 3072 : 0;
                v0 = lut[(x0 * k + sh) & 4095]; v1 = lut[((x0 + 1) * k + sh) & 4095]; }
            *(unsigned*)(tt + (size_t)it * 128 + half * 64 + x0) = cvt_pk_bf16(v0, v1);
        } else if (it < 16384 + 256) { const int r = it - 16384; float v0 = 0.f, v1 = 0.f;
            if ((r & 64) == 0) { const int k2 = r & 63, im = r >> 7;
                const int sh = im ? (half ? 2048 : 1024) : (half ? 1024 : 0);
                v0 = lut[(((x0 * k2) & 63) * 64 + sh) & 4095]; v1 = lut[((((x0 + 1) * k2) & 63) * 64 + sh) & 4095]; }
            *(unsigned*)(ma + (size_t)r * 128 + half * 64 + x0) = cvt_pk_bf16(v0, v1);
        } else { const int k = it - 16384 - 256; const int n0 = lane * 8; const int nn = n0 & 255, sh = n0 >= 256 ? 1024 : 0; float v[8];
#pragma unroll
            for (int e = 0; e < 8; ++e) v[e] = lut[((((k * (nn + e)) & 255) * 16) + sh) & 4095];
            u32x4 w; w.x = cvt_pk_bf16(v[0], v[1]); w.y = cvt_pk_bf16(v[2], v[3]); w.z = cvt_pk_bf16(v[4], v[5]); w.w = cvt_pk_bf16(v[6], v[7]);
            *(u32x4*)(dftc + (size_t)k * 8192 + n0) = w; }
    }
}
template <class AR>
__device__ __forceinline__ void mods_items(const AR& a, int gw, int NGW, int lane) {
    float* mods = (float*)(a.ws + WS_MODS);
    for (int it = gw; it < 768; it += NGW) {
        const int l = it / 384, rem = it % 384, cch = rem >> 3, kp = rem & 7; const int col = cch * 256 + lane * 4, k0 = kp * 256;
        float sv[5][4];
#pragma unroll
        for (int r = 0; r < 5; ++r)
#pragma unroll
            for (int i = 0; i < 4; ++i) { const int k = k0 + lane + 64 * i; const float cv = r < 4 ? a.in[1][r * DM + k] : a.in[3][k]; sv[r][i] = fsilu(cv); }
        f32x4 acc[5];
#pragma unroll
        for (int r = 0; r < 5; ++r) acc[r] = (f32x4){0.f, 0.f, 0.f, 0.f};
        const float* wbase = a.in[4] + ((size_t)l * DM + k0) * 12288 + col;
#pragma unroll
        for (int i = 0; i < 4; ++i) {
#pragma unroll 8
            for (int ll = 0; ll < 64; ++ll) { const f32x4 w = *(const f32x4*)(wbase + (size_t)(i * 64 + ll) * 12288);
#pragma unroll
                for (int r = 0; r < 5; ++r) { const float s = __int_as_float(__builtin_amdgcn_readlane(__float_as_int(sv[r][i]), ll)); acc[r] += w * s; } }
        }
        if (kp == 0) { const f32x4 bv = *(const f32x4*)(a.in[5] + (size_t)l * 12288 + col);
#pragma unroll
            for (int r = 0; r < 5; ++r) acc[r] += bv; }
#pragma unroll
        for (int r = 0; r < 5; ++r) { float* d = mods + ((size_t)l * 5 + r) * 12288 + col; unsafeAtomicAdd(d, acc[r][0]); unsafeAtomicAdd(d + 1, acc[r][1]); unsafeAtomicAdd(d + 2, acc[r][2]); unsafeAtomicAdd(d + 3, acc[r][3]); }
    }
}
__device__ __forceinline__ void norm_rows(const float* xlat, const float* xctx, const float* w, const float* mods_l, int shoff, int scoff, bf16_t* XN, int nrows, int gw, int NGW, int lane) {
    for (int row = gw; row < nrows; row += NGW) {
        const float* xr = row < MLAT ? xlat + (size_t)row * DM : xctx + (size_t)(row - MLAT) * DM; const int b = row < MLAT ? (row >> 12) : 4;
        const float* sh = mods_l + (size_t)b * 12288 + shoff; const float* sc = mods_l + (size_t)b * 12288 + scoff;
        f32x4 v[8]; float ss = 0.f;
#pragma unroll
        for (int j = 0; j < 8; ++j) { v[j] = *(const f32x4*)(xr + 4 * lane + 256 * j); ss += (v[j][0] * v[j][0] + v[j][1] * v[j][1]) + (v[j][2] * v[j][2] + v[j][3] * v[j][3]); }
        const float rstd = rsqrtf(wave_sum(ss, lane) * (1.0f / DM) + EPS);
#pragma unroll
        for (int j = 0; j < 8; ++j) { const int col = 4 * lane + 256 * j; const f32x4 wv = *(const f32x4*)(w + col), scv = *(const f32x4*)(sc + col), shv = *(const f32x4*)(sh + col);
            const f32x4 o = (v[j] * rstd * wv) * (scv + 1.0f) + shv; u32x2 pk; pk.x = cvt_pk_bf16(o[0], o[1]); pk.y = cvt_pk_bf16(o[2], o[3]);
            *(u32x2*)(XN + (size_t)row * DM + col) = pk; }
    }
}
__device__ __forceinline__ void final_norm(float* x, const float* w, int gw, int NGW, int lane) {
    for (int row = gw; row < MLAT; row += NGW) { float* xr = x + (size_t)row * DM; f32x4 v[8]; float ss = 0.f;
#pragma unroll
        for (int j = 0; j < 8; ++j) { v[j] = *(const f32x4*)(xr + 4 * lane + 256 * j); ss += (v[j][0] * v[j][0] + v[j][1] * v[j][1]) + (v[j][2] * v[j][2] + v[j][3] * v[j][3]); }
        const float rstd = rsqrtf(wave_sum(ss, lane) * (1.0f / DM) + EPS);
#pragma unroll
        for (int j = 0; j < 8; ++j) { const int col = 4 * lane + 256 * j; *(f32x4*)(xr + col) = v[j] * rstd * *(const f32x4*)(w + col); } }
}
__device__ __forceinline__ void sgu_unit(bf16_t* proj, int row0, int g, const float* nw, const float* wsg, const float* bsg, LAS unsigned char* lds, int tid) {
    LAS bf16_t* vnt = (LAS bf16_t*)lds;
    const int lane = tid & 63, wid = tid >> 6, fr = lane & 15, fq = lane >> 4;
    {
        const int j = tid >> 2, q = tid & 3; const bf16_t* src = proj + (size_t)(row0 + j) * INW + OFF_C + 512 + g * 128 + q * 32;
        float v[32];
#pragma unroll
        for (int i = 0; i < 4; ++i) { const u32x4 w = *(const u32x4*)(src + 8 * i);
            v[8 * i + 0] = bflo(w.x); v[8 * i + 1] = bfhi(w.x); v[8 * i + 2] = bflo(w.y); v[8 * i + 3] = bfhi(w.y); v[8 * i + 4] = bflo(w.z); v[8 * i + 5] = bfhi(w.z); v[8 * i + 6] = bflo(w.w); v[8 * i + 7] = bfhi(w.w); }
        float s = 0.f;
#pragma unroll
        for (int e = 0; e < 32; ++e) s += v[e];
        s += shx(s, 1, lane); s += shx(s, 2, lane); const float mean = s * (1.0f / 128.0f);
        float qv = 0.f;
#pragma unroll
        for (int e = 0; e < 32; ++e) { v[e] -= mean; qv += v[e] * v[e]; }
        qv += shx(qv, 1, lane); qv += shx(qv, 2, lane); const float rstd = rsqrtf(qv * (1.0f / 128.0f) + EPS);
#pragma unroll
        for (int e = 0; e < 32; e += 2) { const int d = q * 32 + e; const unsigned w = cvt_pk_bf16(v[e] * rstd * nw[g * 128 + d], v[e + 1] * rstd * nw[g * 128 + d + 1]);
            vnt[d * 136 + j] = (bf16_t)(w & 0xffffu); vnt[(d + 1) * 136 + j] = (bf16_t)(w >> 16); }
    }
    __syncthreads();
    {
        const int i = 16 * wid + fr;
        bf16x8 wf[4];
#pragma unroll
        for (int ks = 0; ks < 4; ++ks) { const float* wp = wsg + (size_t)i * 128 + 32 * ks + 8 * fq; const f32x4 a = *(const f32x4*)wp, b = *(const f32x4*)(wp + 4);
            u32x4 w; w.x = cvt_pk_bf16(a[0], a[1]); w.y = cvt_pk_bf16(a[2], a[3]); w.z = cvt_pk_bf16(b[0], b[1]); w.w = cvt_pk_bf16(b[2], b[3]); wf[ks] = __builtin_bit_cast(bf16x8, w); }
        const float bias = bsg[i];
        bf16_t* up = proj + (size_t)(row0 + i) * INW + OFF_C + g * 128 + 4 * fq;
#pragma unroll
        for (int nt = 0; nt < 8; ++nt) { f32x4 acc = (f32x4){0.f, 0.f, 0.f, 0.f};
#pragma unroll
            for (int ks = 0; ks < 4; ++ks) { const bf16x8 af = *(const LAS bf16x8*)((const LAS unsigned char*)vnt + (16 * nt + fr) * 272 + (32 * ks + 8 * fq) * 2);
                acc = __builtin_amdgcn_mfma_f32_16x16x32_bf16(af, wf[ks], acc, 0, 0, 0); }
            const u32x2 uw = *(const u32x2*)(up + 16 * nt); u32x2 o;
            o.x = cvt_pk_bf16(bflo(uw.x) * (acc[0] + bias), bfhi(uw.x) * (acc[1] + bias)); o.y = cvt_pk_bf16(bflo(uw.y) * (acc[2] + bias), bfhi(uw.y) * (acc[3] + bias));
            *(u32x2*)(up + 16 * nt) = o; }
    }
    __syncthreads();
}
template <bool LAT>
__device__ __forceinline__ void attn_task(bf16_t* proj, const bf16_t* vt, const bf16_t* vtc, const float* rpb, int t, int lane) {
    constexpr int NCH = LAT ? 16 : 8, WCH = LAT ? 8 : 0;
    const int fr = lane & 15, fq = lane >> 4;
    int b, h, r = 0, cgp = 0, qrow;
    if (LAT) { cgp = t & 3; r = (t >> 2) & 63; h = (t >> 8) & 7; b = t >> 11; qrow = b * 4096 + r * 64 + cgp * 16 + fr; }
    else { const int qg = t & 15; h = (t >> 4) & 7; b = t >> 7; qrow = MLAT + b * 256 + qg * 16 + fr; }
    bf16_t* qp = proj + (size_t)qrow * INW + OFF_Q + h * 128;
    bf16x8 qf[4];
#pragma unroll
    for (int ks = 0; ks < 4; ++ks) qf[ks] = *(const bf16x8*)(qp + ks * 32 + fq * 8);
    const int rs = r < 4 ? 0 : (r > 60 ? 56 : r - 4);
    const int cb = cgp == 0 ? 0 : (cgp == 1 ? 8 : (cgp == 2 ? 24 : 32));
    float S[NCH][8];
    const int kap = 8 * (fr >> 2) + (fr & 3);
    const bf16_t* kbase = proj + OFF_K + h * 128 + fq * 8;
    bf16x8 kf[2][8];
#define ATT_LOADK(buf, c) do { _Pragma("unroll") for (int tt = 0; tt < 2; ++tt) { \
        const int krow = ((c) < WCH) ? (b * 4096 + (rs + (c)) * 64 + cb + kap + 4 * tt) : (MLAT + b * 256 + 32 * ((c) - WCH) + kap + 4 * tt); \
        const bf16_t* kp = kbase + (size_t)krow * INW; \
        _Pragma("unroll") for (int ks = 0; ks < 4; ++ks) kf[buf][tt * 4 + ks] = *(const bf16x8*)(kp + ks * 32); } } while (0)
    ATT_LOADK(0, 0);
#pragma unroll
    for (int c = 0; c < NCH; ++c) {
        if (c + 1 < NCH) ATT_LOADK((c + 1) & 1, c + 1);
        __builtin_amdgcn_sched_barrier(0);
#pragma unroll
        for (int tt = 0; tt < 2; ++tt) {
            f32x4 acc = (f32x4){0.f, 0.f, 0.f, 0.f};
#pragma unroll
            for (int ks = 0; ks < 4; ++ks) acc = __builtin_amdgcn_mfma_f32_16x16x32_bf16(kf[c & 1][tt * 4 + ks], qf[ks], acc, 0, 0, 0);
            S[c][4 * tt + 0] = acc[0]; S[c][4 * tt + 1] = acc[1]; S[c][4 * tt + 2] = acc[2]; S[c][4 * tt + 3] = acc[3];
        }
        __builtin_amdgcn_sched_barrier(0);
    }
#undef ATT_LOADK
    if (LAT) {
        const int qc = cgp * 16 + fr; const int cs = qc < 8 ? 0 : (qc > 56 ? 48 : qc - 8);
#pragma unroll
        for (int c = 0; c < WCH; ++c) { const int dr = rs + c - r + 7; const float* rp = rpb + (h * 15 + dr) * 31;
#pragma unroll
            for (int jj = 0; jj < 8; ++jj) { const int kc = cb + 8 * fq + jj; const bool valid = (kc >= cs) && (kc < cs + 16); int dc = kc - qc + 15; dc = dc < 0 ? 0 : (dc > 30 ? 30 : dc);
                const float bias = rp[dc]; S[c][jj] = valid ? S[c][jj] + bias : -1e30f; } }
    }
    float mx = -3.0e38f;
#pragma unroll
    for (int c = 0; c < NCH; ++c)
#pragma unroll
        for (int jj = 0; jj < 8; ++jj) mx = fmaxf(mx, S[c][jj]);
    mx = fmaxf(mx, shx(mx, 16, lane)); mx = fmaxf(mx, shx(mx, 32, lane));
    float sum = 0.f; bf16x8 pf[NCH];
#pragma unroll
    for (int c = 0; c < NCH; ++c) { float p[8];
#pragma unroll
        for (int jj = 0; jj < 8; ++jj) { p[jj] = __builtin_amdgcn_exp2f((S[c][jj] - mx) * 1.44269504089f); sum += p[jj]; }
        u32x4 w; w.x = cvt_pk_bf16(p[0], p[1]); w.y = cvt_pk_bf16(p[2], p[3]); w.z = cvt_pk_bf16(p[4], p[5]); w.w = cvt_pk_bf16(p[6], p[7]); pf[c] = __builtin_bit_cast(bf16x8, w); }
    sum += shx(sum, 16, lane); sum += shx(sum, 32, lane);
    const float inv = 1.0f / sum;
    const bf16_t* vlat = vt + ((size_t)(b * 1024 + h * 128 + fr)) * 4096 + cb + 8 * fq;
    const bf16_t* vctx = vtc + ((size_t)(b * 1024 + h * 128 + fr)) * 256 + 8 * fq;
    constexpr int NBH = NCH / 8, NQ = 8 * NBH;
    bf16x8 vf[2][8];
#define ATT_LOADV(buf, q) do { const int dt_ = (q) / NBH, hb_ = (q) % NBH; _Pragma("unroll") for (int i = 0; i < 8; ++i) { const int c_ = hb_ * 8 + i; \
        const bf16_t* vp = (c_ < WCH) ? (vlat + (size_t)dt_ * 16 * 4096 + (rs + c_) * 64) : (vctx + (size_t)dt_ * 16 * 256 + 32 * (c_ - WCH)); \
        vf[buf][i] = *(const bf16x8*)vp; } } while (0)
    ATT_LOADV(0, 0);
    f32x4 oacc = (f32x4){0.f, 0.f, 0.f, 0.f};
#pragma unroll
    for (int q = 0; q < NQ; ++q) {
        if (q + 1 < NQ) ATT_LOADV((q + 1) & 1, q + 1);
        __builtin_amdgcn_sched_barrier(0);
        const int dt = q / NBH, hb = q % NBH;
        if (hb == 0) oacc = (f32x4){0.f, 0.f, 0.f, 0.f};
#pragma unroll
        for (int i = 0; i < 8; ++i) oacc = __builtin_amdgcn_mfma_f32_16x16x32_bf16(vf[q & 1][i], pf[hb * 8 + i], oacc, 0, 0, 0);
        if (hb == NBH - 1) { u32x2 o; o.x = cvt_pk_bf16(oacc[0] * inv, oacc[1] * inv); o.y = cvt_pk_bf16(oacc[2] * inv, oacc[3] * inv);
            *(u32x2*)(qp + dt * 16 + 4 * fq) = o; }
        __builtin_amdgcn_sched_barrier(0);
    }
#undef ATT_LOADV
}
__device__ __forceinline__ void conv_items(const bf16_t* up, bf16_t* hmid, const float* cw, const float* cbias, int nrows, int gtid, int NT) {
    const int nitems = (nrows / 16) * 704;
    for (int it = gtid; it < nitems; it += NT) {
        const int cg8 = it % 704, rb = it / 704; const int row0 = rb * 16, ch = cg8 * 8;
        const int seqlen = row0 < MLAT ? 4096 : 256; const int ts = (row0 < MLAT ? row0 : row0 - MLAT) & (seqlen - 1);
        float w0[8], w1[8], w2[8], bb[8];
#pragma unroll
        for (int e = 0; e < 8; ++e) { w0[e] = cw[ch + e]; w1[e] = cw[DFF + ch + e]; w2[e] = cw[2 * DFF + ch + e]; bb[e] = cbias[ch + e]; }
        const bf16_t* ap = up + (size_t)row0 * UPW + ch; const bf16_t* gp = ap + DFF; bf16_t* hp = hmid + (size_t)row0 * DFF + ch;
        u32x4 prev = (u32x4){0u, 0u, 0u, 0u}; if (ts > 0) prev = *(const u32x4*)(ap - UPW);
        u32x4 cur = *(const u32x4*)ap;
        for (int i = 0; i < 16; ++i) {
            u32x4 nxt = (u32x4){0u, 0u, 0u, 0u}; if (i < 15 || ts + 16 < seqlen) nxt = *(const u32x4*)(ap + (size_t)(i + 1) * UPW);
            const u32x4 gw = *(const u32x4*)(gp + (size_t)i * UPW);
            float o[8];
#pragma unroll
            for (int e = 0; e < 4; ++e) {
                const float y0 = bb[2 * e] + w0[2 * e] * bflo(prev[e]) + w1[2 * e] * bflo(cur[e]) + w2[2 * e] * bflo(nxt[e]);
                const float y1 = bb[2 * e + 1] + w0[2 * e + 1] * bfhi(prev[e]) + w1[2 * e + 1] * bfhi(cur[e]) + w2[2 * e + 1] * bfhi(nxt[e]);
                o[2 * e] = fsilu(y0) * bflo(gw[e]); o[2 * e + 1] = fsilu(y1) * bfhi(gw[e]); }
            u32x4 w; w.x = cvt_pk_bf16(o[0], o[1]); w.y = cvt_pk_bf16(o[2], o[3]); w.z = cvt_pk_bf16(o[4], o[5]); w.w = cvt_pk_bf16(o[6], o[7]);
            *(u32x4*)(hp + (size_t)i * DFF) = w;
            prev = cur; cur = nxt;
        }
    }
}


#define XB_TMO      128
#define XB_XCNT(j)  (256  + 64 * (j))
#define XB_XSUB(j)  (1280 + 64 * (j))
#define XB_XGEN(j)  (2304 + 64 * (j))
#define XB_TOP      3328
#define XB_TOPGEN   3392
#define XCD_BAR_WORDS 3456
#define XB_SPIN_CAP (1u << 18)
__device__ __forceinline__ unsigned xb_ld(unsigned* p)              { return __hip_atomic_load(p, __ATOMIC_RELAXED, __HIP_MEMORY_SCOPE_AGENT); }
__device__ __forceinline__ unsigned xb_add(unsigned* p, unsigned v) { return __hip_atomic_fetch_add(p, v, __ATOMIC_RELAXED, __HIP_MEMORY_SCOPE_AGENT); }
__device__ __forceinline__ unsigned xb_xcc_id() { return (unsigned)__builtin_amdgcn_s_getreg((3 << 11) | 20) & 0xFu; }
#define XB_SPIN(cond, bar) do { unsigned _sp = 0; while (cond) { __builtin_amdgcn_s_sleep(1); \
    if ((++_sp & 255u) == 0u) { if (xb_ld(&(bar)[XB_TMO])) break; if (_sp > XB_SPIN_CAP) { atomicAdd(&(bar)[XB_TMO], 1u); break; } } } } while (0)
struct XcdBarrier { unsigned* bar; unsigned x; volatile LAS unsigned* st; };
__device__ __forceinline__ XcdBarrier xcd_barrier_post(unsigned* bar, volatile LAS unsigned* st) {
    XcdBarrier b; b.bar = bar; b.x = xb_xcc_id(); b.st = st;
    if (threadIdx.x == 0) (void)xb_add(&bar[XB_XCNT(b.x)], 1u);
    return b;
}
__device__ __forceinline__ void xcd_barrier_complete(unsigned* bar, unsigned x, unsigned& nloc, unsigned& nx) {
    const unsigned G = gridDim.x * gridDim.y * gridDim.z;
    unsigned sum, cnt, mine, sp = 0u;
    for (;;) {
        sum = 0u; cnt = 0u; mine = 0u;
#pragma unroll
        for (unsigned j = 0; j < 16; ++j) { const unsigned c = xb_ld(&bar[XB_XCNT(j)]); sum += c; cnt += (c > 0u) ? 1u : 0u; mine = (j == x) ? c : mine; }
        if (sum == G) break;
        __builtin_amdgcn_s_sleep(1);
        if ((++sp & 255u) == 0u) { if (xb_ld(&bar[XB_TMO])) break; if (sp > XB_SPIN_CAP) { atomicAdd(&bar[XB_TMO], 1u); break; } }
    }
    nloc = mine > 0u ? mine : 1u; nx = cnt > 0u ? cnt : 1u;
}
__device__ __forceinline__ void xcd_barrier(const XcdBarrier& b) {
    asm volatile("s_waitcnt vmcnt(0)" ::: "memory");
    __syncthreads();
    if (threadIdx.x == 0) {
        unsigned* bar = b.bar;
        __builtin_amdgcn_s_waitcnt(0);
        unsigned nloc = b.st[0], nx = b.st[1];
        if (nloc == 0u) { xcd_barrier_complete(bar, b.x, nloc, nx); b.st[0] = nloc; b.st[1] = nx; }
        const unsigned old = xb_add(&bar[XB_XSUB(b.x)], 1u);
        const unsigned gen = old / nloc;
        if (old + 1u == (gen + 1u) * nloc) {
            __builtin_amdgcn_fence(__ATOMIC_RELEASE, "agent");
            asm volatile("s_waitcnt vmcnt(0)" ::: "memory");
            const unsigned og = xb_add(&bar[XB_TOP], 1u);
            const unsigned tg = og / nx;
            if (og + 1u == (tg + 1u) * nx) xb_add(&bar[XB_TOPGEN], 1u);
            else XB_SPIN(xb_ld(&bar[XB_TOPGEN]) == tg, bar);
            __builtin_amdgcn_fence(__ATOMIC_ACQUIRE, "agent");
            xb_add(&bar[XB_XGEN(b.x)], 1u);
            asm volatile("s_waitcnt vmcnt(0)" ::: "memory");
        } else {
            XB_SPIN(xb_ld(&bar[XB_XGEN(b.x)]) == gen, bar);
            __builtin_amdgcn_fence(__ATOMIC_ACQUIRE, "agent");
            asm volatile("s_waitcnt vmcnt(0)" ::: "memory");
        }
    }
    __syncthreads();
}
constexpr int NPHASE = 24;
__global__ void __launch_bounds__(512, 2) mega(Args a_) {
    extern __shared__ __attribute__((aligned(16))) unsigned char lds_raw[];
    LAS unsigned char* lds = (LAS unsigned char*)lds_raw;
    cg::grid_group grid = cg::this_grid();
    const int G = gridDim.x, cu = blockIdx.x, NGW = G * 8, wave = __builtin_amdgcn_readfirstlane((int)threadIdx.x >> 6);

    volatile LAS unsigned* xst = (volatile LAS unsigned*)(lds + 143360);
    if (threadIdx.x < 4) xst[threadIdx.x] = 0u;
    __syncthreads();
    const XcdBarrier xbar = xcd_barrier_post((unsigned*)(a_.ws + WS_BAR), xst);

    const int ph_lo = a_.ph_lo, ph_hi = a_.ph_hi;
    for (int p = ph_lo; p < ph_hi; ++p) {
        if (p > ph_lo) { if (p == 1) grid.sync(); else xcd_barrier(xbar); }
#define PH_IDS const int lane = fresh_lane(); const int tid = wave * 64 + lane, gw = cu * 8 + wave; (void)tid; (void)gw; (void)lane;
        typedef const __attribute__((address_space(4))) Args KArgs;
        KArgs* ap = (KArgs*)__builtin_amdgcn_kernarg_segment_ptr(); asm volatile("" : "+s"(ap));
        KArgs& a = *ap;
        unsigned char* ws = a.ws;
        unsigned* ctl = (unsigned*)(ws + WS_CTL);
        bf16_t* PROJ = (bf16_t*)(ws + WS_BIG); bf16_t* XN = (bf16_t*)(ws + WS_XN); bf16_t* HMID = (bf16_t*)(ws + WS_HMID);
        float* XC = (float*)(ws + WS_XC); float* mods = (float*)(ws + WS_MODS);
        bf16_t* VT = (bf16_t*)(ws + WS_VT); bf16_t* VTC = (bf16_t*)(ws + WS_VTC);
        if (p == 0) { PH_IDS
            LAS float* lut = (LAS float*)(lds + 72 * 1024);
            for (int i = tid; i < 4096; i += 512) lut[i] = cospif((float)i * (1.0f / 2048.0f));
            __syncthreads();
            if (cu == 0) { bf16_t* dd = (bf16_t*)(ws + WS_DFTD);
                for (int e = tid; e < 256 * 128; e += 512) { const int row = e >> 7, d = e & 127, j = row & 127; const float ang = (float)((j * d) & 127) * (1.0f / 64.0f);
                    const float v = row < 128 ? cospif(ang) : sinpif(ang); dd[e] = (bf16_t)(cvt_pk_bf16(v, 0.f) & 0xffffu); } }
            for (int i = cu * 512 + tid; i < 1024 * DM / 4; i += G * 512) ((f32x4*)XC)[i] = ((const f32x4*)a.in[2])[i];
            mods_items(a, gw, NGW, lane);
            convert_weights(a, 0, (LAS float*)(lds + wave * 8704), gw, NGW, lane);
            dft_tables(ws, lut, gw, NGW, lane);
            continue;
        }
        if (p == NPHASE - 1) { PH_IDS final_norm(a.out, a.in[21], gw, NGW, lane); continue; }
        const int l = (p - 1) / 11, s = (p - 1) % 11;
        const float* mods_l = mods + (size_t)l * 5 * 12288;
        const float* xlat = (l == 0) ? a.in[0] : a.out; const float* xctx = (l == 0) ? a.in[2] : XC;
        const int nMall = (l == 0) ? 68 : 64;
        switch (s) {
        case 0: { PH_IDS
            if (l == 1) { LAS float* lut = (LAS float*)(lds + 72 * 1024);
                for (int i = tid; i < 4096; i += 512) lut[i] = cospif((float)i * (1.0f / 2048.0f));
                __syncthreads();
                convert_weights(a, 1, (LAS float*)(lds + wave * 8704), gw, NGW, lane);
                dft_tables(ws, lut, gw, NGW, lane); }
            norm_rows(xlat, xctx, a.in[6] + (size_t)l * DM, mods_l, 0, 2048, XN, MT, gw, NGW, lane);
        } break;
        case 1: { PH_IDS
            SchedGrid S; S.so.init(nMall, 42, G, cu); S.A = (const char*)XN; S.B = (const char*)(ws + WS_WIN); S.tsA = (size_t)256 * DM * 2; S.tsB = (size_t)256 * DM * 2; S.nt = 32;
            S.nextra = (l == 0) ? 0 : 32; S.ex_pm0 = 64; S.ex_pn0 = 6; S.ex_w = 8; S.ex_ks = 1;
            EpiInProj E{PROJ, VT, VTC};
            pg8::gemm_phase<EpiInProj, SchedGrid>(lds, tid, DM, DM, S, E);
        } break;
        case 2: { PH_IDS
            const int nun = 512 + ((l == 0) ? 32 : 0);
            for (int u = cu; u < nun; u += G) { int row0, g;
                if (u < 512) { const int b = u >> 7, ch = (u >> 2) & 31; g = u & 3; row0 = b * 4096 + ch * 128; }
                else { const int e = u - 512; const int b = e >> 3, ch = (e >> 2) & 1; g = e & 3; row0 = MLAT + b * 256 + ch * 128; }
                sgu_unit(PROJ, row0, g, a.in[10] + (size_t)l * 512, a.in[11] + ((size_t)l * 4 + g) * 128 * 128, a.in[12] + ((size_t)l * 4 + g) * 128, lds, tid); }
            __syncthreads();
            { SchedF1L S{(const char*)(ws + WS_DFTD), (const char*)PROJ, G, cu}; EpiF1L E{(bf16_t*)(ws + WS_U)};
              pg8::gemm_phase<EpiF1L, SchedF1L>(lds, wave * 64 + fresh_lane(), 128, INW, S, E); }
            if (l == 0) { SchedF1 S{(const char*)(ws + WS_DFTD), (const char*)PROJ, G, (cu + 128) % G, 16}; EpiF1 E{nullptr, (bf16_t*)(ws + WS_PQTC)};
              pg8::gemm_phase<EpiF1, SchedF1>(lds, wave * 64 + fresh_lane(), 128, INW, S, E); }
        } break;
        case 3: { PH_IDS
            { SchedFA S{(const char*)(ws + WS_MA), (const char*)(ws + WS_U), G, cu}; EpiFA E{(bf16_t*)(ws + WS_ZBUF)};
              pg8::gemm_phase<EpiFA, SchedFA>(lds, tid, 128, 128, S, E); }
            if (l == 0) { SchedF2 S{(const char*)(ws + WS_DFTC), (const char*)(ws + WS_PQTC), G, (cu + 128) % G, 8}; EpiF2 E{PROJ};
              pg8::gemm_phase<EpiF2, SchedF2>(lds, wave * 64 + fresh_lane(), 8192, 8192, S, E); }
            const int lane2 = fresh_lane();
            const int ntask = 8192 + ((l == 0) ? 512 : 0), lim = ntask / 2; unsigned* cnt = ctl + 64 * l; const float* rpb = a.in[9] + (size_t)l * 8 * 15 * 31;
            for (;;) { int t = 0; if (lane2 == 0) t = (int)atomicAdd(cnt, 1u); t = __builtin_amdgcn_readfirstlane(t); if (t >= lim) break;
                if (t < 8192) attn_task<true>(PROJ, VT, VTC, rpb, t, lane2); else attn_task<false>(PROJ, VT, VTC, rpb, t - 8192, lane2); }
        } break;
        case 4: { PH_IDS
            { SchedFB S{(const char*)(ws + WS_TT), (const char*)(ws + WS_ZBUF), G, cu}; EpiFB E{PROJ};
              pg8::gemm_phase<EpiFB, SchedFB>(lds, tid, 128, 128, S, E); }
            const int lane2 = fresh_lane();
            const int ntask = 8192 + ((l == 0) ? 512 : 0), lim = ntask / 2; unsigned* cnt = ctl + 64 * l + 16; const float* rpb = a.in[9] + (size_t)l * 8 * 15 * 31;
            for (;;) { int t = 0; if (lane2 == 0) t = (int)atomicAdd(cnt, 1u); t = __builtin_amdgcn_readfirstlane(t) + lim; if (t >= ntask) break;
                if (t < 8192) attn_task<true>(PROJ, VT, VTC, rpb, t, lane2); else attn_task<false>(PROJ, VT, VTC, rpb, t - 8192, lane2); }
        } break;
        case 5: { PH_IDS
            SchedBranch S; S.so.init(nMall, 8, G, cu); S.proj = (const char*)PROJ; S.wbr = (const char*)(ws + WS_WBR);
            EpiBranch E{PROJ, XN};
            pg8::gemm_phase<EpiBranch, SchedBranch>(lds, tid, INW, DM, S, E);
        } break;
        case 6: { PH_IDS
            SchedGrid S; S.so.init(64, 8, G, cu); S.A = (const char*)XN; S.B = (const char*)(ws + WS_WO); S.tsA = (size_t)256 * DM * 2; S.tsB = (size_t)256 * DM * 2; S.nt = 32;
            S.nextra = (l == 0) ? 32 * 8 : 0; S.ex_pm0 = 64; S.ex_pn0 = 0; S.ex_w = 8; S.ex_ks = 8;
            EpiResid E{xlat, XC, a.out, XC, mods_l + 4096};
            pg8::gemm_phase<EpiResid, SchedGrid>(lds, tid, DM, DM, S, E);
        } break;
        case 7: { PH_IDS
            norm_rows(a.out, XC, a.in[7] + (size_t)l * DM, mods_l, 6144, 8192, XN, nMall * 256, gw, NGW, lane);
        } break;
        case 8: { PH_IDS
            SchedGrid S; S.so.init(nMall, 44, G, cu); S.A = (const char*)XN; S.B = (const char*)(ws + WS_WUP); S.tsA = (size_t)256 * DM * 2; S.tsB = (size_t)256 * DM * 2; S.nt = 32; S.nextra = 0; S.ex_pm0 = 0; S.ex_pn0 = 0; S.ex_w = 1; S.ex_ks = 1;
            EpiPlain E{PROJ, UPW};
            pg8::gemm_phase<EpiPlain, SchedGrid>(lds, tid, DM, DM, S, E);
        } break;
        case 9: { PH_IDS
            conv_items(PROJ, HMID, a.in[18] + (size_t)l * 3 * DFF, a.in[19] + (size_t)l * DFF, nMall * 256, cu * 512 + tid, G * 512);
        } break;
        case 10: { PH_IDS
            SchedGrid S; S.so.init(64, 8, G, cu); S.A = (const char*)HMID; S.B = (const char*)(ws + WS_WDN); S.tsA = (size_t)256 * DFF * 2; S.tsB = (size_t)256 * DFF * 2; S.nt = 88;
            S.nextra = (l == 0) ? 32 * 4 : 0; S.ex_pm0 = 64; S.ex_pn0 = 0; S.ex_w = 8; S.ex_ks = 4;
            EpiResid E{a.out, XC, a.out, XC, mods_l + 10240};
            pg8::gemm_phase<EpiResid, SchedGrid>(lds, tid, DFF, DFF, S, E);
        } break;
        }
    }
}

extern "C" void kernel_launch(void* const* d_in, const int* in_sizes, int n_in, void* d_out, int out_size, void* d_ws, size_t ws_size, hipStream_t stream) {
    static int grid = 0;
    if (grid == 0) {
        if (n_in != 22 || ws_size < WS_END) { fprintf(stderr, "kernel_launch: unexpected n_in %d / ws_size %zu (need %zu)\n", n_in, ws_size, (size_t)WS_END); grid = -1; return; }
        int dev = 0, cus = 0, per_cu = 0;
        hipGetDevice(&dev); hipDeviceGetAttribute(&cus, hipDeviceAttributeMultiprocessorCount, dev);
        if (hipFuncSetAttribute((const void*)mega, hipFuncAttributeMaxDynamicSharedMemorySize, LDS_BYTES) != hipSuccess) { fprintf(stderr, "kernel_launch: hipFuncSetAttribute failed\n"); grid = -1; return; }
        hipOccupancyMaxActiveBlocksPerMultiprocessor(&per_cu, (const void*)mega, 512, LDS_BYTES);
        (void)hipGetLastError();
        if (per_cu < 1) fprintf(stderr, "kernel_launch: occupancy query says %d blocks/CU\n", per_cu);
        grid = cus > 0 ? cus : 256;
    }
    if (grid < 0) return;
    hipMemsetAsync((char*)d_ws + WS_CTL, 0, CTL_ZERO_BYTES, stream);
    Args a{};
    for (int i = 0; i < 22; ++i) a.in[i] = (const float*)d_in[i];
    a.out = (float*)d_out; a.ws = (unsigned char*)d_ws; a.ph_lo = 0; a.ph_hi = NPHASE;
    void* args[] = {&a};
    hipError_t e = hipLaunchCooperativeKernel((const void*)mega, dim3(grid), dim3(512), args, LDS_BYTES, stream);
    if (e != hipSuccess) fprintf(stderr, "kernel_launch: cooperative launch failed: %s (grid %d)\n", hipGetErrorString(e), grid);
}
```

```cpp
#include <hip/hip_runtime.h>
#include <hip/hip_cooperative_groups.h>
#include <cstdio>
#include <cstdint>
namespace cg = cooperative_groups;

#define LAS __attribute__((address_space(3)))
typedef unsigned short bf16_t;
typedef short bf16x8 __attribute__((ext_vector_type(8)));
typedef float f32x4 __attribute__((ext_vector_type(4)));
typedef float f32x2 __attribute__((ext_vector_type(2)));
typedef unsigned u32x4 __attribute__((ext_vector_type(4)));
typedef unsigned u32x2 __attribute__((ext_vector_type(2)));

constexpr int DM = 2048, MLAT = 16384, MT = 17408;
constexpr int INW = 10752, DFF = 5632, UPW = 11264;
constexpr int OFF_Q = 512, OFF_K = 1536, OFF_V = 2560, OFF_C = 3584, OFF_G = 4608;
constexpr float EPS = 1e-6f;
constexpr size_t MiB = 1u << 20;
constexpr size_t WS_CTL = 0;
constexpr size_t CTL_ZERO_BYTES = 1 * MiB;
constexpr size_t WS_MODS = 4096;
constexpr size_t WS_BAR = 512 * 1024;
constexpr size_t WS_DFTD = 1 * MiB;
constexpr size_t WS_XC = 2 * MiB;
constexpr size_t WS_WIN = 10 * MiB;
constexpr size_t WS_WBR = 52 * MiB;
constexpr size_t WS_WO = 60 * MiB;
constexpr size_t WS_WUP = 68 * MiB;
constexpr size_t WS_WDN = 112 * MiB;
constexpr size_t WS_XN = 134 * MiB;
constexpr size_t WS_BIG = 202 * MiB;
constexpr size_t WS_HMID = 576 * MiB;
constexpr size_t WS_ZBUF = WS_HMID;
constexpr size_t WS_TT = WS_HMID + 32 * MiB;
constexpr size_t WS_MA = WS_HMID + 36 * MiB;
constexpr size_t WS_U = WS_HMID + 64 * MiB;
constexpr size_t WS_VT = WS_HMID + 96 * MiB;
constexpr size_t WS_DFTC = WS_HMID + 128 * MiB;
constexpr size_t WS_PQTC = WS_HMID + 132 * MiB;
constexpr size_t WS_VTC = WS_HMID + 164 * MiB;
constexpr size_t WS_TMP = WS_HMID;
constexpr size_t WS_END = 763 * MiB;
constexpr int LDS_BYTES = 147456;

#define LDS_WAIT() asm volatile("s_waitcnt lgkmcnt(0)" ::: "memory")
__device__ __forceinline__ unsigned cvt_pk_bf16(float lo, float hi) { unsigned r; asm volatile("v_cvt_pk_bf16_f32 %0, %1, %2" : "=v"(r) : "v"(lo), "v"(hi)); return r; }
__device__ __forceinline__ int fresh_lane() { unsigned z; asm volatile("v_mov_b32 %0, 0" : "=v"(z)); return (int)__builtin_amdgcn_mbcnt_hi(~0u, __builtin_amdgcn_mbcnt_lo(~0u, z)); }
__device__ __forceinline__ float bf2f(unsigned short b) { return __uint_as_float((unsigned)b << 16); }
__device__ __forceinline__ float bflo(unsigned w) { return __uint_as_float(w << 16); }
__device__ __forceinline__ float bfhi(unsigned w) { return __uint_as_float(w & 0xffff0000u); }
__device__ __forceinline__ float shx(float v, int o, int lane) { return __int_as_float(__builtin_amdgcn_ds_bpermute((lane ^ o) << 2, __float_as_int(v))); }
__device__ __forceinline__ float wave_sum(float v, int lane) {
#pragma unroll
    for (int o = 1; o < 64; o <<= 1) v += shx(v, o, lane);
    return v;
}
__device__ __forceinline__ float fsigmoid(float x) { return __builtin_amdgcn_rcpf(1.0f + __builtin_amdgcn_exp2f(-1.44269504089f * x)); }
__device__ __forceinline__ float fsilu(float x) { return x * fsigmoid(x); }
__device__ __forceinline__ f32x2 gelu_pk(f32x2 v) {
    const f32x2 av = __builtin_elementwise_abs(v), d = av * 0.2316418882f + 1.0f;
    f32x2 t; t.x = __builtin_amdgcn_rcpf(d.x); t.y = __builtin_amdgcn_rcpf(d.y);
    f32x2 q = t * 0.5307027145f + (-0.7265760135f); q = q * t + 0.7107068705f; q = q * t + (-0.142248368f); q = q * t + 0.127414796f; q = q * t;
    const f32x2 s = (v * v) * (-0.72134752044f);
    f32x2 e; e.x = __builtin_amdgcn_exp2f(s.x); e.y = __builtin_amdgcn_exp2f(s.y);
    const f32x2 m = v * (q * e), r = v - m;
    f32x2 o; o.x = v.x < 0.f ? m.x : r.x; o.y = v.y < 0.f ? m.y : r.y; return o;
}

namespace pg8 {
constexpr int BM = 256, BK = 64, HALF = 128, HTB = HALF * BK * 2, STAGE_BYTES = 8 * HTB, NXCD = 8, WGM = 8;
__host__ __device__ __forceinline__ int lds_byte(int r, int c) { const int st = (r >> 4) * 2 + (c >> 5), rr = r & 15, cc = c & 31, ob = rr * 64 + cc * 2; return st * 1024 + (ob ^ (((ob >> 9) & 1) << 5)); }
__host__ __device__ __forceinline__ void stage_rc(int b, int& R, int& C) { const int st = b / 1024, sb = b % 1024, swz = sb ^ (((sb >> 9) & 1) << 5); R = (st >> 1) * 16 + swz / 64; C = (st & 1) * 32 + (swz % 64) / 2; }
__host__ __device__ __forceinline__ int perm32(int rho) { const int n = rho >> 4, i = rho & 15; return 8 * (i >> 2) + 4 * n + (i & 3); }

struct Unit { const char* A; const char* B; int nt, pm, pn, aux; };

struct StaticOrder {
    int nM, nN, nwg, G, c;
    __device__ void init(int nM_, int nN_, int G_, int c_) { nM = nM_; nN = nN_; nwg = nM * nN; G = G_; c = c_; }
    __device__ bool next(int i, int& pm, int& pn) const {
        const long L = (long)i * G + c; if (L >= nwg) return false;
        int wgid = (int)L; { const int q = nwg / NXCD, r = nwg % NXCD, xcd = wgid % NXCD, off = wgid / NXCD; wgid = (xcd < r ? xcd * (q + 1) : r * (q + 1) + (xcd - r) * q) + off; }
        const int nig = WGM * nN, gid = wgid / nig, fm = gid * WGM, gsz = (nM - fm) < WGM ? (nM - fm) : WGM;
        pm = fm + ((wgid % nig) % gsz); pn = (wgid % nig) / gsz; return true;
    }
};

template <class Epi, class Sched>
__device__ __forceinline__ void gemm_phase(LAS unsigned char* lds, const int tid, const int lda, const int ldb, const Sched& S, const Epi& E) {
    const int wid = __builtin_amdgcn_readfirstlane(tid >> 6), lane = tid & 63, wr = wid >> 2, wc = wid & 3, fr = lane & 15, fq = lane >> 4;
    unsigned voffA[2], voffB[2];
#pragma unroll
    for (int i = 0; i < 2; ++i) { int R, C; stage_rc(tid * 16 + i * 8192, R, C); const int Rb = Epi::PERM ? ((R & ~31) + perm32(R & 31)) : R;
        voffA[i] = (unsigned)(R * lda + C) * 2u; voffB[i] = (unsigned)(Sched::brow(Rb) * ldb + C) * 2u; }
    const size_t kstep = (size_t)(BK * 2);
    const size_t hstepA = (size_t)HALF * lda * 2, hstepB = (size_t)Sched::BH * ldb * 2;
    const unsigned ldsw = (unsigned)wid * 1024u;
    const int aoff = lds_byte(wr * 64 + fr, fq * 8), boff = lds_byte(wc * 32 + fr, fq * 8);
#define PG8_SA(b, h) (((b) * 2 + (h)) * HTB)
#define PG8_SB(b, h) ((4 + (b) * 2 + (h)) * HTB)
#define PG8_STAGE(bufoff, gbase, voff) do { _Pragma("unroll") for (int _i = 0; _i < 2; ++_i) \
        __builtin_amdgcn_global_load_lds((const unsigned*)((const char*)(gbase) + (voff)[_i]), (LAS unsigned*)(lds + (bufoff) + ldsw + _i * 8192), 16, 0, 0); } while (0)
#define PG8_LDA(dst, b, h) do { _Pragma("unroll") for (int m = 0; m < 4; ++m) _Pragma("unroll") for (int k = 0; k < 2; ++k) dst[m][k] = *(const LAS bf16x8*)(lds + PG8_SA(b, h) + aoff + m * 2048 + k * 1024); } while (0)
#define PG8_LDB(dst, b, h) do { _Pragma("unroll") for (int n = 0; n < 2; ++n) _Pragma("unroll") for (int k = 0; k < 2; ++k) dst[n][k] = *(const LAS bf16x8*)(lds + PG8_SB(b, h) + boff + n * 2048 + k * 1024); } while (0)
#define PG8_MMA(ai, bj, At, Bt) do { __builtin_amdgcn_s_setprio(1); _Pragma("unroll") for (int m = 0; m < 4; ++m) _Pragma("unroll") for (int n = 0; n < 2; ++n) _Pragma("unroll") for (int k = 0; k < 2; ++k) \
        acc[ai][bj][m][n] = __builtin_amdgcn_mfma_f32_16x16x32_bf16(Bt[n][k], At[m][k], acc[ai][bj][m][n], 0, 0, 0); __builtin_amdgcn_s_setprio(0); } while (0)
#define PG8_WAIT_V(n) asm volatile("s_waitcnt vmcnt(" #n ")" ::: "memory")
#define PG8_WAIT_L(n) asm volatile("s_waitcnt lgkmcnt(" #n ")" ::: "memory")
#define PG8_BAR __builtin_amdgcn_s_barrier()
#define PG8_SCHED __builtin_amdgcn_sched_barrier(0)
    Unit cur, nxt; int ui = 0;
    if (!S.next(0, cur)) return;
    f32x4 acc[2][2][4][2];
#pragma unroll
    for (int a = 0; a < 2; ++a)
#pragma unroll
        for (int b = 0; b < 2; ++b)
#pragma unroll
            for (int m = 0; m < 4; ++m)
#pragma unroll
                for (int n = 0; n < 2; ++n) acc[a][b][m][n] = (f32x4){0.f, 0.f, 0.f, 0.f};
    bf16x8 At[4][2], B0[2][2], B1[2][2];
    const char* cA = cur.A; const char* cB = cur.B;
    {
        PG8_STAGE(PG8_SB(0, 0), cB, voffB); PG8_STAGE(PG8_SB(0, 1), cB + hstepB, voffB); PG8_STAGE(PG8_SA(0, 0), cA, voffA); PG8_STAGE(PG8_SA(0, 1), cA + hstepA, voffA);
        if (wr == 1) PG8_BAR;
        PG8_WAIT_V(2); PG8_BAR;
        PG8_STAGE(PG8_SB(1, 0), cB + kstep, voffB); PG8_STAGE(PG8_SA(1, 0), cA + kstep, voffA); PG8_STAGE(PG8_SB(1, 1), cB + hstepB + kstep, voffB);
        PG8_WAIT_V(6); PG8_BAR;
    }
    for (;;) {
        const bool has_next = S.next(ui + 1, nxt);
        const char* nA = has_next ? nxt.A : cA; const char* nB = has_next ? nxt.B : cB;
        const int nt = cur.nt;
        for (int t = 0; t < nt; t += 2) {
            const bool last = (t == nt - 2);
            const char* a1 = cA + (size_t)(t + 1) * kstep;
            const char* a2 = last ? nA : cA + (size_t)(t + 2) * kstep; const char* b2 = last ? nB : cB + (size_t)(t + 2) * kstep;
            const char* a3 = a2 + kstep; const char* b3 = b2 + kstep;
            PG8_LDB(B0, 0, 0); PG8_LDB(B1, 0, 1); PG8_SCHED; PG8_LDA(At, 0, 0); PG8_STAGE(PG8_SA(1, 1), a1 + hstepA, voffA);
            PG8_WAIT_V(8); PG8_WAIT_L(0); PG8_BAR; PG8_MMA(0, 0, At, B0); PG8_MMA(0, 1, At, B1); PG8_BAR; PG8_SCHED;
            PG8_LDA(At, 0, 1); PG8_STAGE(PG8_SB(0, 0), b2, voffB); PG8_STAGE(PG8_SB(0, 1), b2 + hstepB, voffB); PG8_STAGE(PG8_SA(0, 0), a2, voffA);
            PG8_WAIT_V(8); PG8_WAIT_L(0); PG8_BAR; PG8_MMA(1, 0, At, B0); PG8_MMA(1, 1, At, B1); PG8_BAR; PG8_SCHED;
            PG8_LDB(B0, 1, 0); PG8_LDB(B1, 1, 1); PG8_SCHED; PG8_LDA(At, 1, 0); PG8_STAGE(PG8_SA(0, 1), a2 + hstepA, voffA);
            PG8_WAIT_V(8); PG8_WAIT_L(0); PG8_BAR; PG8_MMA(0, 0, At, B0); PG8_MMA(0, 1, At, B1); PG8_BAR; PG8_SCHED;
            PG8_LDA(At, 1, 1); PG8_STAGE(PG8_SB(1, 0), b3, voffB); PG8_STAGE(PG8_SB(1, 1), b3 + hstepB, voffB); PG8_STAGE(PG8_SA(1, 0), a3, voffA);
            PG8_WAIT_V(8); PG8_WAIT_L(0); PG8_BAR; PG8_MMA(1, 0, At, B0); PG8_MMA(1, 1, At, B1); PG8_BAR; PG8_SCHED;
        }
        if (wr == 0) PG8_BAR;
        E(acc, cur, wr, wc);
        if (!has_next) break;
        if (!Epi::CHAIN || cur.aux == 2) {
#pragma unroll
        for (int a = 0; a < 2; ++a)
#pragma unroll
            for (int b = 0; b < 2; ++b)
#pragma unroll
                for (int m = 0; m < 4; ++m)
#pragma unroll
                    for (int n = 0; n < 2; ++n) acc[a][b][m][n] = (f32x4){0.f, 0.f, 0.f, 0.f};
        }
        cur = nxt; cA = nA; cB = nB; ++ui;
        if (wr == 1) PG8_BAR;
    }
    PG8_WAIT_V(0);
    PG8_BAR;
#undef PG8_SA
#undef PG8_SB
#undef PG8_STAGE
#undef PG8_LDA
#undef PG8_LDB
#undef PG8_MMA
#undef PG8_WAIT_V
#undef PG8_WAIT_L
#undef PG8_BAR
#undef PG8_SCHED
}
}
using pg8::Unit;
typedef const f32x4 (&AccRef)[2][2][4][2];

struct SchedGrid {
    static __device__ __forceinline__ int brow(int r) { return r; } static constexpr int BH = 128;
    pg8::StaticOrder so; const char* A; const char* B; size_t tsA, tsB; int nt, nextra, ex_pm0, ex_pn0, ex_w, ex_ks;
    __device__ __forceinline__ bool next(int i, Unit& u) const {
        int pm, pn; int kp = 0, ntu = nt, aux = 0;
        if (!so.next(i, pm, pn)) { const long e = (long)i * so.G + so.c - so.nwg; if (e >= nextra) return false; const int te = (int)e / ex_ks; kp = (int)e % ex_ks; ntu = nt / ex_ks; aux = ex_ks > 1 ? 1 : 0;
            pm = ex_pm0 + te / ex_w; pn = ex_pn0 + te % ex_w; }
        u.A = A + (size_t)pm * tsA + (size_t)kp * ntu * 128; u.B = B + (size_t)pn * tsB + (size_t)kp * ntu * 128; u.nt = ntu; u.pm = pm; u.pn = pn; u.aux = aux; return true;
    }
};
struct SchedBranch {
    static __device__ __forceinline__ int brow(int r) { return r; } static constexpr int BH = 128;
    pg8::StaticOrder so; const char* proj; const char* wbr;
    __device__ __forceinline__ bool next(int i, Unit& u) const {
        int pm, pn; if (!so.next(i / 3, pm, pn)) return false;
        const int br = i % 3; const int acol = br == 0 ? 0 : (br == 1 ? OFF_Q : OFF_C), koff = br == 0 ? 0 : (br == 1 ? 512 : 1536);
        u.A = proj + ((size_t)pm * 256 * INW + acol) * 2; u.B = wbr + ((size_t)pn * 256 * DM + koff) * 2; u.nt = br == 1 ? 16 : 8; u.pm = pm; u.pn = pn; u.aux = br; return true;
    }
};
struct SchedF1L {
    static __device__ __forceinline__ int brow(int r) { return (r >> 6) + 64 * (r & 63); } static constexpr int BH = 2;
    const char* dftd; const char* proj; int G, c;
    __device__ __forceinline__ bool next(int i, Unit& u) const {
        const int L = i * G + c; if (L >= 256) return false;
        { const char* ap = dftd; asm volatile("" : "+s"(ap)); u.A = ap; } u.nt = 2; u.pm = 0;
        const int b = L >> 6, g = (L >> 4) & 3, pn = L & 15; u.B = proj + ((size_t)(b * 4096 + 4 * pn) * INW + g * 128) * 2; u.pn = pn; u.aux = b * 4 + g; return true;
    }
};
struct SchedF1 {
    static __device__ __forceinline__ int brow(int r) { return r; } static constexpr int BH = 128;
    const char* dftd; const char* proj; int G, c, nctx;
    __device__ __forceinline__ bool next(int i, Unit& u) const {
        const int e = i * G + c; if (e >= nctx) return false;
        { const char* ap = dftd; asm volatile("" : "+s"(ap)); u.A = ap; } u.nt = 2; u.pm = 0;
        const int b = e >> 2, g = e & 3; u.B = proj + ((size_t)(MLAT + b * 256) * INW + g * 128) * 2; u.pn = 0; u.aux = 16 + b * 4 + g; return true;
    }
};
struct SchedF2 {
    static __device__ __forceinline__ int brow(int r) { return r; } static constexpr int BH = 128;
    const char* dftc; const char* pqtc; int G, c, nctx;
    __device__ __forceinline__ bool next(int i, Unit& u) const {
        const int e = i * G + c; if (e >= nctx) return false;
        const int b = e >> 1, pn = e & 1; { const char* ap = dftc; asm volatile("" : "+s"(ap)); u.A = ap; } u.B = pqtc + (size_t)(b * 512 + pn * 256) * 8192 * 2; u.nt = 8; u.pm = 0; u.pn = pn; u.aux = 4 + b; return true;
    }
};
struct SchedFA {
    static __device__ __forceinline__ int brow(int r) { return r; } static constexpr int BH = 128;
    const char* ma; const char* ub; int G, c;
    __device__ __forceinline__ bool next(int i, Unit& u) const {
        const int L = i * G + c; if (L >= 512) return false;
        { const char* ap = ma; asm volatile("" : "+s"(ap)); u.A = ap; } u.B = ub + (size_t)L * 256 * 128 * 2; u.nt = 2; u.pm = 0; u.pn = L; u.aux = 0; return true;
    }
};
struct SchedFB {
    static __device__ __forceinline__ int brow(int r) { return r; } static constexpr int BH = 128;
    const char* tt; const char* zb; int G, c;
    __device__ __forceinline__ bool next(int i, Unit& u) const {
        const int L = i * G + c; if (L >= 512) return false;
        const int k2 = L >> 3, pn = L & 7; u.A = tt + (size_t)k2 * 256 * 128 * 2; u.B = zb + ((size_t)k2 * 2048 + pn * 256) * 128 * 2; u.nt = 2; u.pm = 0; u.pn = pn; u.aux = k2; return true;
    }
};

struct EpiInProj {
    static constexpr bool PERM = true, CHAIN = false;
    bf16_t* proj; bf16_t* vt; bf16_t* vtc;
    __device__ __forceinline__ void operator()(AccRef acc, const Unit& u, int wr, int wc) const {
        const int ln_ = fresh_lane(), fr = ln_ & 15, fq = ln_ >> 4;
        const int pm = u.pm, pn = u.pn; const int row0 = pm * 256 + wr * 64 + fr, col0 = pn * 256 + wc * 32 + 8 * fq;
        if (pn >= 10 && pn < 14) {
            const int vc0 = col0 - OFF_V;
#pragma unroll
            for (int ai = 0; ai < 2; ++ai)
#pragma unroll
                for (int m = 0; m < 4; ++m) {
                    const int row = row0 + ai * 128 + m * 16; bf16_t* dst; size_t stride;
                    if (pm < 64) { const int b = pm >> 4; dst = vt + (size_t)b * 1024 * 4096 + (row - b * 4096); stride = 4096; }
                    else { const int b = pm - 64; dst = vtc + (size_t)b * 1024 * 256 + (row - MLAT - b * 256); stride = 256; }
#pragma unroll
                    for (int bj = 0; bj < 2; ++bj)
#pragma unroll
                        for (int n = 0; n < 2; ++n) { const f32x4 v = acc[ai][bj][m][n]; const unsigned w0 = cvt_pk_bf16(v[0], v[1]), w1 = cvt_pk_bf16(v[2], v[3]);
                            bf16_t* d = dst + (size_t)(vc0 + bj * 128 + n * 4) * stride;
                            d[0] = (bf16_t)(w0 & 0xffffu); d[stride] = (bf16_t)(w0 >> 16); d[2 * stride] = (bf16_t)(w1 & 0xffffu); d[3 * stride] = (bf16_t)(w1 >> 16); }
                }
            return;
        }
        const int act = pn < 14 ? 0 : (pn < 18 ? 1 : 2); const float sc = (pn >= 2 && pn < 6) ? 0.08838834764831845f : 1.0f;
#pragma unroll
        for (int ai = 0; ai < 2; ++ai)
#pragma unroll
            for (int m = 0; m < 4; ++m) { bf16_t* rowp = proj + (size_t)(row0 + ai * 128 + m * 16) * INW + col0;
#pragma unroll
                for (int bj = 0; bj < 2; ++bj) { f32x4 v0 = acc[ai][bj][m][0], v1 = acc[ai][bj][m][1];
                    if (act == 1) { f32x2 a = gelu_pk((f32x2){v0[0], v0[1]}), b = gelu_pk((f32x2){v0[2], v0[3]}), c = gelu_pk((f32x2){v1[0], v1[1]}), d = gelu_pk((f32x2){v1[2], v1[3]});
                        v0 = (f32x4){a.x, a.y, b.x, b.y}; v1 = (f32x4){c.x, c.y, d.x, d.y}; }
                    else if (act == 2) { v0 = (f32x4){fsigmoid(v0[0]), fsigmoid(v0[1]), fsigmoid(v0[2]), fsigmoid(v0[3])}; v1 = (f32x4){fsigmoid(v1[0]), fsigmoid(v1[1]), fsigmoid(v1[2]), fsigmoid(v1[3])}; }
                    else { v0 = v0 * sc; v1 = v1 * sc; }
                    u32x4 w; w.x = cvt_pk_bf16(v0[0], v0[1]); w.y = cvt_pk_bf16(v0[2], v0[3]); w.z = cvt_pk_bf16(v1[0], v1[1]); w.w = cvt_pk_bf16(v1[2], v1[3]);
                    *(u32x4*)(rowp + bj * 128) = w; } }
    }
};
struct EpiPlain {
    static constexpr bool PERM = true, CHAIN = false;
    bf16_t* out; int ld;
    __device__ __forceinline__ void operator()(AccRef acc, const Unit& u, int wr, int wc) const {
        const int ln_ = fresh_lane(), fr = ln_ & 15, fq = ln_ >> 4;
        const int row0 = u.pm * 256 + wr * 64 + fr, col0 = u.pn * 256 + wc * 32 + 8 * fq;
#pragma unroll
        for (int ai = 0; ai < 2; ++ai)
#pragma unroll
            for (int m = 0; m < 4; ++m) { bf16_t* rowp = out + (size_t)(row0 + ai * 128 + m * 16) * ld + col0;
#pragma unroll
                for (int bj = 0; bj < 2; ++bj) { const f32x4 v0 = acc[ai][bj][m][0], v1 = acc[ai][bj][m][1];
                    u32x4 w; w.x = cvt_pk_bf16(v0[0], v0[1]); w.y = cvt_pk_bf16(v0[2], v0[3]); w.z = cvt_pk_bf16(v1[0], v1[1]); w.w = cvt_pk_bf16(v1[2], v1[3]);
                    *(u32x4*)(rowp + bj * 128) = w; } }
    }
};
struct EpiF1 {
    static constexpr bool PERM = true, CHAIN = false;
    bf16_t* pqt; bf16_t* pqtc;
    __device__ __forceinline__ void operator()(AccRef acc, const Unit& u, int wr, int wc) const {
        const int ln_ = fresh_lane(), fr = ln_ & 15, fq = ln_ >> 4;
        const int aux = u.aux; const bool isc = aux >= 16; const int bg = aux & 15, b = bg >> 2, g = bg & 3;
        bf16_t* base = (isc ? pqtc : pqt) + (size_t)(b * 512 + g * 128) * 8192; const int half = isc ? 256 : 4096;
        const int n0 = u.pn * 256 + wc * 32 + 8 * fq;
#pragma unroll
        for (int ai = 0; ai < 2; ++ai)
#pragma unroll
            for (int m = 0; m < 4; ++m) { bf16_t* rowp = base + (size_t)(wr * 64 + m * 16 + fr) * 8192 + ai * half + n0;
#pragma unroll
                for (int bj = 0; bj < 2; ++bj) { const f32x4 v0 = acc[ai][bj][m][0], v1 = acc[ai][bj][m][1];
                    u32x4 w; w.x = cvt_pk_bf16(v0[0], v0[1]); w.y = cvt_pk_bf16(v0[2], v0[3]); w.z = cvt_pk_bf16(v1[0], v1[1]); w.w = cvt_pk_bf16(v1[2], v1[3]);
                    *(u32x4*)(rowp + bj * 128) = w; } }
    }
};
struct EpiF1L {
    static constexpr bool PERM = true, CHAIN = false;
    bf16_t* ub;
    __device__ __forceinline__ void operator()(AccRef acc, const Unit& u, int wr, int wc) const {
        const int ln_ = fresh_lane(), fr = ln_ & 15, fq = ln_ >> 4;
        const int b = u.aux >> 2, g = u.aux & 3;
#pragma unroll
        for (int ai = 0; ai < 2; ++ai)
#pragma unroll
            for (int m = 0; m < 4; ++m) { const int ch = b * 512 + g * 128 + wr * 64 + m * 16 + fr;
#pragma unroll
                for (int bj = 0; bj < 2; ++bj) { const int n1 = 4 * u.pn + 2 * bj + (wc >> 1), n2 = 32 * (wc & 1) + 8 * fq;
                    const f32x4 v0 = acc[ai][bj][m][0], v1 = acc[ai][bj][m][1];
                    u32x4 w; w.x = cvt_pk_bf16(v0[0], v0[1]); w.y = cvt_pk_bf16(v0[2], v0[3]); w.z = cvt_pk_bf16(v1[0], v1[1]); w.w = cvt_pk_bf16(v1[2], v1[3]);
                    *(u32x4*)(ub + ((size_t)ch * 64 + n1) * 128 + ai * 64 + n2) = w; } }
    }
};
struct EpiFA {
    static constexpr bool PERM = true, CHAIN = false;
    bf16_t* zb;
    __device__ __forceinline__ void operator()(AccRef acc, const Unit& u, int wr, int wc) const {
        if (wr != 0) return;
        const int ln_ = fresh_lane(), fr = ln_ & 15, fq = ln_ >> 4;
#pragma unroll
        for (int ai = 0; ai < 2; ++ai)
#pragma unroll
            for (int m = 0; m < 4; ++m) { const int k2 = m * 16 + fr;
#pragma unroll
                for (int bj = 0; bj < 2; ++bj) { const int bc = u.pn * 4 + 2 * bj + (wc >> 1), n1 = 32 * (wc & 1) + 8 * fq;
                    const f32x4 v0 = acc[ai][bj][m][0], v1 = acc[ai][bj][m][1];
                    u32x4 w; w.x = cvt_pk_bf16(v0[0], v0[1]); w.y = cvt_pk_bf16(v0[2], v0[3]); w.z = cvt_pk_bf16(v1[0], v1[1]); w.w = cvt_pk_bf16(v1[2], v1[3]);
                    *(u32x4*)(zb + ((size_t)k2 * 2048 + bc) * 128 + ai * 64 + n1) = w; } }
    }
};
struct EpiFB {
    static constexpr bool PERM = true, CHAIN = false;
    bf16_t* proj;
    __device__ __forceinline__ void operator()(AccRef acc, const Unit& u, int wr, int wc) const {
        if (wr != 0) return;
        const int ln_ = fresh_lane(), fr = ln_ & 15, fq = ln_ >> 4;
        const float sc = 0.0013810679320049757f; const int k2 = u.aux;
#pragma unroll
        for (int m = 0; m < 4; ++m) { const int k = 64 * (m * 16 + fr) + k2;
#pragma unroll
            for (int bj = 0; bj < 2; ++bj) { const int ncol = u.pn * 256 + 128 * bj + 32 * wc + 8 * fq; const int b = ncol >> 9, ch = ncol & 511;
                const f32x4 v0 = acc[0][bj][m][0] * sc, v1 = acc[0][bj][m][1] * sc;
                u32x4 w; w.x = cvt_pk_bf16(v0[0], v0[1]); w.y = cvt_pk_bf16(v0[2], v0[3]); w.z = cvt_pk_bf16(v1[0], v1[1]); w.w = cvt_pk_bf16(v1[2], v1[3]);
                *(u32x4*)(proj + (size_t)(b * 4096 + k) * INW + ch) = w; } }
    }
};
struct EpiF2 {
    static constexpr bool PERM = true, CHAIN = false;
    bf16_t* proj;
    __device__ __forceinline__ void operator()(AccRef acc, const Unit& u, int wr, int wc) const {
        const int ln_ = fresh_lane(), fr = ln_ & 15, fq = ln_ >> 4;
        const int aux = u.aux; const bool isc = aux >= 4; const int rowbase = isc ? MLAT + (aux - 4) * 256 : aux * 4096;
        const float sc = isc ? 0.005524271728019903f : 0.0013810679320049757f;
        const int row0 = rowbase + u.pm * 256 + wr * 64 + fr, col0 = u.pn * 256 + wc * 32 + 8 * fq;
#pragma unroll
        for (int ai = 0; ai < 2; ++ai)
#pragma unroll
            for (int m = 0; m < 4; ++m) { bf16_t* rowp = proj + (size_t)(row0 + ai * 128 + m * 16) * INW + col0;
#pragma unroll
                for (int bj = 0; bj < 2; ++bj) { const f32x4 v0 = acc[ai][bj][m][0] * sc, v1 = acc[ai][bj][m][1] * sc;
                    u32x4 w; w.x = cvt_pk_bf16(v0[0], v0[1]); w.y = cvt_pk_bf16(v0[2], v0[3]); w.z = cvt_pk_bf16(v1[0], v1[1]); w.w = cvt_pk_bf16(v1[2], v1[3]);
                    *(u32x4*)(rowp + bj * 128) = w; } }
    }
};
typedef f32x4 (&AccMut)[2][2][4][2];
struct EpiBranch {
    static constexpr bool PERM = false, CHAIN = true;
    const bf16_t* proj; bf16_t* merged;
    __device__ __forceinline__ void operator()(AccMut acc, const Unit& u, int wr, int wc) const {
        const int ln_ = fresh_lane(), fr = ln_ & 15, fq = ln_ >> 4;
        const int br = u.aux; const int col0 = u.pn * 256 + wc * 32 + 4 * fq;
#pragma unroll
        for (int ai = 0; ai < 2; ++ai)
#pragma unroll
            for (int m = 0; m < 4; ++m) { const size_t row = (size_t)(u.pm * 256 + ai * 128 + wr * 64 + m * 16 + fr);
#pragma unroll
                for (int bj = 0; bj < 2; ++bj)
#pragma unroll
                    for (int n = 0; n < 2; ++n) { const int col = col0 + bj * 128 + n * 16;
                        const bf16_t* gp = proj + row * INW + OFF_G + br * DM + col;
                        const u32x2 gw = *(const u32x2*)gp; const f32x4 g = (f32x4){bflo(gw.x), bfhi(gw.x), bflo(gw.y), bfhi(gw.y)};
                        if (br < 2) { const u32x2 hw = *(const u32x2*)(gp + DM);
                            const f32x4 r = (f32x4){__builtin_amdgcn_rcpf(fmaxf(bflo(hw.x), 1e-30f)), __builtin_amdgcn_rcpf(fmaxf(bfhi(hw.x), 1e-30f)), __builtin_amdgcn_rcpf(fmaxf(bflo(hw.y), 1e-30f)), __builtin_amdgcn_rcpf(fmaxf(bfhi(hw.y), 1e-30f))};
                            acc[ai][bj][m][n] = acc[ai][bj][m][n] * (g * r); }
                        else { const f32x4 v = acc[ai][bj][m][n] * g; u32x2 w; w.x = cvt_pk_bf16(v[0], v[1]); w.y = cvt_pk_bf16(v[2], v[3]); *(u32x2*)(merged + row * DM + col) = w; } } }
    }
};
struct EpiResid {
    static constexpr bool PERM = false, CHAIN = false;
    const float* src_lat; const float* src_ctx; float* dst_lat; float* dst_ctx; const float* gate;
    __device__ __forceinline__ void operator()(AccRef acc, const Unit& u, int wr, int wc) const {
        const int ln_ = fresh_lane(), fr = ln_ & 15, fq = ln_ >> 4;
        const int pm = u.pm; const int b = pm < 64 ? (pm >> 4) : 4; const float* g = gate + (size_t)b * 12288; const int col0 = u.pn * 256 + wc * 32 + 4 * fq;
        const float* s0 = pm < 64 ? src_lat + (size_t)pm * 256 * DM : src_ctx + (size_t)(pm - 64) * 256 * DM;
        float* d0 = pm < 64 ? dst_lat + (size_t)pm * 256 * DM : dst_ctx + (size_t)(pm - 64) * 256 * DM;
        f32x4 gv[2][2];
#pragma unroll
        for (int bj = 0; bj < 2; ++bj)
#pragma unroll
            for (int n = 0; n < 2; ++n) gv[bj][n] = *(const f32x4*)(g + col0 + bj * 128 + n * 16);
#pragma unroll
        for (int ai = 0; ai < 2; ++ai)
#pragma unroll
            for (int m = 0; m < 4; ++m) { const size_t ro = (size_t)(ai * 128 + wr * 64 + m * 16 + fr) * DM;
#pragma unroll
                for (int bj = 0; bj < 2; ++bj)
#pragma unroll
                    for (int n = 0; n < 2; ++n) { const int col = col0 + bj * 128 + n * 16;
                        if (u.aux) { const f32x4 v = gv[bj][n] * acc[ai][bj][m][n]; float* d = d0 + ro + col;
                            unsafeAtomicAdd(d, v[0]); unsafeAtomicAdd(d + 1, v[1]); unsafeAtomicAdd(d + 2, v[2]); unsafeAtomicAdd(d + 3, v[3]); }
                        else *(f32x4*)(d0 + ro + col) = *(const f32x4*)(s0 + ro + col) + gv[bj][n] * acc[ai][bj][m][n]; } }
    }
};

struct Args { const float* in[22]; float* out; unsigned char* ws; int ph_lo, ph_hi; };

__device__ __forceinline__ void transpose_item(const float* W, int N, bf16_t* WT, int ldk, int koff, LAS float* scr, int item, int lane) {
    const int nblk = N / 32, kb = item / nblk, nb = item % nblk, k0 = 64 * kb, n0 = 32 * nb;
#pragma unroll 8
    for (int i = 0; i < 32; ++i) { const int kk = 2 * i + (lane >> 5); scr[kk * 33 + (lane & 31)] = W[(size_t)(k0 + kk) * N + n0 + (lane & 31)]; }
    LDS_WAIT(); asm volatile("" ::: "memory");
    const int c = lane & 7;
#pragma unroll
    for (int j = 0; j < 4; ++j) { const int n = (lane >> 3) + 8 * j; const LAS float* s = scr + (8 * c) * 33 + n;
        u32x4 o; o.x = cvt_pk_bf16(s[0 * 33], s[1 * 33]); o.y = cvt_pk_bf16(s[2 * 33], s[3 * 33]); o.z = cvt_pk_bf16(s[4 * 33], s[5 * 33]); o.w = cvt_pk_bf16(s[6 * 33], s[7 * 33]);
        *(u32x4*)(WT + (size_t)(n0 + n) * ldk + koff + k0 + 8 * c) = o; }
    LDS_WAIT(); asm volatile("" ::: "memory");
}
template <class AR>
__device__ __forceinline__ void convert_weights(const AR& a, int l, LAS float* scr, int gw, int NGW, int lane) {
    unsigned char* ws = a.ws;
    const float* w_in = a.in[8] + (size_t)l * DM * INW; const float* w_f = a.in[13] + (size_t)l * 512 * DM; const float* w_na = a.in[14] + (size_t)l * 1024 * DM;
    const float* w_c = a.in[15] + (size_t)l * 512 * DM; const float* w_o = a.in[16] + (size_t)l * DM * DM; const float* w_up = a.in[17] + (size_t)l * DM * UPW; const float* w_dn = a.in[20] + (size_t)l * DFF * DM;
    constexpr int I_IN = 32 * 336, I_F = 8 * 64, I_NA = 16 * 64, I_C = 8 * 64, I_O = 32 * 64, I_UP = 32 * 352, I_DN = 88 * 64;
    constexpr int NITEMS = I_IN + I_F + I_NA + I_C + I_O + I_UP + I_DN;
    for (int it = gw; it < NITEMS; it += NGW) {
        int r = it;
        if (r < I_IN) { transpose_item(w_in, INW, (bf16_t*)(ws + WS_WIN), DM, 0, scr, r, lane); continue; } r -= I_IN;
        if (r < I_F) { transpose_item(w_f, DM, (bf16_t*)(ws + WS_WBR), DM, 0, scr, r, lane); continue; } r -= I_F;
        if (r < I_NA) { transpose_item(w_na, DM, (bf16_t*)(ws + WS_WBR), DM, 512, scr, r, lane); continue; } r -= I_NA;
        if (r < I_C) { transpose_item(w_c, DM, (bf16_t*)(ws + WS_WBR), DM, 1536, scr, r, lane); continue; } r -= I_C;
        if (r < I_O) { transpose_item(w_o, DM, (bf16_t*)(ws + WS_WO), DM, 0, scr, r, lane); continue; } r -= I_O;
        if (r < I_UP) { transpose_item(w_up, UPW, (bf16_t*)(ws + WS_WUP), DM, 0, scr, r, lane); continue; } r -= I_UP;
        transpose_item(w_dn, DM, (bf16_t*)(ws + WS_WDN), DFF, 0, scr, r, lane);
    }
}
__device__ __forceinline__ void dft_tables(unsigned char* ws, const LAS float* lut, int gw, int NGW, int lane) {
    bf16_t* tt = (bf16_t*)(ws + WS_TT); bf16_t* ma = (bf16_t*)(ws + WS_MA); bf16_t* dftc = (bf16_t*)(ws + WS_DFTC);
    const int half = lane >> 5, x0 = (lane & 31) * 2;
    for (int it = gw; it < 16384 + 256 + 256; it += NGW) {
        if (it < 16384) { const int k2 = it >> 8, k1 = it & 255; float v0 = 0.f, v1 = 0.f;
            if (k1 < 64) { const int k = 64 * k1 + k2, sh = half ? 3072 : 0;
                v0 = lut[(x0 * k + sh) & 4095]; v1 = lut[((x0 + 1) * k + sh) & 4095]; }
            *(unsigned*)(tt + (size_t)it * 128 + half * 64 + x0) = cvt_pk_bf16(v0, v1);
        } else if (it < 16384 + 256) { const int r = it - 16384; float v0 = 0.f, v1 = 0.f;
            if ((r & 64) == 0) { const int k2 = r & 63, im = r >> 7;
                const int sh = im ? (half ? 2048 : 1024) : (half ? 1024 : 0);
                v0 = lut[(((x0 * k2) & 63) * 64 + sh) & 4095]; v1 = lut[((((x0 + 1) * k2) & 63) * 64 + sh) & 4095]; }
            *(unsigned*)(ma + (size_t)r * 128 + half * 64 + x0) = cvt_pk_bf16(v0, v1);
        } else { const int k = it - 16384 - 256; const int n0 = lane * 8; const int nn = n0 & 255, sh = n0 >= 256 ? 1024 : 0; float v[8];
#pragma unroll
            for (int e = 0; e < 8; ++e) v[e] = lut[((((k * (nn + e)) & 255) * 16) + sh) & 4095];
            u32x4 w; w.x = cvt_pk_bf16(v[0], v[1]); w.y = cvt_pk_bf16(v[2], v[3]); w.z = cvt_pk_bf16(v[4], v[5]); w.w = cvt_pk_bf16(v[6], v[7]);
            *(u32x4*)(dftc + (size_t)k * 8192 + n0) = w; }
    }
}
template <class AR>
__device__ __forceinline__ void mods_items(const AR& a, int gw, int NGW, int lane) {
    float* mods = (float*)(a.ws + WS_MODS);
    for (int it = gw; it < 1536; it += NGW) {
        const int l = it / 768, rem = it % 768, cch = rem >> 4, kp = rem & 15; const int col = cch * 256 + lane * 4, k0 = kp * 128;
        float sv[5][2];
#pragma unroll
        for (int r = 0; r < 5; ++r)
#pragma unroll
            for (int i = 0; i < 2; ++i) { const int k = k0 + lane + 64 * i; const float cv = r < 4 ? a.in[1][r * DM + k] : a.in[3][k]; sv[r][i] = fsilu(cv); }
        f32x4 acc[5];
#pragma unroll
        for (int r = 0; r < 5; ++r) acc[r] = (f32x4){0.f, 0.f, 0.f, 0.f};
        const float* wbase = a.in[4] + ((size_t)l * DM + k0) * 12288 + col;
#pragma unroll
        for (int i = 0; i < 2; ++i) {
#pragma unroll 16
            for (int ll = 0; ll < 64; ++ll) { const f32x4 w = *(const f32x4*)(wbase + (size_t)(i * 64 + ll) * 12288);
#pragma unroll
                for (int r = 0; r < 5; ++r) { const float s = __int_as_float(__builtin_amdgcn_readlane(__float_as_int(sv[r][i]), ll)); acc[r] += w * s; } }
        }
        if (kp == 0) { const f32x4 bv = *(const f32x4*)(a.in[5] + (size_t)l * 12288 + col);
#pragma unroll
            for (int r = 0; r < 5; ++r) acc[r] += bv; }
#pragma unroll
        for (int r = 0; r < 5; ++r) { float* d = mods + ((size_t)l * 5 + r) * 12288 + col; unsafeAtomicAdd(d, acc[r][0]); unsafeAtomicAdd(d + 1, acc[r][1]); unsafeAtomicAdd(d + 2, acc[r][2]); unsafeAtomicAdd(d + 3, acc[r][3]); }
    }
}
__device__ __forceinline__ void norm_rows(const float* xlat, const float* xctx, const float* w, const float* mods_l, int shoff, int scoff, bf16_t* XN, int nrows, int gw, int NGW, int lane) {
    for (int row = gw; row < nrows; row += NGW) {
        const float* xr = row < MLAT ? xlat + (size_t)row * DM : xctx + (size_t)(row - MLAT) * DM; const int b = row < MLAT ? (row >> 12) : 4;
        const float* sh = mods_l + (size_t)b * 12288 + shoff; const float* sc = mods_l + (size_t)b * 12288 + scoff;
        f32x4 v[8]; float ss = 0.f;
#pragma unroll
        for (int j = 0; j < 8; ++j) { v[j] = *(const f32x4*)(xr + 4 * lane + 256 * j); ss += (v[j][0] * v[j][0] + v[j][1] * v[j][1]) + (v[j][2] * v[j][2] + v[j][3] * v[j][3]); }
        const float rstd = rsqrtf(wave_sum(ss, lane) * (1.0f / DM) + EPS);
#pragma unroll
        for (int j = 0; j < 8; ++j) { const int col = 4 * lane + 256 * j; const f32x4 wv = *(const f32x4*)(w + col), scv = *(const f32x4*)(sc + col), shv = *(const f32x4*)(sh + col);
            const f32x4 o = (v[j] * rstd * wv) * (scv + 1.0f) + shv; u32x2 pk; pk.x = cvt_pk_bf16(o[0], o[1]); pk.y = cvt_pk_bf16(o[2], o[3]);
            *(u32x2*)(XN + (size_t)row * DM + col) = pk; }
    }
}
__device__ __forceinline__ void final_norm(float* x, const float* w, int gw, int NGW, int lane) {
    for (int row = gw; row < MLAT; row += NGW) { float* xr = x + (size_t)row * DM; f32x4 v[8]; float ss = 0.f;
#pragma unroll
        for (int j = 0; j < 8; ++j) { v[j] = *(const f32x4*)(xr + 4 * lane + 256 * j); ss += (v[j][0] * v[j][0] + v[j][1] * v[j][1]) + (v[j][2] * v[j][2] + v[j][3] * v[j][3]); }
        const float rstd = rsqrtf(wave_sum(ss, lane) * (1.0f / DM) + EPS);
#pragma unroll
        for (int j = 0; j < 8; ++j) { const int col = 4 * lane + 256 * j; *(f32x4*)(xr + col) = v[j] * rstd * *(const f32x4*)(w + col); } }
}
__device__ __forceinline__ void sgu_unit(bf16_t* proj, int row0, int g, const float* nw, const float* wsg, const float* bsg, LAS unsigned char* lds, int tid) {
    LAS bf16_t* vnt = (LAS bf16_t*)lds;
    const int lane = tid & 63, wid = tid >> 6, fr = lane & 15, fq = lane >> 4;
    {
        const int j = tid >> 2, q = tid & 3; const bf16_t* src = proj + (size_t)(row0 + j) * INW + OFF_C + 512 + g * 128 + q * 32;
        float v[32];
#pragma unroll
        for (int i = 0; i < 4; ++i) { const u32x4 w = *(const u32x4*)(src + 8 * i);
            v[8 * i + 0] = bflo(w.x); v[8 * i + 1] = bfhi(w.x); v[8 * i + 2] = bflo(w.y); v[8 * i + 3] = bfhi(w.y); v[8 * i + 4] = bflo(w.z); v[8 * i + 5] = bfhi(w.z); v[8 * i + 6] = bflo(w.w); v[8 * i + 7] = bfhi(w.w); }
        float s = 0.f;
#pragma unroll
        for (int e = 0; e < 32; ++e) s += v[e];
        s += shx(s, 1, lane); s += shx(s, 2, lane); const float mean = s * (1.0f / 128.0f);
        float qv = 0.f;
#pragma unroll
        for (int e = 0; e < 32; ++e) { v[e] -= mean; qv += v[e] * v[e]; }
        qv += shx(qv, 1, lane); qv += shx(qv, 2, lane); const float rstd = rsqrtf(qv * (1.0f / 128.0f) + EPS);
#pragma unroll
        for (int e = 0; e < 32; e += 2) { const int d = q * 32 + e; const unsigned w = cvt_pk_bf16(v[e] * rstd * nw[g * 128 + d], v[e + 1] * rstd * nw[g * 128 + d + 1]);
            vnt[d * 136 + j] = (bf16_t)(w & 0xffffu); vnt[(d + 1) * 136 + j] = (bf16_t)(w >> 16); }
    }
    __syncthreads();
    {
        const int i = 16 * wid + fr;
        bf16x8 wf[4];
#pragma unroll
        for (int ks = 0; ks < 4; ++ks) { const float* wp = wsg + (size_t)i * 128 + 32 * ks + 8 * fq; const f32x4 a = *(const f32x4*)wp, b = *(const f32x4*)(wp + 4);
            u32x4 w; w.x = cvt_pk_bf16(a[0], a[1]); w.y = cvt_pk_bf16(a[2], a[3]); w.z = cvt_pk_bf16(b[0], b[1]); w.w = cvt_pk_bf16(b[2], b[3]); wf[ks] = __builtin_bit_cast(bf16x8, w); }
        const float bias = bsg[i];
        bf16_t* up = proj + (size_t)(row0 + i) * INW + OFF_C + g * 128 + 4 * fq;
#pragma unroll
        for (int nt = 0; nt < 8; ++nt) { f32x4 acc = (f32x4){0.f, 0.f, 0.f, 0.f};
#pragma unroll
            for (int ks = 0; ks < 4; ++ks) { const bf16x8 af = *(const LAS bf16x8*)((const LAS unsigned char*)vnt + (16 * nt + fr) * 272 + (32 * ks + 8 * fq) * 2);
                acc = __builtin_amdgcn_mfma_f32_16x16x32_bf16(af, wf[ks], acc, 0, 0, 0); }
            const u32x2 uw = *(const u32x2*)(up + 16 * nt); u32x2 o;
            o.x = cvt_pk_bf16(bflo(uw.x) * (acc[0] + bias), bfhi(uw.x) * (acc[1] + bias)); o.y = cvt_pk_bf16(bflo(uw.y) * (acc[2] + bias), bfhi(uw.y) * (acc[3] + bias));
            *(u32x2*)(up + 16 * nt) = o; }
    }
    __syncthreads();
}
template <bool LAT>
__device__ __forceinline__ void attn_task(bf16_t* proj, const bf16_t* vt, const float* rpb, int t, int lane, const LAS unsigned char* cl) {
    constexpr int NCH = LAT ? 16 : 8, WCH = LAT ? 8 : 0;
    const int fr = lane & 15, fq = lane >> 4;
    int b, h, r = 0, cgp = 0, qrow;
    if (LAT) { cgp = t & 3; r = (t >> 2) & 63; h = (t >> 8) & 7; b = t >> 11; qrow = b * 4096 + r * 64 + cgp * 16 + fr; }
    else { const int qg = t & 15; h = (t >> 4) & 7; b = t >> 7; qrow = MLAT + b * 256 + qg * 16 + fr; }
    bf16_t* qp = proj + (size_t)qrow * INW + OFF_Q + h * 128;
    bf16x8 qf[4];
#pragma unroll
    for (int ks = 0; ks < 4; ++ks) qf[ks] = *(const bf16x8*)(qp + ks * 32 + fq * 8);
    const int rs = r < 4 ? 0 : (r > 60 ? 56 : r - 4);
    const int cb = cgp == 0 ? 0 : (cgp == 1 ? 8 : (cgp == 2 ? 24 : 32));
    float S[NCH][8];
    const int kap = 8 * (fr >> 2) + (fr & 3);
    const bf16_t* kbase = proj + OFF_K + h * 128 + fq * 8;
    bf16x8 kf[2][8];
#define ATT_LOADK(buf, c) do { _Pragma("unroll") for (int tt = 0; tt < 2; ++tt) { \
        if ((c) < WCH) { const int krow = b * 4096 + (rs + (c)) * 64 + cb + kap + 4 * tt; const bf16_t* kp = kbase + (size_t)krow * INW; \
            _Pragma("unroll") for (int ks = 0; ks < 4; ++ks) kf[buf][tt * 4 + ks] = *(const bf16x8*)(kp + ks * 32); } \
        else { const LAS unsigned char* kp = cl + (32 * ((c) - WCH) + kap + 4 * tt) * 256; \
            _Pragma("unroll") for (int ks = 0; ks < 4; ++ks) kf[buf][tt * 4 + ks] = *(const LAS bf16x8*)(kp + (((ks * 4 + fq) ^ fr) * 16)); } } } while (0)
    ATT_LOADK(0, 0);
#pragma unroll
    for (int c = 0; c < NCH; ++c) {
        if (c + 1 < NCH) ATT_LOADK((c + 1) & 1, c + 1);
        __builtin_amdgcn_sched_barrier(0);
#pragma unroll
        for (int tt = 0; tt < 2; ++tt) {
            f32x4 acc = (f32x4){0.f, 0.f, 0.f, 0.f};
#pragma unroll
            for (int ks = 0; ks < 4; ++ks) acc = __builtin_amdgcn_mfma_f32_16x16x32_bf16(kf[c & 1][tt * 4 + ks], qf[ks], acc, 0, 0, 0);
            S[c][4 * tt + 0] = acc[0]; S[c][4 * tt + 1] = acc[1]; S[c][4 * tt + 2] = acc[2]; S[c][4 * tt + 3] = acc[3];
        }
        __builtin_amdgcn_sched_barrier(0);
    }
#undef ATT_LOADK
    if (LAT) {
        const int qc = cgp * 16 + fr; const int cs = qc < 8 ? 0 : (qc > 56 ? 48 : qc - 8);
#pragma unroll
        for (int c = 0; c < WCH; ++c) { const int dr = rs + c - r + 7; const float* rp = rpb + (h * 15 + dr) * 31;
#pragma unroll
            for (int jj = 0; jj < 8; ++jj) { const int kc = cb + 8 * fq + jj; const bool valid = (kc >= cs) && (kc < cs + 16); int dc = kc - qc + 15; dc = dc < 0 ? 0 : (dc > 30 ? 30 : dc);
                const float bias = rp[dc]; S[c][jj] = valid ? S[c][jj] + bias : -1e30f; } }
    }
    float mx = -3.0e38f;
#pragma unroll
    for (int c = 0; c < NCH; ++c)
#pragma unroll
        for (int jj = 0; jj < 8; ++jj) mx = fmaxf(mx, S[c][jj]);
    mx = fmaxf(mx, shx(mx, 16, lane)); mx = fmaxf(mx, shx(mx, 32, lane));
    float sum = 0.f; bf16x8 pf[NCH];
#pragma unroll
    for (int c = 0; c < NCH; ++c) { float p[8];
#pragma unroll
        for (int jj = 0; jj < 8; ++jj) { p[jj] = __builtin_amdgcn_exp2f((S[c][jj] - mx) * 1.44269504089f); sum += p[jj]; }
        u32x4 w; w.x = cvt_pk_bf16(p[0], p[1]); w.y = cvt_pk_bf16(p[2], p[3]); w.z = cvt_pk_bf16(p[4], p[5]); w.w = cvt_pk_bf16(p[6], p[7]); pf[c] = __builtin_bit_cast(bf16x8, w); }
    sum += shx(sum, 16, lane); sum += shx(sum, 32, lane);
    const float inv = 1.0f / sum;
    const bf16_t* vlat = vt + ((size_t)(b * 1024 + h * 128 + fr)) * 4096 + cb + 8 * fq;
    constexpr int NBH = NCH / 8, NQ = 8 * NBH;
    bf16x8 vf[2][8];
#define ATT_LOADV(buf, q) do { const int dt_ = (q) / NBH, hb_ = (q) % NBH; _Pragma("unroll") for (int i = 0; i < 8; ++i) { const int c_ = hb_ * 8 + i; \
        if (c_ < WCH) vf[buf][i] = *(const bf16x8*)(vlat + (size_t)dt_ * 16 * 4096 + (rs + c_) * 64); \
        else vf[buf][i] = *(const LAS bf16x8*)(cl + 65536 + (dt_ * 16 + fr) * 512 + ((((c_ - WCH) * 4 + fq) ^ fr) * 16)); } } while (0)
    ATT_LOADV(0, 0);
    f32x4 oacc = (f32x4){0.f, 0.f, 0.f, 0.f};
#pragma unroll
    for (int q = 0; q < NQ; ++q) {
        if (q + 1 < NQ) ATT_LOADV((q + 1) & 1, q + 1);
        __builtin_amdgcn_sched_barrier(0);
        const int dt = q / NBH, hb = q % NBH;
        if (hb == 0) oacc = (f32x4){0.f, 0.f, 0.f, 0.f};
#pragma unroll
        for (int i = 0; i < 8; ++i) oacc = __builtin_amdgcn_mfma_f32_16x16x32_bf16(vf[q & 1][i], pf[hb * 8 + i], oacc, 0, 0, 0);
        if (hb == NBH - 1) { u32x2 o; o.x = cvt_pk_bf16(oacc[0] * inv, oacc[1] * inv); o.y = cvt_pk_bf16(oacc[2] * inv, oacc[3] * inv);
            *(u32x2*)(qp + dt * 16 + 4 * fq) = o; }
        __builtin_amdgcn_sched_barrier(0);
    }
#undef ATT_LOADV
}
__device__ __forceinline__ void attn_block(bf16_t* proj, const bf16_t* vt, const bf16_t* vtc, const float* rpb, int vcu, int half, bool ctxq, LAS unsigned char* lds, int wave) {
    const int bh = vcu >> 3, b = bh >> 3, h = bh & 7, rb = vcu & 7;
    __syncthreads();
    { const int tid = wave * 64 + fresh_lane();
#pragma unroll
      for (int i = 0; i < 8; ++i) { const int idx = tid + 512 * i, key = idx >> 4, ch = idx & 15, g = (key & 3) | (((key >> 3) & 3) << 2);
          const u32x4 v = *(const u32x4*)(proj + (size_t)(MLAT + b * 256 + key) * INW + OFF_K + h * 128 + ch * 8);
          *(LAS u32x4*)(lds + key * 256 + ((ch ^ g) * 16)) = v; }
#pragma unroll
      for (int i = 0; i < 8; ++i) { const int idx = tid + 512 * i, d = idx >> 5, ch = idx & 31;
          const u32x4 v = *(const u32x4*)(vtc + (size_t)(b * 1024 + h * 128 + d) * 256 + ch * 8);
          *(LAS u32x4*)(lds + 65536 + d * 512 + ((ch ^ (d & 15)) * 16)) = v; } }
    __syncthreads();
    const int lane = fresh_lane();
    for (int round = 0; round < 2; ++round) { const int r = rb * 8 + half * 4 + round * 2 + (wave >> 2), cgp = wave & 3;
        attn_task<true>(proj, vt, rpb, ((bh * 64 + r) << 2) + cgp, lane, lds); }
    if (ctxq && wave == 0) attn_task<false>(proj, vt, rpb, bh * 16 + rb * 2 + half, lane, lds);
}
__device__ __forceinline__ void conv_items(const bf16_t* up, bf16_t* hmid, const float* cw, const float* cbias, int nrows, int gtid, int NT) {
    const int nitems = (nrows / 16) * 704;
    for (int it = gtid; it < nitems; it += NT) {
        const int cg8 = it % 704, rb = it / 704; const int row0 = rb * 16, ch = cg8 * 8;
        const int seqlen = row0 < MLAT ? 4096 : 256; const int ts = (row0 < MLAT ? row0 : row0 - MLAT) & (seqlen - 1);
        float w0[8], w1[8], w2[8], bb[8];
#pragma unroll
        for (int e = 0; e < 8; ++e) { w0[e] = cw[ch + e]; w1[e] = cw[DFF + ch + e]; w2[e] = cw[2 * DFF + ch + e]; bb[e] = cbias[ch + e]; }
        const bf16_t* ap = up + (size_t)row0 * UPW + ch; const bf16_t* gp = ap + DFF; bf16_t* hp = hmid + (size_t)row0 * DFF + ch;
        u32x4 prev = (u32x4){0u, 0u, 0u, 0u}; if (ts > 0) prev = *(const u32x4*)(ap - UPW);
        u32x4 cur = *(const u32x4*)ap;
        for (int i = 0; i < 16; ++i) {
            u32x4 nxt = (u32x4){0u, 0u, 0u, 0u}; if (i < 15 || ts + 16 < seqlen) nxt = *(const u32x4*)(ap + (size_t)(i + 1) * UPW);
            const u32x4 gw = *(const u32x4*)(gp + (size_t)i * UPW);
            float o[8];
#pragma unroll
            for (int e = 0; e < 4; ++e) {
                const float y0 = bb[2 * e] + w0[2 * e] * bflo(prev[e]) + w1[2 * e] * bflo(cur[e]) + w2[2 * e] * bflo(nxt[e]);
                const float y1 = bb[2 * e + 1] + w0[2 * e + 1] * bfhi(prev[e]) + w1[2 * e + 1] * bfhi(cur[e]) + w2[2 * e + 1] * bfhi(nxt[e]);
                o[2 * e] = fsilu(y0) * bflo(gw[e]); o[2 * e + 1] = fsilu(y1) * bfhi(gw[e]); }
            u32x4 w; w.x = cvt_pk_bf16(o[0], o[1]); w.y = cvt_pk_bf16(o[2], o[3]); w.z = cvt_pk_bf16(o[4], o[5]); w.w = cvt_pk_bf16(o[6], o[7]);
            *(u32x4*)(hp + (size_t)i * DFF) = w;
            prev = cur; cur = nxt;
        }
    }
}


#define XB_TMO      128
#define XB_XCNT(j)  (256  + 64 * (j))
#define XB_XSUB(j)  (1280 + 64 * (j))
#define XB_XGEN(j)  (2304 + 64 * (j))
#define XB_TOP      3328
#define XB_TOPGEN   3392
#define XCD_BAR_WORDS 3456
#define XB_SPIN_CAP (1u << 18)
__device__ __forceinline__ unsigned xb_ld(unsigned* p)              { return __hip_atomic_load(p, __ATOMIC_RELAXED, __HIP_MEMORY_SCOPE_AGENT); }
__device__ __forceinline__ unsigned xb_add(unsigned* p, unsigned v) { return __hip_atomic_fetch_add(p, v, __ATOMIC_RELAXED, __HIP_MEMORY_SCOPE_AGENT); }
__device__ __forceinline__ unsigned xb_xcc_id() { return (unsigned)__builtin_amdgcn_s_getreg((3 << 11) | 20) & 0xFu; }
#define XB_SPIN(cond, bar) do { unsigned _sp = 0; while (cond) { __builtin_amdgcn_s_sleep(1); \
    if ((++_sp & 255u) == 0u) { if (xb_ld(&(bar)[XB_TMO])) break; if (_sp > XB_SPIN_CAP) { atomicAdd(&(bar)[XB_TMO], 1u); break; } } } } while (0)
struct XcdBarrier { unsigned* bar; unsigned x; volatile LAS unsigned* st; };
__device__ __forceinline__ XcdBarrier xcd_barrier_post(unsigned* bar, volatile LAS unsigned* st) {
    XcdBarrier b; b.bar = bar; b.x = xb_xcc_id(); b.st = st;
    if (threadIdx.x == 0) (void)xb_add(&bar[XB_XCNT(b.x)], 1u);
    return b;
}
__device__ __forceinline__ void xcd_barrier_complete(unsigned* bar, unsigned x, unsigned& nloc, unsigned& nx) {
    const unsigned G = gridDim.x * gridDim.y * gridDim.z;
    unsigned sum, cnt, mine, sp = 0u;
    for (;;) {
        sum = 0u; cnt = 0u; mine = 0u;
#pragma unroll
        for (unsigned j = 0; j < 16; ++j) { const unsigned c = xb_ld(&bar[XB_XCNT(j)]); sum += c; cnt += (c > 0u) ? 1u : 0u; mine = (j == x) ? c : mine; }
        if (sum == G) break;
        __builtin_amdgcn_s_sleep(1);
        if ((++sp & 255u) == 0u) { if (xb_ld(&bar[XB_TMO])) break; if (sp > XB_SPIN_CAP) { atomicAdd(&bar[XB_TMO], 1u); break; } }
    }
    nloc = mine > 0u ? mine : 1u; nx = cnt > 0u ? cnt : 1u;
}
__device__ __forceinline__ void xcd_barrier(const XcdBarrier& b) {
    asm volatile("s_waitcnt vmcnt(0)" ::: "memory");
    __syncthreads();
    if (threadIdx.x == 0) {
        unsigned* bar = b.bar;
        __builtin_amdgcn_s_waitcnt(0);
        unsigned nloc = b.st[0], nx = b.st[1];
        if (nloc == 0u) { xcd_barrier_complete(bar, b.x, nloc, nx); b.st[0] = nloc; b.st[1] = nx; }
        const unsigned old = xb_add(&bar[XB_XSUB(b.x)], 1u);
        const unsigned gen = old / nloc;
        if (old + 1u == (gen + 1u) * nloc) {
            __builtin_amdgcn_fence(__ATOMIC_RELEASE, "agent");
            asm volatile("s_waitcnt vmcnt(0)" ::: "memory");
            const unsigned og = xb_add(&bar[XB_TOP], 1u);
            const unsigned tg = og / nx;
            if (og + 1u == (tg + 1u) * nx) xb_add(&bar[XB_TOPGEN], 1u);
            else XB_SPIN(xb_ld(&bar[XB_TOPGEN]) == tg, bar);
            __builtin_amdgcn_fence(__ATOMIC_ACQUIRE, "agent");
            xb_add(&bar[XB_XGEN(b.x)], 1u);
            asm volatile("s_waitcnt vmcnt(0)" ::: "memory");
        } else {
            XB_SPIN(xb_ld(&bar[XB_XGEN(b.x)]) == gen, bar);
            __builtin_amdgcn_fence(__ATOMIC_ACQUIRE, "agent");
            asm volatile("s_waitcnt vmcnt(0)" ::: "memory");
        }
    }
    __syncthreads();
}
constexpr int NPHASE = 24;
__global__ void __launch_bounds__(512, 2) mega(Args a_) {
    extern __shared__ __attribute__((aligned(16))) unsigned char lds_raw[];
    LAS unsigned char* lds = (LAS unsigned char*)lds_raw;
    cg::grid_group grid = cg::this_grid();
    const int G = gridDim.x, cu = blockIdx.x, NGW = G * 8, wave = __builtin_amdgcn_readfirstlane((int)threadIdx.x >> 6);

    volatile LAS unsigned* xst = (volatile LAS unsigned*)(lds + 143360);
    if (threadIdx.x < 4) xst[threadIdx.x] = 0u;
    __syncthreads();
    const XcdBarrier xbar = xcd_barrier_post((unsigned*)(a_.ws + WS_BAR), xst);

    const int ph_lo = a_.ph_lo, ph_hi = a_.ph_hi;
    for (int p = ph_lo; p < ph_hi; ++p) {
        if (p > ph_lo) { if (p == 1) grid.sync(); else xcd_barrier(xbar); }
#define PH_IDS const int lane = fresh_lane(); const int tid = wave * 64 + lane, gw = cu * 8 + wave; (void)tid; (void)gw; (void)lane;
        typedef const __attribute__((address_space(4))) Args KArgs;
        KArgs* ap = (KArgs*)__builtin_amdgcn_kernarg_segment_ptr(); asm volatile("" : "+s"(ap));
        KArgs& a = *ap;
        unsigned char* ws = a.ws;
        unsigned* ctl = (unsigned*)(ws + WS_CTL);
        bf16_t* PROJ = (bf16_t*)(ws + WS_BIG); bf16_t* XN = (bf16_t*)(ws + WS_XN); bf16_t* HMID = (bf16_t*)(ws + WS_HMID);
        float* XC = (float*)(ws + WS_XC); float* mods = (float*)(ws + WS_MODS);
        bf16_t* VT = (bf16_t*)(ws + WS_VT); bf16_t* VTC = (bf16_t*)(ws + WS_VTC);
        if (p == 0) { PH_IDS
            LAS float* lut = (LAS float*)(lds + 72 * 1024);
            for (int i = tid; i < 4096; i += 512) lut[i] = cospif((float)i * (1.0f / 2048.0f));
            __syncthreads();
            if (cu == 0) { bf16_t* dd = (bf16_t*)(ws + WS_DFTD);
                for (int e = tid; e < 256 * 128; e += 512) { const int row = e >> 7, d = e & 127, j = row & 127; const float ang = (float)((j * d) & 127) * (1.0f / 64.0f);
                    const float v = row < 128 ? cospif(ang) : sinpif(ang); dd[e] = (bf16_t)(cvt_pk_bf16(v, 0.f) & 0xffffu); } }
            for (int i = cu * 512 + tid; i < 1024 * DM / 4; i += G * 512) ((f32x4*)XC)[i] = ((const f32x4*)a.in[2])[i];
            mods_items(a, gw, NGW, lane);
            convert_weights(a, 0, (LAS float*)(lds + wave * 8704), gw, NGW, lane);
            dft_tables(ws, lut, gw, NGW, lane);
            continue;
        }
        if (p == NPHASE - 1) { PH_IDS final_norm(a.out, a.in[21], gw, NGW, lane); continue; }
        const int l = (p - 1) / 11, s = (p - 1) % 11;
        const float* mods_l = mods + (size_t)l * 5 * 12288;
        const float* xlat = (l == 0) ? a.in[0] : a.out; const float* xctx = (l == 0) ? a.in[2] : XC;
        const int nMall = (l == 0) ? 68 : 64;
        switch (s) {
        case 0: { PH_IDS
            if (l == 1) { LAS float* lut = (LAS float*)(lds + 72 * 1024);
                for (int i = tid; i < 4096; i += 512) lut[i] = cospif((float)i * (1.0f / 2048.0f));
                __syncthreads();
                convert_weights(a, 1, (LAS float*)(lds + wave * 8704), gw, NGW, lane);
                dft_tables(ws, lut, gw, NGW, lane); }
            norm_rows(xlat, xctx, a.in[6] + (size_t)l * DM, mods_l, 0, 2048, XN, MT, gw, NGW, lane);
        } break;
        case 1: { PH_IDS
            SchedGrid S; S.so.init(nMall, 42, G, cu); S.A = (const char*)XN; S.B = (const char*)(ws + WS_WIN); S.tsA = (size_t)256 * DM * 2; S.tsB = (size_t)256 * DM * 2; S.nt = 32;
            S.nextra = (l == 0) ? 0 : 32; S.ex_pm0 = 64; S.ex_pn0 = 6; S.ex_w = 8; S.ex_ks = 1;
            EpiInProj E{PROJ, VT, VTC};
            pg8::gemm_phase<EpiInProj, SchedGrid>(lds, tid, DM, DM, S, E);
        } break;
        case 2: { PH_IDS
            const int nun = 512 + ((l == 0) ? 32 : 0);
            for (int u = cu; u < nun; u += G) { int row0, g;
                if (u < 512) { const int b = u >> 7, ch = (u >> 2) & 31; g = u & 3; row0 = b * 4096 + ch * 128; }
                else { const int e = u - 512; const int b = e >> 3, ch = (e >> 2) & 1; g = e & 3; row0 = MLAT + b * 256 + ch * 128; }
                sgu_unit(PROJ, row0, g, a.in[10] + (size_t)l * 512, a.in[11] + ((size_t)l * 4 + g) * 128 * 128, a.in[12] + ((size_t)l * 4 + g) * 128, lds, tid); }
            __syncthreads();
            { SchedF1L S{(const char*)(ws + WS_DFTD), (const char*)PROJ, G, cu}; EpiF1L E{(bf16_t*)(ws + WS_U)};
              pg8::gemm_phase<EpiF1L, SchedF1L>(lds, wave * 64 + fresh_lane(), 128, INW, S, E); }
            if (l == 0) { SchedF1 S{(const char*)(ws + WS_DFTD), (const char*)PROJ, G, (cu + 128) % G, 16}; EpiF1 E{nullptr, (bf16_t*)(ws + WS_PQTC)};
              pg8::gemm_phase<EpiF1, SchedF1>(lds, wave * 64 + fresh_lane(), 128, INW, S, E); }
        } break;
        case 3: { PH_IDS
            { SchedFA S{(const char*)(ws + WS_MA), (const char*)(ws + WS_U), G, cu}; EpiFA E{(bf16_t*)(ws + WS_ZBUF)};
              pg8::gemm_phase<EpiFA, SchedFA>(lds, tid, 128, 128, S, E); }
            if (l == 0) { SchedF2 S{(const char*)(ws + WS_DFTC), (const char*)(ws + WS_PQTC), G, (cu + 128) % G, 8}; EpiF2 E{PROJ};
              pg8::gemm_phase<EpiF2, SchedF2>(lds, wave * 64 + fresh_lane(), 8192, 8192, S, E); }
            for (int vcu = cu; vcu < 256; vcu += G) attn_block(PROJ, VT, VTC, a.in[9] + (size_t)l * 8 * 15 * 31, vcu, 0, l == 0, lds, wave);
        } break;
        case 4: { PH_IDS
            { SchedFB S{(const char*)(ws + WS_TT), (const char*)(ws + WS_ZBUF), G, cu}; EpiFB E{PROJ};
              pg8::gemm_phase<EpiFB, SchedFB>(lds, tid, 128, 128, S, E); }
            for (int vcu = cu; vcu < 256; vcu += G) attn_block(PROJ, VT, VTC, a.in[9] + (size_t)l * 8 * 15 * 31, vcu, 1, l == 0, lds, wave);
        } break;
        case 5: { PH_IDS
            SchedBranch S; S.so.init(nMall, 8, G, cu); S.proj = (const char*)PROJ; S.wbr = (const char*)(ws + WS_WBR);
            EpiBranch E{PROJ, XN};
            pg8::gemm_phase<EpiBranch, SchedBranch>(lds, tid, INW, DM, S, E);
        } break;
        case 6: { PH_IDS
            SchedGrid S; S.so.init(64, 8, G, cu); S.A = (const char*)XN; S.B = (const char*)(ws + WS_WO); S.tsA = (size_t)256 * DM * 2; S.tsB = (size_t)256 * DM * 2; S.nt = 32;
            S.nextra = (l == 0) ? 32 * 8 : 0; S.ex_pm0 = 64; S.ex_pn0 = 0; S.ex_w = 8; S.ex_ks = 8;
            EpiResid E{xlat, XC, a.out, XC, mods_l + 4096};
            pg8::gemm_phase<EpiResid, SchedGrid>(lds, tid, DM, DM, S, E);
        } break;
        case 7: { PH_IDS
            norm_rows(a.out, XC, a.in[7] + (size_t)l * DM, mods_l, 6144, 8192, XN, nMall * 256, gw, NGW, lane);
        } break;
        case 8: { PH_IDS
            SchedGrid S; S.so.init(nMall, 44, G, cu); S.A = (const char*)XN; S.B = (const char*)(ws + WS_WUP); S.tsA = (size_t)256 * DM * 2; S.tsB = (size_t)256 * DM * 2; S.nt = 32; S.nextra = 0; S.ex_pm0 = 0; S.ex_pn0 = 0; S.ex_w = 1; S.ex_ks = 1;
            EpiPlain E{PROJ, UPW};
            pg8::gemm_phase<EpiPlain, SchedGrid>(lds, tid, DM, DM, S, E);
        } break;
        case 9: { PH_IDS
            conv_items(PROJ, HMID, a.in[18] + (size_t)l * 3 * DFF, a.in[19] + (size_t)l * DFF, nMall * 256, cu * 512 + tid, G * 512);
        } break;
        case 10: { PH_IDS
            SchedGrid S; S.so.init(64, 8, G, cu); S.A = (const char*)HMID; S.B = (const char*)(ws + WS_WDN); S.tsA = (size_t)256 * DFF * 2; S.tsB = (size_t)256 * DFF * 2; S.nt = 88;
            S.nextra = (l == 0) ? 32 * 4 : 0; S.ex_pm0 = 64; S.ex_pn0 = 0; S.ex_w = 8; S.ex_ks = 4;
            EpiResid E{a.out, XC, a.out, XC, mods_l + 10240};
            pg8::gemm_phase<EpiResid, SchedGrid>(lds, tid, DFF, DFF, S, E);
        } break;
        }
    }
}

extern "C" void kernel_launch(void* const* d_in, const int* in_sizes, int n_in, void* d_out, int out_size, void* d_ws, size_t ws_size, hipStream_t stream) {
    static int grid = 0;
    if (grid == 0) {
        if (n_in != 22 || ws_size < WS_END) { fprintf(stderr, "kernel_launch: unexpected n_in %d / ws_size %zu (need %zu)\n", n_in, ws_size, (size_t)WS_END); grid = -1; return; }
        int dev = 0, cus = 0, per_cu = 0;
        hipGetDevice(&dev); hipDeviceGetAttribute(&cus, hipDeviceAttributeMultiprocessorCount, dev);
        if (hipFuncSetAttribute((const void*)mega, hipFuncAttributeMaxDynamicSharedMemorySize, LDS_BYTES) != hipSuccess) { fprintf(stderr, "kernel_launch: hipFuncSetAttribute failed\n"); grid = -1; return; }
        hipOccupancyMaxActiveBlocksPerMultiprocessor(&per_cu, (const void*)mega, 512, LDS_BYTES);
        (void)hipGetLastError();
        if (per_cu < 1) fprintf(stderr, "kernel_launch: occupancy query says %d blocks/CU\n", per_cu);
        grid = cus > 0 ? cus : 256;
    }
    if (grid < 0) return;
    hipMemsetAsync((char*)d_ws + WS_CTL, 0, CTL_ZERO_BYTES, stream);
    Args a{};
    for (int i = 0; i < 22; ++i) a.in[i] = (const float*)d_in[i];
    a.out = (float*)d_out; a.ws = (unsigned char*)d_ws; a.ph_lo = 0; a.ph_hi = NPHASE;
    void* args[] = {&a};
    hipError_t e = hipLaunchCooperativeKernel((const void*)mega, dim3(grid), dim3(512), args, LDS_BYTES, stream);
    if (e != hipSuccess) fprintf(stderr, "kernel_launch: cooperative launch failed: %s (grid %d)\n", hipGetErrorString(e), grid);
}
```

```cpp
#include <hip/hip_runtime.h>
#include <hip/hip_cooperative_groups.h>
#include <cstdio>
#include <cstdint>
namespace cg = cooperative_groups;

#define LAS __attribute__((address_space(3)))
typedef unsigned short bf16_t;
typedef short bf16x8 __attribute__((ext_vector_type(8)));
typedef float f32x4 __attribute__((ext_vector_type(4)));
typedef float f32x2 __attribute__((ext_vector_type(2)));
typedef unsigned u32x4 __attribute__((ext_vector_type(4)));
typedef unsigned u32x2 __attribute__((ext_vector_type(2)));

constexpr int DM = 2048, MLAT = 16384, MT = 17408;
constexpr int INW = 10752, DFF = 5632, UPW = 11264;
constexpr int OFF_Q = 512, OFF_K = 1536, OFF_V = 2560, OFF_C = 3584, OFF_G = 4608;
constexpr float EPS = 1e-6f;
constexpr size_t MiB = 1u << 20;
constexpr size_t WS_CTL = 0;
constexpr size_t CTL_ZERO_BYTES = 1 * MiB;
constexpr size_t WS_MODS = 4096;
constexpr size_t WS_BAR = 512 * 1024;
constexpr size_t WS_DFTD = 1 * MiB;
constexpr size_t WS_XC = 2 * MiB;
constexpr size_t WS_WIN = 10 * MiB;
constexpr size_t WS_WBR = 52 * MiB;
constexpr size_t WS_WO = 60 * MiB;
constexpr size_t WS_WUP = 68 * MiB;
constexpr size_t WS_WDN = 112 * MiB;
constexpr size_t WS_XN = 134 * MiB;
constexpr size_t WS_BIG = 202 * MiB;
constexpr size_t WS_HMID = 576 * MiB;
constexpr size_t WS_ZBUF = WS_HMID;
constexpr size_t WS_TT = WS_HMID + 32 * MiB;
constexpr size_t WS_MA = WS_HMID + 36 * MiB;
constexpr size_t WS_U = WS_HMID + 64 * MiB;
constexpr size_t WS_VT = WS_HMID + 96 * MiB;
constexpr size_t WS_DFTC = WS_HMID + 128 * MiB;
constexpr size_t WS_PQTC = WS_HMID + 132 * MiB;
constexpr size_t WS_VTC = WS_HMID + 164 * MiB;
constexpr size_t WS_TMP = WS_HMID;
constexpr size_t WS_END = 763 * MiB;
constexpr int LDS_BYTES = 147456;

#define LDS_WAIT() asm volatile("s_waitcnt lgkmcnt(0)" ::: "memory")
__device__ __forceinline__ unsigned cvt_pk_bf16(float lo, float hi) { unsigned r; asm volatile("v_cvt_pk_bf16_f32 %0, %1, %2" : "=v"(r) : "v"(lo), "v"(hi)); return r; }
__device__ __forceinline__ int fresh_lane() { unsigned z; asm volatile("v_mov_b32 %0, 0" : "=v"(z)); return (int)__builtin_amdgcn_mbcnt_hi(~0u, __builtin_amdgcn_mbcnt_lo(~0u, z)); }
__device__ __forceinline__ float bf2f(unsigned short b) { return __uint_as_float((unsigned)b << 16); }
__device__ __forceinline__ float bflo(unsigned w) { return __uint_as_float(w << 16); }
__device__ __forceinline__ float bfhi(unsigned w) { return __uint_as_float(w & 0xffff0000u); }
__device__ __forceinline__ float shx(float v, int o, int lane) { return __int_as_float(__builtin_amdgcn_ds_bpermute((lane ^ o) << 2, __float_as_int(v))); }
__device__ __forceinline__ float wave_sum(float v, int lane) {
#pragma unroll
    for (int o = 1; o < 64; o <<= 1) v += shx(v, o, lane);
    return v;
}
__device__ __forceinline__ float fsigmoid(float x) { return __builtin_amdgcn_rcpf(1.0f + __builtin_amdgcn_exp2f(-1.44269504089f * x)); }
__device__ __forceinline__ float fsilu(float x) { return x * fsigmoid(x); }
__device__ __forceinline__ f32x2 gelu_pk(f32x2 v) {
    const f32x2 av = __builtin_elementwise_abs(v), d = av * 0.2316418882f + 1.0f;
    f32x2 t; t.x = __builtin_amdgcn_rcpf(d.x); t.y = __builtin_amdgcn_rcpf(d.y);
    f32x2 q = t * 0.5307027145f + (-0.7265760135f); q = q * t + 0.7107068705f; q = q * t + (-0.142248368f); q = q * t + 0.127414796f; q = q * t;
    const f32x2 s = (v * v) * (-0.72134752044f);
    f32x2 e; e.x = __builtin_amdgcn_exp2f(s.x); e.y = __builtin_amdgcn_exp2f(s.y);
    const f32x2 m = v * (q * e), r = v - m;
    f32x2 o; o.x = v.x < 0.f ? m.x : r.x; o.y = v.y < 0.f ? m.y : r.y; return o;
}

namespace pg8 {
constexpr int BM = 256, BK = 64, HALF = 128, HTB = HALF * BK * 2, STAGE_BYTES = 8 * HTB, NXCD = 8, WGM = 8;
__host__ __device__ __forceinline__ int lds_byte(int r, int c) { const int st = (r >> 4) * 2 + (c >> 5), rr = r & 15, cc = c & 31, ob = rr * 64 + cc * 2; return st * 1024 + (ob ^ (((ob >> 9) & 1) << 5)); }
__host__ __device__ __forceinline__ void stage_rc(int b, int& R, int& C) { const int st = b / 1024, sb = b % 1024, swz = sb ^ (((sb >> 9) & 1) << 5); R = (st >> 1) * 16 + swz / 64; C = (st & 1) * 32 + (swz % 64) / 2; }
__host__ __device__ __forceinline__ int perm32(int rho) { const int n = rho >> 4, i = rho & 15; return 8 * (i >> 2) + 4 * n + (i & 3); }

struct Unit { const char* A; const char* B; int nt, pm, pn, aux; };

struct StaticOrder {
    int nM, nN, nwg, G, c;
    __device__ void init(int nM_, int nN_, int G_, int c_) { nM = nM_; nN = nN_; nwg = nM * nN; G = G_; c = c_; }
    __device__ bool next(int i, int& pm, int& pn) const {
        const long L = (long)i * G + c; if (L >= nwg) return false;
        int wgid = (int)L; { const int q = nwg / NXCD, r = nwg % NXCD, xcd = wgid % NXCD, off = wgid / NXCD; wgid = (xcd < r ? xcd * (q + 1) : r * (q + 1) + (xcd - r) * q) + off; }
        const int nig = WGM * nN, gid = wgid / nig, fm = gid * WGM, gsz = (nM - fm) < WGM ? (nM - fm) : WGM;
        pm = fm + ((wgid % nig) % gsz); pn = (wgid % nig) / gsz; return true;
    }
};

template <class Epi, class Sched>
__device__ __forceinline__ void gemm_phase(LAS unsigned char* lds, const int tid, const int lda, const int ldb, const Sched& S, const Epi& E) {
    const int wid = __builtin_amdgcn_readfirstlane(tid >> 6), lane = tid & 63, wr = wid >> 2, wc = wid & 3, fr = lane & 15, fq = lane >> 4;
    unsigned voffA[2], voffB[2];
#pragma unroll
    for (int i = 0; i < 2; ++i) { int R, C; stage_rc(tid * 16 + i * 8192, R, C); const int Rb = Epi::PERM ? ((R & ~31) + perm32(R & 31)) : R;
        voffA[i] = (unsigned)(R * lda + C) * 2u; voffB[i] = (unsigned)(Sched::brow(Rb) * ldb + C) * 2u; }
    const size_t kstep = (size_t)(BK * 2);
    const size_t hstepA = (size_t)HALF * lda * 2, hstepB = (size_t)Sched::BH * ldb * 2;
    const unsigned ldsw = (unsigned)wid * 1024u;
    const int aoff = lds_byte(wr * 64 + fr, fq * 8), boff = lds_byte(wc * 32 + fr, fq * 8);
#define PG8_SA(b, h) (((b) * 2 + (h)) * HTB)
#define PG8_SB(b, h) ((4 + (b) * 2 + (h)) * HTB)
#define PG8_STAGE(bufoff, gbase, voff) do { _Pragma("unroll") for (int _i = 0; _i < 2; ++_i) \
        __builtin_amdgcn_global_load_lds((const unsigned*)((const char*)(gbase) + (voff)[_i]), (LAS unsigned*)(lds + (bufoff) + ldsw + _i * 8192), 16, 0, 0); } while (0)
#define PG8_LDA(dst, b, h) do { _Pragma("unroll") for (int m = 0; m < 4; ++m) _Pragma("unroll") for (int k = 0; k < 2; ++k) dst[m][k] = *(const LAS bf16x8*)(lds + PG8_SA(b, h) + aoff + m * 2048 + k * 1024); } while (0)
#define PG8_LDB(dst, b, h) do { _Pragma("unroll") for (int n = 0; n < 2; ++n) _Pragma("unroll") for (int k = 0; k < 2; ++k) dst[n][k] = *(const LAS bf16x8*)(lds + PG8_SB(b, h) + boff + n * 2048 + k * 1024); } while (0)
#define PG8_MMA(ai, bj, At, Bt) do { __builtin_amdgcn_s_setprio(1); _Pragma("unroll") for (int m = 0; m < 4; ++m) _Pragma("unroll") for (int n = 0; n < 2; ++n) _Pragma("unroll") for (int k = 0; k < 2; ++k) \
        acc[ai][bj][m][n] = __builtin_amdgcn_mfma_f32_16x16x32_bf16(Bt[n][k], At[m][k], acc[ai][bj][m][n], 0, 0, 0); __builtin_amdgcn_s_setprio(0); } while (0)
#define PG8_WAIT_V(n) asm volatile("s_waitcnt vmcnt(" #n ")" ::: "memory")
#define PG8_WAIT_L(n) asm volatile("s_waitcnt lgkmcnt(" #n ")" ::: "memory")
#define PG8_BAR __builtin_amdgcn_s_barrier()
#define PG8_SCHED __builtin_amdgcn_sched_barrier(0)
    Unit cur, nxt; int ui = 0;
    if (!S.next(0, cur)) return;
    f32x4 acc[2][2][4][2];
#pragma unroll
    for (int a = 0; a < 2; ++a)
#pragma unroll
        for (int b = 0; b < 2; ++b)
#pragma unroll
            for (int m = 0; m < 4; ++m)
#pragma unroll
                for (int n = 0; n < 2; ++n) acc[a][b][m][n] = (f32x4){0.f, 0.f, 0.f, 0.f};
    bf16x8 At[4][2], B0[2][2], B1[2][2];
    const char* cA = cur.A; const char* cB = cur.B;
    {
        PG8_STAGE(PG8_SB(0, 0), cB, voffB); PG8_STAGE(PG8_SB(0, 1), cB + hstepB, voffB); PG8_STAGE(PG8_SA(0, 0), cA, voffA); PG8_STAGE(PG8_SA(0, 1), cA + hstepA, voffA);
        if (wr == 1) PG8_BAR;
        PG8_WAIT_V(2); PG8_BAR;
        PG8_STAGE(PG8_SB(1, 0), cB + kstep, voffB); PG8_STAGE(PG8_SA(1, 0), cA + kstep, voffA); PG8_STAGE(PG8_SB(1, 1), cB + hstepB + kstep, voffB);
        PG8_WAIT_V(6); PG8_BAR;
    }
    for (;;) {
        const bool has_next = S.next(ui + 1, nxt);
        const char* nA = has_next ? nxt.A : cA; const char* nB = has_next ? nxt.B : cB;
        const int nt = cur.nt;
        for (int t = 0; t < nt; t += 2) {
            const bool last = (t == nt - 2);
            const char* a1 = cA + (size_t)(t + 1) * kstep;
            const char* a2 = last ? nA : cA + (size_t)(t + 2) * kstep; const char* b2 = last ? nB : cB + (size_t)(t + 2) * kstep;
            const char* a3 = a2 + kstep; const char* b3 = b2 + kstep;
            PG8_LDB(B0, 0, 0); PG8_LDB(B1, 0, 1); PG8_SCHED; PG8_LDA(At, 0, 0); PG8_STAGE(PG8_SA(1, 1), a1 + hstepA, voffA);
            PG8_WAIT_V(8); PG8_WAIT_L(0); PG8_BAR; PG8_MMA(0, 0, At, B0); PG8_MMA(0, 1, At, B1); PG8_BAR; PG8_SCHED;
            PG8_LDA(At, 0, 1); PG8_STAGE(PG8_SB(0, 0), b2, voffB); PG8_STAGE(PG8_SB(0, 1), b2 + hstepB, voffB); PG8_STAGE(PG8_SA(0, 0), a2, voffA);
            PG8_WAIT_V(8); PG8_WAIT_L(0); PG8_BAR; PG8_MMA(1, 0, At, B0); PG8_MMA(1, 1, At, B1); PG8_BAR; PG8_SCHED;
            PG8_LDB(B0, 1, 0); PG8_LDB(B1, 1, 1); PG8_SCHED; PG8_LDA(At, 1, 0); PG8_STAGE(PG8_SA(0, 1), a2 + hstepA, voffA);
            PG8_WAIT_V(8); PG8_WAIT_L(0); PG8_BAR; PG8_MMA(0, 0, At, B0); PG8_MMA(0, 1, At, B1); PG8_BAR; PG8_SCHED;
            PG8_LDA(At, 1, 1); PG8_STAGE(PG8_SB(1, 0), b3, voffB); PG8_STAGE(PG8_SB(1, 1), b3 + hstepB, voffB); PG8_STAGE(PG8_SA(1, 0), a3, voffA);
            PG8_WAIT_V(8); PG8_WAIT_L(0); PG8_BAR; PG8_MMA(1, 0, At, B0); PG8_MMA(1, 1, At, B1); PG8_BAR; PG8_SCHED;
        }
        if (wr == 0) PG8_BAR;
        E(acc, cur, wr, wc);
        if (!has_next) break;
        if (!Epi::CHAIN || cur.aux == 2) {
#pragma unroll
        for (int a = 0; a < 2; ++a)
#pragma unroll
            for (int b = 0; b < 2; ++b)
#pragma unroll
                for (int m = 0; m < 4; ++m)
#pragma unroll
                    for (int n = 0; n < 2; ++n) acc[a][b][m][n] = (f32x4){0.f, 0.f, 0.f, 0.f};
        }
        cur = nxt; cA = nA; cB = nB; ++ui;
        if (wr == 1) PG8_BAR;
    }
    PG8_WAIT_V(0);
    PG8_BAR;
#undef PG8_SA
#undef PG8_SB
#undef PG8_STAGE
#undef PG8_LDA
#undef PG8_LDB
#undef PG8_MMA
#undef PG8_WAIT_V
#undef PG8_WAIT_L
#undef PG8_BAR
#undef PG8_SCHED
}
}
using pg8::Unit;
typedef const f32x4 (&AccRef)[2][2][4][2];

struct SchedGrid {
    static __device__ __forceinline__ int brow(int r) { return r; } static constexpr int BH = 128;
    pg8::StaticOrder so; const char* A; const char* B; size_t tsA, tsB; int nt, nextra, ex_pm0, ex_pn0, ex_w, ex_ks;
    __device__ __forceinline__ bool next(int i, Unit& u) const {
        int pm, pn; int kp = 0, ntu = nt, aux = 0;
        if (!so.next(i, pm, pn)) { const long e = (long)i * so.G + so.c - so.nwg; if (e >= nextra) return false; const int te = (int)e / ex_ks; kp = (int)e % ex_ks; ntu = nt / ex_ks; aux = ex_ks > 1 ? 1 : 0;
            pm = ex_pm0 + te / ex_w; pn = ex_pn0 + te % ex_w; }
        u.A = A + (size_t)pm * tsA + (size_t)kp * ntu * 128; u.B = B + (size_t)pn * tsB + (size_t)kp * ntu * 128; u.nt = ntu; u.pm = pm; u.pn = pn; u.aux = aux; return true;
    }
};
struct SchedBranch {
    static __device__ __forceinline__ int brow(int r) { return r; } static constexpr int BH = 128;
    pg8::StaticOrder so; const char* proj; const char* wbr;
    __device__ __forceinline__ bool next(int i, Unit& u) const {
        int pm, pn; if (!so.next(i / 3, pm, pn)) return false;
        const int br = i % 3; const int acol = br == 0 ? 0 : (br == 1 ? OFF_Q : OFF_C), koff = br == 0 ? 0 : (br == 1 ? 512 : 1536);
        u.A = proj + ((size_t)pm * 256 * INW + acol) * 2; u.B = wbr + ((size_t)pn * 256 * DM + koff) * 2; u.nt = br == 1 ? 16 : 8; u.pm = pm; u.pn = pn; u.aux = br; return true;
    }
};
struct SchedF1L {
    static __device__ __forceinline__ int brow(int r) { return (r >> 6) + 64 * (r & 63); } static constexpr int BH = 2;
    const char* dftd; const char* proj; int G, c;
    __device__ __forceinline__ bool next(int i, Unit& u) const {
        const int L = i * G + c; if (L >= 256) return false;
        { const char* ap = dftd; asm volatile("" : "+s"(ap)); u.A = ap; } u.nt = 2; u.pm = 0;
        const int b = L >> 6, g = (L >> 4) & 3, pn = L & 15; u.B = proj + ((size_t)(b * 4096 + 4 * pn) * INW + g * 128) * 2; u.pn = pn; u.aux = b * 4 + g; return true;
    }
};
struct SchedF1 {
    static __device__ __forceinline__ int brow(int r) { return r; } static constexpr int BH = 128;
    const char* dftd; const char* proj; int G, c, nctx;
    __device__ __forceinline__ bool next(int i, Unit& u) const {
        const int e = i * G + c; if (e >= nctx) return false;
        { const char* ap = dftd; asm volatile("" : "+s"(ap)); u.A = ap; } u.nt = 2; u.pm = 0;
        const int b = e >> 2, g = e & 3; u.B = proj + ((size_t)(MLAT + b * 256) * INW + g * 128) * 2; u.pn = 0; u.aux = 16 + b * 4 + g; return true;
    }
};
struct SchedF2 {
    static __device__ __forceinline__ int brow(int r) { return r; } static constexpr int BH = 128;
    const char* dftc; const char* pqtc; int G, c, nctx;
    __device__ __forceinline__ bool next(int i, Unit& u) const {
        const int e = i * G + c; if (e >= nctx) return false;
        const int b = e >> 1, pn = e & 1; { const char* ap = dftc; asm volatile("" : "+s"(ap)); u.A = ap; } u.B = pqtc + (size_t)(b * 512 + pn * 256) * 8192 * 2; u.nt = 8; u.pm = 0; u.pn = pn; u.aux = 4 + b; return true;
    }
};
struct SchedFA {
    static __device__ __forceinline__ int brow(int r) { return r; } static constexpr int BH = 128;
    const char* ma; const char* ub; int G, c;
    __device__ __forceinline__ bool next(int i, Unit& u) const {
        const int L = i * G + c; if (L >= 512) return false;
        { const char* ap = ma; asm volatile("" : "+s"(ap)); u.A = ap; } u.B = ub + (size_t)L * 256 * 128 * 2; u.nt = 2; u.pm = 0; u.pn = L; u.aux = 0; return true;
    }
};
struct SchedFB {
    static __device__ __forceinline__ int brow(int r) { return r; } static constexpr int BH = 128;
    const char* tt; const char* zb; int G, c;
    __device__ __forceinline__ bool next(int i, Unit& u) const {
        const int L = i * G + c; if (L >= 512) return false;
        const int k2 = L >> 3, pn = L & 7; u.A = tt + (size_t)k2 * 256 * 128 * 2; u.B = zb + ((size_t)k2 * 2048 + pn * 256) * 128 * 2; u.nt = 2; u.pm = 0; u.pn = pn; u.aux = k2; return true;
    }
};

struct EpiInProj {
    static constexpr bool PERM = true, CHAIN = false;
    bf16_t* proj; bf16_t* vt; bf16_t* vtc;
    __device__ __forceinline__ void operator()(AccRef acc, const Unit& u, int wr, int wc) const {
        const int ln_ = fresh_lane(), fr = ln_ & 15, fq = ln_ >> 4;
        const int pm = u.pm, pn = u.pn; const int row0 = pm * 256 + wr * 64 + fr, col0 = pn * 256 + wc * 32 + 8 * fq;
        if (pn >= 10 && pn < 14) {
            const int vc0 = col0 - OFF_V;
#pragma unroll
            for (int ai = 0; ai < 2; ++ai)
#pragma unroll
                for (int m = 0; m < 4; ++m) {
                    const int row = row0 + ai * 128 + m * 16; bf16_t* dst; size_t stride;
                    if (pm < 64) { const int b = pm >> 4; dst = vt + (size_t)b * 1024 * 4096 + (row - b * 4096); stride = 4096; }
                    else { const int b = pm - 64; dst = vtc + (size_t)b * 1024 * 256 + (row - MLAT - b * 256); stride = 256; }
#pragma unroll
                    for (int bj = 0; bj < 2; ++bj)
#pragma unroll
                        for (int n = 0; n < 2; ++n) { const f32x4 v = acc[ai][bj][m][n]; const unsigned w0 = cvt_pk_bf16(v[0], v[1]), w1 = cvt_pk_bf16(v[2], v[3]);
                            bf16_t* d = dst + (size_t)(vc0 + bj * 128 + n * 4) * stride;
                            d[0] = (bf16_t)(w0 & 0xffffu); d[stride] = (bf16_t)(w0 >> 16); d[2 * stride] = (bf16_t)(w1 & 0xffffu); d[3 * stride] = (bf16_t)(w1 >> 16); }
                }
            return;
        }
        const int act = pn < 14 ? 0 : (pn < 18 ? 1 : 2); const float sc = (pn >= 2 && pn < 6) ? 0.08838834764831845f : 1.0f;
#pragma unroll
        for (int ai = 0; ai < 2; ++ai)
#pragma unroll
            for (int m = 0; m < 4; ++m) { bf16_t* rowp = proj + (size_t)(row0 + ai * 128 + m * 16) * INW + col0;
#pragma unroll
                for (int bj = 0; bj < 2; ++bj) { f32x4 v0 = acc[ai][bj][m][0], v1 = acc[ai][bj][m][1];
                    if (act == 1) { f32x2 a = gelu_pk((f32x2){v0[0], v0[1]}), b = gelu_pk((f32x2){v0[2], v0[3]}), c = gelu_pk((f32x2){v1[0], v1[1]}), d = gelu_pk((f32x2){v1[2], v1[3]});
                        v0 = (f32x4){a.x, a.y, b.x, b.y}; v1 = (f32x4){c.x, c.y, d.x, d.y}; }
                    else if (act == 2) { v0 = (f32x4){fsigmoid(v0[0]), fsigmoid(v0[1]), fsigmoid(v0[2]), fsigmoid(v0[3])}; v1 = (f32x4){fsigmoid(v1[0]), fsigmoid(v1[1]), fsigmoid(v1[2]), fsigmoid(v1[3])}; }
                    else { v0 = v0 * sc; v1 = v1 * sc; }
                    u32x4 w; w.x = cvt_pk_bf16(v0[0], v0[1]); w.y = cvt_pk_bf16(v0[2], v0[3]); w.z = cvt_pk_bf16(v1[0], v1[1]); w.w = cvt_pk_bf16(v1[2], v1[3]);
                    *(u32x4*)(rowp + bj * 128) = w; } }
    }
};
struct EpiPlain {
    static constexpr bool PERM = true, CHAIN = false;
    bf16_t* out; int ld;
    __device__ __forceinline__ void operator()(AccRef acc, const Unit& u, int wr, int wc) const {
        const int ln_ = fresh_lane(), fr = ln_ & 15, fq = ln_ >> 4;
        const int row0 = u.pm * 256 + wr * 64 + fr, col0 = u.pn * 256 + wc * 32 + 8 * fq;
#pragma unroll
        for (int ai = 0; ai < 2; ++ai)
#pragma unroll
            for (int m = 0; m < 4; ++m) { bf16_t* rowp = out + (size_t)(row0 + ai * 128 + m * 16) * ld + col0;
#pragma unroll
                for (int bj = 0; bj < 2; ++bj) { const f32x4 v0 = acc[ai][bj][m][0], v1 = acc[ai][bj][m][1];
                    u32x4 w; w.x = cvt_pk_bf16(v0[0], v0[1]); w.y = cvt_pk_bf16(v0[2], v0[3]); w.z = cvt_pk_bf16(v1[0], v1[1]); w.w = cvt_pk_bf16(v1[2], v1[3]);
                    *(u32x4*)(rowp + bj * 128) = w; } }
    }
};
struct EpiF1 {
    static constexpr bool PERM = true, CHAIN = false;
    bf16_t* pqt; bf16_t* pqtc;
    __device__ __forceinline__ void operator()(AccRef acc, const Unit& u, int wr, int wc) const {
        const int ln_ = fresh_lane(), fr = ln_ & 15, fq = ln_ >> 4;
        const int aux = u.aux; const bool isc = aux >= 16; const int bg = aux & 15, b = bg >> 2, g = bg & 3;
        bf16_t* base = (isc ? pqtc : pqt) + (size_t)(b * 512 + g * 128) * 8192; const int half = isc ? 256 : 4096;
        const int n0 = u.pn * 256 + wc * 32 + 8 * fq;
#pragma unroll
        for (int ai = 0; ai < 2; ++ai)
#pragma unroll
            for (int m = 0; m < 4; ++m) { bf16_t* rowp = base + (size_t)(wr * 64 + m * 16 + fr) * 8192 + ai * half + n0;
#pragma unroll
                for (int bj = 0; bj < 2; ++bj) { const f32x4 v0 = acc[ai][bj][m][0], v1 = acc[ai][bj][m][1];
                    u32x4 w; w.x = cvt_pk_bf16(v0[0], v0[1]); w.y = cvt_pk_bf16(v0[2], v0[3]); w.z = cvt_pk_bf16(v1[0], v1[1]); w.w = cvt_pk_bf16(v1[2], v1[3]);
                    *(u32x4*)(rowp + bj * 128) = w; } }
    }
};
struct EpiF1L {
    static constexpr bool PERM = true, CHAIN = false;
    bf16_t* ub;
    __device__ __forceinline__ void operator()(AccRef acc, const Unit& u, int wr, int wc) const {
        const int ln_ = fresh_lane(), fr = ln_ & 15, fq = ln_ >> 4;
        const int b = u.aux >> 2, g = u.aux & 3;
#pragma unroll
        for (int ai = 0; ai < 2; ++ai)
#pragma unroll
            for (int m = 0; m < 4; ++m) { const int ch = b * 512 + g * 128 + wr * 64 + m * 16 + fr;
#pragma unroll
                for (int bj = 0; bj < 2; ++bj) { const int n1 = 4 * u.pn + 2 * bj + (wc >> 1), n2 = 32 * (wc & 1) + 8 * fq;
                    const f32x4 v0 = acc[ai][bj][m][0], v1 = acc[ai][bj][m][1];
                    u32x4 w; w.x = cvt_pk_bf16(v0[0], v0[1]); w.y = cvt_pk_bf16(v0[2], v0[3]); w.z = cvt_pk_bf16(v1[0], v1[1]); w.w = cvt_pk_bf16(v1[2], v1[3]);
                    *(u32x4*)(ub + ((size_t)ch * 64 + n1) * 128 + ai * 64 + n2) = w; } }
    }
};
struct EpiFA {
    static constexpr bool PERM = true, CHAIN = false;
    bf16_t* zb;
    __device__ __forceinline__ void operator()(AccRef acc, const Unit& u, int wr, int wc) const {
        if (wr != 0) return;
        const int ln_ = fresh_lane(), fr = ln_ & 15, fq = ln_ >> 4;
#pragma unroll
        for (int ai = 0; ai < 2; ++ai)
#pragma unroll
            for (int m = 0; m < 4; ++m) { const int k2 = m * 16 + fr;
#pragma unroll
                for (int bj = 0; bj < 2; ++bj) { const int bc = u.pn * 4 + 2 * bj + (wc >> 1), n1 = 32 * (wc & 1) + 8 * fq;
                    const f32x4 v0 = acc[ai][bj][m][0], v1 = acc[ai][bj][m][1];
                    u32x4 w; w.x = cvt_pk_bf16(v0[0], v0[1]); w.y = cvt_pk_bf16(v0[2], v0[3]); w.z = cvt_pk_bf16(v1[0], v1[1]); w.w = cvt_pk_bf16(v1[2], v1[3]);
                    *(u32x4*)(zb + ((size_t)k2 * 2048 + bc) * 128 + ai * 64 + n1) = w; } }
    }
};
struct EpiFB {
    static constexpr bool PERM = true, CHAIN = false;
    bf16_t* proj;
    __device__ __forceinline__ void operator()(AccRef acc, const Unit& u, int wr, int wc) const {
        if (wr != 0) return;
        const int ln_ = fresh_lane(), fr = ln_ & 15, fq = ln_ >> 4;
        const float sc = 0.0013810679320049757f; const int k2 = u.aux;
#pragma unroll
        for (int m = 0; m < 4; ++m) { const int k = 64 * (m * 16 + fr) + k2;
#pragma unroll
            for (int bj = 0; bj < 2; ++bj) { const int ncol = u.pn * 256 + 128 * bj + 32 * wc + 8 * fq; const int b = ncol >> 9, ch = ncol & 511;
                const f32x4 v0 = acc[0][bj][m][0] * sc, v1 = acc[0][bj][m][1] * sc;
                u32x4 w; w.x = cvt_pk_bf16(v0[0], v0[1]); w.y = cvt_pk_bf16(v0[2], v0[3]); w.z = cvt_pk_bf16(v1[0], v1[1]); w.w = cvt_pk_bf16(v1[2], v1[3]);
                *(u32x4*)(proj + (size_t)(b * 4096 + k) * INW + ch) = w; } }
    }
};
struct EpiF2 {
    static constexpr bool PERM = true, CHAIN = false;
    bf16_t* proj;
    __device__ __forceinline__ void operator()(AccRef acc, const Unit& u, int wr, int wc) const {
        const int ln_ = fresh_lane(), fr = ln_ & 15, fq = ln_ >> 4;
        const int aux = u.aux; const bool isc = aux >= 4; const int rowbase = isc ? MLAT + (aux - 4) * 256 : aux * 4096;
        const float sc = isc ? 0.005524271728019903f : 0.0013810679320049757f;
        const int row0 = rowbase + u.pm * 256 + wr * 64 + fr, col0 = u.pn * 256 + wc * 32 + 8 * fq;
#pragma unroll
        for (int ai = 0; ai < 2; ++ai)
#pragma unroll
            for (int m = 0; m < 4; ++m) { bf16_t* rowp = proj + (size_t)(row0 + ai * 128 + m * 16) * INW + col0;
#pragma unroll
                for (int bj = 0; bj < 2; ++bj) { const f32x4 v0 = acc[ai][bj][m][0] * sc, v1 = acc[ai][bj][m][1] * sc;
                    u32x4 w; w.x = cvt_pk_bf16(v0[0], v0[1]); w.y = cvt_pk_bf16(v0[2], v0[3]); w.z = cvt_pk_bf16(v1[0], v1[1]); w.w = cvt_pk_bf16(v1[2], v1[3]);
                    *(u32x4*)(rowp + bj * 128) = w; } }
    }
};
typedef f32x4 (&AccMut)[2][2][4][2];
struct EpiBranch {
    static constexpr bool PERM = false, CHAIN = true;
    const bf16_t* proj; bf16_t* merged;
    __device__ __forceinline__ void operator()(AccMut acc, const Unit& u, int wr, int wc) const {
        const int ln_ = fresh_lane(), fr = ln_ & 15, fq = ln_ >> 4;
        const int br = u.aux; const int col0 = u.pn * 256 + wc * 32 + 4 * fq;
#pragma unroll
        for (int ai = 0; ai < 2; ++ai)
#pragma unroll
            for (int m = 0; m < 4; ++m) { const size_t row = (size_t)(u.pm * 256 + ai * 128 + wr * 64 + m * 16 + fr);
#pragma unroll
                for (int bj = 0; bj < 2; ++bj)
#pragma unroll
                    for (int n = 0; n < 2; ++n) { const int col = col0 + bj * 128 + n * 16;
                        const bf16_t* gp = proj + row * INW + OFF_G + br * DM + col;
                        const u32x2 gw = *(const u32x2*)gp; const f32x4 g = (f32x4){bflo(gw.x), bfhi(gw.x), bflo(gw.y), bfhi(gw.y)};
                        if (br < 2) { const u32x2 hw = *(const u32x2*)(gp + DM);
                            const f32x4 r = (f32x4){__builtin_amdgcn_rcpf(fmaxf(bflo(hw.x), 1e-30f)), __builtin_amdgcn_rcpf(fmaxf(bfhi(hw.x), 1e-30f)), __builtin_amdgcn_rcpf(fmaxf(bflo(hw.y), 1e-30f)), __builtin_amdgcn_rcpf(fmaxf(bfhi(hw.y), 1e-30f))};
                            acc[ai][bj][m][n] = acc[ai][bj][m][n] * (g * r); }
                        else { const f32x4 v = acc[ai][bj][m][n] * g; u32x2 w; w.x = cvt_pk_bf16(v[0], v[1]); w.y = cvt_pk_bf16(v[2], v[3]); *(u32x2*)(merged + row * DM + col) = w; } } }
    }
};
struct EpiResid {
    static constexpr bool PERM = false, CHAIN = false;
    const float* src_lat; const float* src_ctx; float* dst_lat; float* dst_ctx; const float* gate;
    __device__ __forceinline__ void operator()(AccRef acc, const Unit& u, int wr, int wc) const {
        const int ln_ = fresh_lane(), fr = ln_ & 15, fq = ln_ >> 4;
        const int pm = u.pm; const int b = pm < 64 ? (pm >> 4) : 4; const float* g = gate + (size_t)b * 12288; const int col0 = u.pn * 256 + wc * 32 + 4 * fq;
        const float* s0 = pm < 64 ? src_lat + (size_t)pm * 256 * DM : src_ctx + (size_t)(pm - 64) * 256 * DM;
        float* d0 = pm < 64 ? dst_lat + (size_t)pm * 256 * DM : dst_ctx + (size_t)(pm - 64) * 256 * DM;
        f32x4 gv[2][2];
#pragma unroll
        for (int bj = 0; bj < 2; ++bj)
#pragma unroll
            for (int n = 0; n < 2; ++n) gv[bj][n] = *(const f32x4*)(g + col0 + bj * 128 + n * 16);
#pragma unroll
        for (int ai = 0; ai < 2; ++ai)
#pragma unroll
            for (int m = 0; m < 4; ++m) { const size_t ro = (size_t)(ai * 128 + wr * 64 + m * 16 + fr) * DM;
#pragma unroll
                for (int bj = 0; bj < 2; ++bj)
#pragma unroll
                    for (int n = 0; n < 2; ++n) { const int col = col0 + bj * 128 + n * 16;
                        if (u.aux) { const f32x4 v = gv[bj][n] * acc[ai][bj][m][n]; float* d = d0 + ro + col;
                            unsafeAtomicAdd(d, v[0]); unsafeAtomicAdd(d + 1, v[1]); unsafeAtomicAdd(d + 2, v[2]); unsafeAtomicAdd(d + 3, v[3]); }
                        else *(f32x4*)(d0 + ro + col) = *(const f32x4*)(s0 + ro + col) + gv[bj][n] * acc[ai][bj][m][n]; } }
    }
};

struct EpiUpConv {
    static constexpr bool PERM = true, CHAIN = false;
    bf16_t* hmid; float* sb; const float* cw; const float* cbias;
    __device__ __forceinline__ void operator()(AccRef acc, const Unit& u, int wr, int wc) const {
        const int ln_ = fresh_lane(), fr = ln_ & 15, fq = ln_ >> 4;
        const int pm = u.pm, ch0 = u.pn * 128 + wc * 32 + 8 * fq;
        const int ip = ((ln_ & 48) | ((fr + 15) & 15)) << 2, in = ((ln_ & 48) | ((fr + 1) & 15)) << 2;
        f32x4 w0[2], w1[2], w2[2], cb[2];
#pragma unroll
        for (int n = 0; n < 2; ++n) { w0[n] = *(const f32x4*)(cw + ch0 + 4 * n); w1[n] = *(const f32x4*)(cw + DFF + ch0 + 4 * n); w2[n] = *(const f32x4*)(cw + 2 * DFF + ch0 + 4 * n); cb[n] = *(const f32x4*)(cbias + ch0 + 4 * n); }
#pragma unroll
        for (int ai = 0; ai < 2; ++ai) {
            const int blk = pm * 4 + ai * 2 + wr;
            float* sbb = sb + (size_t)blk * 6 * DFF + ch0;
#pragma unroll
            for (int m = 0; m < 4; ++m) {
                f32x4 o[2];
#pragma unroll
                for (int n = 0; n < 2; ++n) {
                    const f32x4 am = acc[ai][0][m][n], gm = acc[ai][1][m][n];
                    const f32x4 z = (f32x4){0.f, 0.f, 0.f, 0.f};
                    const f32x4 ap = (m > 0) ? acc[ai][0][m > 0 ? m - 1 : 0][n] : z, an = (m < 3) ? acc[ai][0][m < 3 ? m + 1 : 3][n] : z;
                    const f32x4 tp = (fr == 15) ? ap : am, tn = (fr == 0) ? an : am;
                    f32x4 pv, nv;
#pragma unroll
                    for (int e = 0; e < 4; ++e) { pv[e] = __int_as_float(__builtin_amdgcn_ds_bpermute(ip, __float_as_int(tp[e]))); nv[e] = __int_as_float(__builtin_amdgcn_ds_bpermute(in, __float_as_int(tn[e]))); }
                    const f32x4 y = cb[n] + w0[n] * pv + w1[n] * am + w2[n] * nv;
                    o[n] = (f32x4){fsilu(y[0]) * gm[0], fsilu(y[1]) * gm[1], fsilu(y[2]) * gm[2], fsilu(y[3]) * gm[3]};
                    if (m == 0 && fr == 0) { *(f32x4*)(sbb + 0 * DFF + 4 * n) = y; *(f32x4*)(sbb + 2 * DFF + 4 * n) = gm; *(f32x4*)(sbb + 4 * DFF + 4 * n) = am; }
                    if (m == 3 && fr == 15) { *(f32x4*)(sbb + 1 * DFF + 4 * n) = y; *(f32x4*)(sbb + 3 * DFF + 4 * n) = gm; *(f32x4*)(sbb + 5 * DFF + 4 * n) = am; }
                }
                u32x4 w; w.x = cvt_pk_bf16(o[0][0], o[0][1]); w.y = cvt_pk_bf16(o[0][2], o[0][3]); w.z = cvt_pk_bf16(o[1][0], o[1][1]); w.w = cvt_pk_bf16(o[1][2], o[1][3]);
                *(u32x4*)(hmid + (size_t)(pm * 256 + ai * 128 + wr * 64 + m * 16 + fr) * DFF + ch0) = w;
            }
        }
    }
};
__device__ __forceinline__ void ffn_fix_rows(bf16_t* hmid, const float* sb, const float* cw, int nblk, int gtid, int NT) {
    const int nitems = nblk * 2 * (DFF / 4);
    for (int it = gtid; it < nitems; it += NT) {
        const int c4 = (it % (DFF / 4)) * 4, bw = it / (DFF / 4), which = bw & 1, blk = bw >> 1;
        const int row0 = blk * 64; const int rel = row0 < MLAT ? (row0 & 4095) : ((row0 - MLAT) & 255), seqlen = row0 < MLAT ? 4096 : 256;
        const bool edge = which ? (rel + 64 == seqlen) : (rel == 0);
        const float* s = sb + (size_t)blk * 6 * DFF + c4;
        f32x4 y = *(const f32x4*)(s + which * DFF); const f32x4 g = *(const f32x4*)(s + (2 + which) * DFF);
        if (!edge) { const float* sn = sb + (size_t)(which ? blk + 1 : blk - 1) * 6 * DFF + c4; const f32x4 an = *(const f32x4*)(sn + (which ? 4 : 5) * DFF);
            const f32x4 w = *(const f32x4*)(cw + (which ? 2 * DFF : 0) + c4); y = y + w * an; }
        u32x2 o; o.x = cvt_pk_bf16(fsilu(y[0]) * g[0], fsilu(y[1]) * g[1]); o.y = cvt_pk_bf16(fsilu(y[2]) * g[2], fsilu(y[3]) * g[3]);
        *(u32x2*)(hmid + (size_t)(row0 + (which ? 63 : 0)) * DFF + c4) = o;
    }
}

struct Args { const float* in[22]; float* out; unsigned char* ws; int ph_lo, ph_hi; };

template <bool UPMAP = false>
__device__ __forceinline__ void transpose_item(const float* W, int N, bf16_t* WT, int ldk, int koff, LAS float* scr, int item, int lane) {
    const int nblk = N / 32, kb = item / nblk, nb = item % nblk, k0 = 64 * kb, n0 = 32 * nb;
    const int r0 = UPMAP ? (n0 < DFF ? (n0 >> 7) * 256 + (n0 & 127) : ((n0 - DFF) >> 7) * 256 + 128 + ((n0 - DFF) & 127)) : n0;
#pragma unroll 8
    for (int i = 0; i < 32; ++i) { const int kk = 2 * i + (lane >> 5); scr[kk * 33 + (lane & 31)] = W[(size_t)(k0 + kk) * N + n0 + (lane & 31)]; }
    LDS_WAIT(); asm volatile("" ::: "memory");
    const int c = lane & 7;
#pragma unroll
    for (int j = 0; j < 4; ++j) { const int n = (lane >> 3) + 8 * j; const LAS float* s = scr + (8 * c) * 33 + n;
        u32x4 o; o.x = cvt_pk_bf16(s[0 * 33], s[1 * 33]); o.y = cvt_pk_bf16(s[2 * 33], s[3 * 33]); o.z = cvt_pk_bf16(s[4 * 33], s[5 * 33]); o.w = cvt_pk_bf16(s[6 * 33], s[7 * 33]);
        *(u32x4*)(WT + (size_t)(r0 + n) * ldk + koff + k0 + 8 * c) = o; }
    LDS_WAIT(); asm volatile("" ::: "memory");
}
template <class AR>
__device__ __forceinline__ void convert_weights(const AR& a, int l, LAS float* scr, int gw, int NGW, int lane) {
    unsigned char* ws = a.ws;
    const float* w_in = a.in[8] + (size_t)l * DM * INW; const float* w_f = a.in[13] + (size_t)l * 512 * DM; const float* w_na = a.in[14] + (size_t)l * 1024 * DM;
    const float* w_c = a.in[15] + (size_t)l * 512 * DM; const float* w_o = a.in[16] + (size_t)l * DM * DM; const float* w_up = a.in[17] + (size_t)l * DM * UPW; const float* w_dn = a.in[20] + (size_t)l * DFF * DM;
    constexpr int I_IN = 32 * 336, I_F = 8 * 64, I_NA = 16 * 64, I_C = 8 * 64, I_O = 32 * 64, I_UP = 32 * 352, I_DN = 88 * 64;
    constexpr int NITEMS = I_IN + I_F + I_NA + I_C + I_O + I_UP + I_DN;
    for (int it = gw; it < NITEMS; it += NGW) {
        int r = it;
        if (r < I_IN) { transpose_item(w_in, INW, (bf16_t*)(ws + WS_WIN), DM, 0, scr, r, lane); continue; } r -= I_IN;
        if (r < I_F) { transpose_item(w_f, DM, (bf16_t*)(ws + WS_WBR), DM, 0, scr, r, lane); continue; } r -= I_F;
        if (r < I_NA) { transpose_item(w_na, DM, (bf16_t*)(ws + WS_WBR), DM, 512, scr, r, lane); continue; } r -= I_NA;
        if (r < I_C) { transpose_item(w_c, DM, (bf16_t*)(ws + WS_WBR), DM, 1536, scr, r, lane); continue; } r -= I_C;
        if (r < I_O) { transpose_item(w_o, DM, (bf16_t*)(ws + WS_WO), DM, 0, scr, r, lane); continue; } r -= I_O;
        if (r < I_UP) { transpose_item<true>(w_up, UPW, (bf16_t*)(ws + WS_WUP), DM, 0, scr, r, lane); continue; } r -= I_UP;
        transpose_item(w_dn, DM, (bf16_t*)(ws + WS_WDN), DFF, 0, scr, r, lane);
    }
}
__device__ __forceinline__ void dft_tables(unsigned char* ws, const LAS float* lut, int gw, int NGW, int lane) {
    bf16_t* tt = (bf16_t*)(ws + WS_TT); bf16_t* ma = (bf16_t*)(ws + WS_MA); bf16_t* dftc = (bf16_t*)(ws + WS_DFTC);
    const int half = lane >> 5, x0 = (lane & 31) * 2;
    for (int it = gw; it < 16384 + 256 + 256; it += NGW) {
        if (it < 16384) { const int k2 = it >> 8, k1 = it & 255; float v0 = 0.f, v1 = 0.f;
            if (k1 < 64) { const int k = 64 * k1 + k2, sh = half ? 3072 : 0;
                v0 = lut[(x0 * k + sh) & 4095]; v1 = lut[((x0 + 1) * k + sh) & 4095]; }
            *(unsigned*)(tt + (size_t)it * 128 + half * 64 + x0) = cvt_pk_bf16(v0, v1);
        } else if (it < 16384 + 256) { const int r = it - 16384; float v0 = 0.f, v1 = 0.f;
            if ((r & 64) == 0) { const int k2 = r & 63, im = r >> 7;
                const int sh = im ? (half ? 2048 : 1024) : (half ? 1024 : 0);
                v0 = lut[(((x0 * k2) & 63) * 64 + sh) & 4095]; v1 = lut[((((x0 + 1) * k2) & 63) * 64 + sh) & 4095]; }
            *(unsigned*)(ma + (size_t)r * 128 + half * 64 + x0) = cvt_pk_bf16(v0, v1);
        } else { const int k = it - 16384 - 256; const int n0 = lane * 8; const int nn = n0 & 255, sh = n0 >= 256 ? 1024 : 0; float v[8];
#pragma unroll
            for (int e = 0; e < 8; ++e) v[e] = lut[((((k * (nn + e)) & 255) * 16) + sh) & 4095];
            u32x4 w; w.x = cvt_pk_bf16(v[0], v[1]); w.y = cvt_pk_bf16(v[2], v[3]); w.z = cvt_pk_bf16(v[4], v[5]); w.w = cvt_pk_bf16(v[6], v[7]);
            *(u32x4*)(dftc + (size_t)k * 8192 + n0) = w; }
    }
}
template <class AR>
__device__ __forceinline__ void mods_items(const AR& a, int gw, int NGW, int lane) {
    float* mods = (float*)(a.ws + WS_MODS);
    for (int it = gw; it < 1536; it += NGW) {
        const int l = it / 768, rem = it % 768, cch = rem >> 4, kp = rem & 15; const int col = cch * 256 + lane * 4, k0 = kp * 128;
        float sv[5][2];
#pragma unroll
        for (int r = 0; r < 5; ++r)
#pragma unroll
            for (int i = 0; i < 2; ++i) { const int k = k0 + lane + 64 * i; const float cv = r < 4 ? a.in[1][r * DM + k] : a.in[3][k]; sv[r][i] = fsilu(cv); }
        f32x4 acc[5];
#pragma unroll
        for (int r = 0; r < 5; ++r) acc[r] = (f32x4){0.f, 0.f, 0.f, 0.f};
        const float* wbase = a.in[4] + ((size_t)l * DM + k0) * 12288 + col;
#pragma unroll
        for (int i = 0; i < 2; ++i) {
#pragma unroll 16
            for (int ll = 0; ll < 64; ++ll) { const f32x4 w = *(const f32x4*)(wbase + (size_t)(i * 64 + ll) * 12288);
#pragma unroll
                for (int r = 0; r < 5; ++r) { const float s = __int_as_float(__builtin_amdgcn_readlane(__float_as_int(sv[r][i]), ll)); acc[r] += w * s; } }
        }
        if (kp == 0) { const f32x4 bv = *(const f32x4*)(a.in[5] + (size_t)l * 12288 + col);
#pragma unroll
            for (int r = 0; r < 5; ++r) acc[r] += bv; }
#pragma unroll
        for (int r = 0; r < 5; ++r) { float* d = mods + ((size_t)l * 5 + r) * 12288 + col; unsafeAtomicAdd(d, acc[r][0]); unsafeAtomicAdd(d + 1, acc[r][1]); unsafeAtomicAdd(d + 2, acc[r][2]); unsafeAtomicAdd(d + 3, acc[r][3]); }
    }
}
__device__ __forceinline__ void norm_rows(const float* xlat, const float* xctx, const float* w, const float* mods_l, int shoff, int scoff, bf16_t* XN, int nrows, int gw, int NGW, int lane) {
    for (int row = gw; row < nrows; row += NGW) {
        const float* xr = row < MLAT ? xlat + (size_t)row * DM : xctx + (size_t)(row - MLAT) * DM; const int b = row < MLAT ? (row >> 12) : 4;
        const float* sh = mods_l + (size_t)b * 12288 + shoff; const float* sc = mods_l + (size_t)b * 12288 + scoff;
        f32x4 v[8]; float ss = 0.f;
#pragma unroll
        for (int j = 0; j < 8; ++j) { v[j] = *(const f32x4*)(xr + 4 * lane + 256 * j); ss += (v[j][0] * v[j][0] + v[j][1] * v[j][1]) + (v[j][2] * v[j][2] + v[j][3] * v[j][3]); }
        const float rstd = rsqrtf(wave_sum(ss, lane) * (1.0f / DM) + EPS);
#pragma unroll
        for (int j = 0; j < 8; ++j) { const int col = 4 * lane + 256 * j; const f32x4 wv = *(const f32x4*)(w + col), scv = *(const f32x4*)(sc + col), shv = *(const f32x4*)(sh + col);
            const f32x4 o = (v[j] * rstd * wv) * (scv + 1.0f) + shv; u32x2 pk; pk.x = cvt_pk_bf16(o[0], o[1]); pk.y = cvt_pk_bf16(o[2], o[3]);
            *(u32x2*)(XN + (size_t)row * DM + col) = pk; }
    }
}
__device__ __forceinline__ void final_norm(float* x, const float* w, int gw, int NGW, int lane) {
    for (int row = gw; row < MLAT; row += NGW) { float* xr = x + (size_t)row * DM; f32x4 v[8]; float ss = 0.f;
#pragma unroll
        for (int j = 0; j < 8; ++j) { v[j] = *(const f32x4*)(xr + 4 * lane + 256 * j); ss += (v[j][0] * v[j][0] + v[j][1] * v[j][1]) + (v[j][2] * v[j][2] + v[j][3] * v[j][3]); }
        const float rstd = rsqrtf(wave_sum(ss, lane) * (1.0f / DM) + EPS);
#pragma unroll
        for (int j = 0; j < 8; ++j) { const int col = 4 * lane + 256 * j; *(f32x4*)(xr + col) = v[j] * rstd * *(const f32x4*)(w + col); } }
}
__device__ __forceinline__ void sgu_unit(bf16_t* proj, int row0, int g, const float* nw, const float* wsg, const float* bsg, LAS unsigned char* lds, int tid) {
    LAS bf16_t* vnt = (LAS bf16_t*)lds;
    const int lane = tid & 63, wid = tid >> 6, fr = lane & 15, fq = lane >> 4;
    {
        const int j = tid >> 2, q = tid & 3; const bf16_t* src = proj + (size_t)(row0 + j) * INW + OFF_C + 512 + g * 128 + q * 32;
        float v[32];
#pragma unroll
        for (int i = 0; i < 4; ++i) { const u32x4 w = *(const u32x4*)(src + 8 * i);
            v[8 * i + 0] = bflo(w.x); v[8 * i + 1] = bfhi(w.x); v[8 * i + 2] = bflo(w.y); v[8 * i + 3] = bfhi(w.y); v[8 * i + 4] = bflo(w.z); v[8 * i + 5] = bfhi(w.z); v[8 * i + 6] = bflo(w.w); v[8 * i + 7] = bfhi(w.w); }
        float s = 0.f;
#pragma unroll
        for (int e = 0; e < 32; ++e) s += v[e];
        s += shx(s, 1, lane); s += shx(s, 2, lane); const float mean = s * (1.0f / 128.0f);
        float qv = 0.f;
#pragma unroll
        for (int e = 0; e < 32; ++e) { v[e] -= mean; qv += v[e] * v[e]; }
        qv += shx(qv, 1, lane); qv += shx(qv, 2, lane); const float rstd = rsqrtf(qv * (1.0f / 128.0f) + EPS);
#pragma unroll
        for (int e = 0; e < 32; e += 2) { const int d = q * 32 + e; const unsigned w = cvt_pk_bf16(v[e] * rstd * nw[g * 128 + d], v[e + 1] * rstd * nw[g * 128 + d + 1]);
            vnt[d * 136 + j] = (bf16_t)(w & 0xffffu); vnt[(d + 1) * 136 + j] = (bf16_t)(w >> 16); }
    }
    __syncthreads();
    {
        const int i = 16 * wid + fr;
        bf16x8 wf[4];
#pragma unroll
        for (int ks = 0; ks < 4; ++ks) { const float* wp = wsg + (size_t)i * 128 + 32 * ks + 8 * fq; const f32x4 a = *(const f32x4*)wp, b = *(const f32x4*)(wp + 4);
            u32x4 w; w.x = cvt_pk_bf16(a[0], a[1]); w.y = cvt_pk_bf16(a[2], a[3]); w.z = cvt_pk_bf16(b[0], b[1]); w.w = cvt_pk_bf16(b[2], b[3]); wf[ks] = __builtin_bit_cast(bf16x8, w); }
        const float bias = bsg[i];
        bf16_t* up = proj + (size_t)(row0 + i) * INW + OFF_C + g * 128 + 4 * fq;
#pragma unroll
        for (int nt = 0; nt < 8; ++nt) { f32x4 acc = (f32x4){0.f, 0.f, 0.f, 0.f};
#pragma unroll
            for (int ks = 0; ks < 4; ++ks) { const bf16x8 af = *(const LAS bf16x8*)((const LAS unsigned char*)vnt + (16 * nt + fr) * 272 + (32 * ks + 8 * fq) * 2);
                acc = __builtin_amdgcn_mfma_f32_16x16x32_bf16(af, wf[ks], acc, 0, 0, 0); }
            const u32x2 uw = *(const u32x2*)(up + 16 * nt); u32x2 o;
            o.x = cvt_pk_bf16(bflo(uw.x) * (acc[0] + bias), bfhi(uw.x) * (acc[1] + bias)); o.y = cvt_pk_bf16(bflo(uw.y) * (acc[2] + bias), bfhi(uw.y) * (acc[3] + bias));
            *(u32x2*)(up + 16 * nt) = o; }
    }
    __syncthreads();
}
template <bool LAT>
__device__ __forceinline__ void attn_task(bf16_t* proj, const bf16_t* vt, const float* rpb, int t, int lane, const LAS unsigned char* cl) {
    constexpr int NCH = LAT ? 16 : 8, WCH = LAT ? 8 : 0;
    const int fr = lane & 15, fq = lane >> 4;
    int b, h, r = 0, cgp = 0, qrow;
    if (LAT) { cgp = t & 3; r = (t >> 2) & 63; h = (t >> 8) & 7; b = t >> 11; qrow = b * 4096 + r * 64 + cgp * 16 + fr; }
    else { const int qg = t & 15; h = (t >> 4) & 7; b = t >> 7; qrow = MLAT + b * 256 + qg * 16 + fr; }
    bf16_t* qp = proj + (size_t)qrow * INW + OFF_Q + h * 128;
    bf16x8 qf[4];
#pragma unroll
    for (int ks = 0; ks < 4; ++ks) qf[ks] = *(const bf16x8*)(qp + ks * 32 + fq * 8);
    const int rs = r < 4 ? 0 : (r > 60 ? 56 : r - 4);
    const int cb = cgp == 0 ? 0 : (cgp == 1 ? 8 : (cgp == 2 ? 24 : 32));
    float S[NCH][8];
    const int kap = 8 * (fr >> 2) + (fr & 3);
    const bf16_t* kbase = proj + OFF_K + h * 128 + fq * 8;
    bf16x8 kf[2][8];
#define ATT_LOADK(buf, c) do { _Pragma("unroll") for (int tt = 0; tt < 2; ++tt) { \
        if ((c) < WCH) { const int krow = b * 4096 + (rs + (c)) * 64 + cb + kap + 4 * tt; const bf16_t* kp = kbase + (size_t)krow * INW; \
            _Pragma("unroll") for (int ks = 0; ks < 4; ++ks) kf[buf][tt * 4 + ks] = *(const bf16x8*)(kp + ks * 32); } \
        else { const LAS unsigned char* kp = cl + (32 * ((c) - WCH) + kap + 4 * tt) * 256; \
            _Pragma("unroll") for (int ks = 0; ks < 4; ++ks) kf[buf][tt * 4 + ks] = *(const LAS bf16x8*)(kp + (((ks * 4 + fq) ^ fr) * 16)); } } } while (0)
    ATT_LOADK(0, 0);
#pragma unroll
    for (int c = 0; c < NCH; ++c) {
        if (c + 1 < NCH) ATT_LOADK((c + 1) & 1, c + 1);
        __builtin_amdgcn_sched_barrier(0);
#pragma unroll
        for (int tt = 0; tt < 2; ++tt) {
            f32x4 acc = (f32x4){0.f, 0.f, 0.f, 0.f};
#pragma unroll
            for (int ks = 0; ks < 4; ++ks) acc = __builtin_amdgcn_mfma_f32_16x16x32_bf16(kf[c & 1][tt * 4 + ks], qf[ks], acc, 0, 0, 0);
            S[c][4 * tt + 0] = acc[0]; S[c][4 * tt + 1] = acc[1]; S[c][4 * tt + 2] = acc[2]; S[c][4 * tt + 3] = acc[3];
        }
        __builtin_amdgcn_sched_barrier(0);
    }
#undef ATT_LOADK
    if (LAT) {
        const int qc = cgp * 16 + fr; const int cs = qc < 8 ? 0 : (qc > 56 ? 48 : qc - 8);
#pragma unroll
        for (int c = 0; c < WCH; ++c) { const int dr = rs + c - r + 7; const float* rp = rpb + (h * 15 + dr) * 31;
#pragma unroll
            for (int jj = 0; jj < 8; ++jj) { const int kc = cb + 8 * fq + jj; const bool valid = (kc >= cs) && (kc < cs + 16); int dc = kc - qc + 15; dc = dc < 0 ? 0 : (dc > 30 ? 30 : dc);
                const float bias = rp[dc]; S[c][jj] = valid ? S[c][jj] + bias : -1e30f; } }
    }
    float mx = -3.0e38f;
#pragma unroll
    for (int c = 0; c < NCH; ++c)
#pragma unroll
        for (int jj = 0; jj < 8; ++jj) mx = fmaxf(mx, S[c][jj]);
    mx = fmaxf(mx, shx(mx, 16, lane)); mx = fmaxf(mx, shx(mx, 32, lane));
    float sum = 0.f; bf16x8 pf[NCH];
#pragma unroll
    for (int c = 0; c < NCH; ++c) { float p[8];
#pragma unroll
        for (int jj = 0; jj < 8; ++jj) { p[jj] = __builtin_amdgcn_exp2f((S[c][jj] - mx) * 1.44269504089f); sum += p[jj]; }
        u32x4 w; w.x = cvt_pk_bf16(p[0], p[1]); w.y = cvt_pk_bf16(p[2], p[3]); w.z = cvt_pk_bf16(p[4], p[5]); w.w = cvt_pk_bf16(p[6], p[7]); pf[c] = __builtin_bit_cast(bf16x8, w); }
    sum += shx(sum, 16, lane); sum += shx(sum, 32, lane);
    const float inv = 1.0f / sum;
    const bf16_t* vlat = vt + ((size_t)(b * 1024 + h * 128 + fr)) * 4096 + cb + 8 * fq;
    constexpr int NBH = NCH / 8, NQ = 8 * NBH;
    bf16x8 vf[2][8];
#define ATT_LOADV(buf, q) do { const int dt_ = (q) / NBH, hb_ = (q) % NBH; _Pragma("unroll") for (int i = 0; i < 8; ++i) { const int c_ = hb_ * 8 + i; \
        if (c_ < WCH) vf[buf][i] = *(const bf16x8*)(vlat + (size_t)dt_ * 16 * 4096 + (rs + c_) * 64); \
        else vf[buf][i] = *(const LAS bf16x8*)(cl + 65536 + (dt_ * 16 + fr) * 512 + ((((c_ - WCH) * 4 + fq) ^ fr) * 16)); } } while (0)
    ATT_LOADV(0, 0);
    f32x4 oacc = (f32x4){0.f, 0.f, 0.f, 0.f};
#pragma unroll
    for (int q = 0; q < NQ; ++q) {
        if (q + 1 < NQ) ATT_LOADV((q + 1) & 1, q + 1);
        __builtin_amdgcn_sched_barrier(0);
        const int dt = q / NBH, hb = q % NBH;
        if (hb == 0) oacc = (f32x4){0.f, 0.f, 0.f, 0.f};
#pragma unroll
        for (int i = 0; i < 8; ++i) oacc = __builtin_amdgcn_mfma_f32_16x16x32_bf16(vf[q & 1][i], pf[hb * 8 + i], oacc, 0, 0, 0);
        if (hb == NBH - 1) { u32x2 o; o.x = cvt_pk_bf16(oacc[0] * inv, oacc[1] * inv); o.y = cvt_pk_bf16(oacc[2] * inv, oacc[3] * inv);
            *(u32x2*)(qp + dt * 16 + 4 * fq) = o; }
        __builtin_amdgcn_sched_barrier(0);
    }
#undef ATT_LOADV
}
__device__ __forceinline__ void attn_block(bf16_t* proj, const bf16_t* vt, const bf16_t* vtc, const float* rpb, int vcu, int half, bool ctxq, LAS unsigned char* lds, int wave) {
    const int bh = vcu >> 3, b = bh >> 3, h = bh & 7, rb = vcu & 7;
    __syncthreads();
    { const int tid = wave * 64 + fresh_lane();
#pragma unroll
      for (int i = 0; i < 8; ++i) { const int idx = tid + 512 * i, key = idx >> 4, ch = idx & 15, g = (key & 3) | (((key >> 3) & 3) << 2);
          const u32x4 v = *(const u32x4*)(proj + (size_t)(MLAT + b * 256 + key) * INW + OFF_K + h * 128 + ch * 8);
          *(LAS u32x4*)(lds + key * 256 + ((ch ^ g) * 16)) = v; }
#pragma unroll
      for (int i = 0; i < 8; ++i) { const int idx = tid + 512 * i, d = idx >> 5, ch = idx & 31;
          const u32x4 v = *(const u32x4*)(vtc + (size_t)(b * 1024 + h * 128 + d) * 256 + ch * 8);
          *(LAS u32x4*)(lds + 65536 + d * 512 + ((ch ^ (d & 15)) * 16)) = v; } }
    __syncthreads();
    const int lane = fresh_lane();
    for (int round = 0; round < 2; ++round) { const int r = rb * 8 + half * 4 + round * 2 + (wave >> 2), cgp = wave & 3;
        attn_task<true>(proj, vt, rpb, ((bh * 64 + r) << 2) + cgp, lane, lds); }
    if (ctxq && wave == 0) attn_task<false>(proj, vt, rpb, bh * 16 + rb * 2 + half, lane, lds);
}
__device__ __forceinline__ void conv_items(const bf16_t* up, bf16_t* hmid, const float* cw, const float* cbias, int nrows, int gtid, int NT) {
    const int nitems = (nrows / 16) * 704;
    for (int it = gtid; it < nitems; it += NT) {
        const int cg8 = it % 704, rb = it / 704; const int row0 = rb * 16, ch = cg8 * 8;
        const int seqlen = row0 < MLAT ? 4096 : 256; const int ts = (row0 < MLAT ? row0 : row0 - MLAT) & (seqlen - 1);
        float w0[8], w1[8], w2[8], bb[8];
#pragma unroll
        for (int e = 0; e < 8; ++e) { w0[e] = cw[ch + e]; w1[e] = cw[DFF + ch + e]; w2[e] = cw[2 * DFF + ch + e]; bb[e] = cbias[ch + e]; }
        const bf16_t* ap = up + (size_t)row0 * UPW + ch; const bf16_t* gp = ap + DFF; bf16_t* hp = hmid + (size_t)row0 * DFF + ch;
        u32x4 prev = (u32x4){0u, 0u, 0u, 0u}; if (ts > 0) prev = *(const u32x4*)(ap - UPW);
        u32x4 cur = *(const u32x4*)ap;
        for (int i = 0; i < 16; ++i) {
            u32x4 nxt = (u32x4){0u, 0u, 0u, 0u}; if (i < 15 || ts + 16 < seqlen) nxt = *(const u32x4*)(ap + (size_t)(i + 1) * UPW);
            const u32x4 gw = *(const u32x4*)(gp + (size_t)i * UPW);
            float o[8];
#pragma unroll
            for (int e = 0; e < 4; ++e) {
                const float y0 = bb[2 * e] + w0[2 * e] * bflo(prev[e]) + w1[2 * e] * bflo(cur[e]) + w2[2 * e] * bflo(nxt[e]);
                const float y1 = bb[2 * e + 1] + w0[2 * e + 1] * bfhi(prev[e]) + w1[2 * e + 1] * bfhi(cur[e]) + w2[2 * e + 1] * bfhi(nxt[e]);
                o[2 * e] = fsilu(y0) * bflo(gw[e]); o[2 * e + 1] = fsilu(y1) * bfhi(gw[e]); }
            u32x4 w; w.x = cvt_pk_bf16(o[0], o[1]); w.y = cvt_pk_bf16(o[2], o[3]); w.z = cvt_pk_bf16(o[4], o[5]); w.w = cvt_pk_bf16(o[6], o[7]);
            *(u32x4*)(hp + (size_t)i * DFF) = w;
            prev = cur; cur = nxt;
        }
    }
}


#define XB_TMO      128
#define XB_XCNT(j)  (256  + 64 * (j))
#define XB_XSUB(j)  (1280 + 64 * (j))
#define XB_XGEN(j)  (2304 + 64 * (j))
#define XB_TOP      3328
#define XB_TOPGEN   3392
#define XCD_BAR_WORDS 3456
#define XB_SPIN_CAP (1u << 18)
__device__ __forceinline__ unsigned xb_ld(unsigned* p)              { return __hip_atomic_load(p, __ATOMIC_RELAXED, __HIP_MEMORY_SCOPE_AGENT); }
__device__ __forceinline__ unsigned xb_add(unsigned* p, unsigned v) { return __hip_atomic_fetch_add(p, v, __ATOMIC_RELAXED, __HIP_MEMORY_SCOPE_AGENT); }
__device__ __forceinline__ unsigned xb_xcc_id() { return (unsigned)__builtin_amdgcn_s_getreg((3 << 11) | 20) & 0xFu; }
#define XB_SPIN(cond, bar) do { unsigned _sp = 0; while (cond) { __builtin_amdgcn_s_sleep(1); \
    if ((++_sp & 255u) == 0u) { if (xb_ld(&(bar)[XB_TMO])) break; if (_sp > XB_SPIN_CAP) { atomicAdd(&(bar)[XB_TMO], 1u); break; } } } } while (0)
struct XcdBarrier { unsigned* bar; unsigned x; volatile LAS unsigned* st; };
__device__ __forceinline__ XcdBarrier xcd_barrier_post(unsigned* bar, volatile LAS unsigned* st) {
    XcdBarrier b; b.bar = bar; b.x = xb_xcc_id(); b.st = st;
    if (threadIdx.x == 0) (void)xb_add(&bar[XB_XCNT(b.x)], 1u);
    return b;
}
__device__ __forceinline__ void xcd_barrier_complete(unsigned* bar, unsigned x, unsigned& nloc, unsigned& nx) {
    const unsigned G = gridDim.x * gridDim.y * gridDim.z;
    unsigned sum, cnt, mine, sp = 0u;
    for (;;) {
        sum = 0u; cnt = 0u; mine = 0u;
#pragma unroll
        for (unsigned j = 0; j < 16; ++j) { const unsigned c = xb_ld(&bar[XB_XCNT(j)]); sum += c; cnt += (c > 0u) ? 1u : 0u; mine = (j == x) ? c : mine; }
        if (sum == G) break;
        __builtin_amdgcn_s_sleep(1);
        if ((++sp & 255u) == 0u) { if (xb_ld(&bar[XB_TMO])) break; if (sp > XB_SPIN_CAP) { atomicAdd(&bar[XB_TMO], 1u); break; } }
    }
    nloc = mine > 0u ? mine : 1u; nx = cnt > 0u ? cnt : 1u;
}
__device__ __forceinline__ void xcd_barrier(const XcdBarrier& b) {
    asm volatile("s_waitcnt vmcnt(0)" ::: "memory");
    __syncthreads();
    if (threadIdx.x == 0) {
        unsigned* bar = b.bar;
        __builtin_amdgcn_s_waitcnt(0);
        unsigned nloc = b.st[0], nx = b.st[1];
        if (nloc == 0u) { xcd_barrier_complete(bar, b.x, nloc, nx); b.st[0] = nloc; b.st[1] = nx; }
        const unsigned old = xb_add(&bar[XB_XSUB(b.x)], 1u);
        const unsigned gen = old / nloc;
        if (old + 1u == (gen + 1u) * nloc) {
            __builtin_amdgcn_fence(__ATOMIC_RELEASE, "agent");
            asm volatile("s_waitcnt vmcnt(0)" ::: "memory");
            const unsigned og = xb_add(&bar[XB_TOP], 1u);
            const unsigned tg = og / nx;
            if (og + 1u == (tg + 1u) * nx) xb_add(&bar[XB_TOPGEN], 1u);
            else XB_SPIN(xb_ld(&bar[XB_TOPGEN]) == tg, bar);
            __builtin_amdgcn_fence(__ATOMIC_ACQUIRE, "agent");
            xb_add(&bar[XB_XGEN(b.x)], 1u);
            asm volatile("s_waitcnt vmcnt(0)" ::: "memory");
        } else {
            XB_SPIN(xb_ld(&bar[XB_XGEN(b.x)]) == gen, bar);
            __builtin_amdgcn_fence(__ATOMIC_ACQUIRE, "agent");
            asm volatile("s_waitcnt vmcnt(0)" ::: "memory");
        }
    }
    __syncthreads();
}
constexpr int NPHASE = 24;
__global__ void __launch_bounds__(512, 2) mega(Args a_) {
    extern __shared__ __attribute__((aligned(16))) unsigned char lds_raw[];
    LAS unsigned char* lds = (LAS unsigned char*)lds_raw;
    cg::grid_group grid = cg::this_grid();
    const int G = gridDim.x, cu = blockIdx.x, NGW = G * 8, wave = __builtin_amdgcn_readfirstlane((int)threadIdx.x >> 6);

    volatile LAS unsigned* xst = (volatile LAS unsigned*)(lds + 143360);
    if (threadIdx.x < 4) xst[threadIdx.x] = 0u;
    __syncthreads();
    const XcdBarrier xbar = xcd_barrier_post((unsigned*)(a_.ws + WS_BAR), xst);

    const int ph_lo = a_.ph_lo, ph_hi = a_.ph_hi;
    for (int p = ph_lo; p < ph_hi; ++p) {
        if (p > ph_lo) { if (p == 1) grid.sync(); else xcd_barrier(xbar); }
#define PH_IDS const int lane = fresh_lane(); const int tid = wave * 64 + lane, gw = cu * 8 + wave; (void)tid; (void)gw; (void)lane;
        typedef const __attribute__((address_space(4))) Args KArgs;
        KArgs* ap = (KArgs*)__builtin_amdgcn_kernarg_segment_ptr(); asm volatile("" : "+s"(ap));
        KArgs& a = *ap;
        unsigned char* ws = a.ws;
        unsigned* ctl = (unsigned*)(ws + WS_CTL);
        bf16_t* PROJ = (bf16_t*)(ws + WS_BIG); bf16_t* XN = (bf16_t*)(ws + WS_XN); bf16_t* HMID = (bf16_t*)(ws + WS_HMID);
        float* XC = (float*)(ws + WS_XC); float* mods = (float*)(ws + WS_MODS);
        bf16_t* VT = (bf16_t*)(ws + WS_VT); bf16_t* VTC = (bf16_t*)(ws + WS_VTC);
        if (p == 0) { PH_IDS
            LAS float* lut = (LAS float*)(lds + 72 * 1024);
            for (int i = tid; i < 4096; i += 512) lut[i] = cospif((float)i * (1.0f / 2048.0f));
            __syncthreads();
            if (cu == 0) { bf16_t* dd = (bf16_t*)(ws + WS_DFTD);
                for (int e = tid; e < 256 * 128; e += 512) { const int row = e >> 7, d = e & 127, j = row & 127; const float ang = (float)((j * d) & 127) * (1.0f / 64.0f);
                    const float v = row < 128 ? cospif(ang) : sinpif(ang); dd[e] = (bf16_t)(cvt_pk_bf16(v, 0.f) & 0xffffu); } }
            for (int i = cu * 512 + tid; i < 1024 * DM / 4; i += G * 512) ((f32x4*)XC)[i] = ((const f32x4*)a.in[2])[i];
            mods_items(a, gw, NGW, lane);
            convert_weights(a, 0, (LAS float*)(lds + wave * 8704), gw, NGW, lane);
            dft_tables(ws, lut, gw, NGW, lane);
            continue;
        }
        if (p == NPHASE - 1) { PH_IDS final_norm(a.out, a.in[21], gw, NGW, lane); continue; }
        const int l = (p - 1) / 11, s = (p - 1) % 11;
        const float* mods_l = mods + (size_t)l * 5 * 12288;
        const float* xlat = (l == 0) ? a.in[0] : a.out; const float* xctx = (l == 0) ? a.in[2] : XC;
        const int nMall = (l == 0) ? 68 : 64;
        switch (s) {
        case 0: { PH_IDS
            if (l == 1) { LAS float* lut = (LAS float*)(lds + 72 * 1024);
                for (int i = tid; i < 4096; i += 512) lut[i] = cospif((float)i * (1.0f / 2048.0f));
                __syncthreads();
                convert_weights(a, 1, (LAS float*)(lds + wave * 8704), gw, NGW, lane);
                dft_tables(ws, lut, gw, NGW, lane); }
            norm_rows(xlat, xctx, a.in[6] + (size_t)l * DM, mods_l, 0, 2048, XN, MT, gw, NGW, lane);
        } break;
        case 1: { PH_IDS
            SchedGrid S; S.so.init(nMall, 42, G, cu); S.A = (const char*)XN; S.B = (const char*)(ws + WS_WIN); S.tsA = (size_t)256 * DM * 2; S.tsB = (size_t)256 * DM * 2; S.nt = 32;
            S.nextra = (l == 0) ? 0 : 32; S.ex_pm0 = 64; S.ex_pn0 = 6; S.ex_w = 8; S.ex_ks = 1;
            EpiInProj E{PROJ, VT, VTC};
            pg8::gemm_phase<EpiInProj, SchedGrid>(lds, tid, DM, DM, S, E);
        } break;
        case 2: { PH_IDS
            const int nun = 512 + ((l == 0) ? 32 : 0);
            for (int u = cu; u < nun; u += G) { int row0, g;
                if (u < 512) { const int b = u >> 7, ch = (u >> 2) & 31; g = u & 3; row0 = b * 4096 + ch * 128; }
                else { const int e = u - 512; const int b = e >> 3, ch = (e >> 2) & 1; g = e & 3; row0 = MLAT + b * 256 + ch * 128; }
                sgu_unit(PROJ, row0, g, a.in[10] + (size_t)l * 512, a.in[11] + ((size_t)l * 4 + g) * 128 * 128, a.in[12] + ((size_t)l * 4 + g) * 128, lds, tid); }
            __syncthreads();
            { SchedF1L S{(const char*)(ws + WS_DFTD), (const char*)PROJ, G, cu}; EpiF1L E{(bf16_t*)(ws + WS_U)};
              pg8::gemm_phase<EpiF1L, SchedF1L>(lds, wave * 64 + fresh_lane(), 128, INW, S, E); }
            if (l == 0) { SchedF1 S{(const char*)(ws + WS_DFTD), (const char*)PROJ, G, (cu + 128) % G, 16}; EpiF1 E{nullptr, (bf16_t*)(ws + WS_PQTC)};
              pg8::gemm_phase<EpiF1, SchedF1>(lds, wave * 64 + fresh_lane(), 128, INW, S, E); }
        } break;
        case 3: { PH_IDS
            { SchedFA S{(const char*)(ws + WS_MA), (const char*)(ws + WS_U), G, cu}; EpiFA E{(bf16_t*)(ws + WS_ZBUF)};
              pg8::gemm_phase<EpiFA, SchedFA>(lds, tid, 128, 128, S, E); }
            if (l == 0) { SchedF2 S{(const char*)(ws + WS_DFTC), (const char*)(ws + WS_PQTC), G, (cu + 128) % G, 8}; EpiF2 E{PROJ};
              pg8::gemm_phase<EpiF2, SchedF2>(lds, wave * 64 + fresh_lane(), 8192, 8192, S, E); }
            for (int vcu = cu; vcu < 256; vcu += G) attn_block(PROJ, VT, VTC, a.in[9] + (size_t)l * 8 * 15 * 31, vcu, 0, l == 0, lds, wave);
        } break;
        case 4: { PH_IDS
            { SchedFB S{(const char*)(ws + WS_TT), (const char*)(ws + WS_ZBUF), G, cu}; EpiFB E{PROJ};
              pg8::gemm_phase<EpiFB, SchedFB>(lds, tid, 128, 128, S, E); }
            for (int vcu = cu; vcu < 256; vcu += G) attn_block(PROJ, VT, VTC, a.in[9] + (size_t)l * 8 * 15 * 31, vcu, 1, l == 0, lds, wave);
        } break;
        case 5: { PH_IDS
            SchedBranch S; S.so.init(nMall, 8, G, cu); S.proj = (const char*)PROJ; S.wbr = (const char*)(ws + WS_WBR);
            EpiBranch E{PROJ, XN};
            pg8::gemm_phase<EpiBranch, SchedBranch>(lds, tid, INW, DM, S, E);
        } break;
        case 6: { PH_IDS
            SchedGrid S; S.so.init(64, 8, G, cu); S.A = (const char*)XN; S.B = (const char*)(ws + WS_WO); S.tsA = (size_t)256 * DM * 2; S.tsB = (size_t)256 * DM * 2; S.nt = 32;
            S.nextra = (l == 0) ? 32 * 8 : 0; S.ex_pm0 = 64; S.ex_pn0 = 0; S.ex_w = 8; S.ex_ks = 8;
            EpiResid E{xlat, XC, a.out, XC, mods_l + 4096};
            pg8::gemm_phase<EpiResid, SchedGrid>(lds, tid, DM, DM, S, E);
        } break;
        case 7: { PH_IDS
            norm_rows(a.out, XC, a.in[7] + (size_t)l * DM, mods_l, 6144, 8192, XN, nMall * 256, gw, NGW, lane);
        } break;
        case 8: { PH_IDS
            SchedGrid S; S.so.init(nMall, 44, G, cu); S.A = (const char*)XN; S.B = (const char*)(ws + WS_WUP); S.tsA = (size_t)256 * DM * 2; S.tsB = (size_t)256 * DM * 2; S.nt = 32; S.nextra = 0; S.ex_pm0 = 0; S.ex_pn0 = 0; S.ex_w = 1; S.ex_ks = 1;
            EpiUpConv E{HMID, (float*)(ws + WS_BIG), a.in[18] + (size_t)l * 3 * DFF, a.in[19] + (size_t)l * DFF};
            pg8::gemm_phase<EpiUpConv, SchedGrid>(lds, tid, DM, DM, S, E);
        } break;
        case 9: { PH_IDS
            ffn_fix_rows(HMID, (const float*)(ws + WS_BIG), a.in[18] + (size_t)l * 3 * DFF, nMall * 4, cu * 512 + tid, G * 512);
        } break;
        case 10: { PH_IDS
            SchedGrid S; S.so.init(64, 8, G, cu); S.A = (const char*)HMID; S.B = (const char*)(ws + WS_WDN); S.tsA = (size_t)256 * DFF * 2; S.tsB = (size_t)256 * DFF * 2; S.nt = 88;
            S.nextra = (l == 0) ? 32 * 4 : 0; S.ex_pm0 = 64; S.ex_pn0 = 0; S.ex_w = 8; S.ex_ks = 4;
            EpiResid E{a.out, XC, a.out, XC, mods_l + 10240};
            pg8::gemm_phase<EpiResid, SchedGrid>(lds, tid, DFF, DFF, S, E);
        } break;
        }
    }
}

extern "C" void kernel_launch(void* const* d_in, const int* in_sizes, int n_in, void* d_out, int out_size, void* d_ws, size_t ws_size, hipStream_t stream) {
    static int grid = 0;
    if (grid == 0) {
        if (n_in != 22 || ws_size < WS_END) { fprintf(stderr, "kernel_launch: unexpected n_in %d / ws_size %zu (need %zu)\n", n_in, ws_size, (size_t)WS_END); grid = -1; return; }
        int dev = 0, cus = 0, per_cu = 0;
        hipGetDevice(&dev); hipDeviceGetAttribute(&cus, hipDeviceAttributeMultiprocessorCount, dev);
        if (hipFuncSetAttribute((const void*)mega, hipFuncAttributeMaxDynamicSharedMemorySize, LDS_BYTES) != hipSuccess) { fprintf(stderr, "kernel_launch: hipFuncSetAttribute failed\n"); grid = -1; return; }
        hipOccupancyMaxActiveBlocksPerMultiprocessor(&per_cu, (const void*)mega, 512, LDS_BYTES);
        (void)hipGetLastError();
        if (per_cu < 1) fprintf(stderr, "kernel_launch: occupancy query says %d blocks/CU\n", per_cu);
        grid = cus > 0 ? cus : 256;
    }
    if (grid < 0) return;
    hipMemsetAsync((char*)d_ws + WS_CTL, 0, CTL_ZERO_BYTES, stream);
    Args a{};
    for (int i = 0; i < 22; ++i) a.in[i] = (const float*)d_in[i];
    a.out = (float*)d_out; a.ws = (unsigned char*)d_ws; a.ph_lo = 0; a.ph_hi = NPHASE;
    void* args[] = {&a};
    hipError_t e = hipLaunchCooperativeKernel((const void*)mega, dim3(grid), dim3(512), args, LDS_BYTES, stream);
    if (e != hipSuccess) fprintf(stderr, "kernel_launch: cooperative launch failed: %s (grid %d)\n", hipGetErrorString(e), grid);
}
```

```cpp
#include <hip/hip_runtime.h>
#include <hip/hip_cooperative_groups.h>
#include <cstdio>
#include <cstdint>
namespace cg = cooperative_groups;

#define LAS __attribute__((address_space(3)))
typedef unsigned short bf16_t;
typedef short bf16x8 __attribute__((ext_vector_type(8)));
typedef float f32x4 __attribute__((ext_vector_type(4)));
typedef float f32x2 __attribute__((ext_vector_type(2)));
typedef unsigned u32x4 __attribute__((ext_vector_type(4)));
typedef unsigned u32x2 __attribute__((ext_vector_type(2)));

constexpr int DM = 2048, MLAT = 16384, MT = 17408;
constexpr int INW = 10752, DFF = 5632, UPW = 11264;
constexpr int OFF_Q = 512, OFF_K = 1536, OFF_V = 2560, OFF_C = 3584, OFF_G = 4608;
constexpr float EPS = 1e-6f;
constexpr size_t MiB = 1u << 20;
constexpr size_t WS_CTL = 0;
constexpr size_t CTL_ZERO_BYTES = 1 * MiB;
constexpr size_t WS_MODS = 4096;
constexpr size_t WS_BAR = 512 * 1024;
constexpr size_t WS_DFTD = 1 * MiB;
constexpr size_t WS_XC = 2 * MiB;
constexpr size_t WS_WIN = 10 * MiB;
constexpr size_t WS_WBR = 52 * MiB;
constexpr size_t WS_WO = 60 * MiB;
constexpr size_t WS_WUP = 68 * MiB;
constexpr size_t WS_WDN = 112 * MiB;
constexpr size_t WS_XN = 134 * MiB;
constexpr size_t WS_BIG = 202 * MiB;
constexpr size_t WS_HMID = 576 * MiB;
constexpr size_t WS_ZBUF = WS_HMID;
constexpr size_t WS_TT = WS_HMID + 32 * MiB;
constexpr size_t WS_MA = WS_HMID + 36 * MiB;
constexpr size_t WS_U = WS_HMID + 64 * MiB;
constexpr size_t WS_VT = WS_HMID + 96 * MiB;
constexpr size_t WS_DFTC = WS_HMID + 128 * MiB;
constexpr size_t WS_PQTC = WS_HMID + 132 * MiB;
constexpr size_t WS_VTC = WS_HMID + 164 * MiB;
constexpr size_t WS_TMP = WS_HMID;
constexpr size_t WS_END = 763 * MiB;
constexpr int LDS_BYTES = 163840, LDS_XST = 163840 - 64;

#define LDS_WAIT() asm volatile("s_waitcnt lgkmcnt(0)" ::: "memory")
__device__ __forceinline__ unsigned cvt_pk_bf16(float lo, float hi) { unsigned r; asm volatile("v_cvt_pk_bf16_f32 %0, %1, %2" : "=v"(r) : "v"(lo), "v"(hi)); return r; }
__device__ __forceinline__ int fresh_lane() { unsigned z; asm volatile("v_mov_b32 %0, 0" : "=v"(z)); return (int)__builtin_amdgcn_mbcnt_hi(~0u, __builtin_amdgcn_mbcnt_lo(~0u, z)); }
__device__ __forceinline__ float bf2f(unsigned short b) { return __uint_as_float((unsigned)b << 16); }
__device__ __forceinline__ float bflo(unsigned w) { return __uint_as_float(w << 16); }
__device__ __forceinline__ float bfhi(unsigned w) { return __uint_as_float(w & 0xffff0000u); }
__device__ __forceinline__ float shx(float v, int o, int lane) { return __int_as_float(__builtin_amdgcn_ds_bpermute((lane ^ o) << 2, __float_as_int(v))); }
__device__ __forceinline__ float wave_sum(float v, int lane) {
#pragma unroll
    for (int o = 1; o < 64; o <<= 1) v += shx(v, o, lane);
    return v;
}
__device__ __forceinline__ float fsigmoid(float x) { return __builtin_amdgcn_rcpf(1.0f + __builtin_amdgcn_exp2f(-1.44269504089f * x)); }
__device__ __forceinline__ float fsilu(float x) { return x * fsigmoid(x); }
__device__ __forceinline__ f32x2 gelu_pk(f32x2 v) {
    const f32x2 av = __builtin_elementwise_abs(v), d = av * 0.2316418882f + 1.0f;
    f32x2 t; t.x = __builtin_amdgcn_rcpf(d.x); t.y = __builtin_amdgcn_rcpf(d.y);
    f32x2 q = t * 0.5307027145f + (-0.7265760135f); q = q * t + 0.7107068705f; q = q * t + (-0.142248368f); q = q * t + 0.127414796f; q = q * t;
    const f32x2 s = (v * v) * (-0.72134752044f);
    f32x2 e; e.x = __builtin_amdgcn_exp2f(s.x); e.y = __builtin_amdgcn_exp2f(s.y);
    const f32x2 m = v * (q * e), r = v - m;
    f32x2 o; o.x = v.x < 0.f ? m.x : r.x; o.y = v.y < 0.f ? m.y : r.y; return o;
}

namespace pg8 {
constexpr int BM = 256, BK = 64, HALF = 128, HTB = HALF * BK * 2, STAGE_BYTES = 8 * HTB, NXCD = 8, WGM = 8;
__host__ __device__ __forceinline__ int lds_byte(int r, int c) { const int st = (r >> 4) * 2 + (c >> 5), rr = r & 15, cc = c & 31, ob = rr * 64 + cc * 2; return st * 1024 + (ob ^ (((ob >> 9) & 1) << 5)); }
__host__ __device__ __forceinline__ void stage_rc(int b, int& R, int& C) { const int st = b / 1024, sb = b % 1024, swz = sb ^ (((sb >> 9) & 1) << 5); R = (st >> 1) * 16 + swz / 64; C = (st & 1) * 32 + (swz % 64) / 2; }
__host__ __device__ __forceinline__ int perm32(int rho) { const int n = rho >> 4, i = rho & 15; return 8 * (i >> 2) + 4 * n + (i & 3); }

struct Unit { const char* A; const char* B; int nt, pm, pn, aux; };

struct StaticOrder {
    int nM, nN, nwg, G, c;
    __device__ void init(int nM_, int nN_, int G_, int c_) { nM = nM_; nN = nN_; nwg = nM * nN; G = G_; c = c_; }
    __device__ bool next(int i, int& pm, int& pn) const {
        const long L = (long)i * G + c; if (L >= nwg) return false;
        int wgid = (int)L; { const int q = nwg / NXCD, r = nwg % NXCD, xcd = wgid % NXCD, off = wgid / NXCD; wgid = (xcd < r ? xcd * (q + 1) : r * (q + 1) + (xcd - r) * q) + off; }
        const int nig = WGM * nN, gid = wgid / nig, fm = gid * WGM, gsz = (nM - fm) < WGM ? (nM - fm) : WGM;
        pm = fm + ((wgid % nig) % gsz); pn = (wgid % nig) / gsz; return true;
    }
};

template <class Epi, class Sched>
__device__ __forceinline__ void gemm_phase(LAS unsigned char* lds, const int tid, const int lda, const int ldb, const Sched& S, const Epi& E) {
    const int wid = __builtin_amdgcn_readfirstlane(tid >> 6), lane = tid & 63, wr = wid >> 2, wc = wid & 3, fr = lane & 15, fq = lane >> 4;
    unsigned voffA[2], voffB[2];
#pragma unroll
    for (int i = 0; i < 2; ++i) { int R, C; stage_rc(tid * 16 + i * 8192, R, C); const int Rb = Epi::PERM ? ((R & ~31) + perm32(R & 31)) : R;
        voffA[i] = (unsigned)(R * lda + C) * 2u; voffB[i] = (unsigned)(Sched::brow(Rb) * ldb + C) * 2u; }
    const size_t kstep = (size_t)(BK * 2);
    const size_t hstepA = (size_t)HALF * lda * 2, hstepB = (size_t)Sched::BH * ldb * 2;
    const unsigned ldsw = (unsigned)wid * 1024u;
    const int aoff = lds_byte(wr * 64 + fr, fq * 8), boff = lds_byte(wc * 32 + fr, fq * 8);
#define PG8_SA(b, h) (((b) * 2 + (h)) * HTB)
#define PG8_SB(b, h) ((4 + (b) * 2 + (h)) * HTB)
#define PG8_STAGE(bufoff, gbase, voff) do { _Pragma("unroll") for (int _i = 0; _i < 2; ++_i) \
        __builtin_amdgcn_global_load_lds((const unsigned*)((const char*)(gbase) + (voff)[_i]), (LAS unsigned*)(lds + (bufoff) + ldsw + _i * 8192), 16, 0, 0); } while (0)
#define PG8_LDA(dst, b, h) do { _Pragma("unroll") for (int m = 0; m < 4; ++m) _Pragma("unroll") for (int k = 0; k < 2; ++k) dst[m][k] = *(const LAS bf16x8*)(lds + PG8_SA(b, h) + aoff + m * 2048 + k * 1024); } while (0)
#define PG8_LDB(dst, b, h) do { _Pragma("unroll") for (int n = 0; n < 2; ++n) _Pragma("unroll") for (int k = 0; k < 2; ++k) dst[n][k] = *(const LAS bf16x8*)(lds + PG8_SB(b, h) + boff + n * 2048 + k * 1024); } while (0)
#define PG8_MMA(ai, bj, At, Bt) do { __builtin_amdgcn_s_setprio(1); _Pragma("unroll") for (int m = 0; m < 4; ++m) _Pragma("unroll") for (int n = 0; n < 2; ++n) _Pragma("unroll") for (int k = 0; k < 2; ++k) \
        acc[ai][bj][m][n] = __builtin_amdgcn_mfma_f32_16x16x32_bf16(Bt[n][k], At[m][k], acc[ai][bj][m][n], 0, 0, 0); __builtin_amdgcn_s_setprio(0); } while (0)
#define PG8_WAIT_V(n) asm volatile("s_waitcnt vmcnt(" #n ")" ::: "memory")
#define PG8_WAIT_L(n) asm volatile("s_waitcnt lgkmcnt(" #n ")" ::: "memory")
#define PG8_BAR __builtin_amdgcn_s_barrier()
#define PG8_SCHED __builtin_amdgcn_sched_barrier(0)
    Unit cur, nxt; int ui = 0;
    if (!S.next(0, cur)) return;
    f32x4 acc[2][2][4][2];
#pragma unroll
    for (int a = 0; a < 2; ++a)
#pragma unroll
        for (int b = 0; b < 2; ++b)
#pragma unroll
            for (int m = 0; m < 4; ++m)
#pragma unroll
                for (int n = 0; n < 2; ++n) acc[a][b][m][n] = (f32x4){0.f, 0.f, 0.f, 0.f};
    bf16x8 At[4][2], B0[2][2], B1[2][2];
    const char* cA = cur.A; const char* cB = cur.B;
    {
        PG8_STAGE(PG8_SB(0, 0), cB, voffB); PG8_STAGE(PG8_SB(0, 1), cB + hstepB, voffB); PG8_STAGE(PG8_SA(0, 0), cA, voffA); PG8_STAGE(PG8_SA(0, 1), cA + hstepA, voffA);
        if (wr == 1) PG8_BAR;
        PG8_WAIT_V(2); PG8_BAR;
        PG8_STAGE(PG8_SB(1, 0), cB + kstep, voffB); PG8_STAGE(PG8_SA(1, 0), cA + kstep, voffA); PG8_STAGE(PG8_SB(1, 1), cB + hstepB + kstep, voffB);
        PG8_WAIT_V(6); PG8_BAR;
    }
    for (;;) {
        const bool has_next = S.next(ui + 1, nxt);
        const char* nA = has_next ? nxt.A : cA; const char* nB = has_next ? nxt.B : cB;
        const int nt = cur.nt;
        for (int t = 0; t < nt; t += 2) {
            const bool last = (t == nt - 2);
            const char* a1 = cA + (size_t)(t + 1) * kstep;
            const char* a2 = last ? nA : cA + (size_t)(t + 2) * kstep; const char* b2 = last ? nB : cB + (size_t)(t + 2) * kstep;
            const char* a3 = a2 + kstep; const char* b3 = b2 + kstep;
            PG8_LDB(B0, 0, 0); PG8_LDB(B1, 0, 1); PG8_SCHED; PG8_LDA(At, 0, 0); PG8_STAGE(PG8_SA(1, 1), a1 + hstepA, voffA);
            PG8_WAIT_V(8); PG8_WAIT_L(0); PG8_BAR; PG8_MMA(0, 0, At, B0); PG8_MMA(0, 1, At, B1); PG8_BAR; PG8_SCHED;
            PG8_LDA(At, 0, 1); PG8_STAGE(PG8_SB(0, 0), b2, voffB); PG8_STAGE(PG8_SB(0, 1), b2 + hstepB, voffB); PG8_STAGE(PG8_SA(0, 0), a2, voffA);
            PG8_WAIT_V(8); PG8_WAIT_L(0); PG8_BAR; PG8_MMA(1, 0, At, B0); PG8_MMA(1, 1, At, B1); PG8_BAR; PG8_SCHED;
            PG8_LDB(B0, 1, 0); PG8_LDB(B1, 1, 1); PG8_SCHED; PG8_LDA(At, 1, 0); PG8_STAGE(PG8_SA(0, 1), a2 + hstepA, voffA);
            PG8_WAIT_V(8); PG8_WAIT_L(0); PG8_BAR; PG8_MMA(0, 0, At, B0); PG8_MMA(0, 1, At, B1); PG8_BAR; PG8_SCHED;
            PG8_LDA(At, 1, 1); PG8_STAGE(PG8_SB(1, 0), b3, voffB); PG8_STAGE(PG8_SB(1, 1), b3 + hstepB, voffB); PG8_STAGE(PG8_SA(1, 0), a3, voffA);
            PG8_WAIT_V(8); PG8_WAIT_L(0); PG8_BAR; PG8_MMA(1, 0, At, B0); PG8_MMA(1, 1, At, B1); PG8_BAR; PG8_SCHED;
        }
        if (wr == 0) PG8_BAR;
        E(acc, cur, wr, wc);
        if (!has_next) break;
        if (!Epi::CHAIN || cur.aux == 2) {
#pragma unroll
        for (int a = 0; a < 2; ++a)
#pragma unroll
            for (int b = 0; b < 2; ++b)
#pragma unroll
                for (int m = 0; m < 4; ++m)
#pragma unroll
                    for (int n = 0; n < 2; ++n) acc[a][b][m][n] = (f32x4){0.f, 0.f, 0.f, 0.f};
        }
        cur = nxt; cA = nA; cB = nB; ++ui;
        if (wr == 1) PG8_BAR;
    }
    PG8_WAIT_V(0);
    PG8_BAR;
#undef PG8_SA
#undef PG8_SB
#undef PG8_STAGE
#undef PG8_LDA
#undef PG8_LDB
#undef PG8_MMA
#undef PG8_WAIT_V
#undef PG8_WAIT_L
#undef PG8_BAR
#undef PG8_SCHED
}
}
using pg8::Unit;
typedef const f32x4 (&AccRef)[2][2][4][2];

struct SchedGrid {
    static __device__ __forceinline__ int brow(int r) { return r; } static constexpr int BH = 128;
    pg8::StaticOrder so; const char* A; const char* B; size_t tsA, tsB; int nt, nextra, ex_pm0, ex_pn0, ex_w, ex_ks;
    __device__ __forceinline__ bool next(int i, Unit& u) const {
        int pm, pn; int kp = 0, ntu = nt, aux = 0;
        if (!so.next(i, pm, pn)) { const long e = (long)i * so.G + so.c - so.nwg; if (e >= nextra) return false; const int te = (int)e / ex_ks; kp = (int)e % ex_ks; ntu = nt / ex_ks; aux = ex_ks > 1 ? 1 : 0;
            pm = ex_pm0 + te / ex_w; pn = ex_pn0 + te % ex_w; }
        u.A = A + (size_t)pm * tsA + (size_t)kp * ntu * 128; u.B = B + (size_t)pn * tsB + (size_t)kp * ntu * 128; u.nt = ntu; u.pm = pm; u.pn = pn; u.aux = aux; return true;
    }
};
struct SchedBranch {
    static __device__ __forceinline__ int brow(int r) { return r; } static constexpr int BH = 128;
    pg8::StaticOrder so; const char* proj; const char* wbr;
    __device__ __forceinline__ bool next(int i, Unit& u) const {
        int pm, pn; if (!so.next(i / 3, pm, pn)) return false;
        const int br = i % 3; const int acol = br == 0 ? 0 : (br == 1 ? OFF_Q : OFF_C), koff = br == 0 ? 0 : (br == 1 ? 512 : 1536);
        u.A = proj + ((size_t)pm * 256 * INW + acol) * 2; u.B = wbr + ((size_t)pn * 256 * DM + koff) * 2; u.nt = br == 1 ? 16 : 8; u.pm = pm; u.pn = pn; u.aux = br; return true;
    }
};
struct SchedF1L {
    static __device__ __forceinline__ int brow(int r) { return (r >> 6) + 64 * (r & 63); } static constexpr int BH = 2;
    const char* dftd; const char* proj; int G, c;
    __device__ __forceinline__ bool next(int i, Unit& u) const {
        const int L = i * G + c; if (L >= 256) return false;
        { const char* ap = dftd; asm volatile("" : "+s"(ap)); u.A = ap; } u.nt = 2; u.pm = 0;
        const int b = L >> 6, g = (L >> 4) & 3, pn = L & 15; u.B = proj + ((size_t)(b * 4096 + 4 * pn) * INW + g * 128) * 2; u.pn = pn; u.aux = b * 4 + g; return true;
    }
};
struct SchedF1 {
    static __device__ __forceinline__ int brow(int r) { return r; } static constexpr int BH = 128;
    const char* dftd; const char* proj; int G, c, nctx;
    __device__ __forceinline__ bool next(int i, Unit& u) const {
        const int e = i * G + c; if (e >= nctx) return false;
        { const char* ap = dftd; asm volatile("" : "+s"(ap)); u.A = ap; } u.nt = 2; u.pm = 0;
        const int b = e >> 2, g = e & 3; u.B = proj + ((size_t)(MLAT + b * 256) * INW + g * 128) * 2; u.pn = 0; u.aux = 16 + b * 4 + g; return true;
    }
};
struct SchedF2 {
    static __device__ __forceinline__ int brow(int r) { return r; } static constexpr int BH = 128;
    const char* dftc; const char* pqtc; int G, c, nctx;
    __device__ __forceinline__ bool next(int i, Unit& u) const {
        const int e = i * G + c; if (e >= nctx) return false;
        const int b = e >> 1, pn = e & 1; { const char* ap = dftc; asm volatile("" : "+s"(ap)); u.A = ap; } u.B = pqtc + (size_t)(b * 512 + pn * 256) * 8192 * 2; u.nt = 8; u.pm = 0; u.pn = pn; u.aux = 4 + b; return true;
    }
};
struct SchedFA {
    static __device__ __forceinline__ int brow(int r) { return r; } static constexpr int BH = 128;
    const char* ma; const char* ub; int G, c;
    __device__ __forceinline__ bool next(int i, Unit& u) const {
        const int L = i * G + c; if (L >= 512) return false;
        { const char* ap = ma; asm volatile("" : "+s"(ap)); u.A = ap; } u.B = ub + (size_t)L * 256 * 128 * 2; u.nt = 2; u.pm = 0; u.pn = L; u.aux = 0; return true;
    }
};
struct SchedFB {
    static __device__ __forceinline__ int brow(int r) { return r; } static constexpr int BH = 128;
    const char* tt; const char* zb; int G, c;
    __device__ __forceinline__ bool next(int i, Unit& u) const {
        const int L = i * G + c; if (L >= 512) return false;
        const int k2 = L >> 3, pn = L & 7; u.A = tt + (size_t)k2 * 256 * 128 * 2; u.B = zb + ((size_t)k2 * 2048 + pn * 256) * 128 * 2; u.nt = 2; u.pm = 0; u.pn = pn; u.aux = k2; return true;
    }
};

struct EpiInProj {
    static constexpr bool PERM = true, CHAIN = false;
    bf16_t* proj; bf16_t* vt; bf16_t* vtc;
    __device__ __forceinline__ void operator()(AccRef acc, const Unit& u, int wr, int wc) const {
        const int ln_ = fresh_lane(), fr = ln_ & 15, fq = ln_ >> 4;
        const int pm = u.pm, pn = u.pn; const int row0 = pm * 256 + wr * 64 + fr, col0 = pn * 256 + wc * 32 + 8 * fq;
        if (pn >= 10 && pn < 14) {
            const int vc0 = col0 - OFF_V;
#pragma unroll
            for (int ai = 0; ai < 2; ++ai)
#pragma unroll
                for (int m = 0; m < 4; ++m) {
                    const int row = row0 + ai * 128 + m * 16; bf16_t* dst; size_t stride;
                    if (pm < 64) { const int b = pm >> 4; dst = vt + (size_t)b * 1024 * 4096 + (row - b * 4096); stride = 4096; }
                    else { const int b = pm - 64; dst = vtc + (size_t)b * 1024 * 256 + (row - MLAT - b * 256); stride = 256; }
#pragma unroll
                    for (int bj = 0; bj < 2; ++bj)
#pragma unroll
                        for (int n = 0; n < 2; ++n) { const f32x4 v = acc[ai][bj][m][n]; const unsigned w0 = cvt_pk_bf16(v[0], v[1]), w1 = cvt_pk_bf16(v[2], v[3]);
                            bf16_t* d = dst + (size_t)(vc0 + bj * 128 + n * 4) * stride;
                            d[0] = (bf16_t)(w0 & 0xffffu); d[stride] = (bf16_t)(w0 >> 16); d[2 * stride] = (bf16_t)(w1 & 0xffffu); d[3 * stride] = (bf16_t)(w1 >> 16); }
                }
            return;
        }
        const int act = pn < 14 ? 0 : (pn < 18 ? 1 : 2); const float sc = (pn >= 2 && pn < 6) ? 0.08838834764831845f : 1.0f;
#pragma unroll
        for (int ai = 0; ai < 2; ++ai)
#pragma unroll
            for (int m = 0; m < 4; ++m) { bf16_t* rowp = proj + (size_t)(row0 + ai * 128 + m * 16) * INW + col0;
#pragma unroll
                for (int bj = 0; bj < 2; ++bj) { f32x4 v0 = acc[ai][bj][m][0], v1 = acc[ai][bj][m][1];
                    if (act == 1) { f32x2 a = gelu_pk((f32x2){v0[0], v0[1]}), b = gelu_pk((f32x2){v0[2], v0[3]}), c = gelu_pk((f32x2){v1[0], v1[1]}), d = gelu_pk((f32x2){v1[2], v1[3]});
                        v0 = (f32x4){a.x, a.y, b.x, b.y}; v1 = (f32x4){c.x, c.y, d.x, d.y}; }
                    else if (act == 2) { v0 = (f32x4){fsigmoid(v0[0]), fsigmoid(v0[1]), fsigmoid(v0[2]), fsigmoid(v0[3])}; v1 = (f32x4){fsigmoid(v1[0]), fsigmoid(v1[1]), fsigmoid(v1[2]), fsigmoid(v1[3])}; }
                    else { v0 = v0 * sc; v1 = v1 * sc; }
                    u32x4 w; w.x = cvt_pk_bf16(v0[0], v0[1]); w.y = cvt_pk_bf16(v0[2], v0[3]); w.z = cvt_pk_bf16(v1[0], v1[1]); w.w = cvt_pk_bf16(v1[2], v1[3]);
                    *(u32x4*)(rowp + bj * 128) = w; } }
    }
};
struct EpiPlain {
    static constexpr bool PERM = true, CHAIN = false;
    bf16_t* out; int ld;
    __device__ __forceinline__ void operator()(AccRef acc, const Unit& u, int wr, int wc) const {
        const int ln_ = fresh_lane(), fr = ln_ & 15, fq = ln_ >> 4;
        const int row0 = u.pm * 256 + wr * 64 + fr, col0 = u.pn * 256 + wc * 32 + 8 * fq;
#pragma unroll
        for (int ai = 0; ai < 2; ++ai)
#pragma unroll
            for (int m = 0; m < 4; ++m) { bf16_t* rowp = out + (size_t)(row0 + ai * 128 + m * 16) * ld + col0;
#pragma unroll
                for (int bj = 0; bj < 2; ++bj) { const f32x4 v0 = acc[ai][bj][m][0], v1 = acc[ai][bj][m][1];
                    u32x4 w; w.x = cvt_pk_bf16(v0[0], v0[1]); w.y = cvt_pk_bf16(v0[2], v0[3]); w.z = cvt_pk_bf16(v1[0], v1[1]); w.w = cvt_pk_bf16(v1[2], v1[3]);
                    *(u32x4*)(rowp + bj * 128) = w; } }
    }
};
struct EpiF1 {
    static constexpr bool PERM = true, CHAIN = false;
    bf16_t* pqt; bf16_t* pqtc;
    __device__ __forceinline__ void operator()(AccRef acc, const Unit& u, int wr, int wc) const {
        const int ln_ = fresh_lane(), fr = ln_ & 15, fq = ln_ >> 4;
        const int aux = u.aux; const bool isc = aux >= 16; const int bg = aux & 15, b = bg >> 2, g = bg & 3;
        bf16_t* base = (isc ? pqtc : pqt) + (size_t)(b * 512 + g * 128) * 8192; const int half = isc ? 256 : 4096;
        const int n0 = u.pn * 256 + wc * 32 + 8 * fq;
#pragma unroll
        for (int ai = 0; ai < 2; ++ai)
#pragma unroll
            for (int m = 0; m < 4; ++m) { bf16_t* rowp = base + (size_t)(wr * 64 + m * 16 + fr) * 8192 + ai * half + n0;
#pragma unroll
                for (int bj = 0; bj < 2; ++bj) { const f32x4 v0 = acc[ai][bj][m][0], v1 = acc[ai][bj][m][1];
                    u32x4 w; w.x = cvt_pk_bf16(v0[0], v0[1]); w.y = cvt_pk_bf16(v0[2], v0[3]); w.z = cvt_pk_bf16(v1[0], v1[1]); w.w = cvt_pk_bf16(v1[2], v1[3]);
                    *(u32x4*)(rowp + bj * 128) = w; } }
    }
};
struct EpiF1L {
    static constexpr bool PERM = true, CHAIN = false;
    bf16_t* ub;
    __device__ __forceinline__ void operator()(AccRef acc, const Unit& u, int wr, int wc) const {
        const int ln_ = fresh_lane(), fr = ln_ & 15, fq = ln_ >> 4;
        const int b = u.aux >> 2, g = u.aux & 3;
#pragma unroll
        for (int ai = 0; ai < 2; ++ai)
#pragma unroll
            for (int m = 0; m < 4; ++m) { const int ch = b * 512 + g * 128 + wr * 64 + m * 16 + fr;
#pragma unroll
                for (int bj = 0; bj < 2; ++bj) { const int n1 = 4 * u.pn + 2 * bj + (wc >> 1), n2 = 32 * (wc & 1) + 8 * fq;
                    const f32x4 v0 = acc[ai][bj][m][0], v1 = acc[ai][bj][m][1];
                    u32x4 w; w.x = cvt_pk_bf16(v0[0], v0[1]); w.y = cvt_pk_bf16(v0[2], v0[3]); w.z = cvt_pk_bf16(v1[0], v1[1]); w.w = cvt_pk_bf16(v1[2], v1[3]);
                    *(u32x4*)(ub + ((size_t)ch * 64 + n1) * 128 + ai * 64 + n2) = w; } }
    }
};
struct EpiFA {
    static constexpr bool PERM = true, CHAIN = false;
    bf16_t* zb;
    __device__ __forceinline__ void operator()(AccRef acc, const Unit& u, int wr, int wc) const {
        if (wr != 0) return;
        const int ln_ = fresh_lane(), fr = ln_ & 15, fq = ln_ >> 4;
#pragma unroll
        for (int ai = 0; ai < 2; ++ai)
#pragma unroll
            for (int m = 0; m < 4; ++m) { const int k2 = m * 16 + fr;
#pragma unroll
                for (int bj = 0; bj < 2; ++bj) { const int bc = u.pn * 4 + 2 * bj + (wc >> 1), n1 = 32 * (wc & 1) + 8 * fq;
                    const f32x4 v0 = acc[ai][bj][m][0], v1 = acc[ai][bj][m][1];
                    u32x4 w; w.x = cvt_pk_bf16(v0[0], v0[1]); w.y = cvt_pk_bf16(v0[2], v0[3]); w.z = cvt_pk_bf16(v1[0], v1[1]); w.w = cvt_pk_bf16(v1[2], v1[3]);
                    *(u32x4*)(zb + ((size_t)k2 * 2048 + bc) * 128 + ai * 64 + n1) = w; } }
    }
};
struct EpiFB {
    static constexpr bool PERM = true, CHAIN = false;
    bf16_t* proj;
    __device__ __forceinline__ void operator()(AccRef acc, const Unit& u, int wr, int wc) const {
        if (wr != 0) return;
        const int ln_ = fresh_lane(), fr = ln_ & 15, fq = ln_ >> 4;
        const float sc = 0.0013810679320049757f; const int k2 = u.aux;
#pragma unroll
        for (int m = 0; m < 4; ++m) { const int k = 64 * (m * 16 + fr) + k2;
#pragma unroll
            for (int bj = 0; bj < 2; ++bj) { const int ncol = u.pn * 256 + 128 * bj + 32 * wc + 8 * fq; const int b = ncol >> 9, ch = ncol & 511;
                const f32x4 v0 = acc[0][bj][m][0] * sc, v1 = acc[0][bj][m][1] * sc;
                u32x4 w; w.x = cvt_pk_bf16(v0[0], v0[1]); w.y = cvt_pk_bf16(v0[2], v0[3]); w.z = cvt_pk_bf16(v1[0], v1[1]); w.w = cvt_pk_bf16(v1[2], v1[3]);
                *(u32x4*)(proj + (size_t)(b * 4096 + k) * INW + ch) = w; } }
    }
};
struct EpiF2 {
    static constexpr bool PERM = true, CHAIN = false;
    bf16_t* proj;
    __device__ __forceinline__ void operator()(AccRef acc, const Unit& u, int wr, int wc) const {
        const int ln_ = fresh_lane(), fr = ln_ & 15, fq = ln_ >> 4;
        const int aux = u.aux; const bool isc = aux >= 4; const int rowbase = isc ? MLAT + (aux - 4) * 256 : aux * 4096;
        const float sc = isc ? 0.005524271728019903f : 0.0013810679320049757f;
        const int row0 = rowbase + u.pm * 256 + wr * 64 + fr, col0 = u.pn * 256 + wc * 32 + 8 * fq;
#pragma unroll
        for (int ai = 0; ai < 2; ++ai)
#pragma unroll
            for (int m = 0; m < 4; ++m) { bf16_t* rowp = proj + (size_t)(row0 + ai * 128 + m * 16) * INW + col0;
#pragma unroll
                for (int bj = 0; bj < 2; ++bj) { const f32x4 v0 = acc[ai][bj][m][0] * sc, v1 = acc[ai][bj][m][1] * sc;
                    u32x4 w; w.x = cvt_pk_bf16(v0[0], v0[1]); w.y = cvt_pk_bf16(v0[2], v0[3]); w.z = cvt_pk_bf16(v1[0], v1[1]); w.w = cvt_pk_bf16(v1[2], v1[3]);
                    *(u32x4*)(rowp + bj * 128) = w; } }
    }
};
typedef f32x4 (&AccMut)[2][2][4][2];
struct EpiBranch {
    static constexpr bool PERM = false, CHAIN = true;
    const bf16_t* proj; bf16_t* merged;
    __device__ __forceinline__ void operator()(AccMut acc, const Unit& u, int wr, int wc) const {
        const int ln_ = fresh_lane(), fr = ln_ & 15, fq = ln_ >> 4;
        const int br = u.aux; const int col0 = u.pn * 256 + wc * 32 + 4 * fq;
#pragma unroll
        for (int ai = 0; ai < 2; ++ai)
#pragma unroll
            for (int m = 0; m < 4; ++m) { const size_t row = (size_t)(u.pm * 256 + ai * 128 + wr * 64 + m * 16 + fr);
#pragma unroll
                for (int bj = 0; bj < 2; ++bj)
#pragma unroll
                    for (int n = 0; n < 2; ++n) { const int col = col0 + bj * 128 + n * 16;
                        const bf16_t* gp = proj + row * INW + OFF_G + br * DM + col;
                        const u32x2 gw = *(const u32x2*)gp; const f32x4 g = (f32x4){bflo(gw.x), bfhi(gw.x), bflo(gw.y), bfhi(gw.y)};
                        if (br < 2) { const u32x2 hw = *(const u32x2*)(gp + DM);
                            const f32x4 r = (f32x4){__builtin_amdgcn_rcpf(fmaxf(bflo(hw.x), 1e-30f)), __builtin_amdgcn_rcpf(fmaxf(bfhi(hw.x), 1e-30f)), __builtin_amdgcn_rcpf(fmaxf(bflo(hw.y), 1e-30f)), __builtin_amdgcn_rcpf(fmaxf(bfhi(hw.y), 1e-30f))};
                            acc[ai][bj][m][n] = acc[ai][bj][m][n] * (g * r); }
                        else { const f32x4 v = acc[ai][bj][m][n] * g; u32x2 w; w.x = cvt_pk_bf16(v[0], v[1]); w.y = cvt_pk_bf16(v[2], v[3]); *(u32x2*)(merged + row * DM + col) = w; } } }
    }
};
struct EpiResid {
    static constexpr bool PERM = false, CHAIN = false;
    const float* src_lat; const float* src_ctx; float* dst_lat; float* dst_ctx; const float* gate;
    __device__ __forceinline__ void operator()(AccRef acc, const Unit& u, int wr, int wc) const {
        const int ln_ = fresh_lane(), fr = ln_ & 15, fq = ln_ >> 4;
        const int pm = u.pm; const int b = pm < 64 ? (pm >> 4) : 4; const float* g = gate + (size_t)b * 12288; const int col0 = u.pn * 256 + wc * 32 + 4 * fq;
        const float* s0 = pm < 64 ? src_lat + (size_t)pm * 256 * DM : src_ctx + (size_t)(pm - 64) * 256 * DM;
        float* d0 = pm < 64 ? dst_lat + (size_t)pm * 256 * DM : dst_ctx + (size_t)(pm - 64) * 256 * DM;
        f32x4 gv[2][2];
#pragma unroll
        for (int bj = 0; bj < 2; ++bj)
#pragma unroll
            for (int n = 0; n < 2; ++n) gv[bj][n] = *(const f32x4*)(g + col0 + bj * 128 + n * 16);
#pragma unroll
        for (int ai = 0; ai < 2; ++ai)
#pragma unroll
            for (int m = 0; m < 4; ++m) { const size_t ro = (size_t)(ai * 128 + wr * 64 + m * 16 + fr) * DM;
#pragma unroll
                for (int bj = 0; bj < 2; ++bj)
#pragma unroll
                    for (int n = 0; n < 2; ++n) { const int col = col0 + bj * 128 + n * 16;
                        if (u.aux) { const f32x4 v = gv[bj][n] * acc[ai][bj][m][n]; float* d = d0 + ro + col;
                            unsafeAtomicAdd(d, v[0]); unsafeAtomicAdd(d + 1, v[1]); unsafeAtomicAdd(d + 2, v[2]); unsafeAtomicAdd(d + 3, v[3]); }
                        else *(f32x4*)(d0 + ro + col) = *(const f32x4*)(s0 + ro + col) + gv[bj][n] * acc[ai][bj][m][n]; } }
    }
};

struct EpiUpConv {
    static constexpr bool PERM = true, CHAIN = false;
    bf16_t* hmid; float* sb; const float* cw; const float* cbias;
    __device__ __forceinline__ void operator()(AccRef acc, const Unit& u, int wr, int wc) const {
        const int ln_ = fresh_lane(), fr = ln_ & 15, fq = ln_ >> 4;
        const int pm = u.pm, ch0 = u.pn * 128 + wc * 32 + 8 * fq;
        const int ip = ((ln_ & 48) | ((fr + 15) & 15)) << 2, in = ((ln_ & 48) | ((fr + 1) & 15)) << 2;
        f32x4 w0[2], w1[2], w2[2], cb[2];
#pragma unroll
        for (int n = 0; n < 2; ++n) { w0[n] = *(const f32x4*)(cw + ch0 + 4 * n); w1[n] = *(const f32x4*)(cw + DFF + ch0 + 4 * n); w2[n] = *(const f32x4*)(cw + 2 * DFF + ch0 + 4 * n); cb[n] = *(const f32x4*)(cbias + ch0 + 4 * n); }
#pragma unroll
        for (int ai = 0; ai < 2; ++ai) {
            const int blk = pm * 4 + ai * 2 + wr;
            float* sbb = sb + (size_t)blk * 6 * DFF + ch0;
#pragma unroll
            for (int m = 0; m < 4; ++m) {
                f32x4 o[2];
#pragma unroll
                for (int n = 0; n < 2; ++n) {
                    const f32x4 am = acc[ai][0][m][n], gm = acc[ai][1][m][n];
                    const f32x4 z = (f32x4){0.f, 0.f, 0.f, 0.f};
                    const f32x4 ap = (m > 0) ? acc[ai][0][m > 0 ? m - 1 : 0][n] : z, an = (m < 3) ? acc[ai][0][m < 3 ? m + 1 : 3][n] : z;
                    const f32x4 tp = (fr == 15) ? ap : am, tn = (fr == 0) ? an : am;
                    f32x4 pv, nv;
#pragma unroll
                    for (int e = 0; e < 4; ++e) { pv[e] = __int_as_float(__builtin_amdgcn_ds_bpermute(ip, __float_as_int(tp[e]))); nv[e] = __int_as_float(__builtin_amdgcn_ds_bpermute(in, __float_as_int(tn[e]))); }
                    const f32x4 y = cb[n] + w0[n] * pv + w1[n] * am + w2[n] * nv;
                    o[n] = (f32x4){fsilu(y[0]) * gm[0], fsilu(y[1]) * gm[1], fsilu(y[2]) * gm[2], fsilu(y[3]) * gm[3]};
                    if (m == 0 && fr == 0) { *(f32x4*)(sbb + 0 * DFF + 4 * n) = y; *(f32x4*)(sbb + 2 * DFF + 4 * n) = gm; *(f32x4*)(sbb + 4 * DFF + 4 * n) = am; }
                    if (m == 3 && fr == 15) { *(f32x4*)(sbb + 1 * DFF + 4 * n) = y; *(f32x4*)(sbb + 3 * DFF + 4 * n) = gm; *(f32x4*)(sbb + 5 * DFF + 4 * n) = am; }
                }
                u32x4 w; w.x = cvt_pk_bf16(o[0][0], o[0][1]); w.y = cvt_pk_bf16(o[0][2], o[0][3]); w.z = cvt_pk_bf16(o[1][0], o[1][1]); w.w = cvt_pk_bf16(o[1][2], o[1][3]);
                *(u32x4*)(hmid + (size_t)(pm * 256 + ai * 128 + wr * 64 + m * 16 + fr) * DFF + ch0) = w;
            }
        }
    }
};
__device__ __forceinline__ void ffn_fix_rows(bf16_t* hmid, const float* sb, const float* cw, int nblk, int gtid, int NT) {
    const int nitems = nblk * 2 * (DFF / 4);
    for (int it = gtid; it < nitems; it += NT) {
        const int c4 = (it % (DFF / 4)) * 4, bw = it / (DFF / 4), which = bw & 1, blk = bw >> 1;
        const int row0 = blk * 64; const int rel = row0 < MLAT ? (row0 & 4095) : ((row0 - MLAT) & 255), seqlen = row0 < MLAT ? 4096 : 256;
        const bool edge = which ? (rel + 64 == seqlen) : (rel == 0);
        const float* s = sb + (size_t)blk * 6 * DFF + c4;
        f32x4 y = *(const f32x4*)(s + which * DFF); const f32x4 g = *(const f32x4*)(s + (2 + which) * DFF);
        if (!edge) { const float* sn = sb + (size_t)(which ? blk + 1 : blk - 1) * 6 * DFF + c4; const f32x4 an = *(const f32x4*)(sn + (which ? 4 : 5) * DFF);
            const f32x4 w = *(const f32x4*)(cw + (which ? 2 * DFF : 0) + c4); y = y + w * an; }
        u32x2 o; o.x = cvt_pk_bf16(fsilu(y[0]) * g[0], fsilu(y[1]) * g[1]); o.y = cvt_pk_bf16(fsilu(y[2]) * g[2], fsilu(y[3]) * g[3]);
        *(u32x2*)(hmid + (size_t)(row0 + (which ? 63 : 0)) * DFF + c4) = o;
    }
}

struct Args { const float* in[22]; float* out; unsigned char* ws; int ph_lo, ph_hi; };

template <bool UPMAP = false>
__device__ __forceinline__ void transpose_item(const float* W, int N, bf16_t* WT, int ldk, int koff, LAS float* scr, int item, int lane) {
    const int nblk = N / 32, kb = item / nblk, nb = item % nblk, k0 = 64 * kb, n0 = 32 * nb;
    const int r0 = UPMAP ? (n0 < DFF ? (n0 >> 7) * 256 + (n0 & 127) : ((n0 - DFF) >> 7) * 256 + 128 + ((n0 - DFF) & 127)) : n0;
#pragma unroll 8
    for (int i = 0; i < 32; ++i) { const int kk = 2 * i + (lane >> 5); scr[kk * 33 + (lane & 31)] = W[(size_t)(k0 + kk) * N + n0 + (lane & 31)]; }
    LDS_WAIT(); asm volatile("" ::: "memory");
    const int c = lane & 7;
#pragma unroll
    for (int j = 0; j < 4; ++j) { const int n = (lane >> 3) + 8 * j; const LAS float* s = scr + (8 * c) * 33 + n;
        u32x4 o; o.x = cvt_pk_bf16(s[0 * 33], s[1 * 33]); o.y = cvt_pk_bf16(s[2 * 33], s[3 * 33]); o.z = cvt_pk_bf16(s[4 * 33], s[5 * 33]); o.w = cvt_pk_bf16(s[6 * 33], s[7 * 33]);
        *(u32x4*)(WT + (size_t)(r0 + n) * ldk + koff + k0 + 8 * c) = o; }
    LDS_WAIT(); asm volatile("" ::: "memory");
}
template <class AR>
__device__ __forceinline__ void convert_weights(const AR& a, int l, LAS float* scr, int gw, int NGW, int lane) {
    unsigned char* ws = a.ws;
    const float* w_in = a.in[8] + (size_t)l * DM * INW; const float* w_f = a.in[13] + (size_t)l * 512 * DM; const float* w_na = a.in[14] + (size_t)l * 1024 * DM;
    const float* w_c = a.in[15] + (size_t)l * 512 * DM; const float* w_o = a.in[16] + (size_t)l * DM * DM; const float* w_up = a.in[17] + (size_t)l * DM * UPW; const float* w_dn = a.in[20] + (size_t)l * DFF * DM;
    constexpr int I_IN = 32 * 336, I_F = 8 * 64, I_NA = 16 * 64, I_C = 8 * 64, I_O = 32 * 64, I_UP = 32 * 352, I_DN = 88 * 64;
    constexpr int NITEMS = I_IN + I_F + I_NA + I_C + I_O + I_UP + I_DN;
    for (int it = gw; it < NITEMS; it += NGW) {
        int r = it;
        if (r < I_IN) { transpose_item(w_in, INW, (bf16_t*)(ws + WS_WIN), DM, 0, scr, r, lane); continue; } r -= I_IN;
        if (r < I_F) { transpose_item(w_f, DM, (bf16_t*)(ws + WS_WBR), DM, 0, scr, r, lane); continue; } r -= I_F;
        if (r < I_NA) { transpose_item(w_na, DM, (bf16_t*)(ws + WS_WBR), DM, 512, scr, r, lane); continue; } r -= I_NA;
        if (r < I_C) { transpose_item(w_c, DM, (bf16_t*)(ws + WS_WBR), DM, 1536, scr, r, lane); continue; } r -= I_C;
        if (r < I_O) { transpose_item(w_o, DM, (bf16_t*)(ws + WS_WO), DM, 0, scr, r, lane); continue; } r -= I_O;
        if (r < I_UP) { transpose_item<true>(w_up, UPW, (bf16_t*)(ws + WS_WUP), DM, 0, scr, r, lane); continue; } r -= I_UP;
        transpose_item(w_dn, DM, (bf16_t*)(ws + WS_WDN), DFF, 0, scr, r, lane);
    }
}
__device__ __forceinline__ void dft_tables(unsigned char* ws, const LAS float* lut, int gw, int NGW, int lane) {
    bf16_t* tt = (bf16_t*)(ws + WS_TT); bf16_t* ma = (bf16_t*)(ws + WS_MA); bf16_t* dftc = (bf16_t*)(ws + WS_DFTC);
    const int half = lane >> 5, x0 = (lane & 31) * 2;
    for (int it = gw; it < 16384 + 256 + 256; it += NGW) {
        if (it < 16384) { const int k2 = it >> 8, k1 = it & 255; float v0 = 0.f, v1 = 0.f;
            if (k1 < 64) { const int k = 64 * k1 + k2, sh = half ? 3072 : 0;
                v0 = lut[(x0 * k + sh) & 4095]; v1 = lut[((x0 + 1) * k + sh) & 4095]; }
            *(unsigned*)(tt + (size_t)it * 128 + half * 64 + x0) = cvt_pk_bf16(v0, v1);
        } else if (it < 16384 + 256) { const int r = it - 16384; float v0 = 0.f, v1 = 0.f;
            if ((r & 64) == 0) { const int k2 = r & 63, im = r >> 7;
                const int sh = im ? (half ? 2048 : 1024) : (half ? 1024 : 0);
                v0 = lut[(((x0 * k2) & 63) * 64 + sh) & 4095]; v1 = lut[((((x0 + 1) * k2) & 63) * 64 + sh) & 4095]; }
            *(unsigned*)(ma + (size_t)r * 128 + half * 64 + x0) = cvt_pk_bf16(v0, v1);
        } else { const int k = it - 16384 - 256; const int n0 = lane * 8; const int nn = n0 & 255, sh = n0 >= 256 ? 1024 : 0; float v[8];
#pragma unroll
            for (int e = 0; e < 8; ++e) v[e] = lut[((((k * (nn + e)) & 255) * 16) + sh) & 4095];
            u32x4 w; w.x = cvt_pk_bf16(v[0], v[1]); w.y = cvt_pk_bf16(v[2], v[3]); w.z = cvt_pk_bf16(v[4], v[5]); w.w = cvt_pk_bf16(v[6], v[7]);
            *(u32x4*)(dftc + (size_t)k * 8192 + n0) = w; }
    }
}
template <class AR>
__device__ __forceinline__ void mods_items(const AR& a, int gw, int NGW, int lane) {
    float* mods = (float*)(a.ws + WS_MODS);
    for (int it = gw; it < 1536; it += NGW) {
        const int l = it / 768, rem = it % 768, cch = rem >> 4, kp = rem & 15; const int col = cch * 256 + lane * 4, k0 = kp * 128;
        float sv[5][2];
#pragma unroll
        for (int r = 0; r < 5; ++r)
#pragma unroll
            for (int i = 0; i < 2; ++i) { const int k = k0 + lane + 64 * i; const float cv = r < 4 ? a.in[1][r * DM + k] : a.in[3][k]; sv[r][i] = fsilu(cv); }
        f32x4 acc[5];
#pragma unroll
        for (int r = 0; r < 5; ++r) acc[r] = (f32x4){0.f, 0.f, 0.f, 0.f};
        const float* wbase = a.in[4] + ((size_t)l * DM + k0) * 12288 + col;
#pragma unroll
        for (int i = 0; i < 2; ++i) {
#pragma unroll 16
            for (int ll = 0; ll < 64; ++ll) { const f32x4 w = *(const f32x4*)(wbase + (size_t)(i * 64 + ll) * 12288);
#pragma unroll
                for (int r = 0; r < 5; ++r) { const float s = __int_as_float(__builtin_amdgcn_readlane(__float_as_int(sv[r][i]), ll)); acc[r] += w * s; } }
        }
        if (kp == 0) { const f32x4 bv = *(const f32x4*)(a.in[5] + (size_t)l * 12288 + col);
#pragma unroll
            for (int r = 0; r < 5; ++r) acc[r] += bv; }
#pragma unroll
        for (int r = 0; r < 5; ++r) { float* d = mods + ((size_t)l * 5 + r) * 12288 + col; unsafeAtomicAdd(d, acc[r][0]); unsafeAtomicAdd(d + 1, acc[r][1]); unsafeAtomicAdd(d + 2, acc[r][2]); unsafeAtomicAdd(d + 3, acc[r][3]); }
    }
}
__device__ __forceinline__ void norm_rows(const float* xlat, const float* xctx, const float* w, const float* mods_l, int shoff, int scoff, bf16_t* XN, int nrows, int gw, int NGW, int lane) {
    for (int row = gw; row < nrows; row += NGW) {
        const float* xr = row < MLAT ? xlat + (size_t)row * DM : xctx + (size_t)(row - MLAT) * DM; const int b = row < MLAT ? (row >> 12) : 4;
        const float* sh = mods_l + (size_t)b * 12288 + shoff; const float* sc = mods_l + (size_t)b * 12288 + scoff;
        f32x4 v[8]; float ss = 0.f;
#pragma unroll
        for (int j = 0; j < 8; ++j) { v[j] = *(const f32x4*)(xr + 4 * lane + 256 * j); ss += (v[j][0] * v[j][0] + v[j][1] * v[j][1]) + (v[j][2] * v[j][2] + v[j][3] * v[j][3]); }
        const float rstd = rsqrtf(wave_sum(ss, lane) * (1.0f / DM) + EPS);
#pragma unroll
        for (int j = 0; j < 8; ++j) { const int col = 4 * lane + 256 * j; const f32x4 wv = *(const f32x4*)(w + col), scv = *(const f32x4*)(sc + col), shv = *(const f32x4*)(sh + col);
            const f32x4 o = (v[j] * rstd * wv) * (scv + 1.0f) + shv; u32x2 pk; pk.x = cvt_pk_bf16(o[0], o[1]); pk.y = cvt_pk_bf16(o[2], o[3]);
            *(u32x2*)(XN + (size_t)row * DM + col) = pk; }
    }
}
__device__ __forceinline__ void final_norm(float* x, const float* w, int gw, int NGW, int lane) {
    for (int row = gw; row < MLAT; row += NGW) { float* xr = x + (size_t)row * DM; f32x4 v[8]; float ss = 0.f;
#pragma unroll
        for (int j = 0; j < 8; ++j) { v[j] = *(const f32x4*)(xr + 4 * lane + 256 * j); ss += (v[j][0] * v[j][0] + v[j][1] * v[j][1]) + (v[j][2] * v[j][2] + v[j][3] * v[j][3]); }
        const float rstd = rsqrtf(wave_sum(ss, lane) * (1.0f / DM) + EPS);
#pragma unroll
        for (int j = 0; j < 8; ++j) { const int col = 4 * lane + 256 * j; *(f32x4*)(xr + col) = v[j] * rstd * *(const f32x4*)(w + col); } }
}
__device__ __forceinline__ void sgu_unit(bf16_t* proj, int row0, int g, const float* nw, const float* wsg, const float* bsg, LAS unsigned char* lds, int tid) {
    LAS bf16_t* vnt = (LAS bf16_t*)lds;
    const int lane = tid & 63, wid = tid >> 6, fr = lane & 15, fq = lane >> 4;
    {
        const int j = tid >> 2, q = tid & 3; const bf16_t* src = proj + (size_t)(row0 + j) * INW + OFF_C + 512 + g * 128 + q * 32;
        float v[32];
#pragma unroll
        for (int i = 0; i < 4; ++i) { const u32x4 w = *(const u32x4*)(src + 8 * i);
            v[8 * i + 0] = bflo(w.x); v[8 * i + 1] = bfhi(w.x); v[8 * i + 2] = bflo(w.y); v[8 * i + 3] = bfhi(w.y); v[8 * i + 4] = bflo(w.z); v[8 * i + 5] = bfhi(w.z); v[8 * i + 6] = bflo(w.w); v[8 * i + 7] = bfhi(w.w); }
        float s = 0.f;
#pragma unroll
        for (int e = 0; e < 32; ++e) s += v[e];
        s += shx(s, 1, lane); s += shx(s, 2, lane); const float mean = s * (1.0f / 128.0f);
        float qv = 0.f;
#pragma unroll
        for (int e = 0; e < 32; ++e) { v[e] -= mean; qv += v[e] * v[e]; }
        qv += shx(qv, 1, lane); qv += shx(qv, 2, lane); const float rstd = rsqrtf(qv * (1.0f / 128.0f) + EPS);
#pragma unroll
        for (int e = 0; e < 32; e += 2) { const int d = q * 32 + e; const unsigned w = cvt_pk_bf16(v[e] * rstd * nw[g * 128 + d], v[e + 1] * rstd * nw[g * 128 + d + 1]);
            vnt[d * 136 + j] = (bf16_t)(w & 0xffffu); vnt[(d + 1) * 136 + j] = (bf16_t)(w >> 16); }
    }
    __syncthreads();
    {
        const int i = 16 * wid + fr;
        bf16x8 wf[4];
#pragma unroll
        for (int ks = 0; ks < 4; ++ks) { const float* wp = wsg + (size_t)i * 128 + 32 * ks + 8 * fq; const f32x4 a = *(const f32x4*)wp, b = *(const f32x4*)(wp + 4);
            u32x4 w; w.x = cvt_pk_bf16(a[0], a[1]); w.y = cvt_pk_bf16(a[2], a[3]); w.z = cvt_pk_bf16(b[0], b[1]); w.w = cvt_pk_bf16(b[2], b[3]); wf[ks] = __builtin_bit_cast(bf16x8, w); }
        const float bias = bsg[i];
        bf16_t* up = proj + (size_t)(row0 + i) * INW + OFF_C + g * 128 + 4 * fq;
#pragma unroll
        for (int nt = 0; nt < 8; ++nt) { f32x4 acc = (f32x4){0.f, 0.f, 0.f, 0.f};
#pragma unroll
            for (int ks = 0; ks < 4; ++ks) { const bf16x8 af = *(const LAS bf16x8*)((const LAS unsigned char*)vnt + (16 * nt + fr) * 272 + (32 * ks + 8 * fq) * 2);
                acc = __builtin_amdgcn_mfma_f32_16x16x32_bf16(af, wf[ks], acc, 0, 0, 0); }
            const u32x2 uw = *(const u32x2*)(up + 16 * nt); u32x2 o;
            o.x = cvt_pk_bf16(bflo(uw.x) * (acc[0] + bias), bfhi(uw.x) * (acc[1] + bias)); o.y = cvt_pk_bf16(bflo(uw.y) * (acc[2] + bias), bfhi(uw.y) * (acc[3] + bias));
            *(u32x2*)(up + 16 * nt) = o; }
    }
    __syncthreads();
}
template <bool LAT>
__device__ __forceinline__ void attn_task(bf16_t* proj, const bf16_t* vt, const float* rpb, int t, int lane, const LAS unsigned char* cl) {
    constexpr int NCH = LAT ? 16 : 8, WCH = LAT ? 8 : 0;
    const int fr = lane & 15, fq = lane >> 4;
    int b, h, r = 0, cgp = 0, qrow;
    if (LAT) { cgp = t & 3; r = (t >> 2) & 63; h = (t >> 8) & 7; b = t >> 11; qrow = b * 4096 + r * 64 + cgp * 16 + fr; }
    else { const int qg = t & 15; h = (t >> 4) & 7; b = t >> 7; qrow = MLAT + b * 256 + qg * 16 + fr; }
    bf16_t* qp = proj + (size_t)qrow * INW + OFF_Q + h * 128;
    bf16x8 qf[4];
#pragma unroll
    for (int ks = 0; ks < 4; ++ks) qf[ks] = *(const bf16x8*)(qp + ks * 32 + fq * 8);
    const int rs = r < 4 ? 0 : (r > 60 ? 56 : r - 4);
    const int cb = cgp == 0 ? 0 : (cgp == 1 ? 8 : (cgp == 2 ? 24 : 32));
    float S[NCH][8];
    const int kap = 8 * (fr >> 2) + (fr & 3);
    const bf16_t* kbase = proj + OFF_K + h * 128 + fq * 8;
    bf16x8 kf[2][8];
#define ATT_LOADK(buf, c) do { _Pragma("unroll") for (int tt = 0; tt < 2; ++tt) { \
        if ((c) < WCH) { const int krow = b * 4096 + (rs + (c)) * 64 + cb + kap + 4 * tt; const bf16_t* kp = kbase + (size_t)krow * INW; \
            _Pragma("unroll") for (int ks = 0; ks < 4; ++ks) kf[buf][tt * 4 + ks] = *(const bf16x8*)(kp + ks * 32); } \
        else { const LAS unsigned char* kp = cl + (32 * ((c) - WCH) + kap + 4 * tt) * 256; \
            _Pragma("unroll") for (int ks = 0; ks < 4; ++ks) kf[buf][tt * 4 + ks] = *(const LAS bf16x8*)(kp + (((ks * 4 + fq) ^ fr) * 16)); } } } while (0)
    ATT_LOADK(0, 0);
#pragma unroll
    for (int c = 0; c < NCH; ++c) {
        if (c + 1 < NCH) ATT_LOADK((c + 1) & 1, c + 1);
        __builtin_amdgcn_sched_barrier(0);
#pragma unroll
        for (int tt = 0; tt < 2; ++tt) {
            f32x4 acc = (f32x4){0.f, 0.f, 0.f, 0.f};
#pragma unroll
            for (int ks = 0; ks < 4; ++ks) acc = __builtin_amdgcn_mfma_f32_16x16x32_bf16(kf[c & 1][tt * 4 + ks], qf[ks], acc, 0, 0, 0);
            S[c][4 * tt + 0] = acc[0]; S[c][4 * tt + 1] = acc[1]; S[c][4 * tt + 2] = acc[2]; S[c][4 * tt + 3] = acc[3];
        }
        __builtin_amdgcn_sched_barrier(0);
    }
#undef ATT_LOADK
    if (LAT) {
        const int qc = cgp * 16 + fr; const int cs = qc < 8 ? 0 : (qc > 56 ? 48 : qc - 8);
#pragma unroll
        for (int c = 0; c < WCH; ++c) { const int dr = rs + c - r + 7; const float* rp = rpb + (h * 15 + dr) * 31;
#pragma unroll
            for (int jj = 0; jj < 8; ++jj) { const int kc = cb + 8 * fq + jj; const bool valid = (kc >= cs) && (kc < cs + 16); int dc = kc - qc + 15; dc = dc < 0 ? 0 : (dc > 30 ? 30 : dc);
                const float bias = rp[dc]; S[c][jj] = valid ? S[c][jj] + bias : -1e30f; } }
    }
    float mx = -3.0e38f;
#pragma unroll
    for (int c = 0; c < NCH; ++c)
#pragma unroll
        for (int jj = 0; jj < 8; ++jj) mx = fmaxf(mx, S[c][jj]);
    mx = fmaxf(mx, shx(mx, 16, lane)); mx = fmaxf(mx, shx(mx, 32, lane));
    float sum = 0.f; bf16x8 pf[NCH];
#pragma unroll
    for (int c = 0; c < NCH; ++c) { float p[8];
#pragma unroll
        for (int jj = 0; jj < 8; ++jj) { p[jj] = __builtin_amdgcn_exp2f((S[c][jj] - mx) * 1.44269504089f); sum += p[jj]; }
        u32x4 w; w.x = cvt_pk_bf16(p[0], p[1]); w.y = cvt_pk_bf16(p[2], p[3]); w.z = cvt_pk_bf16(p[4], p[5]); w.w = cvt_pk_bf16(p[6], p[7]); pf[c] = __builtin_bit_cast(bf16x8, w); }
    sum += shx(sum, 16, lane); sum += shx(sum, 32, lane);
    const float inv = 1.0f / sum;
    const bf16_t* vlat = vt + ((size_t)(b * 1024 + h * 128 + fr)) * 4096 + cb + 8 * fq;
    constexpr int NBH = NCH / 8, NQ = 8 * NBH;
    bf16x8 vf[2][8];
#define ATT_LOADV(buf, q) do { const int dt_ = (q) / NBH, hb_ = (q) % NBH; _Pragma("unroll") for (int i = 0; i < 8; ++i) { const int c_ = hb_ * 8 + i; \
        if (c_ < WCH) vf[buf][i] = *(const bf16x8*)(vlat + (size_t)dt_ * 16 * 4096 + (rs + c_) * 64); \
        else vf[buf][i] = *(const LAS bf16x8*)(cl + 65536 + (dt_ * 16 + fr) * 512 + ((((c_ - WCH) * 4 + fq) ^ fr) * 16)); } } while (0)
    ATT_LOADV(0, 0);
    f32x4 oacc = (f32x4){0.f, 0.f, 0.f, 0.f};
#pragma unroll
    for (int q = 0; q < NQ; ++q) {
        if (q + 1 < NQ) ATT_LOADV((q + 1) & 1, q + 1);
        __builtin_amdgcn_sched_barrier(0);
        const int dt = q / NBH, hb = q % NBH;
        if (hb == 0) oacc = (f32x4){0.f, 0.f, 0.f, 0.f};
#pragma unroll
        for (int i = 0; i < 8; ++i) oacc = __builtin_amdgcn_mfma_f32_16x16x32_bf16(vf[q & 1][i], pf[hb * 8 + i], oacc, 0, 0, 0);
        if (hb == NBH - 1) { u32x2 o; o.x = cvt_pk_bf16(oacc[0] * inv, oacc[1] * inv); o.y = cvt_pk_bf16(oacc[2] * inv, oacc[3] * inv);
            *(u32x2*)(qp + dt * 16 + 4 * fq) = o; }
        __builtin_amdgcn_sched_barrier(0);
    }
#undef ATT_LOADV
}
template <bool LAT>
__device__ __forceinline__ void attn_pass(bf16_t* proj, const bf16_t* vt, const bf16_t* vtc, const float* rpb, int b, int h, int ra, LAS unsigned char* lds, int wave) {
    constexpr int NCH = LAT ? 16 : 8, WCH = LAT ? 8 : 0;
    const int lane = fresh_lane(), fr = lane & 15, fq = lane >> 4, tid = wave * 64 + lane;
    const int r = LAT ? ra + (wave >> 2) : 0, cgp = LAT ? (wave & 3) : 0;
    const int rsa = ra < 4 ? 0 : (ra > 60 ? 56 : ra - 4), rs = r < 4 ? 0 : (r > 60 ? 56 : r - 4), shw = rs - rsa;
    const int rsb = (ra + 1) < 4 ? 0 : ((ra + 1) > 60 ? 56 : ra + 1 - 4), T = 8 + (rsb - rsa);
    const int cb = cgp == 0 ? 0 : (cgp == 1 ? 8 : (cgp == 2 ? 24 : 32));
    const bool active = LAT || wave == 0;
    const int qrow = LAT ? (b * 4096 + r * 64 + cgp * 16 + fr) : (MLAT + b * 256 + ra * 16 + fr);
    bf16_t* qp = proj + (size_t)qrow * INW + OFF_Q + h * 128;
    bf16x8 qf[4];
#pragma unroll
    for (int ks = 0; ks < 4; ++ks) qf[ks] = *(const bf16x8*)(qp + ks * 32 + fq * 8);
    const int kap = 8 * (fr >> 2) + (fr & 3);
    float S[NCH][8];
    if (LAT) {
        __syncthreads();
        { u32x4 v[18];
#pragma unroll
          for (int i = 0; i < 18; ++i) { const int idx = tid + 512 * i, key = idx >> 4, ch = idx & 15;
            if (i < 2 * T) v[i] = *(const u32x4*)(proj + (size_t)(b * 4096 + rsa * 64 + key) * INW + OFF_K + h * 128 + ch * 8); }
#pragma unroll
          for (int i = 0; i < 18; ++i) { const int idx = tid + 512 * i, key = idx >> 4, ch = idx & 15, g = (key & 3) | (((key >> 3) & 3) << 2);
            if (i < 2 * T) *(LAS u32x4*)(lds + key * 256 + ((ch ^ g) * 16)) = v[i]; } }
        __syncthreads();
        const int gw = (fr & 3) | ((((cb >> 3) + (fr >> 2)) & 3) << 2);
#pragma unroll
        for (int c = 0; c < WCH; ++c) {
#pragma unroll
            for (int tt = 0; tt < 2; ++tt) { const LAS unsigned char* kp = lds + ((c + shw) * 64 + cb + kap + 4 * tt) * 256;
                f32x4 acc = (f32x4){0.f, 0.f, 0.f, 0.f};
#pragma unroll
                for (int ks = 0; ks < 4; ++ks) { const bf16x8 kf = *(const LAS bf16x8*)(kp + (((ks * 4 + fq) ^ gw) * 16)); acc = __builtin_amdgcn_mfma_f32_16x16x32_bf16(kf, qf[ks], acc, 0, 0, 0); }
                S[c][4 * tt + 0] = acc[0]; S[c][4 * tt + 1] = acc[1]; S[c][4 * tt + 2] = acc[2]; S[c][4 * tt + 3] = acc[3]; } }
    }
    __syncthreads();
    { u32x4 v[8];
#pragma unroll
      for (int i = 0; i < 8; ++i) { const int idx = tid + 512 * i, key = idx >> 4, ch = idx & 15; v[i] = *(const u32x4*)(proj + (size_t)(MLAT + b * 256 + key) * INW + OFF_K + h * 128 + ch * 8); }
#pragma unroll
      for (int i = 0; i < 8; ++i) { const int idx = tid + 512 * i, key = idx >> 4, ch = idx & 15, g = (key & 3) | (((key >> 3) & 3) << 2); *(LAS u32x4*)(lds + key * 256 + ((ch ^ g) * 16)) = v[i]; } }
    __syncthreads();
    float mx = -3.0e38f, sum = 0.f, inv = 0.f; bf16x8 pf[NCH];
    if (active) {
#pragma unroll
        for (int c = WCH; c < NCH; ++c) {
#pragma unroll
            for (int tt = 0; tt < 2; ++tt) { const LAS unsigned char* kp = lds + (32 * (c - WCH) + kap + 4 * tt) * 256;
                f32x4 acc = (f32x4){0.f, 0.f, 0.f, 0.f};
#pragma unroll
                for (int ks = 0; ks < 4; ++ks) { const bf16x8 kf = *(const LAS bf16x8*)(kp + (((ks * 4 + fq) ^ fr) * 16)); acc = __builtin_amdgcn_mfma_f32_16x16x32_bf16(kf, qf[ks], acc, 0, 0, 0); }
                S[c][4 * tt + 0] = acc[0]; S[c][4 * tt + 1] = acc[1]; S[c][4 * tt + 2] = acc[2]; S[c][4 * tt + 3] = acc[3]; } }
        if (LAT) {
            const int qc = cgp * 16 + fr; const int cs = qc < 8 ? 0 : (qc > 56 ? 48 : qc - 8);
#pragma unroll
            for (int c = 0; c < WCH; ++c) { const int dr = rs + c - r + 7; const float* rp = rpb + (h * 15 + dr) * 31;
#pragma unroll
                for (int jj = 0; jj < 8; ++jj) { const int kc = cb + 8 * fq + jj; const bool valid = (kc >= cs) && (kc < cs + 16); int dc = kc - qc + 15; dc = dc < 0 ? 0 : (dc > 30 ? 30 : dc);
                    const float bias = rp[dc]; S[c][jj] = valid ? S[c][jj] + bias : -1e30f; } }
        }
#pragma unroll
        for (int c = 0; c < NCH; ++c)
#pragma unroll
            for (int jj = 0; jj < 8; ++jj) mx = fmaxf(mx, S[c][jj]);
        mx = fmaxf(mx, shx(mx, 16, lane)); mx = fmaxf(mx, shx(mx, 32, lane));
#pragma unroll
        for (int c = 0; c < NCH; ++c) { float p[8];
#pragma unroll
            for (int jj = 0; jj < 8; ++jj) { p[jj] = __builtin_amdgcn_exp2f((S[c][jj] - mx) * 1.44269504089f); sum += p[jj]; }
            u32x4 w; w.x = cvt_pk_bf16(p[0], p[1]); w.y = cvt_pk_bf16(p[2], p[3]); w.z = cvt_pk_bf16(p[4], p[5]); w.w = cvt_pk_bf16(p[6], p[7]); pf[c] = __builtin_bit_cast(bf16x8, w); }
        sum += shx(sum, 16, lane); sum += shx(sum, 32, lane);
        inv = 1.0f / sum;
    }
    f32x4 oacc[8];
#pragma unroll
    for (int dt = 0; dt < 8; ++dt) oacc[dt] = (f32x4){0.f, 0.f, 0.f, 0.f};
    if (LAT) {
        __syncthreads();
        const int cpr = T * 8;
        { u32x4 v[18];
#pragma unroll
          for (int i = 0; i < 18; ++i) { const int idx = tid + 512 * i, d = idx / cpr, ch = idx - d * cpr;
            if (i < 2 * T) v[i] = *(const u32x4*)(vt + (size_t)(b * 1024 + h * 128 + d) * 4096 + rsa * 64 + ch * 8); }
#pragma unroll
          for (int i = 0; i < 18; ++i) { const int idx = tid + 512 * i, d = idx / cpr, ch = idx - d * cpr;
            if (i < 2 * T) *(LAS u32x4*)(lds + d * 1152 + (((ch & ~7) | ((ch & 7) ^ ((d >> 1) & 7))) * 16)) = v[i]; } }
        __syncthreads();
#pragma unroll
        for (int dt = 0; dt < 8; ++dt)
#pragma unroll
            for (int c = 0; c < WCH; ++c) { const int ch = (c + shw) * 8 + (cb >> 3) + fq;
                const bf16x8 vf = *(const LAS bf16x8*)(lds + (dt * 16 + fr) * 1152 + (((ch & ~7) | ((ch & 7) ^ (fr >> 1))) * 16));
                oacc[dt] = __builtin_amdgcn_mfma_f32_16x16x32_bf16(vf, pf[c], oacc[dt], 0, 0, 0); }
    }
    __syncthreads();
    { u32x4 v[8];
#pragma unroll
      for (int i = 0; i < 8; ++i) { const int idx = tid + 512 * i, d = idx >> 5, ch = idx & 31; v[i] = *(const u32x4*)(vtc + (size_t)(b * 1024 + h * 128 + d) * 256 + ch * 8); }
#pragma unroll
      for (int i = 0; i < 8; ++i) { const int idx = tid + 512 * i, d = idx >> 5, ch = idx & 31; *(LAS u32x4*)(lds + d * 512 + ((ch ^ (d & 15)) * 16)) = v[i]; } }
    __syncthreads();
    if (active) {
#pragma unroll
        for (int dt = 0; dt < 8; ++dt) {
#pragma unroll
            for (int c = WCH; c < NCH; ++c) { const bf16x8 vf = *(const LAS bf16x8*)(lds + (dt * 16 + fr) * 512 + ((((c - WCH) * 4 + fq) ^ fr) * 16));
                oacc[dt] = __builtin_amdgcn_mfma_f32_16x16x32_bf16(vf, pf[c], oacc[dt], 0, 0, 0); }
            u32x2 o; o.x = cvt_pk_bf16(oacc[dt][0] * inv, oacc[dt][1] * inv); o.y = cvt_pk_bf16(oacc[dt][2] * inv, oacc[dt][3] * inv);
            *(u32x2*)(qp + dt * 16 + 4 * fq) = o; }
    }
}
__device__ __forceinline__ void attn_block(bf16_t* proj, const bf16_t* vt, const bf16_t* vtc, const float* rpb, int vcu, int half, bool ctxq, LAS unsigned char* lds, int wave) {
    const int bh = vcu >> 3, b = bh >> 3, h = bh & 7, rb = vcu & 7;
    __syncthreads();
    { const int tid = wave * 64 + fresh_lane();
#pragma unroll
      for (int i = 0; i < 8; ++i) { const int idx = tid + 512 * i, key = idx >> 4, ch = idx & 15, g = (key & 3) | (((key >> 3) & 3) << 2);
          const u32x4 v = *(const u32x4*)(proj + (size_t)(MLAT + b * 256 + key) * INW + OFF_K + h * 128 + ch * 8);
          *(LAS u32x4*)(lds + key * 256 + ((ch ^ g) * 16)) = v; }
#pragma unroll
      for (int i = 0; i < 8; ++i) { const int idx = tid + 512 * i, d = idx >> 5, ch = idx & 31;
          const u32x4 v = *(const u32x4*)(vtc + (size_t)(b * 1024 + h * 128 + d) * 256 + ch * 8);
          *(LAS u32x4*)(lds + 65536 + d * 512 + ((ch ^ (d & 15)) * 16)) = v; } }
    __syncthreads();
    const int lane = fresh_lane();
    for (int round = 0; round < 2; ++round) { const int r = rb * 8 + half * 4 + round * 2 + (wave >> 2), cgp = wave & 3;
        attn_task<true>(proj, vt, rpb, ((bh * 64 + r) << 2) + cgp, lane, lds); }
    if (ctxq && wave == 0) attn_task<false>(proj, vt, rpb, bh * 16 + rb * 2 + half, lane, lds);
}
__device__ __forceinline__ void conv_items(const bf16_t* up, bf16_t* hmid, const float* cw, const float* cbias, int nrows, int gtid, int NT) {
    const int nitems = (nrows / 16) * 704;
    for (int it = gtid; it < nitems; it += NT) {
        const int cg8 = it % 704, rb = it / 704; const int row0 = rb * 16, ch = cg8 * 8;
        const int seqlen = row0 < MLAT ? 4096 : 256; const int ts = (row0 < MLAT ? row0 : row0 - MLAT) & (seqlen - 1);
        float w0[8], w1[8], w2[8], bb[8];
#pragma unroll
        for (int e = 0; e < 8; ++e) { w0[e] = cw[ch + e]; w1[e] = cw[DFF + ch + e]; w2[e] = cw[2 * DFF + ch + e]; bb[e] = cbias[ch + e]; }
        const bf16_t* ap = up + (size_t)row0 * UPW + ch; const bf16_t* gp = ap + DFF; bf16_t* hp = hmid + (size_t)row0 * DFF + ch;
        u32x4 prev = (u32x4){0u, 0u, 0u, 0u}; if (ts > 0) prev = *(const u32x4*)(ap - UPW);
        u32x4 cur = *(const u32x4*)ap;
        for (int i = 0; i < 16; ++i) {
            u32x4 nxt = (u32x4){0u, 0u, 0u, 0u}; if (i < 15 || ts + 16 < seqlen) nxt = *(const u32x4*)(ap + (size_t)(i + 1) * UPW);
            const u32x4 gw = *(const u32x4*)(gp + (size_t)i * UPW);
            float o[8];
#pragma unroll
            for (int e = 0; e < 4; ++e) {
                const float y0 = bb[2 * e] + w0[2 * e] * bflo(prev[e]) + w1[2 * e] * bflo(cur[e]) + w2[2 * e] * bflo(nxt[e]);
                const float y1 = bb[2 * e + 1] + w0[2 * e + 1] * bfhi(prev[e]) + w1[2 * e + 1] * bfhi(cur[e]) + w2[2 * e + 1] * bfhi(nxt[e]);
                o[2 * e] = fsilu(y0) * bflo(gw[e]); o[2 * e + 1] = fsilu(y1) * bfhi(gw[e]); }
            u32x4 w; w.x = cvt_pk_bf16(o[0], o[1]); w.y = cvt_pk_bf16(o[2], o[3]); w.z = cvt_pk_bf16(o[4], o[5]); w.w = cvt_pk_bf16(o[6], o[7]);
            *(u32x4*)(hp + (size_t)i * DFF) = w;
            prev = cur; cur = nxt;
        }
    }
}


#define XB_TMO      128
#define XB_XCNT(j)  (256  + 64 * (j))
#define XB_XSUB(j)  (1280 + 64 * (j))
#define XB_XGEN(j)  (2304 + 64 * (j))
#define XB_TOP      3328
#define XB_TOPGEN   3392
#define XCD_BAR_WORDS 3456
#define XB_SPIN_CAP (1u << 18)
__device__ __forceinline__ unsigned xb_ld(unsigned* p)              { return __hip_atomic_load(p, __ATOMIC_RELAXED, __HIP_MEMORY_SCOPE_AGENT); }
__device__ __forceinline__ unsigned xb_add(unsigned* p, unsigned v) { return __hip_atomic_fetch_add(p, v, __ATOMIC_RELAXED, __HIP_MEMORY_SCOPE_AGENT); }
__device__ __forceinline__ unsigned xb_xcc_id() { return (unsigned)__builtin_amdgcn_s_getreg((3 << 11) | 20) & 0xFu; }
#define XB_SPIN(cond, bar) do { unsigned _sp = 0; while (cond) { __builtin_amdgcn_s_sleep(1); \
    if ((++_sp & 255u) == 0u) { if (xb_ld(&(bar)[XB_TMO])) break; if (_sp > XB_SPIN_CAP) { atomicAdd(&(bar)[XB_TMO], 1u); break; } } } } while (0)
struct XcdBarrier { unsigned* bar; unsigned x; volatile LAS unsigned* st; };
__device__ __forceinline__ XcdBarrier xcd_barrier_post(unsigned* bar, volatile LAS unsigned* st) {
    XcdBarrier b; b.bar = bar; b.x = xb_xcc_id(); b.st = st;
    if (threadIdx.x == 0) (void)xb_add(&bar[XB_XCNT(b.x)], 1u);
    return b;
}
__device__ __forceinline__ void xcd_barrier_complete(unsigned* bar, unsigned x, unsigned& nloc, unsigned& nx) {
    const unsigned G = gridDim.x * gridDim.y * gridDim.z;
    unsigned sum, cnt, mine, sp = 0u;
    for (;;) {
        sum = 0u; cnt = 0u; mine = 0u;
#pragma unroll
        for (unsigned j = 0; j < 16; ++j) { const unsigned c = xb_ld(&bar[XB_XCNT(j)]); sum += c; cnt += (c > 0u) ? 1u : 0u; mine = (j == x) ? c : mine; }
        if (sum == G) break;
        __builtin_amdgcn_s_sleep(1);
        if ((++sp & 255u) == 0u) { if (xb_ld(&bar[XB_TMO])) break; if (sp > XB_SPIN_CAP) { atomicAdd(&bar[XB_TMO], 1u); break; } }
    }
    nloc = mine > 0u ? mine : 1u; nx = cnt > 0u ? cnt : 1u;
}
__device__ __forceinline__ void xcd_barrier(const XcdBarrier& b) {
    asm volatile("s_waitcnt vmcnt(0)" ::: "memory");
    __syncthreads();
    if (threadIdx.x == 0) {
        unsigned* bar = b.bar;
        __builtin_amdgcn_s_waitcnt(0);
        unsigned nloc = b.st[0], nx = b.st[1];
        if (nloc == 0u) { xcd_barrier_complete(bar, b.x, nloc, nx); b.st[0] = nloc; b.st[1] = nx; }
        const unsigned old = xb_add(&bar[XB_XSUB(b.x)], 1u);
        const unsigned gen = old / nloc;
        if (old + 1u == (gen + 1u) * nloc) {
            __builtin_amdgcn_fence(__ATOMIC_RELEASE, "agent");
            asm volatile("s_waitcnt vmcnt(0)" ::: "memory");
            const unsigned og = xb_add(&bar[XB_TOP], 1u);
            const unsigned tg = og / nx;
            if (og + 1u == (tg + 1u) * nx) xb_add(&bar[XB_TOPGEN], 1u);
            else XB_SPIN(xb_ld(&bar[XB_TOPGEN]) == tg, bar);
            __builtin_amdgcn_fence(__ATOMIC_ACQUIRE, "agent");
            xb_add(&bar[XB_XGEN(b.x)], 1u);
            asm volatile("s_waitcnt vmcnt(0)" ::: "memory");
        } else {
            XB_SPIN(xb_ld(&bar[XB_XGEN(b.x)]) == gen, bar);
            __builtin_amdgcn_fence(__ATOMIC_ACQUIRE, "agent");
            asm volatile("s_waitcnt vmcnt(0)" ::: "memory");
        }
    }
    __syncthreads();
}
constexpr int NPHASE = 24;
__global__ void __launch_bounds__(512, 2) mega(Args a_) {
    extern __shared__ __attribute__((aligned(16))) unsigned char lds_raw[];
    LAS unsigned char* lds = (LAS unsigned char*)lds_raw;
    cg::grid_group grid = cg::this_grid();
    const int G = gridDim.x, cu = blockIdx.x, NGW = G * 8, wave = __builtin_amdgcn_readfirstlane((int)threadIdx.x >> 6);

    volatile LAS unsigned* xst = (volatile LAS unsigned*)(lds + LDS_XST);
    if (threadIdx.x < 4) xst[threadIdx.x] = 0u;
    __syncthreads();
    const XcdBarrier xbar = xcd_barrier_post((unsigned*)(a_.ws + WS_BAR), xst);

    const int ph_lo = a_.ph_lo, ph_hi = a_.ph_hi;
    for (int p = ph_lo; p < ph_hi; ++p) {
        if (p > ph_lo) { if (p == 1) grid.sync(); else xcd_barrier(xbar); }
#define PH_IDS const int lane = fresh_lane(); const int tid = wave * 64 + lane, gw = cu * 8 + wave; (void)tid; (void)gw; (void)lane;
        typedef const __attribute__((address_space(4))) Args KArgs;
        KArgs* ap = (KArgs*)__builtin_amdgcn_kernarg_segment_ptr(); asm volatile("" : "+s"(ap));
        KArgs& a = *ap;
        unsigned char* ws = a.ws;
        unsigned* ctl = (unsigned*)(ws + WS_CTL);
        bf16_t* PROJ = (bf16_t*)(ws + WS_BIG); bf16_t* XN = (bf16_t*)(ws + WS_XN); bf16_t* HMID = (bf16_t*)(ws + WS_HMID);
        float* XC = (float*)(ws + WS_XC); float* mods = (float*)(ws + WS_MODS);
        bf16_t* VT = (bf16_t*)(ws + WS_VT); bf16_t* VTC = (bf16_t*)(ws + WS_VTC);
        if (p == 0) { PH_IDS
            LAS float* lut = (LAS float*)(lds + 72 * 1024);
            for (int i = tid; i < 4096; i += 512) lut[i] = cospif((float)i * (1.0f / 2048.0f));
            __syncthreads();
            if (cu == 0) { bf16_t* dd = (bf16_t*)(ws + WS_DFTD);
                for (int e = tid; e < 256 * 128; e += 512) { const int row = e >> 7, d = e & 127, j = row & 127; const float ang = (float)((j * d) & 127) * (1.0f / 64.0f);
                    const float v = row < 128 ? cospif(ang) : sinpif(ang); dd[e] = (bf16_t)(cvt_pk_bf16(v, 0.f) & 0xffffu); } }
            for (int i = cu * 512 + tid; i < 1024 * DM / 4; i += G * 512) ((f32x4*)XC)[i] = ((const f32x4*)a.in[2])[i];
            mods_items(a, gw, NGW, lane);
            convert_weights(a, 0, (LAS float*)(lds + wave * 8704), gw, NGW, lane);
            dft_tables(ws, lut, gw, NGW, lane);
            continue;
        }
        if (p == NPHASE - 1) { PH_IDS final_norm(a.out, a.in[21], gw, NGW, lane); continue; }
        const int l = (p - 1) / 11, s = (p - 1) % 11;
        const float* mods_l = mods + (size_t)l * 5 * 12288;
        const float* xlat = (l == 0) ? a.in[0] : a.out; const float* xctx = (l == 0) ? a.in[2] : XC;
        const int nMall = (l == 0) ? 68 : 64;
        switch (s) {
        case 0: { PH_IDS
            if (l == 1) { LAS float* lut = (LAS float*)(lds + 72 * 1024);
                for (int i = tid; i < 4096; i += 512) lut[i] = cospif((float)i * (1.0f / 2048.0f));
                __syncthreads();
                convert_weights(a, 1, (LAS float*)(lds + wave * 8704), gw, NGW, lane);
                dft_tables(ws, lut, gw, NGW, lane); }
            norm_rows(xlat, xctx, a.in[6] + (size_t)l * DM, mods_l, 0, 2048, XN, MT, gw, NGW, lane);
        } break;
        case 1: { PH_IDS
            SchedGrid S; S.so.init(nMall, 42, G, cu); S.A = (const char*)XN; S.B = (const char*)(ws + WS_WIN); S.tsA = (size_t)256 * DM * 2; S.tsB = (size_t)256 * DM * 2; S.nt = 32;
            S.nextra = (l == 0) ? 0 : 32; S.ex_pm0 = 64; S.ex_pn0 = 6; S.ex_w = 8; S.ex_ks = 1;
            EpiInProj E{PROJ, VT, VTC};
            pg8::gemm_phase<EpiInProj, SchedGrid>(lds, tid, DM, DM, S, E);
        } break;
        case 2: { PH_IDS
            const int nun = 512 + ((l == 0) ? 32 : 0);
            for (int u = cu; u < nun; u += G) { int row0, g;
                if (u < 512) { const int b = u >> 7, ch = (u >> 2) & 31; g = u & 3; row0 = b * 4096 + ch * 128; }
                else { const int e = u - 512; const int b = e >> 3, ch = (e >> 2) & 1; g = e & 3; row0 = MLAT + b * 256 + ch * 128; }
                sgu_unit(PROJ, row0, g, a.in[10] + (size_t)l * 512, a.in[11] + ((size_t)l * 4 + g) * 128 * 128, a.in[12] + ((size_t)l * 4 + g) * 128, lds, tid); }
            __syncthreads();
            { SchedF1L S{(const char*)(ws + WS_DFTD), (const char*)PROJ, G, cu}; EpiF1L E{(bf16_t*)(ws + WS_U)};
              pg8::gemm_phase<EpiF1L, SchedF1L>(lds, wave * 64 + fresh_lane(), 128, INW, S, E); }
            if (l == 0) { SchedF1 S{(const char*)(ws + WS_DFTD), (const char*)PROJ, G, (cu + 128) % G, 16}; EpiF1 E{nullptr, (bf16_t*)(ws + WS_PQTC)};
              pg8::gemm_phase<EpiF1, SchedF1>(lds, wave * 64 + fresh_lane(), 128, INW, S, E); }
        } break;
        case 3: { PH_IDS
            { SchedFA S{(const char*)(ws + WS_MA), (const char*)(ws + WS_U), G, cu}; EpiFA E{(bf16_t*)(ws + WS_ZBUF)};
              pg8::gemm_phase<EpiFA, SchedFA>(lds, tid, 128, 128, S, E); }
            if (l == 0) { SchedF2 S{(const char*)(ws + WS_DFTC), (const char*)(ws + WS_PQTC), G, (cu + 128) % G, 8}; EpiF2 E{PROJ};
              pg8::gemm_phase<EpiF2, SchedF2>(lds, wave * 64 + fresh_lane(), 8192, 8192, S, E); }
            for (int vcu = cu; vcu < 256; vcu += G) { const int bh = vcu >> 3, rb = vcu & 7; const float* rpb = a.in[9] + (size_t)l * 8 * 15 * 31;
#pragma unroll 1
                for (int pp = 0; pp < 2; ++pp) attn_pass<true>(PROJ, VT, VTC, rpb, bh >> 3, bh & 7, rb * 8 + 0 * 4 + pp * 2, lds, wave);
                if (l == 0) attn_pass<false>(PROJ, VT, VTC, rpb, bh >> 3, bh & 7, rb * 2 + 0, lds, wave); }
        } break;
        case 4: { PH_IDS
            { SchedFB S{(const char*)(ws + WS_TT), (const char*)(ws + WS_ZBUF), G, cu}; EpiFB E{PROJ};
              pg8::gemm_phase<EpiFB, SchedFB>(lds, tid, 128, 128, S, E); }
            for (int vcu = cu; vcu < 256; vcu += G) { const int bh = vcu >> 3, rb = vcu & 7; const float* rpb = a.in[9] + (size_t)l * 8 * 15 * 31;
#pragma unroll 1
                for (int pp = 0; pp < 2; ++pp) attn_pass<true>(PROJ, VT, VTC, rpb, bh >> 3, bh & 7, rb * 8 + 1 * 4 + pp * 2, lds, wave);
                if (l == 0) attn_pass<false>(PROJ, VT, VTC, rpb, bh >> 3, bh & 7, rb * 2 + 1, lds, wave); }
        } break;
        case 5: { PH_IDS
            SchedBranch S; S.so.init(nMall, 8, G, cu); S.proj = (const char*)PROJ; S.wbr = (const char*)(ws + WS_WBR);
            EpiBranch E{PROJ, XN};
            pg8::gemm_phase<EpiBranch, SchedBranch>(lds, tid, INW, DM, S, E);
        } break;
        case 6: { PH_IDS
            SchedGrid S; S.so.init(64, 8, G, cu); S.A = (const char*)XN; S.B = (const char*)(ws + WS_WO); S.tsA = (size_t)256 * DM * 2; S.tsB = (size_t)256 * DM * 2; S.nt = 32;
            S.nextra = (l == 0) ? 32 * 8 : 0; S.ex_pm0 = 64; S.ex_pn0 = 0; S.ex_w = 8; S.ex_ks = 8;
            EpiResid E{xlat, XC, a.out, XC, mods_l + 4096};
            pg8::gemm_phase<EpiResid, SchedGrid>(lds, tid, DM, DM, S, E);
        } break;
        case 7: { PH_IDS
            norm_rows(a.out, XC, a.in[7] + (size_t)l * DM, mods_l, 6144, 8192, XN, nMall * 256, gw, NGW, lane);
        } break;
        case 8: { PH_IDS
            SchedGrid S; S.so.init(nMall, 44, G, cu); S.A = (const char*)XN; S.B = (const char*)(ws + WS_WUP); S.tsA = (size_t)256 * DM * 2; S.tsB = (size_t)256 * DM * 2; S.nt = 32; S.nextra = 0; S.ex_pm0 = 0; S.ex_pn0 = 0; S.ex_w = 1; S.ex_ks = 1;
            EpiUpConv E{HMID, (float*)(ws + WS_BIG), a.in[18] + (size_t)l * 3 * DFF, a.in[19] + (size_t)l * DFF};
            pg8::gemm_phase<EpiUpConv, SchedGrid>(lds, tid, DM, DM, S, E);
        } break;
        case 9: { PH_IDS
            ffn_fix_rows(HMID, (const float*)(ws + WS_BIG), a.in[18] + (size_t)l * 3 * DFF, nMall * 4, cu * 512 + tid, G * 512);
        } break;
        case 10: { PH_IDS
            SchedGrid S; S.so.init(64, 8, G, cu); S.A = (const char*)HMID; S.B = (const char*)(ws + WS_WDN); S.tsA = (size_t)256 * DFF * 2; S.tsB = (size_t)256 * DFF * 2; S.nt = 88;
            S.nextra = (l == 0) ? 32 * 4 : 0; S.ex_pm0 = 64; S.ex_pn0 = 0; S.ex_w = 8; S.ex_ks = 4;
            EpiResid E{a.out, XC, a.out, XC, mods_l + 10240};
            pg8::gemm_phase<EpiResid, SchedGrid>(lds, tid, DFF, DFF, S, E);
        } break;
        }
    }
}

extern "C" void kernel_launch(void* const* d_in, const int* in_sizes, int n_in, void* d_out, int out_size, void* d_ws, size_t ws_size, hipStream_t stream) {
    static int grid = 0;
    if (grid == 0) {
        if (n_in != 22 || ws_size < WS_END) { fprintf(stderr, "kernel_launch: unexpected n_in %d / ws_size %zu (need %zu)\n", n_in, ws_size, (size_t)WS_END); grid = -1; return; }
        int dev = 0, cus = 0, per_cu = 0;
        hipGetDevice(&dev); hipDeviceGetAttribute(&cus, hipDeviceAttributeMultiprocessorCount, dev);
        if (hipFuncSetAttribute((const void*)mega, hipFuncAttributeMaxDynamicSharedMemorySize, LDS_BYTES) != hipSuccess) { fprintf(stderr, "kernel_launch: hipFuncSetAttribute failed\n"); grid = -1; return; }
        hipOccupancyMaxActiveBlocksPerMultiprocessor(&per_cu, (const void*)mega, 512, LDS_BYTES);
        (void)hipGetLastError();
        if (per_cu < 1) fprintf(stderr, "kernel_launch: occupancy query says %d blocks/CU\n", per_cu);
        grid = cus > 0 ? cus : 256;
    }
    if (grid < 0) return;
    hipMemsetAsync((char*)d_ws + WS_CTL, 0, CTL_ZERO_BYTES, stream);
    Args a{};
    for (int i = 0; i < 22; ++i) a.in[i] = (const float*)d_in[i];
    a.out = (float*)d_out; a.ws = (unsigned char*)d_ws; a.ph_lo = 0; a.ph_hi = NPHASE;
    void* args[] = {&a};
    hipError_t e = hipLaunchCooperativeKernel((const void*)mega, dim3(grid), dim3(512), args, LDS_BYTES, stream);
    if (e != hipSuccess) fprintf(stderr, "kernel_launch: cooperative launch failed: %s (grid %d)\n", hipGetErrorString(e), grid);
}
```

```cpp
#include <hip/hip_runtime.h>
#include <hip/hip_cooperative_groups.h>
#include <cstdio>
#include <cstdint>
namespace cg = cooperative_groups;

#define LAS __attribute__((address_space(3)))
typedef unsigned short bf16_t;
typedef short bf16x8 __attribute__((ext_vector_type(8)));
typedef float f32x4 __attribute__((ext_vector_type(4)));
typedef float f32x2 __attribute__((ext_vector_type(2)));
typedef unsigned u32x4 __attribute__((ext_vector_type(4)));
typedef unsigned u32x2 __attribute__((ext_vector_type(2)));

constexpr int DM = 2048, MLAT = 16384, MT = 17408;
constexpr int INW = 10752, DFF = 5632, UPW = 11264;
constexpr int OFF_Q = 512, OFF_K = 1536, OFF_V = 2560, OFF_C = 3584, OFF_G = 4608;
constexpr float EPS = 1e-6f;
constexpr size_t MiB = 1u << 20;
constexpr size_t WS_CTL = 0;
constexpr size_t CTL_ZERO_BYTES = 1 * MiB;
constexpr size_t WS_MODS = 4096;
constexpr size_t WS_BAR = 512 * 1024;
constexpr size_t WS_DFTD = 1 * MiB;
constexpr size_t WS_XC = 2 * MiB;
constexpr size_t WS_WIN = 10 * MiB;
constexpr size_t WS_WBR = 52 * MiB;
constexpr size_t WS_WO = 60 * MiB;
constexpr size_t WS_WUP = 68 * MiB;
constexpr size_t WS_WDN = 112 * MiB;
constexpr size_t WS_XN = 134 * MiB;
constexpr size_t WS_BIG = 202 * MiB;
constexpr size_t WS_HMID = 576 * MiB;
constexpr size_t WS_ZBUF = WS_HMID;
constexpr size_t WS_TT = WS_HMID + 32 * MiB;
constexpr size_t WS_MA = WS_HMID + 36 * MiB;
constexpr size_t WS_U = WS_HMID + 64 * MiB;
constexpr size_t WS_VT = WS_HMID + 96 * MiB;
constexpr size_t WS_DFTC = WS_HMID + 128 * MiB;
constexpr size_t WS_PQTC = WS_HMID + 132 * MiB;
constexpr size_t WS_VTC = WS_HMID + 164 * MiB;
constexpr size_t WS_TMP = WS_HMID;
constexpr size_t WS_END = 763 * MiB;
constexpr int LDS_BYTES = 163840, LDS_XST = 163840 - 64;

#define LDS_WAIT() asm volatile("s_waitcnt lgkmcnt(0)" ::: "memory")
__device__ __forceinline__ unsigned cvt_pk_bf16(float lo, float hi) { unsigned r; asm volatile("v_cvt_pk_bf16_f32 %0, %1, %2" : "=v"(r) : "v"(lo), "v"(hi)); return r; }
__device__ __forceinline__ int fresh_lane() { unsigned z; asm volatile("v_mov_b32 %0, 0" : "=v"(z)); return (int)__builtin_amdgcn_mbcnt_hi(~0u, __builtin_amdgcn_mbcnt_lo(~0u, z)); }
__device__ __forceinline__ float bf2f(unsigned short b) { return __uint_as_float((unsigned)b << 16); }
__device__ __forceinline__ float bflo(unsigned w) { return __uint_as_float(w << 16); }
__device__ __forceinline__ float bfhi(unsigned w) { return __uint_as_float(w & 0xffff0000u); }
__device__ __forceinline__ float shx(float v, int o, int lane) { return __int_as_float(__builtin_amdgcn_ds_bpermute((lane ^ o) << 2, __float_as_int(v))); }
__device__ __forceinline__ float wave_sum(float v, int lane) {
#pragma unroll
    for (int o = 1; o < 64; o <<= 1) v += shx(v, o, lane);
    return v;
}
__device__ __forceinline__ float fsigmoid(float x) { return __builtin_amdgcn_rcpf(1.0f + __builtin_amdgcn_exp2f(-1.44269504089f * x)); }
__device__ __forceinline__ float fsilu(float x) { return x * fsigmoid(x); }
__device__ __forceinline__ f32x2 gelu_pk(f32x2 v) {
    const f32x2 av = __builtin_elementwise_abs(v), d = av * 0.2316418882f + 1.0f;
    f32x2 t; t.x = __builtin_amdgcn_rcpf(d.x); t.y = __builtin_amdgcn_rcpf(d.y);
    f32x2 q = t * 0.5307027145f + (-0.7265760135f); q = q * t + 0.7107068705f; q = q * t + (-0.142248368f); q = q * t + 0.127414796f; q = q * t;
    const f32x2 s = (v * v) * (-0.72134752044f);
    f32x2 e; e.x = __builtin_amdgcn_exp2f(s.x); e.y = __builtin_amdgcn_exp2f(s.y);
    const f32x2 m = v * (q * e), r = v - m;
    f32x2 o; o.x = v.x < 0.f ? m.x : r.x; o.y = v.y < 0.f ? m.y : r.y; return o;
}

namespace pg8 {
constexpr int BM = 256, BK = 64, HALF = 128, HTB = HALF * BK * 2, STAGE_BYTES = 8 * HTB, NXCD = 8, WGM = 8;
__host__ __device__ __forceinline__ int lds_byte(int r, int c) { const int st = (r >> 4) * 2 + (c >> 5), rr = r & 15, cc = c & 31, ob = rr * 64 + cc * 2; return st * 1024 + (ob ^ (((ob >> 9) & 1) << 5)); }
__host__ __device__ __forceinline__ void stage_rc(int b, int& R, int& C) { const int st = b / 1024, sb = b % 1024, swz = sb ^ (((sb >> 9) & 1) << 5); R = (st >> 1) * 16 + swz / 64; C = (st & 1) * 32 + (swz % 64) / 2; }
__host__ __device__ __forceinline__ int perm32(int rho) { const int n = rho >> 4, i = rho & 15; return 8 * (i >> 2) + 4 * n + (i & 3); }

struct Unit { const char* A; const char* B; int nt, pm, pn, aux; };

struct StaticOrder {
    int nM, nN, nwg, G, c;
    __device__ void init(int nM_, int nN_, int G_, int c_) { nM = nM_; nN = nN_; nwg = nM * nN; G = G_; c = c_; }
    __device__ bool next(int i, int& pm, int& pn) const {
        const long L = (long)i * G + c; if (L >= nwg) return false;
        int wgid = (int)L; { const int q = nwg / NXCD, r = nwg % NXCD, xcd = wgid % NXCD, off = wgid / NXCD; wgid = (xcd < r ? xcd * (q + 1) : r * (q + 1) + (xcd - r) * q) + off; }
        const int nig = WGM * nN, gid = wgid / nig, fm = gid * WGM, gsz = (nM - fm) < WGM ? (nM - fm) : WGM;
        pm = fm + ((wgid % nig) % gsz); pn = (wgid % nig) / gsz; return true;
    }
};

template <class Epi, class Sched>
__device__ __forceinline__ void gemm_phase(LAS unsigned char* lds, const int tid, const int lda, const int ldb, const Sched& S, const Epi& E) {
    const int wid = __builtin_amdgcn_readfirstlane(tid >> 6), lane = tid & 63, wr = wid >> 2, wc = wid & 3, fr = lane & 15, fq = lane >> 4;
    unsigned voffA[2], voffB[2];
#pragma unroll
    for (int i = 0; i < 2; ++i) { int R, C; stage_rc(tid * 16 + i * 8192, R, C); const int Rb = Epi::PERM ? ((R & ~31) + perm32(R & 31)) : R;
        voffA[i] = (unsigned)(R * lda + C) * 2u; voffB[i] = (unsigned)(Sched::brow(Rb) * ldb + C) * 2u; }
    const size_t kstep = (size_t)(BK * 2);
    const size_t hstepA = (size_t)HALF * lda * 2, hstepB = (size_t)Sched::BH * ldb * 2;
    const unsigned ldsw = (unsigned)wid * 1024u;
    const int aoff = lds_byte(wr * 64 + fr, fq * 8), boff = lds_byte(wc * 32 + fr, fq * 8);
#define PG8_SA(b, h) (((b) * 2 + (h)) * HTB)
#define PG8_SB(b, h) ((4 + (b) * 2 + (h)) * HTB)
#define PG8_STAGE(bufoff, gbase, voff) do { _Pragma("unroll") for (int _i = 0; _i < 2; ++_i) \
        __builtin_amdgcn_global_load_lds((const unsigned*)((const char*)(gbase) + (voff)[_i]), (LAS unsigned*)(lds + (bufoff) + ldsw + _i * 8192), 16, 0, 0); } while (0)
#define PG8_LDA(dst, b, h) do { _Pragma("unroll") for (int m = 0; m < 4; ++m) _Pragma("unroll") for (int k = 0; k < 2; ++k) dst[m][k] = *(const LAS bf16x8*)(lds + PG8_SA(b, h) + aoff + m * 2048 + k * 1024); } while (0)
#define PG8_LDB(dst, b, h) do { _Pragma("unroll") for (int n = 0; n < 2; ++n) _Pragma("unroll") for (int k = 0; k < 2; ++k) dst[n][k] = *(const LAS bf16x8*)(lds + PG8_SB(b, h) + boff + n * 2048 + k * 1024); } while (0)
#define PG8_MMA(ai, bj, At, Bt) do { __builtin_amdgcn_s_setprio(1); _Pragma("unroll") for (int m = 0; m < 4; ++m) _Pragma("unroll") for (int n = 0; n < 2; ++n) _Pragma("unroll") for (int k = 0; k < 2; ++k) \
        acc[ai][bj][m][n] = __builtin_amdgcn_mfma_f32_16x16x32_bf16(Bt[n][k], At[m][k], acc[ai][bj][m][n], 0, 0, 0); __builtin_amdgcn_s_setprio(0); } while (0)
#define PG8_WAIT_V(n) asm volatile("s_waitcnt vmcnt(" #n ")" ::: "memory")
#define PG8_WAIT_L(n) asm volatile("s_waitcnt lgkmcnt(" #n ")" ::: "memory")
#define PG8_BAR __builtin_amdgcn_s_barrier()
#define PG8_SCHED __builtin_amdgcn_sched_barrier(0)
    Unit cur, nxt; int ui = 0;
    if (!S.next(0, cur)) return;
    f32x4 acc[2][2][4][2];
#pragma unroll
    for (int a = 0; a < 2; ++a)
#pragma unroll
        for (int b = 0; b < 2; ++b)
#pragma unroll
            for (int m = 0; m < 4; ++m)
#pragma unroll
                for (int n = 0; n < 2; ++n) acc[a][b][m][n] = (f32x4){0.f, 0.f, 0.f, 0.f};
    bf16x8 At[4][2], B0[2][2], B1[2][2];
    const char* cA = cur.A; const char* cB = cur.B;
    {
        PG8_STAGE(PG8_SB(0, 0), cB, voffB); PG8_STAGE(PG8_SB(0, 1), cB + hstepB, voffB); PG8_STAGE(PG8_SA(0, 0), cA, voffA); PG8_STAGE(PG8_SA(0, 1), cA + hstepA, voffA);
        if (wr == 1) PG8_BAR;
        PG8_WAIT_V(2); PG8_BAR;
        PG8_STAGE(PG8_SB(1, 0), cB + kstep, voffB); PG8_STAGE(PG8_SA(1, 0), cA + kstep, voffA); PG8_STAGE(PG8_SB(1, 1), cB + hstepB + kstep, voffB);
        PG8_WAIT_V(6); PG8_BAR;
    }
    for (;;) {
        const bool has_next = S.next(ui + 1, nxt);
        const char* nA = has_next ? nxt.A : cA; const char* nB = has_next ? nxt.B : cB;
        const int nt = cur.nt;
        for (int t = 0; t < nt; t += 2) {
            const bool last = (t == nt - 2);
            const char* a1 = cA + (size_t)(t + 1) * kstep;
            const char* a2 = last ? nA : cA + (size_t)(t + 2) * kstep; const char* b2 = last ? nB : cB + (size_t)(t + 2) * kstep;
            const char* a3 = a2 + kstep; const char* b3 = b2 + kstep;
            PG8_LDB(B0, 0, 0); PG8_LDB(B1, 0, 1); PG8_SCHED; PG8_LDA(At, 0, 0); PG8_STAGE(PG8_SA(1, 1), a1 + hstepA, voffA);
            PG8_WAIT_V(8); PG8_WAIT_L(0); PG8_BAR; PG8_MMA(0, 0, At, B0); PG8_MMA(0, 1, At, B1); PG8_BAR; PG8_SCHED;
            PG8_LDA(At, 0, 1); PG8_STAGE(PG8_SB(0, 0), b2, voffB); PG8_STAGE(PG8_SB(0, 1), b2 + hstepB, voffB); PG8_STAGE(PG8_SA(0, 0), a2, voffA);
            PG8_WAIT_V(8); PG8_WAIT_L(0); PG8_BAR; PG8_MMA(1, 0, At, B0); PG8_MMA(1, 1, At, B1); PG8_BAR; PG8_SCHED;
            PG8_LDB(B0, 1, 0); PG8_LDB(B1, 1, 1); PG8_SCHED; PG8_LDA(At, 1, 0); PG8_STAGE(PG8_SA(0, 1), a2 + hstepA, voffA);
            PG8_WAIT_V(8); PG8_WAIT_L(0); PG8_BAR; PG8_MMA(0, 0, At, B0); PG8_MMA(0, 1, At, B1); PG8_BAR; PG8_SCHED;
            PG8_LDA(At, 1, 1); PG8_STAGE(PG8_SB(1, 0), b3, voffB); PG8_STAGE(PG8_SB(1, 1), b3 + hstepB, voffB); PG8_STAGE(PG8_SA(1, 0), a3, voffA);
            PG8_WAIT_V(8); PG8_WAIT_L(0); PG8_BAR; PG8_MMA(1, 0, At, B0); PG8_MMA(1, 1, At, B1); PG8_BAR; PG8_SCHED;
        }
        if (wr == 0) PG8_BAR;
        E(acc, cur, wr, wc);
        if (!has_next) break;
        if (!Epi::CHAIN || cur.aux == 2) {
#pragma unroll
        for (int a = 0; a < 2; ++a)
#pragma unroll
            for (int b = 0; b < 2; ++b)
#pragma unroll
                for (int m = 0; m < 4; ++m)
#pragma unroll
                    for (int n = 0; n < 2; ++n) acc[a][b][m][n] = (f32x4){0.f, 0.f, 0.f, 0.f};
        }
        cur = nxt; cA = nA; cB = nB; ++ui;
        if (wr == 1) PG8_BAR;
    }
    PG8_WAIT_V(0);
    PG8_BAR;
#undef PG8_SA
#undef PG8_SB
#undef PG8_STAGE
#undef PG8_LDA
#undef PG8_LDB
#undef PG8_MMA
#undef PG8_WAIT_V
#undef PG8_WAIT_L
#undef PG8_BAR
#undef PG8_SCHED
}
}
using pg8::Unit;
typedef const f32x4 (&AccRef)[2][2][4][2];

struct SchedGrid {
    static __device__ __forceinline__ int brow(int r) { return r; } static constexpr int BH = 128;
    pg8::StaticOrder so; const char* A; const char* B; size_t tsA, tsB; int nt, nextra, ex_pm0, ex_pn0, ex_w, ex_ks;
    __device__ __forceinline__ bool next(int i, Unit& u) const {
        int pm, pn; int kp = 0, ntu = nt, aux = 0;
        if (!so.next(i, pm, pn)) { const long e = (long)i * so.G + so.c - so.nwg; if (e >= nextra) return false; const int te = (int)e / ex_ks; kp = (int)e % ex_ks; ntu = nt / ex_ks; aux = ex_ks > 1 ? 1 : 0;
            pm = ex_pm0 + te / ex_w; pn = ex_pn0 + te % ex_w; }
        u.A = A + (size_t)pm * tsA + (size_t)kp * ntu * 128; u.B = B + (size_t)pn * tsB + (size_t)kp * ntu * 128; u.nt = ntu; u.pm = pm; u.pn = pn; u.aux = aux; return true;
    }
};
struct SchedBranch {
    static __device__ __forceinline__ int brow(int r) { return r; } static constexpr int BH = 128;
    pg8::StaticOrder so; const char* proj; const char* wbr;
    __device__ __forceinline__ bool next(int i, Unit& u) const {
        int pm, pn; if (!so.next(i / 3, pm, pn)) return false;
        const int br = i % 3; const int acol = br == 0 ? 0 : (br == 1 ? OFF_Q : OFF_C), koff = br == 0 ? 0 : (br == 1 ? 512 : 1536);
        u.A = proj + ((size_t)pm * 256 * INW + acol) * 2; u.B = wbr + ((size_t)pn * 256 * DM + koff) * 2; u.nt = br == 1 ? 16 : 8; u.pm = pm; u.pn = pn; u.aux = br; return true;
    }
};
struct SchedF1L {
    static __device__ __forceinline__ int brow(int r) { return (r >> 6) + 64 * (r & 63); } static constexpr int BH = 2;
    const char* dftd; const char* proj; int G, c;
    __device__ __forceinline__ bool next(int i, Unit& u) const {
        const int L = i * G + c; if (L >= 256) return false;
        { const char* ap = dftd; asm volatile("" : "+s"(ap)); u.A = ap; } u.nt = 2; u.pm = 0;
        const int b = L >> 6, g = (L >> 4) & 3, pn = L & 15; u.B = proj + ((size_t)(b * 4096 + 4 * pn) * INW + g * 128) * 2; u.pn = pn; u.aux = b * 4 + g; return true;
    }
};
struct SchedF1 {
    static __device__ __forceinline__ int brow(int r) { return r; } static constexpr int BH = 128;
    const char* dftd; const char* proj; int G, c, nctx;
    __device__ __forceinline__ bool next(int i, Unit& u) const {
        const int e = i * G + c; if (e >= nctx) return false;
        { const char* ap = dftd; asm volatile("" : "+s"(ap)); u.A = ap; } u.nt = 2; u.pm = 0;
        const int b = e >> 2, g = e & 3; u.B = proj + ((size_t)(MLAT + b * 256) * INW + g * 128) * 2; u.pn = 0; u.aux = 16 + b * 4 + g; return true;
    }
};
struct SchedF2 {
    static __device__ __forceinline__ int brow(int r) { return r; } static constexpr int BH = 128;
    const char* dftc; const char* pqtc; int G, c, nctx;
    __device__ __forceinline__ bool next(int i, Unit& u) const {
        const int e = i * G + c; if (e >= nctx) return false;
        const int b = e >> 1, pn = e & 1; { const char* ap = dftc; asm volatile("" : "+s"(ap)); u.A = ap; } u.B = pqtc + (size_t)(b * 512 + pn * 256) * 8192 * 2; u.nt = 8; u.pm = 0; u.pn = pn; u.aux = 4 + b; return true;
    }
};
struct SchedFA {
    static __device__ __forceinline__ int brow(int r) { return r; } static constexpr int BH = 128;
    const char* ma; const char* ub; int G, c;
    __device__ __forceinline__ bool next(int i, Unit& u) const {
        const int L = i * G + c; if (L >= 512) return false;
        { const char* ap = ma; asm volatile("" : "+s"(ap)); u.A = ap; } u.B = ub + (size_t)L * 256 * 128 * 2; u.nt = 2; u.pm = 0; u.pn = L; u.aux = 0; return true;
    }
};
struct SchedFB {
    static __device__ __forceinline__ int brow(int r) { return r; } static constexpr int BH = 128;
    const char* tt; const char* zb; int G, c;
    __device__ __forceinline__ bool next(int i, Unit& u) const {
        const int L = i * G + c; if (L >= 512) return false;
        const int k2 = L >> 3, pn = L & 7; u.A = tt + (size_t)k2 * 256 * 128 * 2; u.B = zb + ((size_t)k2 * 2048 + pn * 256) * 128 * 2; u.nt = 2; u.pm = 0; u.pn = pn; u.aux = k2; return true;
    }
};

struct EpiInProj {
    static constexpr bool PERM = true, CHAIN = false;
    bf16_t* proj; bf16_t* vt; bf16_t* vtc;
    __device__ __forceinline__ void operator()(AccRef acc, const Unit& u, int wr, int wc) const {
        const int ln_ = fresh_lane(), fr = ln_ & 15, fq = ln_ >> 4;
        const int pm = u.pm, pn = u.pn; const int row0 = pm * 256 + wr * 64 + fr, col0 = pn * 256 + wc * 32 + 8 * fq;
        if (pn >= 10 && pn < 14) {
            const int vc0 = col0 - OFF_V;
#pragma unroll
            for (int ai = 0; ai < 2; ++ai)
#pragma unroll
                for (int m = 0; m < 4; ++m) {
                    const int row = row0 + ai * 128 + m * 16; bf16_t* dst; size_t stride;
                    if (pm < 64) { const int b = pm >> 4; dst = vt + (size_t)b * 1024 * 4096 + (row - b * 4096); stride = 4096; }
                    else { const int b = pm - 64; dst = vtc + (size_t)b * 1024 * 256 + (row - MLAT - b * 256); stride = 256; }
#pragma unroll
                    for (int bj = 0; bj < 2; ++bj)
#pragma unroll
                        for (int n = 0; n < 2; ++n) { const f32x4 v = acc[ai][bj][m][n]; const unsigned w0 = cvt_pk_bf16(v[0], v[1]), w1 = cvt_pk_bf16(v[2], v[3]);
                            bf16_t* d = dst + (size_t)(vc0 + bj * 128 + n * 4) * stride;
                            d[0] = (bf16_t)(w0 & 0xffffu); d[stride] = (bf16_t)(w0 >> 16); d[2 * stride] = (bf16_t)(w1 & 0xffffu); d[3 * stride] = (bf16_t)(w1 >> 16); }
                }
            return;
        }
        const int act = pn < 14 ? 0 : (pn < 18 ? 1 : 2); const float sc = (pn >= 2 && pn < 6) ? 0.08838834764831845f : 1.0f;
#pragma unroll
        for (int ai = 0; ai < 2; ++ai)
#pragma unroll
            for (int m = 0; m < 4; ++m) { bf16_t* rowp = proj + (size_t)(row0 + ai * 128 + m * 16) * INW + col0;
#pragma unroll
                for (int bj = 0; bj < 2; ++bj) { f32x4 v0 = acc[ai][bj][m][0], v1 = acc[ai][bj][m][1];
                    if (act == 1) { f32x2 a = gelu_pk((f32x2){v0[0], v0[1]}), b = gelu_pk((f32x2){v0[2], v0[3]}), c = gelu_pk((f32x2){v1[0], v1[1]}), d = gelu_pk((f32x2){v1[2], v1[3]});
                        v0 = (f32x4){a.x, a.y, b.x, b.y}; v1 = (f32x4){c.x, c.y, d.x, d.y}; }
                    else if (act == 2) { v0 = (f32x4){fsigmoid(v0[0]), fsigmoid(v0[1]), fsigmoid(v0[2]), fsigmoid(v0[3])}; v1 = (f32x4){fsigmoid(v1[0]), fsigmoid(v1[1]), fsigmoid(v1[2]), fsigmoid(v1[3])}; }
                    else { v0 = v0 * sc; v1 = v1 * sc; }
                    u32x4 w; w.x = cvt_pk_bf16(v0[0], v0[1]); w.y = cvt_pk_bf16(v0[2], v0[3]); w.z = cvt_pk_bf16(v1[0], v1[1]); w.w = cvt_pk_bf16(v1[2], v1[3]);
                    *(u32x4*)(rowp + bj * 128) = w; } }
    }
};
struct EpiPlain {
    static constexpr bool PERM = true, CHAIN = false;
    bf16_t* out; int ld;
    __device__ __forceinline__ void operator()(AccRef acc, const Unit& u, int wr, int wc) const {
        const int ln_ = fresh_lane(), fr = ln_ & 15, fq = ln_ >> 4;
        const int row0 = u.pm * 256 + wr * 64 + fr, col0 = u.pn * 256 + wc * 32 + 8 * fq;
#pragma unroll
        for (int ai = 0; ai < 2; ++ai)
#pragma unroll
            for (int m = 0; m < 4; ++m) { bf16_t* rowp = out + (size_t)(row0 + ai * 128 + m * 16) * ld + col0;
#pragma unroll
                for (int bj = 0; bj < 2; ++bj) { const f32x4 v0 = acc[ai][bj][m][0], v1 = acc[ai][bj][m][1];
                    u32x4 w; w.x = cvt_pk_bf16(v0[0], v0[1]); w.y = cvt_pk_bf16(v0[2], v0[3]); w.z = cvt_pk_bf16(v1[0], v1[1]); w.w = cvt_pk_bf16(v1[2], v1[3]);
                    *(u32x4*)(rowp + bj * 128) = w; } }
    }
};
struct EpiF1 {
    static constexpr bool PERM = true, CHAIN = false;
    bf16_t* pqt; bf16_t* pqtc;
    __device__ __forceinline__ void operator()(AccRef acc, const Unit& u, int wr, int wc) const {
        const int ln_ = fresh_lane(), fr = ln_ & 15, fq = ln_ >> 4;
        const int aux = u.aux; const bool isc = aux >= 16; const int bg = aux & 15, b = bg >> 2, g = bg & 3;
        bf16_t* base = (isc ? pqtc : pqt) + (size_t)(b * 512 + g * 128) * 8192; const int half = isc ? 256 : 4096;
        const int n0 = u.pn * 256 + wc * 32 + 8 * fq;
#pragma unroll
        for (int ai = 0; ai < 2; ++ai)
#pragma unroll
            for (int m = 0; m < 4; ++m) { bf16_t* rowp = base + (size_t)(wr * 64 + m * 16 + fr) * 8192 + ai * half + n0;
#pragma unroll
                for (int bj = 0; bj < 2; ++bj) { const f32x4 v0 = acc[ai][bj][m][0], v1 = acc[ai][bj][m][1];
                    u32x4 w; w.x = cvt_pk_bf16(v0[0], v0[1]); w.y = cvt_pk_bf16(v0[2], v0[3]); w.z = cvt_pk_bf16(v1[0], v1[1]); w.w = cvt_pk_bf16(v1[2], v1[3]);
                    *(u32x4*)(rowp + bj * 128) = w; } }
    }
};
struct EpiF1L {
    static constexpr bool PERM = true, CHAIN = false;
    bf16_t* ub;
    __device__ __forceinline__ void operator()(AccRef acc, const Unit& u, int wr, int wc) const {
        const int ln_ = fresh_lane(), fr = ln_ & 15, fq = ln_ >> 4;
        const int b = u.aux >> 2, g = u.aux & 3;
#pragma unroll
        for (int ai = 0; ai < 2; ++ai)
#pragma unroll
            for (int m = 0; m < 4; ++m) { const int ch = b * 512 + g * 128 + wr * 64 + m * 16 + fr;
#pragma unroll
                for (int bj = 0; bj < 2; ++bj) { const int n1 = 4 * u.pn + 2 * bj + (wc >> 1), n2 = 32 * (wc & 1) + 8 * fq;
                    const f32x4 v0 = acc[ai][bj][m][0], v1 = acc[ai][bj][m][1];
                    u32x4 w; w.x = cvt_pk_bf16(v0[0], v0[1]); w.y = cvt_pk_bf16(v0[2], v0[3]); w.z = cvt_pk_bf16(v1[0], v1[1]); w.w = cvt_pk_bf16(v1[2], v1[3]);
                    *(u32x4*)(ub + ((size_t)ch * 64 + n1) * 128 + ai * 64 + n2) = w; } }
    }
};
struct EpiFA {
    static constexpr bool PERM = true, CHAIN = false;
    bf16_t* zb;
    __device__ __forceinline__ void operator()(AccRef acc, const Unit& u, int wr, int wc) const {
        if (wr != 0) return;
        const int ln_ = fresh_lane(), fr = ln_ & 15, fq = ln_ >> 4;
#pragma unroll
        for (int ai = 0; ai < 2; ++ai)
#pragma unroll
            for (int m = 0; m < 4; ++m) { const int k2 = m * 16 + fr;
#pragma unroll
                for (int bj = 0; bj < 2; ++bj) { const int bc = u.pn * 4 + 2 * bj + (wc >> 1), n1 = 32 * (wc & 1) + 8 * fq;
                    const f32x4 v0 = acc[ai][bj][m][0], v1 = acc[ai][bj][m][1];
                    u32x4 w; w.x = cvt_pk_bf16(v0[0], v0[1]); w.y = cvt_pk_bf16(v0[2], v0[3]); w.z = cvt_pk_bf16(v1[0], v1[1]); w.w = cvt_pk_bf16(v1[2], v1[3]);
                    *(u32x4*)(zb + ((size_t)k2 * 2048 + bc) * 128 + ai * 64 + n1) = w; } }
    }
};
struct EpiFB {
    static constexpr bool PERM = true, CHAIN = false;
    bf16_t* proj;
    __device__ __forceinline__ void operator()(AccRef acc, const Unit& u, int wr, int wc) const {
        if (wr != 0) return;
        const int ln_ = fresh_lane(), fr = ln_ & 15, fq = ln_ >> 4;
        const float sc = 0.0013810679320049757f; const int k2 = u.aux;
#pragma unroll
        for (int m = 0; m < 4; ++m) { const int k = 64 * (m * 16 + fr) + k2;
#pragma unroll
            for (int bj = 0; bj < 2; ++bj) { const int ncol = u.pn * 256 + 128 * bj + 32 * wc + 8 * fq; const int b = ncol >> 9, ch = ncol & 511;
                const f32x4 v0 = acc[0][bj][m][0] * sc, v1 = acc[0][bj][m][1] * sc;
                u32x4 w; w.x = cvt_pk_bf16(v0[0], v0[1]); w.y = cvt_pk_bf16(v0[2], v0[3]); w.z = cvt_pk_bf16(v1[0], v1[1]); w.w = cvt_pk_bf16(v1[2], v1[3]);
                *(u32x4*)(proj + (size_t)(b * 4096 + k) * INW + ch) = w; } }
    }
};
struct EpiF2 {
    static constexpr bool PERM = true, CHAIN = false;
    bf16_t* proj;
    __device__ __forceinline__ void operator()(AccRef acc, const Unit& u, int wr, int wc) const {
        const int ln_ = fresh_lane(), fr = ln_ & 15, fq = ln_ >> 4;
        const int aux = u.aux; const bool isc = aux >= 4; const int rowbase = isc ? MLAT + (aux - 4) * 256 : aux * 4096;
        const float sc = isc ? 0.005524271728019903f : 0.0013810679320049757f;
        const int row0 = rowbase + u.pm * 256 + wr * 64 + fr, col0 = u.pn * 256 + wc * 32 + 8 * fq;
#pragma unroll
        for (int ai = 0; ai < 2; ++ai)
#pragma unroll
            for (int m = 0; m < 4; ++m) { bf16_t* rowp = proj + (size_t)(row0 + ai * 128 + m * 16) * INW + col0;
#pragma unroll
                for (int bj = 0; bj < 2; ++bj) { const f32x4 v0 = acc[ai][bj][m][0] * sc, v1 = acc[ai][bj][m][1] * sc;
                    u32x4 w; w.x = cvt_pk_bf16(v0[0], v0[1]); w.y = cvt_pk_bf16(v0[2], v0[3]); w.z = cvt_pk_bf16(v1[0], v1[1]); w.w = cvt_pk_bf16(v1[2], v1[3]);
                    *(u32x4*)(rowp + bj * 128) = w; } }
    }
};
typedef f32x4 (&AccMut)[2][2][4][2];
struct EpiBranch {
    static constexpr bool PERM = true, CHAIN = true;
    const bf16_t* proj; bf16_t* merged;
    __device__ __forceinline__ void operator()(AccMut acc, const Unit& u, int wr, int wc) const {
        const int ln_ = fresh_lane(), fr = ln_ & 15, fq = ln_ >> 4;
        const int br = u.aux; const int col0 = u.pn * 256 + wc * 32 + 8 * fq;
#pragma unroll
        for (int ai = 0; ai < 2; ++ai)
#pragma unroll
            for (int m = 0; m < 4; ++m) { const size_t row = (size_t)(u.pm * 256 + ai * 128 + wr * 64 + m * 16 + fr);
#pragma unroll
                for (int bj = 0; bj < 2; ++bj) { const int col = col0 + bj * 128;
                    const bf16_t* gp = proj + row * INW + OFF_G + br * DM + col;
                    const u32x4 gw = *(const u32x4*)gp;
                    const f32x4 g0 = (f32x4){bflo(gw.x), bfhi(gw.x), bflo(gw.y), bfhi(gw.y)}, g1 = (f32x4){bflo(gw.z), bfhi(gw.z), bflo(gw.w), bfhi(gw.w)};
                    if (br < 2) { const u32x4 hw = *(const u32x4*)(gp + DM);
                        const f32x4 r0 = (f32x4){__builtin_amdgcn_rcpf(fmaxf(bflo(hw.x), 1e-30f)), __builtin_amdgcn_rcpf(fmaxf(bfhi(hw.x), 1e-30f)), __builtin_amdgcn_rcpf(fmaxf(bflo(hw.y), 1e-30f)), __builtin_amdgcn_rcpf(fmaxf(bfhi(hw.y), 1e-30f))};
                        const f32x4 r1 = (f32x4){__builtin_amdgcn_rcpf(fmaxf(bflo(hw.z), 1e-30f)), __builtin_amdgcn_rcpf(fmaxf(bfhi(hw.z), 1e-30f)), __builtin_amdgcn_rcpf(fmaxf(bflo(hw.w), 1e-30f)), __builtin_amdgcn_rcpf(fmaxf(bfhi(hw.w), 1e-30f))};
                        acc[ai][bj][m][0] = acc[ai][bj][m][0] * (g0 * r0); acc[ai][bj][m][1] = acc[ai][bj][m][1] * (g1 * r1); }
                    else { const f32x4 v0 = acc[ai][bj][m][0] * g0, v1 = acc[ai][bj][m][1] * g1;
                        u32x4 w; w.x = cvt_pk_bf16(v0[0], v0[1]); w.y = cvt_pk_bf16(v0[2], v0[3]); w.z = cvt_pk_bf16(v1[0], v1[1]); w.w = cvt_pk_bf16(v1[2], v1[3]);
                        *(u32x4*)(merged + row * DM + col) = w; } } }
    }
};
struct EpiResid {
    static constexpr bool PERM = false, CHAIN = false;
    const float* src_lat; const float* src_ctx; float* dst_lat; float* dst_ctx; const float* gate;
    __device__ __forceinline__ void operator()(AccRef acc, const Unit& u, int wr, int wc) const {
        const int ln_ = fresh_lane(), fr = ln_ & 15, fq = ln_ >> 4;
        const int pm = u.pm; const int b = pm < 64 ? (pm >> 4) : 4; const float* g = gate + (size_t)b * 12288; const int col0 = u.pn * 256 + wc * 32 + 4 * fq;
        const float* s0 = pm < 64 ? src_lat + (size_t)pm * 256 * DM : src_ctx + (size_t)(pm - 64) * 256 * DM;
        float* d0 = pm < 64 ? dst_lat + (size_t)pm * 256 * DM : dst_ctx + (size_t)(pm - 64) * 256 * DM;
        f32x4 gv[2][2];
#pragma unroll
        for (int bj = 0; bj < 2; ++bj)
#pragma unroll
            for (int n = 0; n < 2; ++n) gv[bj][n] = *(const f32x4*)(g + col0 + bj * 128 + n * 16);
#pragma unroll
        for (int ai = 0; ai < 2; ++ai)
#pragma unroll
            for (int m = 0; m < 4; ++m) { const size_t ro = (size_t)(ai * 128 + wr * 64 + m * 16 + fr) * DM;
#pragma unroll
                for (int bj = 0; bj < 2; ++bj)
#pragma unroll
                    for (int n = 0; n < 2; ++n) { const int col = col0 + bj * 128 + n * 16;
                        if (u.aux) { const f32x4 v = gv[bj][n] * acc[ai][bj][m][n]; float* d = d0 + ro + col;
                            unsafeAtomicAdd(d, v[0]); unsafeAtomicAdd(d + 1, v[1]); unsafeAtomicAdd(d + 2, v[2]); unsafeAtomicAdd(d + 3, v[3]); }
                        else *(f32x4*)(d0 + ro + col) = *(const f32x4*)(s0 + ro + col) + gv[bj][n] * acc[ai][bj][m][n]; } }
    }
};

struct EpiUpConv {
    static constexpr bool PERM = true, CHAIN = false;
    bf16_t* hmid; float* sb; const float* cw; const float* cbias;
    __device__ __forceinline__ void operator()(AccRef acc, const Unit& u, int wr, int wc) const {
        const int ln_ = fresh_lane(), fr = ln_ & 15, fq = ln_ >> 4;
        const int pm = u.pm, ch0 = u.pn * 128 + wc * 32 + 8 * fq;
        const int ip = ((ln_ & 48) | ((fr + 15) & 15)) << 2, in = ((ln_ & 48) | ((fr + 1) & 15)) << 2;
        f32x4 w0[2], w1[2], w2[2], cb[2];
#pragma unroll
        for (int n = 0; n < 2; ++n) { w0[n] = *(const f32x4*)(cw + ch0 + 4 * n); w1[n] = *(const f32x4*)(cw + DFF + ch0 + 4 * n); w2[n] = *(const f32x4*)(cw + 2 * DFF + ch0 + 4 * n); cb[n] = *(const f32x4*)(cbias + ch0 + 4 * n); }
#pragma unroll
        for (int ai = 0; ai < 2; ++ai) {
            const int blk = pm * 4 + ai * 2 + wr;
            float* sbb = sb + (size_t)blk * 6 * DFF + ch0;
#pragma unroll
            for (int m = 0; m < 4; ++m) {
                f32x4 o[2];
#pragma unroll
                for (int n = 0; n < 2; ++n) {
                    const f32x4 am = acc[ai][0][m][n], gm = acc[ai][1][m][n];
                    const f32x4 z = (f32x4){0.f, 0.f, 0.f, 0.f};
                    const f32x4 ap = (m > 0) ? acc[ai][0][m > 0 ? m - 1 : 0][n] : z, an = (m < 3) ? acc[ai][0][m < 3 ? m + 1 : 3][n] : z;
                    const f32x4 tp = (fr == 15) ? ap : am, tn = (fr == 0) ? an : am;
                    f32x4 pv, nv;
#pragma unroll
                    for (int e = 0; e < 4; ++e) { pv[e] = __int_as_float(__builtin_amdgcn_ds_bpermute(ip, __float_as_int(tp[e]))); nv[e] = __int_as_float(__builtin_amdgcn_ds_bpermute(in, __float_as_int(tn[e]))); }
                    const f32x4 y = cb[n] + w0[n] * pv + w1[n] * am + w2[n] * nv;
                    o[n] = (f32x4){fsilu(y[0]) * gm[0], fsilu(y[1]) * gm[1], fsilu(y[2]) * gm[2], fsilu(y[3]) * gm[3]};
                    if (m == 0 && fr == 0) { *(f32x4*)(sbb + 0 * DFF + 4 * n) = y; *(f32x4*)(sbb + 2 * DFF + 4 * n) = gm; *(f32x4*)(sbb + 4 * DFF + 4 * n) = am; }
                    if (m == 3 && fr == 15) { *(f32x4*)(sbb + 1 * DFF + 4 * n) = y; *(f32x4*)(sbb + 3 * DFF + 4 * n) = gm; *(f32x4*)(sbb + 5 * DFF + 4 * n) = am; }
                }
                u32x4 w; w.x = cvt_pk_bf16(o[0][0], o[0][1]); w.y = cvt_pk_bf16(o[0][2], o[0][3]); w.z = cvt_pk_bf16(o[1][0], o[1][1]); w.w = cvt_pk_bf16(o[1][2], o[1][3]);
                *(u32x4*)(hmid + (size_t)(pm * 256 + ai * 128 + wr * 64 + m * 16 + fr) * DFF + ch0) = w;
            }
        }
    }
};
__device__ __forceinline__ void ffn_fix_rows(bf16_t* hmid, const float* sb, const float* cw, int nblk, int gtid, int NT) {
    const int nitems = nblk * 2 * (DFF / 4);
    for (int it = gtid; it < nitems; it += NT) {
        const int c4 = (it % (DFF / 4)) * 4, bw = it / (DFF / 4), which = bw & 1, blk = bw >> 1;
        const int row0 = blk * 64; const int rel = row0 < MLAT ? (row0 & 4095) : ((row0 - MLAT) & 255), seqlen = row0 < MLAT ? 4096 : 256;
        const bool edge = which ? (rel + 64 == seqlen) : (rel == 0);
        const float* s = sb + (size_t)blk * 6 * DFF + c4;
        f32x4 y = *(const f32x4*)(s + which * DFF); const f32x4 g = *(const f32x4*)(s + (2 + which) * DFF);
        if (!edge) { const float* sn = sb + (size_t)(which ? blk + 1 : blk - 1) * 6 * DFF + c4; const f32x4 an = *(const f32x4*)(sn + (which ? 4 : 5) * DFF);
            const f32x4 w = *(const f32x4*)(cw + (which ? 2 * DFF : 0) + c4); y = y + w * an; }
        u32x2 o; o.x = cvt_pk_bf16(fsilu(y[0]) * g[0], fsilu(y[1]) * g[1]); o.y = cvt_pk_bf16(fsilu(y[2]) * g[2], fsilu(y[3]) * g[3]);
        *(u32x2*)(hmid + (size_t)(row0 + (which ? 63 : 0)) * DFF + c4) = o;
    }
}

struct Args { const float* in[22]; float* out; unsigned char* ws; int ph_lo, ph_hi; };

template <bool UPMAP = false>
__device__ __forceinline__ void transpose_item(const float* W, int N, bf16_t* WT, int ldk, int koff, LAS float* scr, int item, int lane) {
    const int nblk = N / 32, kb = item / nblk, nb = item % nblk, k0 = 64 * kb, n0 = 32 * nb;
    const int r0 = UPMAP ? (n0 < DFF ? (n0 >> 7) * 256 + (n0 & 127) : ((n0 - DFF) >> 7) * 256 + 128 + ((n0 - DFF) & 127)) : n0;
#pragma unroll 8
    for (int i = 0; i < 32; ++i) { const int kk = 2 * i + (lane >> 5); scr[kk * 33 + (lane & 31)] = W[(size_t)(k0 + kk) * N + n0 + (lane & 31)]; }
    LDS_WAIT(); asm volatile("" ::: "memory");
    const int c = lane & 7;
#pragma unroll
    for (int j = 0; j < 4; ++j) { const int n = (lane >> 3) + 8 * j; const LAS float* s = scr + (8 * c) * 33 + n;
        u32x4 o; o.x = cvt_pk_bf16(s[0 * 33], s[1 * 33]); o.y = cvt_pk_bf16(s[2 * 33], s[3 * 33]); o.z = cvt_pk_bf16(s[4 * 33], s[5 * 33]); o.w = cvt_pk_bf16(s[6 * 33], s[7 * 33]);
        *(u32x4*)(WT + (size_t)(r0 + n) * ldk + koff + k0 + 8 * c) = o; }
    LDS_WAIT(); asm volatile("" ::: "memory");
}
template <class AR>
__device__ __forceinline__ void convert_weights(const AR& a, int l, LAS float* scr, int gw, int NGW, int lane) {
    unsigned char* ws = a.ws;
    const float* w_in = a.in[8] + (size_t)l * DM * INW; const float* w_f = a.in[13] + (size_t)l * 512 * DM; const float* w_na = a.in[14] + (size_t)l * 1024 * DM;
    const float* w_c = a.in[15] + (size_t)l * 512 * DM; const float* w_o = a.in[16] + (size_t)l * DM * DM; const float* w_up = a.in[17] + (size_t)l * DM * UPW; const float* w_dn = a.in[20] + (size_t)l * DFF * DM;
    constexpr int I_IN = 32 * 336, I_F = 8 * 64, I_NA = 16 * 64, I_C = 8 * 64, I_O = 32 * 64, I_UP = 32 * 352, I_DN = 88 * 64;
    constexpr int NITEMS = I_IN + I_F + I_NA + I_C + I_O + I_UP + I_DN;
    for (int it = gw; it < NITEMS; it += NGW) {
        int r = it;
        if (r < I_IN) { transpose_item(w_in, INW, (bf16_t*)(ws + WS_WIN), DM, 0, scr, r, lane); continue; } r -= I_IN;
        if (r < I_F) { transpose_item(w_f, DM, (bf16_t*)(ws + WS_WBR), DM, 0, scr, r, lane); continue; } r -= I_F;
        if (r < I_NA) { transpose_item(w_na, DM, (bf16_t*)(ws + WS_WBR), DM, 512, scr, r, lane); continue; } r -= I_NA;
        if (r < I_C) { transpose_item(w_c, DM, (bf16_t*)(ws + WS_WBR), DM, 1536, scr, r, lane); continue; } r -= I_C;
        if (r < I_O) { transpose_item(w_o, DM, (bf16_t*)(ws + WS_WO), DM, 0, scr, r, lane); continue; } r -= I_O;
        if (r < I_UP) { transpose_item<true>(w_up, UPW, (bf16_t*)(ws + WS_WUP), DM, 0, scr, r, lane); continue; } r -= I_UP;
        transpose_item(w_dn, DM, (bf16_t*)(ws + WS_WDN), DFF, 0, scr, r, lane);
    }
}
__device__ __forceinline__ void dft_tables(unsigned char* ws, const LAS float* lut, int gw, int NGW, int lane) {
    bf16_t* tt = (bf16_t*)(ws + WS_TT); bf16_t* ma = (bf16_t*)(ws + WS_MA); bf16_t* dftc = (bf16_t*)(ws + WS_DFTC);
    const int half = lane >> 5, x0 = (lane & 31) * 2;
    for (int it = gw; it < 16384 + 256 + 256; it += NGW) {
        if (it < 16384) { const int k2 = it >> 8, k1 = it & 255; float v0 = 0.f, v1 = 0.f;
            if (k1 < 64) { const int k = 64 * k1 + k2, sh = half ? 3072 : 0;
                v0 = lut[(x0 * k + sh) & 4095]; v1 = lut[((x0 + 1) * k + sh) & 4095]; }
            *(unsigned*)(tt + (size_t)it * 128 + half * 64 + x0) = cvt_pk_bf16(v0, v1);
        } else if (it < 16384 + 256) { const int r = it - 16384; float v0 = 0.f, v1 = 0.f;
            if ((r & 64) == 0) { const int k2 = r & 63, im = r >> 7;
                const int sh = im ? (half ? 2048 : 1024) : (half ? 1024 : 0);
                v0 = lut[(((x0 * k2) & 63) * 64 + sh) & 4095]; v1 = lut[((((x0 + 1) * k2) & 63) * 64 + sh) & 4095]; }
            *(unsigned*)(ma + (size_t)r * 128 + half * 64 + x0) = cvt_pk_bf16(v0, v1);
        } else { const int k = it - 16384 - 256; const int n0 = lane * 8; const int nn = n0 & 255, sh = n0 >= 256 ? 1024 : 0; float v[8];
#pragma unroll
            for (int e = 0; e < 8; ++e) v[e] = lut[((((k * (nn + e)) & 255) * 16) + sh) & 4095];
            u32x4 w; w.x = cvt_pk_bf16(v[0], v[1]); w.y = cvt_pk_bf16(v[2], v[3]); w.z = cvt_pk_bf16(v[4], v[5]); w.w = cvt_pk_bf16(v[6], v[7]);
            *(u32x4*)(dftc + (size_t)k * 8192 + n0) = w; }
    }
}
template <class AR>
__device__ __forceinline__ void mods_items(const AR& a, int gw, int NGW, int lane) {
    float* mods = (float*)(a.ws + WS_MODS);
    for (int it = gw; it < 1536; it += NGW) {
        const int l = it / 768, rem = it % 768, cch = rem >> 4, kp = rem & 15; const int col = cch * 256 + lane * 4, k0 = kp * 128;
        float sv[5][2];
#pragma unroll
        for (int r = 0; r < 5; ++r)
#pragma unroll
            for (int i = 0; i < 2; ++i) { const int k = k0 + lane + 64 * i; const float cv = r < 4 ? a.in[1][r * DM + k] : a.in[3][k]; sv[r][i] = fsilu(cv); }
        f32x4 acc[5];
#pragma unroll
        for (int r = 0; r < 5; ++r) acc[r] = (f32x4){0.f, 0.f, 0.f, 0.f};
        const float* wbase = a.in[4] + ((size_t)l * DM + k0) * 12288 + col;
#pragma unroll
        for (int i = 0; i < 2; ++i) {
#pragma unroll 16
            for (int ll = 0; ll < 64; ++ll) { const f32x4 w = *(const f32x4*)(wbase + (size_t)(i * 64 + ll) * 12288);
#pragma unroll
                for (int r = 0; r < 5; ++r) { const float s = __int_as_float(__builtin_amdgcn_readlane(__float_as_int(sv[r][i]), ll)); acc[r] += w * s; } }
        }
        if (kp == 0) { const f32x4 bv = *(const f32x4*)(a.in[5] + (size_t)l * 12288 + col);
#pragma unroll
            for (int r = 0; r < 5; ++r) acc[r] += bv; }
#pragma unroll
        for (int r = 0; r < 5; ++r) { float* d = mods + ((size_t)l * 5 + r) * 12288 + col; unsafeAtomicAdd(d, acc[r][0]); unsafeAtomicAdd(d + 1, acc[r][1]); unsafeAtomicAdd(d + 2, acc[r][2]); unsafeAtomicAdd(d + 3, acc[r][3]); }
    }
}
__device__ __forceinline__ void norm_rows(const float* xlat, const float* xctx, const float* w, const float* mods_l, int shoff, int scoff, bf16_t* XN, int nrows, int gw, int NGW, int lane) {
    for (int row = gw; row < nrows; row += NGW) {
        const float* xr = row < MLAT ? xlat + (size_t)row * DM : xctx + (size_t)(row - MLAT) * DM; const int b = row < MLAT ? (row >> 12) : 4;
        const float* sh = mods_l + (size_t)b * 12288 + shoff; const float* sc = mods_l + (size_t)b * 12288 + scoff;
        f32x4 v[8]; float ss = 0.f;
#pragma unroll
        for (int j = 0; j < 8; ++j) { v[j] = *(const f32x4*)(xr + 4 * lane + 256 * j); ss += (v[j][0] * v[j][0] + v[j][1] * v[j][1]) + (v[j][2] * v[j][2] + v[j][3] * v[j][3]); }
        const float rstd = rsqrtf(wave_sum(ss, lane) * (1.0f / DM) + EPS);
#pragma unroll
        for (int j = 0; j < 8; ++j) { const int col = 4 * lane + 256 * j; const f32x4 wv = *(const f32x4*)(w + col), scv = *(const f32x4*)(sc + col), shv = *(const f32x4*)(sh + col);
            const f32x4 o = (v[j] * rstd * wv) * (scv + 1.0f) + shv; u32x2 pk; pk.x = cvt_pk_bf16(o[0], o[1]); pk.y = cvt_pk_bf16(o[2], o[3]);
            *(u32x2*)(XN + (size_t)row * DM + col) = pk; }
    }
}
__device__ __forceinline__ void final_norm(float* x, const float* w, int gw, int NGW, int lane) {
    for (int row = gw; row < MLAT; row += NGW) { float* xr = x + (size_t)row * DM; f32x4 v[8]; float ss = 0.f;
#pragma unroll
        for (int j = 0; j < 8; ++j) { v[j] = *(const f32x4*)(xr + 4 * lane + 256 * j); ss += (v[j][0] * v[j][0] + v[j][1] * v[j][1]) + (v[j][2] * v[j][2] + v[j][3] * v[j][3]); }
        const float rstd = rsqrtf(wave_sum(ss, lane) * (1.0f / DM) + EPS);
#pragma unroll
        for (int j = 0; j < 8; ++j) { const int col = 4 * lane + 256 * j; *(f32x4*)(xr + col) = v[j] * rstd * *(const f32x4*)(w + col); } }
}
__device__ __forceinline__ void sgu_unit(bf16_t* proj, int row0, int g, const float* nw, const float* wsg, const float* bsg, LAS unsigned char* lds, int tid) {
    LAS bf16_t* vnt = (LAS bf16_t*)lds;
    const int lane = tid & 63, wid = tid >> 6, fr = lane & 15, fq = lane >> 4;
    {
        const int j = tid >> 2, q = tid & 3; const bf16_t* src = proj + (size_t)(row0 + j) * INW + OFF_C + 512 + g * 128 + q * 32;
        float v[32];
#pragma unroll
        for (int i = 0; i < 4; ++i) { const u32x4 w = *(const u32x4*)(src + 8 * i);
            v[8 * i + 0] = bflo(w.x); v[8 * i + 1] = bfhi(w.x); v[8 * i + 2] = bflo(w.y); v[8 * i + 3] = bfhi(w.y); v[8 * i + 4] = bflo(w.z); v[8 * i + 5] = bfhi(w.z); v[8 * i + 6] = bflo(w.w); v[8 * i + 7] = bfhi(w.w); }
        float s = 0.f;
#pragma unroll
        for (int e = 0; e < 32; ++e) s += v[e];
        s += shx(s, 1, lane); s += shx(s, 2, lane); const float mean = s * (1.0f / 128.0f);
        float qv = 0.f;
#pragma unroll
        for (int e = 0; e < 32; ++e) { v[e] -= mean; qv += v[e] * v[e]; }
        qv += shx(qv, 1, lane); qv += shx(qv, 2, lane); const float rstd = rsqrtf(qv * (1.0f / 128.0f) + EPS);
#pragma unroll
        for (int e = 0; e < 32; e += 2) { const int d = q * 32 + e; const unsigned w = cvt_pk_bf16(v[e] * rstd * nw[g * 128 + d], v[e + 1] * rstd * nw[g * 128 + d + 1]);
            vnt[d * 136 + j] = (bf16_t)(w & 0xffffu); vnt[(d + 1) * 136 + j] = (bf16_t)(w >> 16); }
    }
    __syncthreads();
    {
        const int i = 16 * wid + fr;
        bf16x8 wf[4];
#pragma unroll
        for (int ks = 0; ks < 4; ++ks) { const float* wp = wsg + (size_t)i * 128 + 32 * ks + 8 * fq; const f32x4 a = *(const f32x4*)wp, b = *(const f32x4*)(wp + 4);
            u32x4 w; w.x = cvt_pk_bf16(a[0], a[1]); w.y = cvt_pk_bf16(a[2], a[3]); w.z = cvt_pk_bf16(b[0], b[1]); w.w = cvt_pk_bf16(b[2], b[3]); wf[ks] = __builtin_bit_cast(bf16x8, w); }
        const float bias = bsg[i];
        bf16_t* up = proj + (size_t)(row0 + i) * INW + OFF_C + g * 128 + 4 * fq;
#pragma unroll
        for (int nt = 0; nt < 8; ++nt) { f32x4 acc = (f32x4){0.f, 0.f, 0.f, 0.f};
#pragma unroll
            for (int ks = 0; ks < 4; ++ks) { const bf16x8 af = *(const LAS bf16x8*)((const LAS unsigned char*)vnt + (16 * nt + fr) * 272 + (32 * ks + 8 * fq) * 2);
                acc = __builtin_amdgcn_mfma_f32_16x16x32_bf16(af, wf[ks], acc, 0, 0, 0); }
            const u32x2 uw = *(const u32x2*)(up + 16 * nt); u32x2 o;
            o.x = cvt_pk_bf16(bflo(uw.x) * (acc[0] + bias), bfhi(uw.x) * (acc[1] + bias)); o.y = cvt_pk_bf16(bflo(uw.y) * (acc[2] + bias), bfhi(uw.y) * (acc[3] + bias));
            *(u32x2*)(up + 16 * nt) = o; }
    }
    __syncthreads();
}
template <bool LAT>
__device__ __forceinline__ void attn_task(bf16_t* proj, const bf16_t* vt, const float* rpb, int t, int lane, const LAS unsigned char* cl) {
    constexpr int NCH = LAT ? 16 : 8, WCH = LAT ? 8 : 0;
    const int fr = lane & 15, fq = lane >> 4;
    int b, h, r = 0, cgp = 0, qrow;
    if (LAT) { cgp = t & 3; r = (t >> 2) & 63; h = (t >> 8) & 7; b = t >> 11; qrow = b * 4096 + r * 64 + cgp * 16 + fr; }
    else { const int qg = t & 15; h = (t >> 4) & 7; b = t >> 7; qrow = MLAT + b * 256 + qg * 16 + fr; }
    bf16_t* qp = proj + (size_t)qrow * INW + OFF_Q + h * 128;
    bf16x8 qf[4];
#pragma unroll
    for (int ks = 0; ks < 4; ++ks) qf[ks] = *(const bf16x8*)(qp + ks * 32 + fq * 8);
    const int rs = r < 4 ? 0 : (r > 60 ? 56 : r - 4);
    const int cb = cgp == 0 ? 0 : (cgp == 1 ? 8 : (cgp == 2 ? 24 : 32));
    float S[NCH][8];
    const int kap = 8 * (fr >> 2) + (fr & 3);
    const bf16_t* kbase = proj + OFF_K + h * 128 + fq * 8;
    bf16x8 kf[2][8];
#define ATT_LOADK(buf, c) do { _Pragma("unroll") for (int tt = 0; tt < 2; ++tt) { \
        if ((c) < WCH) { const int krow = b * 4096 + (rs + (c)) * 64 + cb + kap + 4 * tt; const bf16_t* kp = kbase + (size_t)krow * INW; \
            _Pragma("unroll") for (int ks = 0; ks < 4; ++ks) kf[buf][tt * 4 + ks] = *(const bf16x8*)(kp + ks * 32); } \
        else { const LAS unsigned char* kp = cl + (32 * ((c) - WCH) + kap + 4 * tt) * 256; \
            _Pragma("unroll") for (int ks = 0; ks < 4; ++ks) kf[buf][tt * 4 + ks] = *(const LAS bf16x8*)(kp + (((ks * 4 + fq) ^ fr) * 16)); } } } while (0)
    ATT_LOADK(0, 0);
#pragma unroll
    for (int c = 0; c < NCH; ++c) {
        if (c + 1 < NCH) ATT_LOADK((c + 1) & 1, c + 1);
        __builtin_amdgcn_sched_barrier(0);
#pragma unroll
        for (int tt = 0; tt < 2; ++tt) {
            f32x4 acc = (f32x4){0.f, 0.f, 0.f, 0.f};
#pragma unroll
            for (int ks = 0; ks < 4; ++ks) acc = __builtin_amdgcn_mfma_f32_16x16x32_bf16(kf[c & 1][tt * 4 + ks], qf[ks], acc, 0, 0, 0);
            S[c][4 * tt + 0] = acc[0]; S[c][4 * tt + 1] = acc[1]; S[c][4 * tt + 2] = acc[2]; S[c][4 * tt + 3] = acc[3];
        }
        __builtin_amdgcn_sched_barrier(0);
    }
#undef ATT_LOADK
    if (LAT) {
        const int qc = cgp * 16 + fr; const int cs = qc < 8 ? 0 : (qc > 56 ? 48 : qc - 8);
#pragma unroll
        for (int c = 0; c < WCH; ++c) { const int dr = rs + c - r + 7; const float* rp = rpb + (h * 15 + dr) * 31;
#pragma unroll
            for (int jj = 0; jj < 8; ++jj) { const int kc = cb + 8 * fq + jj; const bool valid = (kc >= cs) && (kc < cs + 16); int dc = kc - qc + 15; dc = dc < 0 ? 0 : (dc > 30 ? 30 : dc);
                const float bias = rp[dc]; S[c][jj] = valid ? S[c][jj] + bias : -1e30f; } }
    }
    float mx = -3.0e38f;
#pragma unroll
    for (int c = 0; c < NCH; ++c)
#pragma unroll
        for (int jj = 0; jj < 8; ++jj) mx = fmaxf(mx, S[c][jj]);
    mx = fmaxf(mx, shx(mx, 16, lane)); mx = fmaxf(mx, shx(mx, 32, lane));
    float sum = 0.f; bf16x8 pf[NCH];
#pragma unroll
    for (int c = 0; c < NCH; ++c) { float p[8];
#pragma unroll
        for (int jj = 0; jj < 8; ++jj) { p[jj] = __builtin_amdgcn_exp2f((S[c][jj] - mx) * 1.44269504089f); sum += p[jj]; }
        u32x4 w; w.x = cvt_pk_bf16(p[0], p[1]); w.y = cvt_pk_bf16(p[2], p[3]); w.z = cvt_pk_bf16(p[4], p[5]); w.w = cvt_pk_bf16(p[6], p[7]); pf[c] = __builtin_bit_cast(bf16x8, w); }
    sum += shx(sum, 16, lane); sum += shx(sum, 32, lane);
    const float inv = 1.0f / sum;
    const bf16_t* vlat = vt + ((size_t)(b * 1024 + h * 128 + fr)) * 4096 + cb + 8 * fq;
    constexpr int NBH = NCH / 8, NQ = 8 * NBH;
    bf16x8 vf[2][8];
#define ATT_LOADV(buf, q) do { const int dt_ = (q) / NBH, hb_ = (q) % NBH; _Pragma("unroll") for (int i = 0; i < 8; ++i) { const int c_ = hb_ * 8 + i; \
        if (c_ < WCH) vf[buf][i] = *(const bf16x8*)(vlat + (size_t)dt_ * 16 * 4096 + (rs + c_) * 64); \
        else vf[buf][i] = *(const LAS bf16x8*)(cl + 65536 + (dt_ * 16 + fr) * 512 + ((((c_ - WCH) * 4 + fq) ^ fr) * 16)); } } while (0)
    ATT_LOADV(0, 0);
    f32x4 oacc = (f32x4){0.f, 0.f, 0.f, 0.f};
#pragma unroll
    for (int q = 0; q < NQ; ++q) {
        if (q + 1 < NQ) ATT_LOADV((q + 1) & 1, q + 1);
        __builtin_amdgcn_sched_barrier(0);
        const int dt = q / NBH, hb = q % NBH;
        if (hb == 0) oacc = (f32x4){0.f, 0.f, 0.f, 0.f};
#pragma unroll
        for (int i = 0; i < 8; ++i) oacc = __builtin_amdgcn_mfma_f32_16x16x32_bf16(vf[q & 1][i], pf[hb * 8 + i], oacc, 0, 0, 0);
        if (hb == NBH - 1) { u32x2 o; o.x = cvt_pk_bf16(oacc[0] * inv, oacc[1] * inv); o.y = cvt_pk_bf16(oacc[2] * inv, oacc[3] * inv);
            *(u32x2*)(qp + dt * 16 + 4 * fq) = o; }
        __builtin_amdgcn_sched_barrier(0);
    }
#undef ATT_LOADV
}
template <bool LAT>
__device__ __forceinline__ void attn_pass(bf16_t* proj, const bf16_t* vt, const bf16_t* vtc, const float* rpb, int b, int h, int ra, LAS unsigned char* lds, int wave) {
    constexpr int NCH = LAT ? 16 : 8, WCH = LAT ? 8 : 0;
    const int lane = fresh_lane(), fr = lane & 15, fq = lane >> 4, tid = wave * 64 + lane;
    const int r = LAT ? ra + (wave >> 2) : 0, cgp = LAT ? (wave & 3) : 0;
    const int rsa = ra < 4 ? 0 : (ra > 60 ? 56 : ra - 4), rs = r < 4 ? 0 : (r > 60 ? 56 : r - 4), shw = rs - rsa;
    const int rsb = (ra + 1) < 4 ? 0 : ((ra + 1) > 60 ? 56 : ra + 1 - 4), T = 8 + (rsb - rsa);
    const int cb = cgp == 0 ? 0 : (cgp == 1 ? 8 : (cgp == 2 ? 24 : 32));
    const bool active = LAT || wave == 0;
    const int qrow = LAT ? (b * 4096 + r * 64 + cgp * 16 + fr) : (MLAT + b * 256 + ra * 16 + fr);
    bf16_t* qp = proj + (size_t)qrow * INW + OFF_Q + h * 128;
    bf16x8 qf[4];
#pragma unroll
    for (int ks = 0; ks < 4; ++ks) qf[ks] = *(const bf16x8*)(qp + ks * 32 + fq * 8);
    const int kap = 8 * (fr >> 2) + (fr & 3);
    float S[NCH][8];
    if (LAT) {
        __syncthreads();
        { u32x4 v[18];
#pragma unroll
          for (int i = 0; i < 18; ++i) { const int idx = tid + 512 * i, key = idx >> 4, ch = idx & 15;
            if (i < 2 * T) v[i] = *(const u32x4*)(proj + (size_t)(b * 4096 + rsa * 64 + key) * INW + OFF_K + h * 128 + ch * 8); }
#pragma unroll
          for (int i = 0; i < 18; ++i) { const int idx = tid + 512 * i, key = idx >> 4, ch = idx & 15, g = (key & 3) | (((key >> 3) & 3) << 2);
            if (i < 2 * T) *(LAS u32x4*)(lds + key * 256 + ((ch ^ g) * 16)) = v[i]; } }
        __syncthreads();
        const int gw = (fr & 3) | ((((cb >> 3) + (fr >> 2)) & 3) << 2);
#pragma unroll
        for (int c = 0; c < WCH; ++c) {
#pragma unroll
            for (int tt = 0; tt < 2; ++tt) { const LAS unsigned char* kp = lds + ((c + shw) * 64 + cb + kap + 4 * tt) * 256;
                f32x4 acc = (f32x4){0.f, 0.f, 0.f, 0.f};
#pragma unroll
                for (int ks = 0; ks < 4; ++ks) { const bf16x8 kf = *(const LAS bf16x8*)(kp + (((ks * 4 + fq) ^ gw) * 16)); acc = __builtin_amdgcn_mfma_f32_16x16x32_bf16(kf, qf[ks], acc, 0, 0, 0); }
                S[c][4 * tt + 0] = acc[0]; S[c][4 * tt + 1] = acc[1]; S[c][4 * tt + 2] = acc[2]; S[c][4 * tt + 3] = acc[3]; } }
    }
    __syncthreads();
    { u32x4 v[8];
#pragma unroll
      for (int i = 0; i < 8; ++i) { const int idx = tid + 512 * i, key = idx >> 4, ch = idx & 15; v[i] = *(const u32x4*)(proj + (size_t)(MLAT + b * 256 + key) * INW + OFF_K + h * 128 + ch * 8); }
#pragma unroll
      for (int i = 0; i < 8; ++i) { const int idx = tid + 512 * i, key = idx >> 4, ch = idx & 15, g = (key & 3) | (((key >> 3) & 3) << 2); *(LAS u32x4*)(lds + key * 256 + ((ch ^ g) * 16)) = v[i]; } }
    __syncthreads();
    float mx = -3.0e38f, sum = 0.f, inv = 0.f; bf16x8 pf[NCH];
    if (active) {
#pragma unroll
        for (int c = WCH; c < NCH; ++c) {
#pragma unroll
            for (int tt = 0; tt < 2; ++tt) { const LAS unsigned char* kp = lds + (32 * (c - WCH) + kap + 4 * tt) * 256;
                f32x4 acc = (f32x4){0.f, 0.f, 0.f, 0.f};
#pragma unroll
                for (int ks = 0; ks < 4; ++ks) { const bf16x8 kf = *(const LAS bf16x8*)(kp + (((ks * 4 + fq) ^ fr) * 16)); acc = __builtin_amdgcn_mfma_f32_16x16x32_bf16(kf, qf[ks], acc, 0, 0, 0); }
                S[c][4 * tt + 0] = acc[0]; S[c][4 * tt + 1] = acc[1]; S[c][4 * tt + 2] = acc[2]; S[c][4 * tt + 3] = acc[3]; } }
        if (LAT) {
            const int qc = cgp * 16 + fr; const int cs = qc < 8 ? 0 : (qc > 56 ? 48 : qc - 8);
#pragma unroll
            for (int c = 0; c < WCH; ++c) { const int dr = rs + c - r + 7; const float* rp = rpb + (h * 15 + dr) * 31;
#pragma unroll
                for (int jj = 0; jj < 8; ++jj) { const int kc = cb + 8 * fq + jj; const bool valid = (kc >= cs) && (kc < cs + 16); int dc = kc - qc + 15; dc = dc < 0 ? 0 : (dc > 30 ? 30 : dc);
                    const float bias = rp[dc]; S[c][jj] = valid ? S[c][jj] + bias : -1e30f; } }
        }
#pragma unroll
        for (int c = 0; c < NCH; ++c)
#pragma unroll
            for (int jj = 0; jj < 8; ++jj) mx = fmaxf(mx, S[c][jj]);
        mx = fmaxf(mx, shx(mx, 16, lane)); mx = fmaxf(mx, shx(mx, 32, lane));
#pragma unroll
        for (int c = 0; c < NCH; ++c) { float p[8];
#pragma unroll
            for (int jj = 0; jj < 8; ++jj) { p[jj] = __builtin_amdgcn_exp2f((S[c][jj] - mx) * 1.44269504089f); sum += p[jj]; }
            u32x4 w; w.x = cvt_pk_bf16(p[0], p[1]); w.y = cvt_pk_bf16(p[2], p[3]); w.z = cvt_pk_bf16(p[4], p[5]); w.w = cvt_pk_bf16(p[6], p[7]); pf[c] = __builtin_bit_cast(bf16x8, w); }
        sum += shx(sum, 16, lane); sum += shx(sum, 32, lane);
        inv = 1.0f / sum;
    }
    f32x4 oacc[8];
#pragma unroll
    for (int dt = 0; dt < 8; ++dt) oacc[dt] = (f32x4){0.f, 0.f, 0.f, 0.f};
    if (LAT) {
        __syncthreads();
        const int cpr = T * 8;
        { u32x4 v[18];
#pragma unroll
          for (int i = 0; i < 18; ++i) { const int idx = tid + 512 * i, d = idx / cpr, ch = idx - d * cpr;
            if (i < 2 * T) v[i] = *(const u32x4*)(vt + (size_t)(b * 1024 + h * 128 + d) * 4096 + rsa * 64 + ch * 8); }
#pragma unroll
          for (int i = 0; i < 18; ++i) { const int idx = tid + 512 * i, d = idx / cpr, ch = idx - d * cpr;
            if (i < 2 * T) *(LAS u32x4*)(lds + d * 1152 + (((ch & ~7) | ((ch & 7) ^ ((d >> 1) & 7))) * 16)) = v[i]; } }
        __syncthreads();
#pragma unroll
        for (int dt = 0; dt < 8; ++dt)
#pragma unroll
            for (int c = 0; c < WCH; ++c) { const int ch = (c + shw) * 8 + (cb >> 3) + fq;
                const bf16x8 vf = *(const LAS bf16x8*)(lds + (dt * 16 + fr) * 1152 + (((ch & ~7) | ((ch & 7) ^ (fr >> 1))) * 16));
                oacc[dt] = __builtin_amdgcn_mfma_f32_16x16x32_bf16(vf, pf[c], oacc[dt], 0, 0, 0); }
    }
    __syncthreads();
    { u32x4 v[8];
#pragma unroll
      for (int i = 0; i < 8; ++i) { const int idx = tid + 512 * i, d = idx >> 5, ch = idx & 31; v[i] = *(const u32x4*)(vtc + (size_t)(b * 1024 + h * 128 + d) * 256 + ch * 8); }
#pragma unroll
      for (int i = 0; i < 8; ++i) { const int idx = tid + 512 * i, d = idx >> 5, ch = idx & 31; *(LAS u32x4*)(lds + d * 512 + ((ch ^ (d & 15)) * 16)) = v[i]; } }
    __syncthreads();
    if (active) {
#pragma unroll
        for (int dt = 0; dt < 8; ++dt) {
#pragma unroll
            for (int c = WCH; c < NCH; ++c) { const bf16x8 vf = *(const LAS bf16x8*)(lds + (dt * 16 + fr) * 512 + ((((c - WCH) * 4 + fq) ^ fr) * 16));
                oacc[dt] = __builtin_amdgcn_mfma_f32_16x16x32_bf16(vf, pf[c], oacc[dt], 0, 0, 0); }
            u32x2 o; o.x = cvt_pk_bf16(oacc[dt][0] * inv, oacc[dt][1] * inv); o.y = cvt_pk_bf16(oacc[dt][2] * inv, oacc[dt][3] * inv);
            *(u32x2*)(qp + dt * 16 + 4 * fq) = o; }
    }
}
__device__ __forceinline__ void attn_block(bf16_t* proj, const bf16_t* vt, const bf16_t* vtc, const float* rpb, int vcu, int half, bool ctxq, LAS unsigned char* lds, int wave) {
    const int bh = vcu >> 3, b = bh >> 3, h = bh & 7, rb = vcu & 7;
    __syncthreads();
    { const int tid = wave * 64 + fresh_lane();
#pragma unroll
      for (int i = 0; i < 8; ++i) { const int idx = tid + 512 * i, key = idx >> 4, ch = idx & 15, g = (key & 3) | (((key >> 3) & 3) << 2);
          const u32x4 v = *(const u32x4*)(proj + (size_t)(MLAT + b * 256 + key) * INW + OFF_K + h * 128 + ch * 8);
          *(LAS u32x4*)(lds + key * 256 + ((ch ^ g) * 16)) = v; }
#pragma unroll
      for (int i = 0; i < 8; ++i) { const int idx = tid + 512 * i, d = idx >> 5, ch = idx & 31;
          const u32x4 v = *(const u32x4*)(vtc + (size_t)(b * 1024 + h * 128 + d) * 256 + ch * 8);
          *(LAS u32x4*)(lds + 65536 + d * 512 + ((ch ^ (d & 15)) * 16)) = v; } }
    __syncthreads();
    const int lane = fresh_lane();
    for (int round = 0; round < 2; ++round) { const int r = rb * 8 + half * 4 + round * 2 + (wave >> 2), cgp = wave & 3;
        attn_task<true>(proj, vt, rpb, ((bh * 64 + r) << 2) + cgp, lane, lds); }
    if (ctxq && wave == 0) attn_task<false>(proj, vt, rpb, bh * 16 + rb * 2 + half, lane, lds);
}
__device__ __forceinline__ void conv_items(const bf16_t* up, bf16_t* hmid, const float* cw, const float* cbias, int nrows, int gtid, int NT) {
    const int nitems = (nrows / 16) * 704;
    for (int it = gtid; it < nitems; it += NT) {
        const int cg8 = it % 704, rb = it / 704; const int row0 = rb * 16, ch = cg8 * 8;
        const int seqlen = row0 < MLAT ? 4096 : 256; const int ts = (row0 < MLAT ? row0 : row0 - MLAT) & (seqlen - 1);
        float w0[8], w1[8], w2[8], bb[8];
#pragma unroll
        for (int e = 0; e < 8; ++e) { w0[e] = cw[ch + e]; w1[e] = cw[DFF + ch + e]; w2[e] = cw[2 * DFF + ch + e]; bb[e] = cbias[ch + e]; }
        const bf16_t* ap = up + (size_t)row0 * UPW + ch; const bf16_t* gp = ap + DFF; bf16_t* hp = hmid + (size_t)row0 * DFF + ch;
        u32x4 prev = (u32x4){0u, 0u, 0u, 0u}; if (ts > 0) prev = *(const u32x4*)(ap - UPW);
        u32x4 cur = *(const u32x4*)ap;
        for (int i = 0; i < 16; ++i) {
            u32x4 nxt = (u32x4){0u, 0u, 0u, 0u}; if (i < 15 || ts + 16 < seqlen) nxt = *(const u32x4*)(ap + (size_t)(i + 1) * UPW);
            const u32x4 gw = *(const u32x4*)(gp + (size_t)i * UPW);
            float o[8];
#pragma unroll
            for (int e = 0; e < 4; ++e) {
                const float y0 = bb[2 * e] + w0[2 * e] * bflo(prev[e]) + w1[2 * e] * bflo(cur[e]) + w2[2 * e] * bflo(nxt[e]);
                const float y1 = bb[2 * e + 1] + w0[2 * e + 1] * bfhi(prev[e]) + w1[2 * e + 1] * bfhi(cur[e]) + w2[2 * e + 1] * bfhi(nxt[e]);
                o[2 * e] = fsilu(y0) * bflo(gw[e]); o[2 * e + 1] = fsilu(y1) * bfhi(gw[e]); }
            u32x4 w; w.x = cvt_pk_bf16(o[0], o[1]); w.y = cvt_pk_bf16(o[2], o[3]); w.z = cvt_pk_bf16(o[4], o[5]); w.w = cvt_pk_bf16(o[6], o[7]);
            *(u32x4*)(hp + (size_t)i * DFF) = w;
            prev = cur; cur = nxt;
        }
    }
}


#define XB_TMO      128
#define XB_XCNT(j)  (256  + 64 * (j))
#define XB_XSUB(j)  (1280 + 64 * (j))
#define XB_XGEN(j)  (2304 + 64 * (j))
#define XB_TOP      3328
#define XB_TOPGEN   3392
#define XCD_BAR_WORDS 3456
#define XB_SPIN_CAP (1u << 18)
__device__ __forceinline__ unsigned xb_ld(unsigned* p)              { return __hip_atomic_load(p, __ATOMIC_RELAXED, __HIP_MEMORY_SCOPE_AGENT); }
__device__ __forceinline__ unsigned xb_add(unsigned* p, unsigned v) { return __hip_atomic_fetch_add(p, v, __ATOMIC_RELAXED, __HIP_MEMORY_SCOPE_AGENT); }
__device__ __forceinline__ unsigned xb_xcc_id() { return (unsigned)__builtin_amdgcn_s_getreg((3 << 11) | 20) & 0xFu; }
#define XB_SPIN(cond, bar) do { unsigned _sp = 0; while (cond) { __builtin_amdgcn_s_sleep(1); \
    if ((++_sp & 255u) == 0u) { if (xb_ld(&(bar)[XB_TMO])) break; if (_sp > XB_SPIN_CAP) { atomicAdd(&(bar)[XB_TMO], 1u); break; } } } } while (0)
struct XcdBarrier { unsigned* bar; unsigned x; volatile LAS unsigned* st; };
__device__ __forceinline__ XcdBarrier xcd_barrier_post(unsigned* bar, volatile LAS unsigned* st) {
    XcdBarrier b; b.bar = bar; b.x = xb_xcc_id(); b.st = st;
    if (threadIdx.x == 0) (void)xb_add(&bar[XB_XCNT(b.x)], 1u);
    return b;
}
__device__ __forceinline__ void xcd_barrier_complete(unsigned* bar, unsigned x, unsigned& nloc, unsigned& nx) {
    const unsigned G = gridDim.x * gridDim.y * gridDim.z;
    unsigned sum, cnt, mine, sp = 0u;
    for (;;) {
        sum = 0u; cnt = 0u; mine = 0u;
#pragma unroll
        for (unsigned j = 0; j < 16; ++j) { const unsigned c = xb_ld(&bar[XB_XCNT(j)]); sum += c; cnt += (c > 0u) ? 1u : 0u; mine = (j == x) ? c : mine; }
        if (sum == G) break;
        __builtin_amdgcn_s_sleep(1);
        if ((++sp & 255u) == 0u) { if (xb_ld(&bar[XB_TMO])) break; if (sp > XB_SPIN_CAP) { atomicAdd(&bar[XB_TMO], 1u); break; } }
    }
    nloc = mine > 0u ? mine : 1u; nx = cnt > 0u ? cnt : 1u;
}
__device__ __forceinline__ void xcd_barrier(const XcdBarrier& b) {
    asm volatile("s_waitcnt vmcnt(0)" ::: "memory");
    __syncthreads();
    if (threadIdx.x == 0) {
        unsigned* bar = b.bar;
        __builtin_amdgcn_s_waitcnt(0);
        unsigned nloc = b.st[0], nx = b.st[1];
        if (nloc == 0u) { xcd_barrier_complete(bar, b.x, nloc, nx); b.st[0] = nloc; b.st[1] = nx; }
        const unsigned old = xb_add(&bar[XB_XSUB(b.x)], 1u);
        const unsigned gen = old / nloc;
        if (old + 1u == (gen + 1u) * nloc) {
            __builtin_amdgcn_fence(__ATOMIC_RELEASE, "agent");
            asm volatile("s_waitcnt vmcnt(0)" ::: "memory");
            const unsigned og = xb_add(&bar[XB_TOP], 1u);
            const unsigned tg = og / nx;
            if (og + 1u == (tg + 1u) * nx) xb_add(&bar[XB_TOPGEN], 1u);
            else XB_SPIN(xb_ld(&bar[XB_TOPGEN]) == tg, bar);
            __builtin_amdgcn_fence(__ATOMIC_ACQUIRE, "agent");
            xb_add(&bar[XB_XGEN(b.x)], 1u);
            asm volatile("s_waitcnt vmcnt(0)" ::: "memory");
        } else {
            XB_SPIN(xb_ld(&bar[XB_XGEN(b.x)]) == gen, bar);
            __builtin_amdgcn_fence(__ATOMIC_ACQUIRE, "agent");
            asm volatile("s_waitcnt vmcnt(0)" ::: "memory");
        }
    }
    __syncthreads();
}
constexpr int NPHASE = 24;
__global__ void __launch_bounds__(512, 2) mega(Args a_) {
    extern __shared__ __attribute__((aligned(16))) unsigned char lds_raw[];
    LAS unsigned char* lds = (LAS unsigned char*)lds_raw;
    cg::grid_group grid = cg::this_grid();
    const int G = gridDim.x, cu = blockIdx.x, NGW = G * 8, wave = __builtin_amdgcn_readfirstlane((int)threadIdx.x >> 6);

    volatile LAS unsigned* xst = (volatile LAS unsigned*)(lds + LDS_XST);
    if (threadIdx.x < 4) xst[threadIdx.x] = 0u;
    __syncthreads();
    const XcdBarrier xbar = xcd_barrier_post((unsigned*)(a_.ws + WS_BAR), xst);

    const int ph_lo = a_.ph_lo, ph_hi = a_.ph_hi;
    for (int p = ph_lo; p < ph_hi; ++p) {
        if (p > ph_lo) { if (p == 1) grid.sync(); else xcd_barrier(xbar); }
#define PH_IDS const int lane = fresh_lane(); const int tid = wave * 64 + lane, gw = cu * 8 + wave; (void)tid; (void)gw; (void)lane;
        typedef const __attribute__((address_space(4))) Args KArgs;
        KArgs* ap = (KArgs*)__builtin_amdgcn_kernarg_segment_ptr(); asm volatile("" : "+s"(ap));
        KArgs& a = *ap;
        unsigned char* ws = a.ws;
        unsigned* ctl = (unsigned*)(ws + WS_CTL);
        bf16_t* PROJ = (bf16_t*)(ws + WS_BIG); bf16_t* XN = (bf16_t*)(ws + WS_XN); bf16_t* HMID = (bf16_t*)(ws + WS_HMID);
        float* XC = (float*)(ws + WS_XC); float* mods = (float*)(ws + WS_MODS);
        bf16_t* VT = (bf16_t*)(ws + WS_VT); bf16_t* VTC = (bf16_t*)(ws + WS_VTC);
        if (p == 0) { PH_IDS
            LAS float* lut = (LAS float*)(lds + 72 * 1024);
            for (int i = tid; i < 4096; i += 512) lut[i] = cospif((float)i * (1.0f / 2048.0f));
            __syncthreads();
            if (cu == 0) { bf16_t* dd = (bf16_t*)(ws + WS_DFTD);
                for (int e = tid; e < 256 * 128; e += 512) { const int row = e >> 7, d = e & 127, j = row & 127; const float ang = (float)((j * d) & 127) * (1.0f / 64.0f);
                    const float v = row < 128 ? cospif(ang) : sinpif(ang); dd[e] = (bf16_t)(cvt_pk_bf16(v, 0.f) & 0xffffu); } }
            for (int i = cu * 512 + tid; i < 1024 * DM / 4; i += G * 512) ((f32x4*)XC)[i] = ((const f32x4*)a.in[2])[i];
            mods_items(a, gw, NGW, lane);
            convert_weights(a, 0, (LAS float*)(lds + wave * 8704), gw, NGW, lane);
            dft_tables(ws, lut, gw, NGW, lane);
            continue;
        }
        if (p == NPHASE - 1) { PH_IDS final_norm(a.out, a.in[21], gw, NGW, lane); continue; }
        const int l = (p - 1) / 11, s = (p - 1) % 11;
        const float* mods_l = mods + (size_t)l * 5 * 12288;
        const float* xlat = (l == 0) ? a.in[0] : a.out; const float* xctx = (l == 0) ? a.in[2] : XC;
        const int nMall = (l == 0) ? 68 : 64;
        switch (s) {
        case 0: { PH_IDS
            if (l == 1) { LAS float* lut = (LAS float*)(lds + 72 * 1024);
                for (int i = tid; i < 4096; i += 512) lut[i] = cospif((float)i * (1.0f / 2048.0f));
                __syncthreads();
                convert_weights(a, 1, (LAS float*)(lds + wave * 8704), gw, NGW, lane);
                dft_tables(ws, lut, gw, NGW, lane); }
            norm_rows(xlat, xctx, a.in[6] + (size_t)l * DM, mods_l, 0, 2048, XN, MT, gw, NGW, lane);
        } break;
        case 1: { PH_IDS
            SchedGrid S; S.so.init(nMall, 42, G, cu); S.A = (const char*)XN; S.B = (const char*)(ws + WS_WIN); S.tsA = (size_t)256 * DM * 2; S.tsB = (size_t)256 * DM * 2; S.nt = 32;
            S.nextra = (l == 0) ? 0 : 32; S.ex_pm0 = 64; S.ex_pn0 = 6; S.ex_w = 8; S.ex_ks = 1;
            EpiInProj E{PROJ, VT, VTC};
            pg8::gemm_phase<EpiInProj, SchedGrid>(lds, tid, DM, DM, S, E);
        } break;
        case 2: { PH_IDS
            const int nun = 512 + ((l == 0) ? 32 : 0);
            for (int u = cu; u < nun; u += G) { int row0, g;
                if (u < 512) { const int b = u >> 7, ch = (u >> 2) & 31; g = u & 3; row0 = b * 4096 + ch * 128; }
                else { const int e = u - 512; const int b = e >> 3, ch = (e >> 2) & 1; g = e & 3; row0 = MLAT + b * 256 + ch * 128; }
                sgu_unit(PROJ, row0, g, a.in[10] + (size_t)l * 512, a.in[11] + ((size_t)l * 4 + g) * 128 * 128, a.in[12] + ((size_t)l * 4 + g) * 128, lds, tid); }
            __syncthreads();
            { SchedF1L S{(const char*)(ws + WS_DFTD), (const char*)PROJ, G, cu}; EpiF1L E{(bf16_t*)(ws + WS_U)};
              pg8::gemm_phase<EpiF1L, SchedF1L>(lds, wave * 64 + fresh_lane(), 128, INW, S, E); }
            if (l == 0) { SchedF1 S{(const char*)(ws + WS_DFTD), (const char*)PROJ, G, (cu + 128) % G, 16}; EpiF1 E{nullptr, (bf16_t*)(ws + WS_PQTC)};
              pg8::gemm_phase<EpiF1, SchedF1>(lds, wave * 64 + fresh_lane(), 128, INW, S, E); }
        } break;
        case 3: { PH_IDS
            { SchedFA S{(const char*)(ws + WS_MA), (const char*)(ws + WS_U), G, cu}; EpiFA E{(bf16_t*)(ws + WS_ZBUF)};
              pg8::gemm_phase<EpiFA, SchedFA>(lds, tid, 128, 128, S, E); }
            if (l == 0) { SchedF2 S{(const char*)(ws + WS_DFTC), (const char*)(ws + WS_PQTC), G, (cu + 128) % G, 8}; EpiF2 E{PROJ};
              pg8::gemm_phase<EpiF2, SchedF2>(lds, wave * 64 + fresh_lane(), 8192, 8192, S, E); }
            for (int vcu = cu; vcu < 256; vcu += G) { const int bh = vcu >> 3, rb = vcu & 7; const float* rpb = a.in[9] + (size_t)l * 8 * 15 * 31;
#pragma unroll 1
                for (int pp = 0; pp < 2; ++pp) attn_pass<true>(PROJ, VT, VTC, rpb, bh >> 3, bh & 7, rb * 8 + 0 * 4 + pp * 2, lds, wave);
                if (l == 0) attn_pass<false>(PROJ, VT, VTC, rpb, bh >> 3, bh & 7, rb * 2 + 0, lds, wave); }
        } break;
        case 4: { PH_IDS
            { SchedFB S{(const char*)(ws + WS_TT), (const char*)(ws + WS_ZBUF), G, cu}; EpiFB E{PROJ};
              pg8::gemm_phase<EpiFB, SchedFB>(lds, tid, 128, 128, S, E); }
            for (int vcu = cu; vcu < 256; vcu += G) { const int bh = vcu >> 3, rb = vcu & 7; const float* rpb = a.in[9] + (size_t)l * 8 * 15 * 31;
#pragma unroll 1
                for (int pp = 0; pp < 2; ++pp) attn_pass<true>(PROJ, VT, VTC, rpb, bh >> 3, bh & 7, rb * 8 + 1 * 4 + pp * 2, lds, wave);
                if (l == 0) attn_pass<false>(PROJ, VT, VTC, rpb, bh >> 3, bh & 7, rb * 2 + 1, lds, wave); }
        } break;
        case 5: { PH_IDS
            SchedBranch S; S.so.init(nMall, 8, G, cu); S.proj = (const char*)PROJ; S.wbr = (const char*)(ws + WS_WBR);
            EpiBranch E{PROJ, XN};
            pg8::gemm_phase<EpiBranch, SchedBranch>(lds, tid, INW, DM, S, E);
        } break;
        case 6: { PH_IDS
            SchedGrid S; S.so.init(64, 8, G, cu); S.A = (const char*)XN; S.B = (const char*)(ws + WS_WO); S.tsA = (size_t)256 * DM * 2; S.tsB = (size_t)256 * DM * 2; S.nt = 32;
            S.nextra = (l == 0) ? 32 * 8 : 0; S.ex_pm0 = 64; S.ex_pn0 = 0; S.ex_w = 8; S.ex_ks = 8;
            EpiResid E{xlat, XC, a.out, XC, mods_l + 4096};
            pg8::gemm_phase<EpiResid, SchedGrid>(lds, tid, DM, DM, S, E);
        } break;
        case 7: { PH_IDS
            norm_rows(a.out, XC, a.in[7] + (size_t)l * DM, mods_l, 6144, 8192, XN, nMall * 256, gw, NGW, lane);
        } break;
        case 8: { PH_IDS
            SchedGrid S; S.so.init(nMall, 44, G, cu); S.A = (const char*)XN; S.B = (const char*)(ws + WS_WUP); S.tsA = (size_t)256 * DM * 2; S.tsB = (size_t)256 * DM * 2; S.nt = 32; S.nextra = 0; S.ex_pm0 = 0; S.ex_pn0 = 0; S.ex_w = 1; S.ex_ks = 1;
            EpiUpConv E{HMID, (float*)(ws + WS_BIG), a.in[18] + (size_t)l * 3 * DFF, a.in[19] + (size_t)l * DFF};
            pg8::gemm_phase<EpiUpConv, SchedGrid>(lds, tid, DM, DM, S, E);
        } break;
        case 9: { PH_IDS
            ffn_fix_rows(HMID, (const float*)(ws + WS_BIG), a.in[18] + (size_t)l * 3 * DFF, nMall * 4, cu * 512 + tid, G * 512);
        } break;
        case 10: { PH_IDS
            SchedGrid S; S.so.init(64, 8, G, cu); S.A = (const char*)HMID; S.B = (const char*)(ws + WS_WDN); S.tsA = (size_t)256 * DFF * 2; S.tsB = (size_t)256 * DFF * 2; S.nt = 88;
            S.nextra = (l == 0) ? 32 * 4 : 0; S.ex_pm0 = 64; S.ex_pn0 = 0; S.ex_w = 8; S.ex_ks = 4;
            EpiResid E{a.out, XC, a.out, XC, mods_l + 10240};
            pg8::gemm_phase<EpiResid, SchedGrid>(lds, tid, DFF, DFF, S, E);
        } break;
        }
    }
}

extern "C" void kernel_launch(void* const* d_in, const int* in_sizes, int n_in, void* d_out, int out_size, void* d_ws, size_t ws_size, hipStream_t stream) {
    static int grid = 0;
    if (grid == 0) {
        if (n_in != 22 || ws_size < WS_END) { fprintf(stderr, "kernel_launch: unexpected n_in %d / ws_size %zu (need %zu)\n", n_in, ws_size, (size_t)WS_END); grid = -1; return; }
        int dev = 0, cus = 0, per_cu = 0;
        hipGetDevice(&dev); hipDeviceGetAttribute(&cus, hipDeviceAttributeMultiprocessorCount, dev);
        if (hipFuncSetAttribute((const void*)mega, hipFuncAttributeMaxDynamicSharedMemorySize, LDS_BYTES) != hipSuccess) { fprintf(stderr, "kernel_launch: hipFuncSetAttribute failed\n"); grid = -1; return; }
        hipOccupancyMaxActiveBlocksPerMultiprocessor(&per_cu, (const void*)mega, 512, LDS_BYTES);
        (void)hipGetLastError();
        if (per_cu < 1) fprintf(stderr, "kernel_launch: occupancy query says %d blocks/CU\n", per_cu);
        grid = cus > 0 ? cus : 256;
    }
    if (grid < 0) return;
    hipMemsetAsync((char*)d_ws + WS_CTL, 0, CTL_ZERO_BYTES, stream);
    Args a{};
    for (int i = 0; i < 22; ++i) a.in[i] = (const float*)d_in[i];
    a.out = (float*)d_out; a.ws = (unsigned char*)d_ws; a.ph_lo = 0; a.ph_hi = NPHASE;
    void* args[] = {&a};
    hipError_t e = hipLaunchCooperativeKernel((const void*)mega, dim3(grid), dim3(512), args, LDS_BYTES, stream);
    if (e != hipSuccess) fprintf(stderr, "kernel_launch: cooperative launch failed: %s (grid %d)\n", hipGetErrorString(e), grid);
}
```

```cpp
#include <hip/hip_runtime.h>
#include <hip/hip_cooperative_groups.h>
#include <cstdio>
#include <cstdint>
namespace cg = cooperative_groups;

#define LAS __attribute__((address_space(3)))
typedef unsigned short bf16_t;
typedef short bf16x8 __attribute__((ext_vector_type(8)));
typedef float f32x4 __attribute__((ext_vector_type(4)));
typedef float f32x2 __attribute__((ext_vector_type(2)));
typedef unsigned u32x4 __attribute__((ext_vector_type(4)));
typedef unsigned u32x2 __attribute__((ext_vector_type(2)));

constexpr int DM = 2048, MLAT = 16384, MT = 17408;
constexpr int INW = 10752, DFF = 5632, UPW = 11264;
constexpr int OFF_Q = 512, OFF_K = 1536, OFF_V = 2560, OFF_C = 3584, OFF_G = 4608;
constexpr float EPS = 1e-6f;
constexpr size_t MiB = 1u << 20;
constexpr size_t WS_CTL = 0;
constexpr size_t CTL_ZERO_BYTES = 1 * MiB;
constexpr size_t WS_MODS = 4096;
constexpr size_t WS_BAR = 512 * 1024;
constexpr size_t WS_DFTD = 1 * MiB;
constexpr size_t WS_XC = 2 * MiB;
constexpr size_t WS_WIN = 10 * MiB;
constexpr size_t WS_WBR = 52 * MiB;
constexpr size_t WS_WO = 60 * MiB;
constexpr size_t WS_WUP = 68 * MiB;
constexpr size_t WS_WDN = 112 * MiB;
constexpr size_t WS_XN = 134 * MiB;
constexpr size_t WS_BIG = 202 * MiB;
constexpr size_t WS_HMID = 576 * MiB;
constexpr size_t WS_ZBUF = WS_HMID;
constexpr size_t WS_TT = WS_HMID + 32 * MiB;
constexpr size_t WS_MA = WS_HMID + 36 * MiB;
constexpr size_t WS_U = WS_HMID + 64 * MiB;
constexpr size_t WS_VT = WS_HMID + 96 * MiB;
constexpr size_t WS_DFTC = WS_HMID + 128 * MiB;
constexpr size_t WS_PQTC = WS_HMID + 132 * MiB;
constexpr size_t WS_VTC = WS_HMID + 164 * MiB;
constexpr size_t WS_TMP = WS_HMID;
constexpr size_t WS_END = 763 * MiB;
constexpr int LDS_BYTES = 163840, LDS_XST = 163840 - 64;

#define LDS_WAIT() asm volatile("s_waitcnt lgkmcnt(0)" ::: "memory")
__device__ __forceinline__ unsigned cvt_pk_bf16(float lo, float hi) { unsigned r; asm volatile("v_cvt_pk_bf16_f32 %0, %1, %2" : "=v"(r) : "v"(lo), "v"(hi)); return r; }
__device__ __forceinline__ int fresh_lane() { unsigned z; asm volatile("v_mov_b32 %0, 0" : "=v"(z)); return (int)__builtin_amdgcn_mbcnt_hi(~0u, __builtin_amdgcn_mbcnt_lo(~0u, z)); }
__device__ __forceinline__ float bf2f(unsigned short b) { return __uint_as_float((unsigned)b << 16); }
__device__ __forceinline__ float bflo(unsigned w) { return __uint_as_float(w << 16); }
__device__ __forceinline__ float bfhi(unsigned w) { return __uint_as_float(w & 0xffff0000u); }
__device__ __forceinline__ float shx(float v, int o, int lane) { return __int_as_float(__builtin_amdgcn_ds_bpermute((lane ^ o) << 2, __float_as_int(v))); }
__device__ __forceinline__ float wave_sum(float v, int lane) {
#pragma unroll
    for (int o = 1; o < 64; o <<= 1) v += shx(v, o, lane);
    return v;
}
__device__ __forceinline__ float fsigmoid(float x) { return __builtin_amdgcn_rcpf(1.0f + __builtin_amdgcn_exp2f(-1.44269504089f * x)); }
__device__ __forceinline__ float fsilu(float x) { return x * fsigmoid(x); }
__device__ __forceinline__ f32x2 gelu_pk(f32x2 v) {
    const f32x2 av = __builtin_elementwise_abs(v), d = av * 0.2316418882f + 1.0f;
    f32x2 t; t.x = __builtin_amdgcn_rcpf(d.x); t.y = __builtin_amdgcn_rcpf(d.y);
    f32x2 q = t * 0.5307027145f + (-0.7265760135f); q = q * t + 0.7107068705f; q = q * t + (-0.142248368f); q = q * t + 0.127414796f; q = q * t;
    const f32x2 s = (v * v) * (-0.72134752044f);
    f32x2 e; e.x = __builtin_amdgcn_exp2f(s.x); e.y = __builtin_amdgcn_exp2f(s.y);
    const f32x2 m = v * (q * e), r = v - m;
    f32x2 o; o.x = v.x < 0.f ? m.x : r.x; o.y = v.y < 0.f ? m.y : r.y; return o;
}

namespace pg8 {
constexpr int BM = 256, BK = 64, HALF = 128, HTB = HALF * BK * 2, STAGE_BYTES = 8 * HTB, NXCD = 8, WGM = 8;
__host__ __device__ __forceinline__ int lds_byte(int r, int c) { const int st = (r >> 4) * 2 + (c >> 5), rr = r & 15, cc = c & 31, ob = rr * 64 + cc * 2; return st * 1024 + (ob ^ (((ob >> 9) & 1) << 5)); }
__host__ __device__ __forceinline__ void stage_rc(int b, int& R, int& C) { const int st = b / 1024, sb = b % 1024, swz = sb ^ (((sb >> 9) & 1) << 5); R = (st >> 1) * 16 + swz / 64; C = (st & 1) * 32 + (swz % 64) / 2; }
__host__ __device__ __forceinline__ int perm32(int rho) { const int n = rho >> 4, i = rho & 15; return 8 * (i >> 2) + 4 * n + (i & 3); }

struct Unit { const char* A; const char* B; int nt, pm, pn, aux; };

struct StaticOrder {
    int nM, nN, nwg, G, c;
    __device__ void init(int nM_, int nN_, int G_, int c_) { nM = nM_; nN = nN_; nwg = nM * nN; G = G_; c = c_; }
    __device__ bool next(int i, int& pm, int& pn) const {
        const long L = (long)i * G + c; if (L >= nwg) return false;
        int wgid = (int)L; { const int q = nwg / NXCD, r = nwg % NXCD, xcd = wgid % NXCD, off = wgid / NXCD; wgid = (xcd < r ? xcd * (q + 1) : r * (q + 1) + (xcd - r) * q) + off; }
        const int nig = WGM * nN, gid = wgid / nig, fm = gid * WGM, gsz = (nM - fm) < WGM ? (nM - fm) : WGM;
        pm = fm + ((wgid % nig) % gsz); pn = (wgid % nig) / gsz; return true;
    }
};

template <class Epi, class Sched>
__device__ __forceinline__ void gemm_phase(LAS unsigned char* lds, const int tid, const int lda, const int ldb, const Sched& S, const Epi& E) {
    const int wid = __builtin_amdgcn_readfirstlane(tid >> 6), lane = tid & 63, wr = wid >> 2, wc = wid & 3, fr = lane & 15, fq = lane >> 4;
    unsigned voffA[2], voffB[2];
#pragma unroll
    for (int i = 0; i < 2; ++i) { int R, C; stage_rc(tid * 16 + i * 8192, R, C); const int Rb = Epi::PERM ? ((R & ~31) + perm32(R & 31)) : R;
        voffA[i] = (unsigned)(R * lda + C) * 2u; voffB[i] = (unsigned)(Sched::brow(Rb) * ldb + C) * 2u; }
    const size_t kstep = (size_t)(BK * 2);
    const size_t hstepA = (size_t)HALF * lda * 2, hstepB = (size_t)Sched::BH * ldb * 2;
    const unsigned ldsw = (unsigned)wid * 1024u;
    const int aoff = lds_byte(wr * 64 + fr, fq * 8), boff = lds_byte(wc * 32 + fr, fq * 8);
#define PG8_SA(b, h) (((b) * 2 + (h)) * HTB)
#define PG8_SB(b, h) ((4 + (b) * 2 + (h)) * HTB)
#define PG8_STAGE(bufoff, gbase, voff) do { _Pragma("unroll") for (int _i = 0; _i < 2; ++_i) \
        __builtin_amdgcn_global_load_lds((const unsigned*)((const char*)(gbase) + (voff)[_i]), (LAS unsigned*)(lds + (bufoff) + ldsw + _i * 8192), 16, 0, 0); } while (0)
#define PG8_LDA(dst, b, h) do { _Pragma("unroll") for (int m = 0; m < 4; ++m) _Pragma("unroll") for (int k = 0; k < 2; ++k) dst[m][k] = *(const LAS bf16x8*)(lds + PG8_SA(b, h) + aoff + m * 2048 + k * 1024); } while (0)
#define PG8_LDB(dst, b, h) do { _Pragma("unroll") for (int n = 0; n < 2; ++n) _Pragma("unroll") for (int k = 0; k < 2; ++k) dst[n][k] = *(const LAS bf16x8*)(lds + PG8_SB(b, h) + boff + n * 2048 + k * 1024); } while (0)
#define PG8_MMA(ai, bj, At, Bt) do { __builtin_amdgcn_s_setprio(1); _Pragma("unroll") for (int m = 0; m < 4; ++m) _Pragma("unroll") for (int n = 0; n < 2; ++n) _Pragma("unroll") for (int k = 0; k < 2; ++k) \
        acc[ai][bj][m][n] = __builtin_amdgcn_mfma_f32_16x16x32_bf16(Bt[n][k], At[m][k], acc[ai][bj][m][n], 0, 0, 0); __builtin_amdgcn_s_setprio(0); } while (0)
#define PG8_WAIT_V(n) asm volatile("s_waitcnt vmcnt(" #n ")" ::: "memory")
#define PG8_WAIT_L(n) asm volatile("s_waitcnt lgkmcnt(" #n ")" ::: "memory")
#define PG8_BAR __builtin_amdgcn_s_barrier()
#define PG8_SCHED __builtin_amdgcn_sched_barrier(0)
    Unit cur, nxt; int ui = 0;
    if (!S.next(0, cur)) return;
    f32x4 acc[2][2][4][2];
#pragma unroll
    for (int a = 0; a < 2; ++a)
#pragma unroll
        for (int b = 0; b < 2; ++b)
#pragma unroll
            for (int m = 0; m < 4; ++m)
#pragma unroll
                for (int n = 0; n < 2; ++n) acc[a][b][m][n] = (f32x4){0.f, 0.f, 0.f, 0.f};
    bf16x8 At[4][2], B0[2][2], B1[2][2];
    const char* cA = cur.A; const char* cB = cur.B;
    {
        PG8_STAGE(PG8_SB(0, 0), cB, voffB); PG8_STAGE(PG8_SB(0, 1), cB + hstepB, voffB); PG8_STAGE(PG8_SA(0, 0), cA, voffA); PG8_STAGE(PG8_SA(0, 1), cA + hstepA, voffA);
        if (wr == 1) PG8_BAR;
        PG8_WAIT_V(2); PG8_BAR;
        PG8_STAGE(PG8_SB(1, 0), cB + kstep, voffB); PG8_STAGE(PG8_SA(1, 0), cA + kstep, voffA); PG8_STAGE(PG8_SB(1, 1), cB + hstepB + kstep, voffB);
        PG8_WAIT_V(6); PG8_BAR;
    }
    for (;;) {
        const bool has_next = S.next(ui + 1, nxt);
        const char* nA = has_next ? nxt.A : cA; const char* nB = has_next ? nxt.B : cB;
        const int nt = cur.nt;
        for (int t = 0; t < nt; t += 2) {
            const bool last = (t == nt - 2);
            const char* a1 = cA + (size_t)(t + 1) * kstep;
            const char* a2 = last ? nA : cA + (size_t)(t + 2) * kstep; const char* b2 = last ? nB : cB + (size_t)(t + 2) * kstep;
            const char* a3 = a2 + kstep; const char* b3 = b2 + kstep;
            PG8_LDB(B0, 0, 0); PG8_LDB(B1, 0, 1); PG8_SCHED; PG8_LDA(At, 0, 0); PG8_STAGE(PG8_SA(1, 1), a1 + hstepA, voffA);
            PG8_WAIT_V(8); PG8_WAIT_L(0); PG8_BAR; PG8_MMA(0, 0, At, B0); PG8_MMA(0, 1, At, B1); PG8_BAR; PG8_SCHED;
            PG8_LDA(At, 0, 1); PG8_STAGE(PG8_SB(0, 0), b2, voffB); PG8_STAGE(PG8_SB(0, 1), b2 + hstepB, voffB); PG8_STAGE(PG8_SA(0, 0), a2, voffA);
            PG8_WAIT_V(8); PG8_WAIT_L(0); PG8_BAR; PG8_MMA(1, 0, At, B0); PG8_MMA(1, 1, At, B1); PG8_BAR; PG8_SCHED;
            PG8_LDB(B0, 1, 0); PG8_LDB(B1, 1, 1); PG8_SCHED; PG8_LDA(At, 1, 0); PG8_STAGE(PG8_SA(0, 1), a2 + hstepA, voffA);
            PG8_WAIT_V(8); PG8_WAIT_L(0); PG8_BAR; PG8_MMA(0, 0, At, B0); PG8_MMA(0, 1, At, B1); PG8_BAR; PG8_SCHED;
            PG8_LDA(At, 1, 1); PG8_STAGE(PG8_SB(1, 0), b3, voffB); PG8_STAGE(PG8_SB(1, 1), b3 + hstepB, voffB); PG8_STAGE(PG8_SA(1, 0), a3, voffA);
            PG8_WAIT_V(8); PG8_WAIT_L(0); PG8_BAR; PG8_MMA(1, 0, At, B0); PG8_MMA(1, 1, At, B1); PG8_BAR; PG8_SCHED;
        }
        if (wr == 0) PG8_BAR;
        E(acc, cur, wr, wc);
        if (!has_next) break;
        if (!Epi::CHAIN || cur.aux == 2) {
#pragma unroll
        for (int a = 0; a < 2; ++a)
#pragma unroll
            for (int b = 0; b < 2; ++b)
#pragma unroll
                for (int m = 0; m < 4; ++m)
#pragma unroll
                    for (int n = 0; n < 2; ++n) acc[a][b][m][n] = (f32x4){0.f, 0.f, 0.f, 0.f};
        }
        cur = nxt; cA = nA; cB = nB; ++ui;
        if (wr == 1) PG8_BAR;
    }
    PG8_WAIT_V(0);
    PG8_BAR;
#undef PG8_SA
#undef PG8_SB
#undef PG8_STAGE
#undef PG8_LDA
#undef PG8_LDB
#undef PG8_MMA
#undef PG8_WAIT_V
#undef PG8_WAIT_L
#undef PG8_BAR
#undef PG8_SCHED
}
}
using pg8::Unit;
typedef const f32x4 (&AccRef)[2][2][4][2];

struct SchedGrid {
    static __device__ __forceinline__ int brow(int r) { return r; } static constexpr int BH = 128;
    pg8::StaticOrder so; const char* A; const char* B; size_t tsA, tsB; int nt, nextra, ex_pm0, ex_pn0, ex_w, ex_ks;
    __device__ __forceinline__ bool next(int i, Unit& u) const {
        int pm, pn; int kp = 0, ntu = nt, aux = 0;
        if (!so.next(i, pm, pn)) { const long e = (long)i * so.G + so.c - so.nwg; if (e >= nextra) return false; const int te = (int)e / ex_ks; kp = (int)e % ex_ks; ntu = nt / ex_ks; aux = ex_ks > 1 ? 1 : 0;
            pm = ex_pm0 + te / ex_w; pn = ex_pn0 + te % ex_w; }
        u.A = A + (size_t)pm * tsA + (size_t)kp * ntu * 128; u.B = B + (size_t)pn * tsB + (size_t)kp * ntu * 128; u.nt = ntu; u.pm = pm; u.pn = pn; u.aux = aux; return true;
    }
};
struct SchedBranch {
    static __device__ __forceinline__ int brow(int r) { return r; } static constexpr int BH = 128;
    pg8::StaticOrder so; const char* proj; const char* wbr;
    __device__ __forceinline__ bool next(int i, Unit& u) const {
        int pm, pn; if (!so.next(i / 3, pm, pn)) return false;
        const int br = i % 3; const int acol = br == 0 ? 0 : (br == 1 ? OFF_Q : OFF_C), koff = br == 0 ? 0 : (br == 1 ? 512 : 1536);
        u.A = proj + ((size_t)pm * 256 * INW + acol) * 2; u.B = wbr + ((size_t)pn * 256 * DM + koff) * 2; u.nt = br == 1 ? 16 : 8; u.pm = pm; u.pn = pn; u.aux = br; return true;
    }
};
struct SchedF1L {
    static __device__ __forceinline__ int brow(int r) { return (r >> 6) + 64 * (r & 63); } static constexpr int BH = 2;
    const char* dftd; const char* proj; int G, c;
    __device__ __forceinline__ bool next(int i, Unit& u) const {
        const int L = i * G + c; if (L >= 256) return false;
        { const char* ap = dftd; asm volatile("" : "+s"(ap)); u.A = ap; } u.nt = 2; u.pm = 0;
        const int b = L >> 6, g = (L >> 4) & 3, pn = L & 15; u.B = proj + ((size_t)(b * 4096 + 4 * pn) * INW + g * 128) * 2; u.pn = pn; u.aux = b * 4 + g; return true;
    }
};
struct SchedF1 {
    static __device__ __forceinline__ int brow(int r) { return r; } static constexpr int BH = 128;
    const char* dftd; const char* proj; int G, c, nctx;
    __device__ __forceinline__ bool next(int i, Unit& u) const {
        const int e = i * G + c; if (e >= nctx) return false;
        { const char* ap = dftd; asm volatile("" : "+s"(ap)); u.A = ap; } u.nt = 2; u.pm = 0;
        const int b = e >> 2, g = e & 3; u.B = proj + ((size_t)(MLAT + b * 256) * INW + g * 128) * 2; u.pn = 0; u.aux = 16 + b * 4 + g; return true;
    }
};
struct SchedF2 {
    static __device__ __forceinline__ int brow(int r) { return r; } static constexpr int BH = 128;
    const char* dftc; const char* pqtc; int G, c, nctx;
    __device__ __forceinline__ bool next(int i, Unit& u) const {
        const int e = i * G + c; if (e >= nctx) return false;
        const int b = e >> 1, pn = e & 1; { const char* ap = dftc; asm volatile("" : "+s"(ap)); u.A = ap; } u.B = pqtc + (size_t)(b * 512 + pn * 256) * 8192 * 2; u.nt = 8; u.pm = 0; u.pn = pn; u.aux = 4 + b; return true;
    }
};
struct SchedFA {
    static __device__ __forceinline__ int brow(int r) { return r; } static constexpr int BH = 128;
    const char* ma; const char* ub; int G, c;
    __device__ __forceinline__ bool next(int i, Unit& u) const {
        const int L = i * G + c; if (L >= 512) return false;
        { const char* ap = ma; asm volatile("" : "+s"(ap)); u.A = ap; } u.B = ub + (size_t)L * 256 * 128 * 2; u.nt = 2; u.pm = 0; u.pn = L; u.aux = 0; return true;
    }
};
struct SchedFB {
    static __device__ __forceinline__ int brow(int r) { return r; } static constexpr int BH = 128;
    const char* tt; const char* zb; int G, c;
    __device__ __forceinline__ bool next(int i, Unit& u) const {
        const int L = i * G + c; if (L >= 512) return false;
        const int k2 = L >> 3, pn = L & 7; u.A = tt + (size_t)k2 * 256 * 128 * 2; u.B = zb + ((size_t)k2 * 2048 + pn * 256) * 128 * 2; u.nt = 2; u.pm = 0; u.pn = pn; u.aux = k2; return true;
    }
};

struct EpiInProj {
    static constexpr bool PERM = true, CHAIN = false;
    bf16_t* proj; bf16_t* vt; bf16_t* vtc;
    __device__ __forceinline__ void operator()(AccRef acc, const Unit& u, int wr, int wc) const {
        const int ln_ = fresh_lane(), fr = ln_ & 15, fq = ln_ >> 4;
        const int pm = u.pm, pn = u.pn; const int row0 = pm * 256 + wr * 64 + fr, col0 = pn * 256 + wc * 32 + 8 * fq;
        if (pn >= 10 && pn < 14) {
            const int vc0 = col0 - OFF_V;
#pragma unroll
            for (int ai = 0; ai < 2; ++ai)
#pragma unroll
                for (int m = 0; m < 4; ++m) {
                    const int row = row0 + ai * 128 + m * 16; bf16_t* dst; size_t stride;
                    if (pm < 64) { const int b = pm >> 4; dst = vt + (size_t)b * 1024 * 4096 + (row - b * 4096); stride = 4096; }
                    else { const int b = pm - 64; dst = vtc + (size_t)b * 1024 * 256 + (row - MLAT - b * 256); stride = 256; }
#pragma unroll
                    for (int bj = 0; bj < 2; ++bj)
#pragma unroll
                        for (int n = 0; n < 2; ++n) { const f32x4 v = acc[ai][bj][m][n]; const unsigned w0 = cvt_pk_bf16(v[0], v[1]), w1 = cvt_pk_bf16(v[2], v[3]);
                            bf16_t* d = dst + (size_t)(vc0 + bj * 128 + n * 4) * stride;
                            d[0] = (bf16_t)(w0 & 0xffffu); d[stride] = (bf16_t)(w0 >> 16); d[2 * stride] = (bf16_t)(w1 & 0xffffu); d[3 * stride] = (bf16_t)(w1 >> 16); }
                }
            return;
        }
        const int act = pn < 14 ? 0 : (pn < 18 ? 1 : 2); const float sc = (pn >= 2 && pn < 6) ? 0.08838834764831845f : 1.0f;
#pragma unroll
        for (int ai = 0; ai < 2; ++ai)
#pragma unroll
            for (int m = 0; m < 4; ++m) { bf16_t* rowp = proj + (size_t)(row0 + ai * 128 + m * 16) * INW + col0;
#pragma unroll
                for (int bj = 0; bj < 2; ++bj) { f32x4 v0 = acc[ai][bj][m][0], v1 = acc[ai][bj][m][1];
                    if (act == 1) { f32x2 a = gelu_pk((f32x2){v0[0], v0[1]}), b = gelu_pk((f32x2){v0[2], v0[3]}), c = gelu_pk((f32x2){v1[0], v1[1]}), d = gelu_pk((f32x2){v1[2], v1[3]});
                        v0 = (f32x4){a.x, a.y, b.x, b.y}; v1 = (f32x4){c.x, c.y, d.x, d.y}; }
                    else if (act == 2) { v0 = (f32x4){fsigmoid(v0[0]), fsigmoid(v0[1]), fsigmoid(v0[2]), fsigmoid(v0[3])}; v1 = (f32x4){fsigmoid(v1[0]), fsigmoid(v1[1]), fsigmoid(v1[2]), fsigmoid(v1[3])}; }
                    else { v0 = v0 * sc; v1 = v1 * sc; }
                    u32x4 w; w.x = cvt_pk_bf16(v0[0], v0[1]); w.y = cvt_pk_bf16(v0[2], v0[3]); w.z = cvt_pk_bf16(v1[0], v1[1]); w.w = cvt_pk_bf16(v1[2], v1[3]);
                    *(u32x4*)(rowp + bj * 128) = w; } }
    }
};
struct EpiPlain {
    static constexpr bool PERM = true, CHAIN = false;
    bf16_t* out; int ld;
    __device__ __forceinline__ void operator()(AccRef acc, const Unit& u, int wr, int wc) const {
        const int ln_ = fresh_lane(), fr = ln_ & 15, fq = ln_ >> 4;
        const int row0 = u.pm * 256 + wr * 64 + fr, col0 = u.pn * 256 + wc * 32 + 8 * fq;
#pragma unroll
        for (int ai = 0; ai < 2; ++ai)
#pragma unroll
            for (int m = 0; m < 4; ++m) { bf16_t* rowp = out + (size_t)(row0 + ai * 128 + m * 16) * ld + col0;
#pragma unroll
                for (int bj = 0; bj < 2; ++bj) { const f32x4 v0 = acc[ai][bj][m][0], v1 = acc[ai][bj][m][1];
                    u32x4 w; w.x = cvt_pk_bf16(v0[0], v0[1]); w.y = cvt_pk_bf16(v0[2], v0[3]); w.z = cvt_pk_bf16(v1[0], v1[1]); w.w = cvt_pk_bf16(v1[2], v1[3]);
                    *(u32x4*)(rowp + bj * 128) = w; } }
    }
};
struct EpiF1 {
    static constexpr bool PERM = true, CHAIN = false;
    bf16_t* pqt; bf16_t* pqtc;
    __device__ __forceinline__ void operator()(AccRef acc, const Unit& u, int wr, int wc) const {
        const int ln_ = fresh_lane(), fr = ln_ & 15, fq = ln_ >> 4;
        const int aux = u.aux; const bool isc = aux >= 16; const int bg = aux & 15, b = bg >> 2, g = bg & 3;
        bf16_t* base = (isc ? pqtc : pqt) + (size_t)(b * 512 + g * 128) * 8192; const int half = isc ? 256 : 4096;
        const int n0 = u.pn * 256 + wc * 32 + 8 * fq;
#pragma unroll
        for (int ai = 0; ai < 2; ++ai)
#pragma unroll
            for (int m = 0; m < 4; ++m) { bf16_t* rowp = base + (size_t)(wr * 64 + m * 16 + fr) * 8192 + ai * half + n0;
#pragma unroll
                for (int bj = 0; bj < 2; ++bj) { const f32x4 v0 = acc[ai][bj][m][0], v1 = acc[ai][bj][m][1];
                    u32x4 w; w.x = cvt_pk_bf16(v0[0], v0[1]); w.y = cvt_pk_bf16(v0[2], v0[3]); w.z = cvt_pk_bf16(v1[0], v1[1]); w.w = cvt_pk_bf16(v1[2], v1[3]);
                    *(u32x4*)(rowp + bj * 128) = w; } }
    }
};
struct EpiF1L {
    static constexpr bool PERM = true, CHAIN = false;
    bf16_t* ub;
    __device__ __forceinline__ void operator()(AccRef acc, const Unit& u, int wr, int wc) const {
        const int ln_ = fresh_lane(), fr = ln_ & 15, fq = ln_ >> 4;
        const int b = u.aux >> 2, g = u.aux & 3;
#pragma unroll
        for (int ai = 0; ai < 2; ++ai)
#pragma unroll
            for (int m = 0; m < 4; ++m) { const int ch = b * 512 + g * 128 + wr * 64 + m * 16 + fr;
#pragma unroll
                for (int bj = 0; bj < 2; ++bj) { const int n1 = 4 * u.pn + 2 * bj + (wc >> 1), n2 = 32 * (wc & 1) + 8 * fq;
                    const f32x4 v0 = acc[ai][bj][m][0], v1 = acc[ai][bj][m][1];
                    u32x4 w; w.x = cvt_pk_bf16(v0[0], v0[1]); w.y = cvt_pk_bf16(v0[2], v0[3]); w.z = cvt_pk_bf16(v1[0], v1[1]); w.w = cvt_pk_bf16(v1[2], v1[3]);
                    *(u32x4*)(ub + ((size_t)ch * 64 + n1) * 128 + ai * 64 + n2) = w; } }
    }
};
struct EpiFA {
    static constexpr bool PERM = true, CHAIN = false;
    bf16_t* zb;
    __device__ __forceinline__ void operator()(AccRef acc, const Unit& u, int wr, int wc) const {
        if (wr != 0) return;
        const int ln_ = fresh_lane(), fr = ln_ & 15, fq = ln_ >> 4;
#pragma unroll
        for (int ai = 0; ai < 2; ++ai)
#pragma unroll
            for (int m = 0; m < 4; ++m) { const int k2 = m * 16 + fr;
#pragma unroll
                for (int bj = 0; bj < 2; ++bj) { const int bc = u.pn * 4 + 2 * bj + (wc >> 1), n1 = 32 * (wc & 1) + 8 * fq;
                    const f32x4 v0 = acc[ai][bj][m][0], v1 = acc[ai][bj][m][1];
                    u32x4 w; w.x = cvt_pk_bf16(v0[0], v0[1]); w.y = cvt_pk_bf16(v0[2], v0[3]); w.z = cvt_pk_bf16(v1[0], v1[1]); w.w = cvt_pk_bf16(v1[2], v1[3]);
                    *(u32x4*)(zb + ((size_t)k2 * 2048 + bc) * 128 + ai * 64 + n1) = w; } }
    }
};
struct EpiFB {
    static constexpr bool PERM = true, CHAIN = false;
    bf16_t* proj;
    __device__ __forceinline__ void operator()(AccRef acc, const Unit& u, int wr, int wc) const {
        if (wr != 0) return;
        const int ln_ = fresh_lane(), fr = ln_ & 15, fq = ln_ >> 4;
        const float sc = 0.0013810679320049757f; const int k2 = u.aux;
#pragma unroll
        for (int m = 0; m < 4; ++m) { const int k = 64 * (m * 16 + fr) + k2;
#pragma unroll
            for (int bj = 0; bj < 2; ++bj) { const int ncol = u.pn * 256 + 128 * bj + 32 * wc + 8 * fq; const int b = ncol >> 9, ch = ncol & 511;
                const f32x4 v0 = acc[0][bj][m][0] * sc, v1 = acc[0][bj][m][1] * sc;
                u32x4 w; w.x = cvt_pk_bf16(v0[0], v0[1]); w.y = cvt_pk_bf16(v0[2], v0[3]); w.z = cvt_pk_bf16(v1[0], v1[1]); w.w = cvt_pk_bf16(v1[2], v1[3]);
                *(u32x4*)(proj + (size_t)(b * 4096 + k) * INW + ch) = w; } }
    }
};
struct EpiF2 {
    static constexpr bool PERM = true, CHAIN = false;
    bf16_t* proj;
    __device__ __forceinline__ void operator()(AccRef acc, const Unit& u, int wr, int wc) const {
        const int ln_ = fresh_lane(), fr = ln_ & 15, fq = ln_ >> 4;
        const int aux = u.aux; const bool isc = aux >= 4; const int rowbase = isc ? MLAT + (aux - 4) * 256 : aux * 4096;
        const float sc = isc ? 0.005524271728019903f : 0.0013810679320049757f;
        const int row0 = rowbase + u.pm * 256 + wr * 64 + fr, col0 = u.pn * 256 + wc * 32 + 8 * fq;
#pragma unroll
        for (int ai = 0; ai < 2; ++ai)
#pragma unroll
            for (int m = 0; m < 4; ++m) { bf16_t* rowp = proj + (size_t)(row0 + ai * 128 + m * 16) * INW + col0;
#pragma unroll
                for (int bj = 0; bj < 2; ++bj) { const f32x4 v0 = acc[ai][bj][m][0] * sc, v1 = acc[ai][bj][m][1] * sc;
                    u32x4 w; w.x = cvt_pk_bf16(v0[0], v0[1]); w.y = cvt_pk_bf16(v0[2], v0[3]); w.z = cvt_pk_bf16(v1[0], v1[1]); w.w = cvt_pk_bf16(v1[2], v1[3]);
                    *(u32x4*)(rowp + bj * 128) = w; } }
    }
};
typedef f32x4 (&AccMut)[2][2][4][2];
struct EpiBranch {
    static constexpr bool PERM = true, CHAIN = true;
    const bf16_t* proj; bf16_t* merged;
    __device__ __forceinline__ void operator()(AccMut acc, const Unit& u, int wr, int wc) const {
        const int ln_ = fresh_lane(), fr = ln_ & 15, fq = ln_ >> 4;
        const int br = u.aux; const int col0 = u.pn * 256 + wc * 32 + 8 * fq;
#pragma unroll
        for (int ai = 0; ai < 2; ++ai)
#pragma unroll
            for (int m = 0; m < 4; ++m) { const size_t row = (size_t)(u.pm * 256 + ai * 128 + wr * 64 + m * 16 + fr);
#pragma unroll
                for (int bj = 0; bj < 2; ++bj) { const int col = col0 + bj * 128;
                    const bf16_t* gp = proj + row * INW + OFF_G + br * DM + col;
                    const u32x4 gw = *(const u32x4*)gp;
                    const f32x4 g0 = (f32x4){bflo(gw.x), bfhi(gw.x), bflo(gw.y), bfhi(gw.y)}, g1 = (f32x4){bflo(gw.z), bfhi(gw.z), bflo(gw.w), bfhi(gw.w)};
                    if (br < 2) { const u32x4 hw = *(const u32x4*)(gp + DM);
                        const f32x4 r0 = (f32x4){__builtin_amdgcn_rcpf(fmaxf(bflo(hw.x), 1e-30f)), __builtin_amdgcn_rcpf(fmaxf(bfhi(hw.x), 1e-30f)), __builtin_amdgcn_rcpf(fmaxf(bflo(hw.y), 1e-30f)), __builtin_amdgcn_rcpf(fmaxf(bfhi(hw.y), 1e-30f))};
                        const f32x4 r1 = (f32x4){__builtin_amdgcn_rcpf(fmaxf(bflo(hw.z), 1e-30f)), __builtin_amdgcn_rcpf(fmaxf(bfhi(hw.z), 1e-30f)), __builtin_amdgcn_rcpf(fmaxf(bflo(hw.w), 1e-30f)), __builtin_amdgcn_rcpf(fmaxf(bfhi(hw.w), 1e-30f))};
                        acc[ai][bj][m][0] = acc[ai][bj][m][0] * (g0 * r0); acc[ai][bj][m][1] = acc[ai][bj][m][1] * (g1 * r1); }
                    else { const f32x4 v0 = acc[ai][bj][m][0] * g0, v1 = acc[ai][bj][m][1] * g1;
                        u32x4 w; w.x = cvt_pk_bf16(v0[0], v0[1]); w.y = cvt_pk_bf16(v0[2], v0[3]); w.z = cvt_pk_bf16(v1[0], v1[1]); w.w = cvt_pk_bf16(v1[2], v1[3]);
                        *(u32x4*)(merged + row * DM + col) = w; } } }
    }
};
struct EpiResid {
    static constexpr bool PERM = false, CHAIN = false;
    const float* src_lat; const float* src_ctx; float* dst_lat; float* dst_ctx; const float* gate;
    LAS unsigned char* lds;
    __device__ __forceinline__ void operator()(AccRef acc, const Unit& u, int wr, int wc) const {
        const int ln_ = fresh_lane(), fr = ln_ & 15, fq = ln_ >> 4;
        const int pm = u.pm; const int b = pm < 64 ? (pm >> 4) : 4; const float* g = gate + (size_t)b * 12288;
        const float* s0 = pm < 64 ? src_lat + (size_t)pm * 256 * DM : src_ctx + (size_t)(pm - 64) * 256 * DM;
        float* d0 = pm < 64 ? dst_lat + (size_t)pm * 256 * DM : dst_ctx + (size_t)(pm - 64) * 256 * DM;
        if (u.aux) {
            const int col0 = u.pn * 256 + wc * 32 + 4 * fq;
#pragma unroll
            for (int ai = 0; ai < 2; ++ai)
#pragma unroll
                for (int m = 0; m < 4; ++m) { const size_t ro = (size_t)(ai * 128 + wr * 64 + m * 16 + fr) * DM;
#pragma unroll
                    for (int bj = 0; bj < 2; ++bj)
#pragma unroll
                        for (int n = 0; n < 2; ++n) { const int col = col0 + bj * 128 + n * 16; const f32x4 v = *(const f32x4*)(g + col) * acc[ai][bj][m][n]; float* d = d0 + ro + col;
                            unsafeAtomicAdd(d, v[0]); unsafeAtomicAdd(d + 1, v[1]); unsafeAtomicAdd(d + 2, v[2]); unsafeAtomicAdd(d + 3, v[3]); } }
            return;
        }
        LAS float* sc = (LAS float*)(lds + 131072 + (wr * 4 + wc) * 2048);
        const int rrow = ln_ >> 3, rc = (ln_ & 7) * 4;
        f32x4 gr[2];
#pragma unroll
        for (int bj = 0; bj < 2; ++bj) gr[bj] = *(const f32x4*)(g + u.pn * 256 + bj * 128 + wc * 32 + rc);
#pragma unroll
        for (int ai = 0; ai < 2; ++ai)
#pragma unroll
            for (int m = 0; m < 4; ++m)
#pragma unroll
                for (int bj = 0; bj < 2; ++bj) {
                    *(LAS f32x4*)(sc + fr * 32 + 4 * fq) = acc[ai][bj][m][0]; *(LAS f32x4*)(sc + fr * 32 + 16 + 4 * fq) = acc[ai][bj][m][1];
                    asm volatile("s_waitcnt lgkmcnt(0)" ::: "memory");
#pragma unroll
                    for (int i = 0; i < 2; ++i) { const int row = rrow + 8 * i; const f32x4 v = *(const LAS f32x4*)(sc + row * 32 + rc);
                        const size_t off = (size_t)(ai * 128 + wr * 64 + m * 16 + row) * DM + u.pn * 256 + bj * 128 + wc * 32 + rc;
                        *(f32x4*)(d0 + off) = *(const f32x4*)(s0 + off) + gr[bj] * v; }
                    asm volatile("s_waitcnt lgkmcnt(0)" ::: "memory");
                }
    }
};

struct EpiUpConv {
    static constexpr bool PERM = true, CHAIN = false;
    bf16_t* hmid; float* sb; const float* cw; const float* cbias;
    __device__ __forceinline__ void operator()(AccRef acc, const Unit& u, int wr, int wc) const {
        const int ln_ = fresh_lane(), fr = ln_ & 15, fq = ln_ >> 4;
        const int pm = u.pm, ch0 = u.pn * 128 + wc * 32 + 8 * fq;
        const int ip = ((ln_ & 48) | ((fr + 15) & 15)) << 2, in = ((ln_ & 48) | ((fr + 1) & 15)) << 2;
        f32x4 w0[2], w1[2], w2[2], cb[2];
#pragma unroll
        for (int n = 0; n < 2; ++n) { w0[n] = *(const f32x4*)(cw + ch0 + 4 * n); w1[n] = *(const f32x4*)(cw + DFF + ch0 + 4 * n); w2[n] = *(const f32x4*)(cw + 2 * DFF + ch0 + 4 * n); cb[n] = *(const f32x4*)(cbias + ch0 + 4 * n); }
#pragma unroll
        for (int ai = 0; ai < 2; ++ai) {
            const int blk = pm * 4 + ai * 2 + wr;
            float* sbb = sb + (size_t)blk * 6 * DFF + ch0;
#pragma unroll
            for (int m = 0; m < 4; ++m) {
                f32x4 o[2];
#pragma unroll
                for (int n = 0; n < 2; ++n) {
                    const f32x4 am = acc[ai][0][m][n], gm = acc[ai][1][m][n];
                    const f32x4 z = (f32x4){0.f, 0.f, 0.f, 0.f};
                    const f32x4 ap = (m > 0) ? acc[ai][0][m > 0 ? m - 1 : 0][n] : z, an = (m < 3) ? acc[ai][0][m < 3 ? m + 1 : 3][n] : z;
                    const f32x4 tp = (fr == 15) ? ap : am, tn = (fr == 0) ? an : am;
                    f32x4 pv, nv;
#pragma unroll
                    for (int e = 0; e < 4; ++e) { pv[e] = __int_as_float(__builtin_amdgcn_ds_bpermute(ip, __float_as_int(tp[e]))); nv[e] = __int_as_float(__builtin_amdgcn_ds_bpermute(in, __float_as_int(tn[e]))); }
                    const f32x4 y = cb[n] + w0[n] * pv + w1[n] * am + w2[n] * nv;
                    o[n] = (f32x4){fsilu(y[0]) * gm[0], fsilu(y[1]) * gm[1], fsilu(y[2]) * gm[2], fsilu(y[3]) * gm[3]};
                    if (m == 0 && fr == 0) { *(f32x4*)(sbb + 0 * DFF + 4 * n) = y; *(f32x4*)(sbb + 2 * DFF + 4 * n) = gm; *(f32x4*)(sbb + 4 * DFF + 4 * n) = am; }
                    if (m == 3 && fr == 15) { *(f32x4*)(sbb + 1 * DFF + 4 * n) = y; *(f32x4*)(sbb + 3 * DFF + 4 * n) = gm; *(f32x4*)(sbb + 5 * DFF + 4 * n) = am; }
                }
                u32x4 w; w.x = cvt_pk_bf16(o[0][0], o[0][1]); w.y = cvt_pk_bf16(o[0][2], o[0][3]); w.z = cvt_pk_bf16(o[1][0], o[1][1]); w.w = cvt_pk_bf16(o[1][2], o[1][3]);
                *(u32x4*)(hmid + (size_t)(pm * 256 + ai * 128 + wr * 64 + m * 16 + fr) * DFF + ch0) = w;
            }
        }
    }
};
__device__ __forceinline__ void ffn_fix_rows(bf16_t* hmid, const float* sb, const float* cw, int nblk, int gtid, int NT) {
    const int nitems = nblk * 2 * (DFF / 4);
    for (int it = gtid; it < nitems; it += NT) {
        const int c4 = (it % (DFF / 4)) * 4, bw = it / (DFF / 4), which = bw & 1, blk = bw >> 1;
        const int row0 = blk * 64; const int rel = row0 < MLAT ? (row0 & 4095) : ((row0 - MLAT) & 255), seqlen = row0 < MLAT ? 4096 : 256;
        const bool edge = which ? (rel + 64 == seqlen) : (rel == 0);
        const float* s = sb + (size_t)blk * 6 * DFF + c4;
        f32x4 y = *(const f32x4*)(s + which * DFF); const f32x4 g = *(const f32x4*)(s + (2 + which) * DFF);
        if (!edge) { const float* sn = sb + (size_t)(which ? blk + 1 : blk - 1) * 6 * DFF + c4; const f32x4 an = *(const f32x4*)(sn + (which ? 4 : 5) * DFF);
            const f32x4 w = *(const f32x4*)(cw + (which ? 2 * DFF : 0) + c4); y = y + w * an; }
        u32x2 o; o.x = cvt_pk_bf16(fsilu(y[0]) * g[0], fsilu(y[1]) * g[1]); o.y = cvt_pk_bf16(fsilu(y[2]) * g[2], fsilu(y[3]) * g[3]);
        *(u32x2*)(hmid + (size_t)(row0 + (which ? 63 : 0)) * DFF + c4) = o;
    }
}

struct Args { const float* in[22]; float* out; unsigned char* ws; int ph_lo, ph_hi; };

template <bool UPMAP = false>
__device__ __forceinline__ void transpose_item(const float* W, int N, bf16_t* WT, int ldk, int koff, LAS float* scr, int item, int lane) {
    const int nblk = N / 32, kb = item / nblk, nb = item % nblk, k0 = 64 * kb, n0 = 32 * nb;
    const int r0 = UPMAP ? (n0 < DFF ? (n0 >> 7) * 256 + (n0 & 127) : ((n0 - DFF) >> 7) * 256 + 128 + ((n0 - DFF) & 127)) : n0;
#pragma unroll 8
    for (int i = 0; i < 32; ++i) { const int kk = 2 * i + (lane >> 5); scr[kk * 33 + (lane & 31)] = W[(size_t)(k0 + kk) * N + n0 + (lane & 31)]; }
    LDS_WAIT(); asm volatile("" ::: "memory");
    const int c = lane & 7;
#pragma unroll
    for (int j = 0; j < 4; ++j) { const int n = (lane >> 3) + 8 * j; const LAS float* s = scr + (8 * c) * 33 + n;
        u32x4 o; o.x = cvt_pk_bf16(s[0 * 33], s[1 * 33]); o.y = cvt_pk_bf16(s[2 * 33], s[3 * 33]); o.z = cvt_pk_bf16(s[4 * 33], s[5 * 33]); o.w = cvt_pk_bf16(s[6 * 33], s[7 * 33]);
        *(u32x4*)(WT + (size_t)(r0 + n) * ldk + koff + k0 + 8 * c) = o; }
    LDS_WAIT(); asm volatile("" ::: "memory");
}
template <class AR>
__device__ __forceinline__ void convert_weights(const AR& a, int l, LAS float* scr, int gw, int NGW, int lane) {
    unsigned char* ws = a.ws;
    const float* w_in = a.in[8] + (size_t)l * DM * INW; const float* w_f = a.in[13] + (size_t)l * 512 * DM; const float* w_na = a.in[14] + (size_t)l * 1024 * DM;
    const float* w_c = a.in[15] + (size_t)l * 512 * DM; const float* w_o = a.in[16] + (size_t)l * DM * DM; const float* w_up = a.in[17] + (size_t)l * DM * UPW; const float* w_dn = a.in[20] + (size_t)l * DFF * DM;
    constexpr int I_IN = 32 * 336, I_F = 8 * 64, I_NA = 16 * 64, I_C = 8 * 64, I_O = 32 * 64, I_UP = 32 * 352, I_DN = 88 * 64;
    constexpr int NITEMS = I_IN + I_F + I_NA + I_C + I_O + I_UP + I_DN;
    for (int it = gw; it < NITEMS; it += NGW) {
        int r = it;
        if (r < I_IN) { transpose_item(w_in, INW, (bf16_t*)(ws + WS_WIN), DM, 0, scr, r, lane); continue; } r -= I_IN;
        if (r < I_F) { transpose_item(w_f, DM, (bf16_t*)(ws + WS_WBR), DM, 0, scr, r, lane); continue; } r -= I_F;
        if (r < I_NA) { transpose_item(w_na, DM, (bf16_t*)(ws + WS_WBR), DM, 512, scr, r, lane); continue; } r -= I_NA;
        if (r < I_C) { transpose_item(w_c, DM, (bf16_t*)(ws + WS_WBR), DM, 1536, scr, r, lane); continue; } r -= I_C;
        if (r < I_O) { transpose_item(w_o, DM, (bf16_t*)(ws + WS_WO), DM, 0, scr, r, lane); continue; } r -= I_O;
        if (r < I_UP) { transpose_item<true>(w_up, UPW, (bf16_t*)(ws + WS_WUP), DM, 0, scr, r, lane); continue; } r -= I_UP;
        transpose_item(w_dn, DM, (bf16_t*)(ws + WS_WDN), DFF, 0, scr, r, lane);
    }
}
__device__ __forceinline__ void dft_tables(unsigned char* ws, const LAS float* lut, int gw, int NGW, int lane) {
    bf16_t* tt = (bf16_t*)(ws + WS_TT); bf16_t* ma = (bf16_t*)(ws + WS_MA); bf16_t* dftc = (bf16_t*)(ws + WS_DFTC);
    const int half = lane >> 5, x0 = (lane & 31) * 2;
    for (int it = gw; it < 16384 + 256 + 256; it += NGW) {
        if (it < 16384) { const int k2 = it >> 8, k1 = it & 255; float v0 = 0.f, v1 = 0.f;
            if (k1 < 64) { const int k = 64 * k1 + k2, sh = half ? 3072 : 0;
                v0 = lut[(x0 * k + sh) & 4095]; v1 = lut[((x0 + 1) * k + sh) & 4095]; }
            *(unsigned*)(tt + (size_t)it * 128 + half * 64 + x0) = cvt_pk_bf16(v0, v1);
        } else if (it < 16384 + 256) { const int r = it - 16384; float v0 = 0.f, v1 = 0.f;
            if ((r & 64) == 0) { const int k2 = r & 63, im = r >> 7;
                const int sh = im ? (half ? 2048 : 1024) : (half ? 1024 : 0);
                v0 = lut[(((x0 * k2) & 63) * 64 + sh) & 4095]; v1 = lut[((((x0 + 1) * k2) & 63) * 64 + sh) & 4095]; }
            *(unsigned*)(ma + (size_t)r * 128 + half * 64 + x0) = cvt_pk_bf16(v0, v1);
        } else { const int k = it - 16384 - 256; const int n0 = lane * 8; const int nn = n0 & 255, sh = n0 >= 256 ? 1024 : 0; float v[8];
#pragma unroll
            for (int e = 0; e < 8; ++e) v[e] = lut[((((k * (nn + e)) & 255) * 16) + sh) & 4095];
            u32x4 w; w.x = cvt_pk_bf16(v[0], v[1]); w.y = cvt_pk_bf16(v[2], v[3]); w.z = cvt_pk_bf16(v[4], v[5]); w.w = cvt_pk_bf16(v[6], v[7]);
            *(u32x4*)(dftc + (size_t)k * 8192 + n0) = w; }
    }
}
template <class AR>
__device__ __forceinline__ void mods_items(const AR& a, int gw, int NGW, int lane) {
    float* mods = (float*)(a.ws + WS_MODS);
    for (int it = gw; it < 1536; it += NGW) {
        const int l = it / 768, rem = it % 768, cch = rem >> 4, kp = rem & 15; const int col = cch * 256 + lane * 4, k0 = kp * 128;
        float sv[5][2];
#pragma unroll
        for (int r = 0; r < 5; ++r)
#pragma unroll
            for (int i = 0; i < 2; ++i) { const int k = k0 + lane + 64 * i; const float cv = r < 4 ? a.in[1][r * DM + k] : a.in[3][k]; sv[r][i] = fsilu(cv); }
        f32x4 acc[5];
#pragma unroll
        for (int r = 0; r < 5; ++r) acc[r] = (f32x4){0.f, 0.f, 0.f, 0.f};
        const float* wbase = a.in[4] + ((size_t)l * DM + k0) * 12288 + col;
#pragma unroll
        for (int i = 0; i < 2; ++i) {
#pragma unroll 16
            for (int ll = 0; ll < 64; ++ll) { const f32x4 w = *(const f32x4*)(wbase + (size_t)(i * 64 + ll) * 12288);
#pragma unroll
                for (int r = 0; r < 5; ++r) { const float s = __int_as_float(__builtin_amdgcn_readlane(__float_as_int(sv[r][i]), ll)); acc[r] += w * s; } }
        }
        if (kp == 0) { const f32x4 bv = *(const f32x4*)(a.in[5] + (size_t)l * 12288 + col);
#pragma unroll
            for (int r = 0; r < 5; ++r) acc[r] += bv; }
#pragma unroll
        for (int r = 0; r < 5; ++r) { float* d = mods + ((size_t)l * 5 + r) * 12288 + col; unsafeAtomicAdd(d, acc[r][0]); unsafeAtomicAdd(d + 1, acc[r][1]); unsafeAtomicAdd(d + 2, acc[r][2]); unsafeAtomicAdd(d + 3, acc[r][3]); }
    }
}
__device__ __forceinline__ void norm_rows(const float* xlat, const float* xctx, const float* w, const float* mods_l, int shoff, int scoff, bf16_t* XN, int nrows, int gw, int NGW, int lane) {
    for (int row = gw; row < nrows; row += NGW) {
        const float* xr = row < MLAT ? xlat + (size_t)row * DM : xctx + (size_t)(row - MLAT) * DM; const int b = row < MLAT ? (row >> 12) : 4;
        const float* sh = mods_l + (size_t)b * 12288 + shoff; const float* sc = mods_l + (size_t)b * 12288 + scoff;
        f32x4 v[8]; float ss = 0.f;
#pragma unroll
        for (int j = 0; j < 8; ++j) { v[j] = *(const f32x4*)(xr + 4 * lane + 256 * j); ss += (v[j][0] * v[j][0] + v[j][1] * v[j][1]) + (v[j][2] * v[j][2] + v[j][3] * v[j][3]); }
        const float rstd = rsqrtf(wave_sum(ss, lane) * (1.0f / DM) + EPS);
#pragma unroll
        for (int j = 0; j < 8; ++j) { const int col = 4 * lane + 256 * j; const f32x4 wv = *(const f32x4*)(w + col), scv = *(const f32x4*)(sc + col), shv = *(const f32x4*)(sh + col);
            const f32x4 o = (v[j] * rstd * wv) * (scv + 1.0f) + shv; u32x2 pk; pk.x = cvt_pk_bf16(o[0], o[1]); pk.y = cvt_pk_bf16(o[2], o[3]);
            *(u32x2*)(XN + (size_t)row * DM + col) = pk; }
    }
}
__device__ __forceinline__ void final_norm(float* x, const float* w, int gw, int NGW, int lane) {
    for (int row = gw; row < MLAT; row += NGW) { float* xr = x + (size_t)row * DM; f32x4 v[8]; float ss = 0.f;
#pragma unroll
        for (int j = 0; j < 8; ++j) { v[j] = *(const f32x4*)(xr + 4 * lane + 256 * j); ss += (v[j][0] * v[j][0] + v[j][1] * v[j][1]) + (v[j][2] * v[j][2] + v[j][3] * v[j][3]); }
        const float rstd = rsqrtf(wave_sum(ss, lane) * (1.0f / DM) + EPS);
#pragma unroll
        for (int j = 0; j < 8; ++j) { const int col = 4 * lane + 256 * j; *(f32x4*)(xr + col) = v[j] * rstd * *(const f32x4*)(w + col); } }
}
__device__ __forceinline__ void sgu_unit(bf16_t* proj, int row0, int g, const float* nw, const float* wsg, const float* bsg, LAS unsigned char* lds, int tid) {
    LAS bf16_t* vnt = (LAS bf16_t*)lds;
    const int lane = tid & 63, wid = tid >> 6, fr = lane & 15, fq = lane >> 4;
    {
        const int j = tid >> 2, q = tid & 3; const bf16_t* src = proj + (size_t)(row0 + j) * INW + OFF_C + 512 + g * 128 + q * 32;
        float v[32];
#pragma unroll
        for (int i = 0; i < 4; ++i) { const u32x4 w = *(const u32x4*)(src + 8 * i);
            v[8 * i + 0] = bflo(w.x); v[8 * i + 1] = bfhi(w.x); v[8 * i + 2] = bflo(w.y); v[8 * i + 3] = bfhi(w.y); v[8 * i + 4] = bflo(w.z); v[8 * i + 5] = bfhi(w.z); v[8 * i + 6] = bflo(w.w); v[8 * i + 7] = bfhi(w.w); }
        float s = 0.f;
#pragma unroll
        for (int e = 0; e < 32; ++e) s += v[e];
        s += shx(s, 1, lane); s += shx(s, 2, lane); const float mean = s * (1.0f / 128.0f);
        float qv = 0.f;
#pragma unroll
        for (int e = 0; e < 32; ++e) { v[e] -= mean; qv += v[e] * v[e]; }
        qv += shx(qv, 1, lane); qv += shx(qv, 2, lane); const float rstd = rsqrtf(qv * (1.0f / 128.0f) + EPS);
#pragma unroll
        for (int e = 0; e < 32; e += 2) { const int d = q * 32 + e; const unsigned w = cvt_pk_bf16(v[e] * rstd * nw[g * 128 + d], v[e + 1] * rstd * nw[g * 128 + d + 1]);
            vnt[d * 136 + j] = (bf16_t)(w & 0xffffu); vnt[(d + 1) * 136 + j] = (bf16_t)(w >> 16); }
    }
    __syncthreads();
    {
        const int i = 16 * wid + fr;
        bf16x8 wf[4];
#pragma unroll
        for (int ks = 0; ks < 4; ++ks) { const float* wp = wsg + (size_t)i * 128 + 32 * ks + 8 * fq; const f32x4 a = *(const f32x4*)wp, b = *(const f32x4*)(wp + 4);
            u32x4 w; w.x = cvt_pk_bf16(a[0], a[1]); w.y = cvt_pk_bf16(a[2], a[3]); w.z = cvt_pk_bf16(b[0], b[1]); w.w = cvt_pk_bf16(b[2], b[3]); wf[ks] = __builtin_bit_cast(bf16x8, w); }
        const float bias = bsg[i];
        bf16_t* up = proj + (size_t)(row0 + i) * INW + OFF_C + g * 128 + 4 * fq;
#pragma unroll
        for (int nt = 0; nt < 8; ++nt) { f32x4 acc = (f32x4){0.f, 0.f, 0.f, 0.f};
#pragma unroll
            for (int ks = 0; ks < 4; ++ks) { const bf16x8 af = *(const LAS bf16x8*)((const LAS unsigned char*)vnt + (16 * nt + fr) * 272 + (32 * ks + 8 * fq) * 2);
                acc = __builtin_amdgcn_mfma_f32_16x16x32_bf16(af, wf[ks], acc, 0, 0, 0); }
            const u32x2 uw = *(const u32x2*)(up + 16 * nt); u32x2 o;
            o.x = cvt_pk_bf16(bflo(uw.x) * (acc[0] + bias), bfhi(uw.x) * (acc[1] + bias)); o.y = cvt_pk_bf16(bflo(uw.y) * (acc[2] + bias), bfhi(uw.y) * (acc[3] + bias));
            *(u32x2*)(up + 16 * nt) = o; }
    }
    __syncthreads();
}
template <bool LAT>
__device__ __forceinline__ void attn_task(bf16_t* proj, const bf16_t* vt, const float* rpb, int t, int lane, const LAS unsigned char* cl) {
    constexpr int NCH = LAT ? 16 : 8, WCH = LAT ? 8 : 0;
    const int fr = lane & 15, fq = lane >> 4;
    int b, h, r = 0, cgp = 0, qrow;
    if (LAT) { cgp = t & 3; r = (t >> 2) & 63; h = (t >> 8) & 7; b = t >> 11; qrow = b * 4096 + r * 64 + cgp * 16 + fr; }
    else { const int qg = t & 15; h = (t >> 4) & 7; b = t >> 7; qrow = MLAT + b * 256 + qg * 16 + fr; }
    bf16_t* qp = proj + (size_t)qrow * INW + OFF_Q + h * 128;
    bf16x8 qf[4];
#pragma unroll
    for (int ks = 0; ks < 4; ++ks) qf[ks] = *(const bf16x8*)(qp + ks * 32 + fq * 8);
    const int rs = r < 4 ? 0 : (r > 60 ? 56 : r - 4);
    const int cb = cgp == 0 ? 0 : (cgp == 1 ? 8 : (cgp == 2 ? 24 : 32));
    float S[NCH][8];
    const int kap = 8 * (fr >> 2) + (fr & 3);
    const bf16_t* kbase = proj + OFF_K + h * 128 + fq * 8;
    bf16x8 kf[2][8];
#define ATT_LOADK(buf, c) do { _Pragma("unroll") for (int tt = 0; tt < 2; ++tt) { \
        if ((c) < WCH) { const int krow = b * 4096 + (rs + (c)) * 64 + cb + kap + 4 * tt; const bf16_t* kp = kbase + (size_t)krow * INW; \
            _Pragma("unroll") for (int ks = 0; ks < 4; ++ks) kf[buf][tt * 4 + ks] = *(const bf16x8*)(kp + ks * 32); } \
        else { const LAS unsigned char* kp = cl + (32 * ((c) - WCH) + kap + 4 * tt) * 256; \
            _Pragma("unroll") for (int ks = 0; ks < 4; ++ks) kf[buf][tt * 4 + ks] = *(const LAS bf16x8*)(kp + (((ks * 4 + fq) ^ fr) * 16)); } } } while (0)
    ATT_LOADK(0, 0);
#pragma unroll
    for (int c = 0; c < NCH; ++c) {
        if (c + 1 < NCH) ATT_LOADK((c + 1) & 1, c + 1);
        __builtin_amdgcn_sched_barrier(0);
#pragma unroll
        for (int tt = 0; tt < 2; ++tt) {
            f32x4 acc = (f32x4){0.f, 0.f, 0.f, 0.f};
#pragma unroll
            for (int ks = 0; ks < 4; ++ks) acc = __builtin_amdgcn_mfma_f32_16x16x32_bf16(kf[c & 1][tt * 4 + ks], qf[ks], acc, 0, 0, 0);
            S[c][4 * tt + 0] = acc[0]; S[c][4 * tt + 1] = acc[1]; S[c][4 * tt + 2] = acc[2]; S[c][4 * tt + 3] = acc[3];
        }
        __builtin_amdgcn_sched_barrier(0);
    }
#undef ATT_LOADK
    if (LAT) {
        const int qc = cgp * 16 + fr; const int cs = qc < 8 ? 0 : (qc > 56 ? 48 : qc - 8);
#pragma unroll
        for (int c = 0; c < WCH; ++c) { const int dr = rs + c - r + 7; const float* rp = rpb + (h * 15 + dr) * 31;
#pragma unroll
            for (int jj = 0; jj < 8; ++jj) { const int kc = cb + 8 * fq + jj; const bool valid = (kc >= cs) && (kc < cs + 16); int dc = kc - qc + 15; dc = dc < 0 ? 0 : (dc > 30 ? 30 : dc);
                const float bias = rp[dc]; S[c][jj] = valid ? S[c][jj] + bias : -1e30f; } }
    }
    float mx = -3.0e38f;
#pragma unroll
    for (int c = 0; c < NCH; ++c)
#pragma unroll
        for (int jj = 0; jj < 8; ++jj) mx = fmaxf(mx, S[c][jj]);
    mx = fmaxf(mx, shx(mx, 16, lane)); mx = fmaxf(mx, shx(mx, 32, lane));
    float sum = 0.f; bf16x8 pf[NCH];
#pragma unroll
    for (int c = 0; c < NCH; ++c) { float p[8];
#pragma unroll
        for (int jj = 0; jj < 8; ++jj) { p[jj] = __builtin_amdgcn_exp2f((S[c][jj] - mx) * 1.44269504089f); sum += p[jj]; }
        u32x4 w; w.x = cvt_pk_bf16(p[0], p[1]); w.y = cvt_pk_bf16(p[2], p[3]); w.z = cvt_pk_bf16(p[4], p[5]); w.w = cvt_pk_bf16(p[6], p[7]); pf[c] = __builtin_bit_cast(bf16x8, w); }
    sum += shx(sum, 16, lane); sum += shx(sum, 32, lane);
    const float inv = 1.0f / sum;
    const bf16_t* vlat = vt + ((size_t)(b * 1024 + h * 128 + fr)) * 4096 + cb + 8 * fq;
    constexpr int NBH = NCH / 8, NQ = 8 * NBH;
    bf16x8 vf[2][8];
#define ATT_LOADV(buf, q) do { const int dt_ = (q) / NBH, hb_ = (q) % NBH; _Pragma("unroll") for (int i = 0; i < 8; ++i) { const int c_ = hb_ * 8 + i; \
        if (c_ < WCH) vf[buf][i] = *(const bf16x8*)(vlat + (size_t)dt_ * 16 * 4096 + (rs + c_) * 64); \
        else vf[buf][i] = *(const LAS bf16x8*)(cl + 65536 + (dt_ * 16 + fr) * 512 + ((((c_ - WCH) * 4 + fq) ^ fr) * 16)); } } while (0)
    ATT_LOADV(0, 0);
    f32x4 oacc = (f32x4){0.f, 0.f, 0.f, 0.f};
#pragma unroll
    for (int q = 0; q < NQ; ++q) {
        if (q + 1 < NQ) ATT_LOADV((q + 1) & 1, q + 1);
        __builtin_amdgcn_sched_barrier(0);
        const int dt = q / NBH, hb = q % NBH;
        if (hb == 0) oacc = (f32x4){0.f, 0.f, 0.f, 0.f};
#pragma unroll
        for (int i = 0; i < 8; ++i) oacc = __builtin_amdgcn_mfma_f32_16x16x32_bf16(vf[q & 1][i], pf[hb * 8 + i], oacc, 0, 0, 0);
        if (hb == NBH - 1) { u32x2 o; o.x = cvt_pk_bf16(oacc[0] * inv, oacc[1] * inv); o.y = cvt_pk_bf16(oacc[2] * inv, oacc[3] * inv);
            *(u32x2*)(qp + dt * 16 + 4 * fq) = o; }
        __builtin_amdgcn_sched_barrier(0);
    }
#undef ATT_LOADV
}
template <bool LAT>
__device__ __forceinline__ void attn_pass(bf16_t* proj, const bf16_t* vt, const bf16_t* vtc, const float* rpb, int b, int h, int ra, LAS unsigned char* lds, int wave) {
    constexpr int NCH = LAT ? 16 : 8, WCH = LAT ? 8 : 0;
    const int lane = fresh_lane(), fr = lane & 15, fq = lane >> 4, tid = wave * 64 + lane;
    const int r = LAT ? ra + (wave >> 2) : 0, cgp = LAT ? (wave & 3) : 0;
    const int rsa = ra < 4 ? 0 : (ra > 60 ? 56 : ra - 4), rs = r < 4 ? 0 : (r > 60 ? 56 : r - 4), shw = rs - rsa;
    const int rsb = (ra + 1) < 4 ? 0 : ((ra + 1) > 60 ? 56 : ra + 1 - 4), T = 8 + (rsb - rsa);
    const int cb = cgp == 0 ? 0 : (cgp == 1 ? 8 : (cgp == 2 ? 24 : 32));
    const bool active = LAT || wave == 0;
    const int qrow = LAT ? (b * 4096 + r * 64 + cgp * 16 + fr) : (MLAT + b * 256 + ra * 16 + fr);
    bf16_t* qp = proj + (size_t)qrow * INW + OFF_Q + h * 128;
    bf16x8 qf[4];
#pragma unroll
    for (int ks = 0; ks < 4; ++ks) qf[ks] = *(const bf16x8*)(qp + ks * 32 + fq * 8);
    const int kap = 8 * (fr >> 2) + (fr & 3);
    float S[NCH][8];
    if (LAT) {
        __syncthreads();
        { u32x4 v[18];
#pragma unroll
          for (int i = 0; i < 18; ++i) { const int idx = tid + 512 * i, key = idx >> 4, ch = idx & 15;
            if (i < 2 * T) v[i] = *(const u32x4*)(proj + (size_t)(b * 4096 + rsa * 64 + key) * INW + OFF_K + h * 128 + ch * 8); }
#pragma unroll
          for (int i = 0; i < 18; ++i) { const int idx = tid + 512 * i, key = idx >> 4, ch = idx & 15, g = (key & 3) | (((key >> 3) & 3) << 2);
            if (i < 2 * T) *(LAS u32x4*)(lds + key * 256 + ((ch ^ g) * 16)) = v[i]; } }
        __syncthreads();
        const int gw = (fr & 3) | ((((cb >> 3) + (fr >> 2)) & 3) << 2);
#pragma unroll
        for (int c = 0; c < WCH; ++c) {
#pragma unroll
            for (int tt = 0; tt < 2; ++tt) { const LAS unsigned char* kp = lds + ((c + shw) * 64 + cb + kap + 4 * tt) * 256;
                f32x4 acc = (f32x4){0.f, 0.f, 0.f, 0.f};
#pragma unroll
                for (int ks = 0; ks < 4; ++ks) { const bf16x8 kf = *(const LAS bf16x8*)(kp + (((ks * 4 + fq) ^ gw) * 16)); acc = __builtin_amdgcn_mfma_f32_16x16x32_bf16(kf, qf[ks], acc, 0, 0, 0); }
                S[c][4 * tt + 0] = acc[0]; S[c][4 * tt + 1] = acc[1]; S[c][4 * tt + 2] = acc[2]; S[c][4 * tt + 3] = acc[3]; } }
    }
    __syncthreads();
    { u32x4 v[8];
#pragma unroll
      for (int i = 0; i < 8; ++i) { const int idx = tid + 512 * i, key = idx >> 4, ch = idx & 15; v[i] = *(const u32x4*)(proj + (size_t)(MLAT + b * 256 + key) * INW + OFF_K + h * 128 + ch * 8); }
#pragma unroll
      for (int i = 0; i < 8; ++i) { const int idx = tid + 512 * i, key = idx >> 4, ch = idx & 15, g = (key & 3) | (((key >> 3) & 3) << 2); *(LAS u32x4*)(lds + key * 256 + ((ch ^ g) * 16)) = v[i]; } }
    __syncthreads();
    float mx = -3.0e38f, sum = 0.f, inv = 0.f; bf16x8 pf[NCH];
    if (active) {
#pragma unroll
        for (int c = WCH; c < NCH; ++c) {
#pragma unroll
            for (int tt = 0; tt < 2; ++tt) { const LAS unsigned char* kp = lds + (32 * (c - WCH) + kap + 4 * tt) * 256;
                f32x4 acc = (f32x4){0.f, 0.f, 0.f, 0.f};
#pragma unroll
                for (int ks = 0; ks < 4; ++ks) { const bf16x8 kf = *(const LAS bf16x8*)(kp + (((ks * 4 + fq) ^ fr) * 16)); acc = __builtin_amdgcn_mfma_f32_16x16x32_bf16(kf, qf[ks], acc, 0, 0, 0); }
                S[c][4 * tt + 0] = acc[0]; S[c][4 * tt + 1] = acc[1]; S[c][4 * tt + 2] = acc[2]; S[c][4 * tt + 3] = acc[3]; } }
        if (LAT) {
            const int qc = cgp * 16 + fr; const int cs = qc < 8 ? 0 : (qc > 56 ? 48 : qc - 8);
#pragma unroll
            for (int c = 0; c < WCH; ++c) { const int dr = rs + c - r + 7; const float* rp = rpb + (h * 15 + dr) * 31;
#pragma unroll
                for (int jj = 0; jj < 8; ++jj) { const int kc = cb + 8 * fq + jj; const bool valid = (kc >= cs) && (kc < cs + 16); int dc = kc - qc + 15; dc = dc < 0 ? 0 : (dc > 30 ? 30 : dc);
                    const float bias = rp[dc]; S[c][jj] = valid ? S[c][jj] + bias : -1e30f; } }
        }
#pragma unroll
        for (int c = 0; c < NCH; ++c)
#pragma unroll
            for (int jj = 0; jj < 8; ++jj) mx = fmaxf(mx, S[c][jj]);
        mx = fmaxf(mx, shx(mx, 16, lane)); mx = fmaxf(mx, shx(mx, 32, lane));
#pragma unroll
        for (int c = 0; c < NCH; ++c) { float p[8];
#pragma unroll
            for (int jj = 0; jj < 8; ++jj) { p[jj] = __builtin_amdgcn_exp2f((S[c][jj] - mx) * 1.44269504089f); sum += p[jj]; }
            u32x4 w; w.x = cvt_pk_bf16(p[0], p[1]); w.y = cvt_pk_bf16(p[2], p[3]); w.z = cvt_pk_bf16(p[4], p[5]); w.w = cvt_pk_bf16(p[6], p[7]); pf[c] = __builtin_bit_cast(bf16x8, w); }
        sum += shx(sum, 16, lane); sum += shx(sum, 32, lane);
        inv = 1.0f / sum;
    }
    f32x4 oacc[8];
#pragma unroll
    for (int dt = 0; dt < 8; ++dt) oacc[dt] = (f32x4){0.f, 0.f, 0.f, 0.f};
    if (LAT) {
        __syncthreads();
        const int cpr = T * 8;
        { u32x4 v[18];
#pragma unroll
          for (int i = 0; i < 18; ++i) { const int idx = tid + 512 * i, d = idx / cpr, ch = idx - d * cpr;
            if (i < 2 * T) v[i] = *(const u32x4*)(vt + (size_t)(b * 1024 + h * 128 + d) * 4096 + rsa * 64 + ch * 8); }
#pragma unroll
          for (int i = 0; i < 18; ++i) { const int idx = tid + 512 * i, d = idx / cpr, ch = idx - d * cpr;
            if (i < 2 * T) *(LAS u32x4*)(lds + d * 1152 + (((ch & ~7) | ((ch & 7) ^ ((d >> 1) & 7))) * 16)) = v[i]; } }
        __syncthreads();
#pragma unroll
        for (int dt = 0; dt < 8; ++dt)
#pragma unroll
            for (int c = 0; c < WCH; ++c) { const int ch = (c + shw) * 8 + (cb >> 3) + fq;
                const bf16x8 vf = *(const LAS bf16x8*)(lds + (dt * 16 + fr) * 1152 + (((ch & ~7) | ((ch & 7) ^ (fr >> 1))) * 16));
                oacc[dt] = __builtin_amdgcn_mfma_f32_16x16x32_bf16(vf, pf[c], oacc[dt], 0, 0, 0); }
    }
    __syncthreads();
    { u32x4 v[8];
#pragma unroll
      for (int i = 0; i < 8; ++i) { const int idx = tid + 512 * i, d = idx >> 5, ch = idx & 31; v[i] = *(const u32x4*)(vtc + (size_t)(b * 1024 + h * 128 + d) * 256 + ch * 8); }
#pragma unroll
      for (int i = 0; i < 8; ++i) { const int idx = tid + 512 * i, d = idx >> 5, ch = idx & 31; *(LAS u32x4*)(lds + d * 512 + ((ch ^ (d & 15)) * 16)) = v[i]; } }
    __syncthreads();
    if (active) {
#pragma unroll
        for (int dt = 0; dt < 8; ++dt) {
#pragma unroll
            for (int c = WCH; c < NCH; ++c) { const bf16x8 vf = *(const LAS bf16x8*)(lds + (dt * 16 + fr) * 512 + ((((c - WCH) * 4 + fq) ^ fr) * 16));
                oacc[dt] = __builtin_amdgcn_mfma_f32_16x16x32_bf16(vf, pf[c], oacc[dt], 0, 0, 0); }
            u32x2 o; o.x = cvt_pk_bf16(oacc[dt][0] * inv, oacc[dt][1] * inv); o.y = cvt_pk_bf16(oacc[dt][2] * inv, oacc[dt][3] * inv);
            *(u32x2*)(qp + dt * 16 + 4 * fq) = o; }
    }
}
__device__ __forceinline__ void attn_block(bf16_t* proj, const bf16_t* vt, const bf16_t* vtc, const float* rpb, int vcu, int half, bool ctxq, LAS unsigned char* lds, int wave) {
    const int bh = vcu >> 3, b = bh >> 3, h = bh & 7, rb = vcu & 7;
    __syncthreads();
    { const int tid = wave * 64 + fresh_lane();
#pragma unroll
      for (int i = 0; i < 8; ++i) { const int idx = tid + 512 * i, key = idx >> 4, ch = idx & 15, g = (key & 3) | (((key >> 3) & 3) << 2);
          const u32x4 v = *(const u32x4*)(proj + (size_t)(MLAT + b * 256 + key) * INW + OFF_K + h * 128 + ch * 8);
          *(LAS u32x4*)(lds + key * 256 + ((ch ^ g) * 16)) = v; }
#pragma unroll
      for (int i = 0; i < 8; ++i) { const int idx = tid + 512 * i, d = idx >> 5, ch = idx & 31;
          const u32x4 v = *(const u32x4*)(vtc + (size_t)(b * 1024 + h * 128 + d) * 256 + ch * 8);
          *(LAS u32x4*)(lds + 65536 + d * 512 + ((ch ^ (d & 15)) * 16)) = v; } }
    __syncthreads();
    const int lane = fresh_lane();
    for (int round = 0; round < 2; ++round) { const int r = rb * 8 + half * 4 + round * 2 + (wave >> 2), cgp = wave & 3;
        attn_task<true>(proj, vt, rpb, ((bh * 64 + r) << 2) + cgp, lane, lds); }
    if (ctxq && wave == 0) attn_task<false>(proj, vt, rpb, bh * 16 + rb * 2 + half, lane, lds);
}
__device__ __forceinline__ void conv_items(const bf16_t* up, bf16_t* hmid, const float* cw, const float* cbias, int nrows, int gtid, int NT) {
    const int nitems = (nrows / 16) * 704;
    for (int it = gtid; it < nitems; it += NT) {
        const int cg8 = it % 704, rb = it / 704; const int row0 = rb * 16, ch = cg8 * 8;
        const int seqlen = row0 < MLAT ? 4096 : 256; const int ts = (row0 < MLAT ? row0 : row0 - MLAT) & (seqlen - 1);
        float w0[8], w1[8], w2[8], bb[8];
#pragma unroll
        for (int e = 0; e < 8; ++e) { w0[e] = cw[ch + e]; w1[e] = cw[DFF + ch + e]; w2[e] = cw[2 * DFF + ch + e]; bb[e] = cbias[ch + e]; }
        const bf16_t* ap = up + (size_t)row0 * UPW + ch; const bf16_t* gp = ap + DFF; bf16_t* hp = hmid + (size_t)row0 * DFF + ch;
        u32x4 prev = (u32x4){0u, 0u, 0u, 0u}; if (ts > 0) prev = *(const u32x4*)(ap - UPW);
        u32x4 cur = *(const u32x4*)ap;
        for (int i = 0; i < 16; ++i) {
            u32x4 nxt = (u32x4){0u, 0u, 0u, 0u}; if (i < 15 || ts + 16 < seqlen) nxt = *(const u32x4*)(ap + (size_t)(i + 1) * UPW);
            const u32x4 gw = *(const u32x4*)(gp + (size_t)i * UPW);
            float o[8];
#pragma unroll
            for (int e = 0; e < 4; ++e) {
                const float y0 = bb[2 * e] + w0[2 * e] * bflo(prev[e]) + w1[2 * e] * bflo(cur[e]) + w2[2 * e] * bflo(nxt[e]);
                const float y1 = bb[2 * e + 1] + w0[2 * e + 1] * bfhi(prev[e]) + w1[2 * e + 1] * bfhi(cur[e]) + w2[2 * e + 1] * bfhi(nxt[e]);
                o[2 * e] = fsilu(y0) * bflo(gw[e]); o[2 * e + 1] = fsilu(y1) * bfhi(gw[e]); }
            u32x4 w; w.x = cvt_pk_bf16(o[0], o[1]); w.y = cvt_pk_bf16(o[2], o[3]); w.z = cvt_pk_bf16(o[4], o[5]); w.w = cvt_pk_bf16(o[6], o[7]);
            *(u32x4*)(hp + (size_t)i * DFF) = w;
            prev = cur; cur = nxt;
        }
    }
}


#define XB_TMO      128
#define XB_XCNT(j)  (256  + 64 * (j))
#define XB_XSUB(j)  (1280 + 64 * (j))
#define XB_XGEN(j)  (2304 + 64 * (j))
#define XB_TOP      3328
#define XB_TOPGEN   3392
#define XCD_BAR_WORDS 3456
#define XB_SPIN_CAP (1u << 18)
__device__ __forceinline__ unsigned xb_ld(unsigned* p)              { return __hip_atomic_load(p, __ATOMIC_RELAXED, __HIP_MEMORY_SCOPE_AGENT); }
__device__ __forceinline__ unsigned xb_add(unsigned* p, unsigned v) { return __hip_atomic_fetch_add(p, v, __ATOMIC_RELAXED, __HIP_MEMORY_SCOPE_AGENT); }
__device__ __forceinline__ unsigned xb_xcc_id() { return (unsigned)__builtin_amdgcn_s_getreg((3 << 11) | 20) & 0xFu; }
#define XB_SPIN(cond, bar) do { unsigned _sp = 0; while (cond) { __builtin_amdgcn_s_sleep(1); \
    if ((++_sp & 255u) == 0u) { if (xb_ld(&(bar)[XB_TMO])) break; if (_sp > XB_SPIN_CAP) { atomicAdd(&(bar)[XB_TMO], 1u); break; } } } } while (0)
struct XcdBarrier { unsigned* bar; unsigned x; volatile LAS unsigned* st; };
__device__ __forceinline__ XcdBarrier xcd_barrier_post(unsigned* bar, volatile LAS unsigned* st) {
    XcdBarrier b; b.bar = bar; b.x = xb_xcc_id(); b.st = st;
    if (threadIdx.x == 0) (void)xb_add(&bar[XB_XCNT(b.x)], 1u);
    return b;
}
__device__ __forceinline__ void xcd_barrier_complete(unsigned* bar, unsigned x, unsigned& nloc, unsigned& nx) {
    const unsigned G = gridDim.x * gridDim.y * gridDim.z;
    unsigned sum, cnt, mine, sp = 0u;
    for (;;) {
        sum = 0u; cnt = 0u; mine = 0u;
#pragma unroll
        for (unsigned j = 0; j < 16; ++j) { const unsigned c = xb_ld(&bar[XB_XCNT(j)]); sum += c; cnt += (c > 0u) ? 1u : 0u; mine = (j == x) ? c : mine; }
        if (sum == G) break;
        __builtin_amdgcn_s_sleep(1);
        if ((++sp & 255u) == 0u) { if (xb_ld(&bar[XB_TMO])) break; if (sp > XB_SPIN_CAP) { atomicAdd(&bar[XB_TMO], 1u); break; } }
    }
    nloc = mine > 0u ? mine : 1u; nx = cnt > 0u ? cnt : 1u;
}
__device__ __forceinline__ void xcd_barrier(const XcdBarrier& b) {
    asm volatile("s_waitcnt vmcnt(0)" ::: "memory");
    __syncthreads();
    if (threadIdx.x == 0) {
        unsigned* bar = b.bar;
        __builtin_amdgcn_s_waitcnt(0);
        unsigned nloc = b.st[0], nx = b.st[1];
        if (nloc == 0u) { xcd_barrier_complete(bar, b.x, nloc, nx); b.st[0] = nloc; b.st[1] = nx; }
        const unsigned old = xb_add(&bar[XB_XSUB(b.x)], 1u);
        const unsigned gen = old / nloc;
        if (old + 1u == (gen + 1u) * nloc) {
            __builtin_amdgcn_fence(__ATOMIC_RELEASE, "agent");
            asm volatile("s_waitcnt vmcnt(0)" ::: "memory");
            const unsigned og = xb_add(&bar[XB_TOP], 1u);
            const unsigned tg = og / nx;
            if (og + 1u == (tg + 1u) * nx) xb_add(&bar[XB_TOPGEN], 1u);
            else XB_SPIN(xb_ld(&bar[XB_TOPGEN]) == tg, bar);
            __builtin_amdgcn_fence(__ATOMIC_ACQUIRE, "agent");
            xb_add(&bar[XB_XGEN(b.x)], 1u);
            asm volatile("s_waitcnt vmcnt(0)" ::: "memory");
        } else {
            XB_SPIN(xb_ld(&bar[XB_XGEN(b.x)]) == gen, bar);
            __builtin_amdgcn_fence(__ATOMIC_ACQUIRE, "agent");
            asm volatile("s_waitcnt vmcnt(0)" ::: "memory");
        }
    }
    __syncthreads();
}
constexpr int NPHASE = 24;
__global__ void __launch_bounds__(512, 2) mega(Args a_) {
    extern __shared__ __attribute__((aligned(16))) unsigned char lds_raw[];
    LAS unsigned char* lds = (LAS unsigned char*)lds_raw;
    cg::grid_group grid = cg::this_grid();
    const int G = gridDim.x, cu = blockIdx.x, NGW = G * 8, wave = __builtin_amdgcn_readfirstlane((int)threadIdx.x >> 6);

    volatile LAS unsigned* xst = (volatile LAS unsigned*)(lds + LDS_XST);
    if (threadIdx.x < 4) xst[threadIdx.x] = 0u;
    __syncthreads();
    const XcdBarrier xbar = xcd_barrier_post((unsigned*)(a_.ws + WS_BAR), xst);

    const int ph_lo = a_.ph_lo, ph_hi = a_.ph_hi;
    for (int p = ph_lo; p < ph_hi; ++p) {
        if (p > ph_lo) { if (p == 1) grid.sync(); else xcd_barrier(xbar); }
#define PH_IDS const int lane = fresh_lane(); const int tid = wave * 64 + lane, gw = cu * 8 + wave; (void)tid; (void)gw; (void)lane;
        typedef const __attribute__((address_space(4))) Args KArgs;
        KArgs* ap = (KArgs*)__builtin_amdgcn_kernarg_segment_ptr(); asm volatile("" : "+s"(ap));
        KArgs& a = *ap;
        unsigned char* ws = a.ws;
        unsigned* ctl = (unsigned*)(ws + WS_CTL);
        bf16_t* PROJ = (bf16_t*)(ws + WS_BIG); bf16_t* XN = (bf16_t*)(ws + WS_XN); bf16_t* HMID = (bf16_t*)(ws + WS_HMID);
        float* XC = (float*)(ws + WS_XC); float* mods = (float*)(ws + WS_MODS);
        bf16_t* VT = (bf16_t*)(ws + WS_VT); bf16_t* VTC = (bf16_t*)(ws + WS_VTC);
        if (p == 0) { PH_IDS
            LAS float* lut = (LAS float*)(lds + 72 * 1024);
            for (int i = tid; i < 4096; i += 512) lut[i] = cospif((float)i * (1.0f / 2048.0f));
            __syncthreads();
            if (cu == 0) { bf16_t* dd = (bf16_t*)(ws + WS_DFTD);
                for (int e = tid; e < 256 * 128; e += 512) { const int row = e >> 7, d = e & 127, j = row & 127; const float ang = (float)((j * d) & 127) * (1.0f / 64.0f);
                    const float v = row < 128 ? cospif(ang) : sinpif(ang); dd[e] = (bf16_t)(cvt_pk_bf16(v, 0.f) & 0xffffu); } }
            for (int i = cu * 512 + tid; i < 1024 * DM / 4; i += G * 512) ((f32x4*)XC)[i] = ((const f32x4*)a.in[2])[i];
            mods_items(a, gw, NGW, lane);
            convert_weights(a, 0, (LAS float*)(lds + wave * 8704), gw, NGW, lane);
            dft_tables(ws, lut, gw, NGW, lane);
            continue;
        }
        if (p == NPHASE - 1) { PH_IDS final_norm(a.out, a.in[21], gw, NGW, lane); continue; }
        const int l = (p - 1) / 11, s = (p - 1) % 11;
        const float* mods_l = mods + (size_t)l * 5 * 12288;
        const float* xlat = (l == 0) ? a.in[0] : a.out; const float* xctx = (l == 0) ? a.in[2] : XC;
        const int nMall = (l == 0) ? 68 : 64;
        switch (s) {
        case 0: { PH_IDS
            if (l == 1) { LAS float* lut = (LAS float*)(lds + 72 * 1024);
                for (int i = tid; i < 4096; i += 512) lut[i] = cospif((float)i * (1.0f / 2048.0f));
                __syncthreads();
                convert_weights(a, 1, (LAS float*)(lds + wave * 8704), gw, NGW, lane);
                dft_tables(ws, lut, gw, NGW, lane); }
            norm_rows(xlat, xctx, a.in[6] + (size_t)l * DM, mods_l, 0, 2048, XN, MT, gw, NGW, lane);
        } break;
        case 1: { PH_IDS
            SchedGrid S; S.so.init(nMall, 42, G, cu); S.A = (const char*)XN; S.B = (const char*)(ws + WS_WIN); S.tsA = (size_t)256 * DM * 2; S.tsB = (size_t)256 * DM * 2; S.nt = 32;
            S.nextra = (l == 0) ? 0 : 32; S.ex_pm0 = 64; S.ex_pn0 = 6; S.ex_w = 8; S.ex_ks = 1;
            EpiInProj E{PROJ, VT, VTC};
            pg8::gemm_phase<EpiInProj, SchedGrid>(lds, tid, DM, DM, S, E);
        } break;
        case 2: { PH_IDS
            const int nun = 512 + ((l == 0) ? 32 : 0);
            for (int u = cu; u < nun; u += G) { int row0, g;
                if (u < 512) { const int b = u >> 7, ch = (u >> 2) & 31; g = u & 3; row0 = b * 4096 + ch * 128; }
                else { const int e = u - 512; const int b = e >> 3, ch = (e >> 2) & 1; g = e & 3; row0 = MLAT + b * 256 + ch * 128; }
                sgu_unit(PROJ, row0, g, a.in[10] + (size_t)l * 512, a.in[11] + ((size_t)l * 4 + g) * 128 * 128, a.in[12] + ((size_t)l * 4 + g) * 128, lds, tid); }
            __syncthreads();
            { SchedF1L S{(const char*)(ws + WS_DFTD), (const char*)PROJ, G, cu}; EpiF1L E{(bf16_t*)(ws + WS_U)};
              pg8::gemm_phase<EpiF1L, SchedF1L>(lds, wave * 64 + fresh_lane(), 128, INW, S, E); }
            if (l == 0) { SchedF1 S{(const char*)(ws + WS_DFTD), (const char*)PROJ, G, (cu + 128) % G, 16}; EpiF1 E{nullptr, (bf16_t*)(ws + WS_PQTC)};
              pg8::gemm_phase<EpiF1, SchedF1>(lds, wave * 64 + fresh_lane(), 128, INW, S, E); }
        } break;
        case 3: { PH_IDS
            { SchedFA S{(const char*)(ws + WS_MA), (const char*)(ws + WS_U), G, cu}; EpiFA E{(bf16_t*)(ws + WS_ZBUF)};
              pg8::gemm_phase<EpiFA, SchedFA>(lds, tid, 128, 128, S, E); }
            if (l == 0) { SchedF2 S{(const char*)(ws + WS_DFTC), (const char*)(ws + WS_PQTC), G, (cu + 128) % G, 8}; EpiF2 E{PROJ};
              pg8::gemm_phase<EpiF2, SchedF2>(lds, wave * 64 + fresh_lane(), 8192, 8192, S, E); }
            for (int vcu = cu; vcu < 256; vcu += G) { const int bh = vcu >> 3, rb = vcu & 7; const float* rpb = a.in[9] + (size_t)l * 8 * 15 * 31;
#pragma unroll 1
                for (int pp = 0; pp < 2; ++pp) attn_pass<true>(PROJ, VT, VTC, rpb, bh >> 3, bh & 7, rb * 8 + 0 * 4 + pp * 2, lds, wave);
                if (l == 0) attn_pass<false>(PROJ, VT, VTC, rpb, bh >> 3, bh & 7, rb * 2 + 0, lds, wave); }
        } break;
        case 4: { PH_IDS
            { SchedFB S{(const char*)(ws + WS_TT), (const char*)(ws + WS_ZBUF), G, cu}; EpiFB E{PROJ};
              pg8::gemm_phase<EpiFB, SchedFB>(lds, tid, 128, 128, S, E); }
            for (int vcu = cu; vcu < 256; vcu += G) { const int bh = vcu >> 3, rb = vcu & 7; const float* rpb = a.in[9] + (size_t)l * 8 * 15 * 31;
#pragma unroll 1
                for (int pp = 0; pp < 2; ++pp) attn_pass<true>(PROJ, VT, VTC, rpb, bh >> 3, bh & 7, rb * 8 + 1 * 4 + pp * 2, lds, wave);
                if (l == 0) attn_pass<false>(PROJ, VT, VTC, rpb, bh >> 3, bh & 7, rb * 2 + 1, lds, wave); }
        } break;
        case 5: { PH_IDS
            SchedBranch S; S.so.init(nMall, 8, G, cu); S.proj = (const char*)PROJ; S.wbr = (const char*)(ws + WS_WBR);
            EpiBranch E{PROJ, XN};
            pg8::gemm_phase<EpiBranch, SchedBranch>(lds, tid, INW, DM, S, E);
        } break;
        case 6: { PH_IDS
            SchedGrid S; S.so.init(64, 8, G, cu); S.A = (const char*)XN; S.B = (const char*)(ws + WS_WO); S.tsA = (size_t)256 * DM * 2; S.tsB = (size_t)256 * DM * 2; S.nt = 32;
            S.nextra = (l == 0) ? 32 * 8 : 0; S.ex_pm0 = 64; S.ex_pn0 = 0; S.ex_w = 8; S.ex_ks = 8;
            EpiResid E{xlat, XC, a.out, XC, mods_l + 4096, lds};
            pg8::gemm_phase<EpiResid, SchedGrid>(lds, tid, DM, DM, S, E);
        } break;
        case 7: { PH_IDS
            norm_rows(a.out, XC, a.in[7] + (size_t)l * DM, mods_l, 6144, 8192, XN, nMall * 256, gw, NGW, lane);
        } break;
        case 8: { PH_IDS
            SchedGrid S; S.so.init(nMall, 44, G, cu); S.A = (const char*)XN; S.B = (const char*)(ws + WS_WUP); S.tsA = (size_t)256 * DM * 2; S.tsB = (size_t)256 * DM * 2; S.nt = 32; S.nextra = 0; S.ex_pm0 = 0; S.ex_pn0 = 0; S.ex_w = 1; S.ex_ks = 1;
            EpiUpConv E{HMID, (float*)(ws + WS_BIG), a.in[18] + (size_t)l * 3 * DFF, a.in[19] + (size_t)l * DFF};
            pg8::gemm_phase<EpiUpConv, SchedGrid>(lds, tid, DM, DM, S, E);
        } break;
        case 9: { PH_IDS
            ffn_fix_rows(HMID, (const float*)(ws + WS_BIG), a.in[18] + (size_t)l * 3 * DFF, nMall * 4, cu * 512 + tid, G * 512);
        } break;
        case 10: { PH_IDS
            SchedGrid S; S.so.init(64, 8, G, cu); S.A = (const char*)HMID; S.B = (const char*)(ws + WS_WDN); S.tsA = (size_t)256 * DFF * 2; S.tsB = (size_t)256 * DFF * 2; S.nt = 88;
            S.nextra = (l == 0) ? 32 * 4 : 0; S.ex_pm0 = 64; S.ex_pn0 = 0; S.ex_w = 8; S.ex_ks = 4;
            EpiResid E{a.out, XC, a.out, XC, mods_l + 10240, lds};
            pg8::gemm_phase<EpiResid, SchedGrid>(lds, tid, DFF, DFF, S, E);
        } break;
        }
    }
}

extern "C" void kernel_launch(void* const* d_in, const int* in_sizes, int n_in, void* d_out, int out_size, void* d_ws, size_t ws_size, hipStream_t stream) {
    static int grid = 0;
    if (grid == 0) {
        if (n_in != 22 || ws_size < WS_END) { fprintf(stderr, "kernel_launch: unexpected n_in %d / ws_size %zu (need %zu)\n", n_in, ws_size, (size_t)WS_END); grid = -1; return; }
        int dev = 0, cus = 0, per_cu = 0;
        hipGetDevice(&dev); hipDeviceGetAttribute(&cus, hipDeviceAttributeMultiprocessorCount, dev);
        if (hipFuncSetAttribute((const void*)mega, hipFuncAttributeMaxDynamicSharedMemorySize, LDS_BYTES) != hipSuccess) { fprintf(stderr, "kernel_launch: hipFuncSetAttribute failed\n"); grid = -1; return; }
        hipOccupancyMaxActiveBlocksPerMultiprocessor(&per_cu, (const void*)mega, 512, LDS_BYTES);
        (void)hipGetLastError();
        if (per_cu < 1) fprintf(stderr, "kernel_launch: occupancy query says %d blocks/CU\n", per_cu);
        grid = cus > 0 ? cus : 256;
    }
    if (grid < 0) return;
    hipMemsetAsync((char*)d_ws + WS_CTL, 0, CTL_ZERO_BYTES, stream);
    Args a{};
    for (int i = 0; i < 22; ++i) a.in[i] = (const float*)d_in[i];
    a.out = (float*)d_out; a.ws = (unsigned char*)d_ws; a.ph_lo = 0; a.ph_hi = NPHASE;
    void* args[] = {&a};
    hipError_t e = hipLaunchCooperativeKernel((const void*)mega, dim3(grid), dim3(512), args, LDS_BYTES, stream);
    if (e != hipSuccess) fprintf(stderr, "kernel_launch: cooperative launch failed: %s (grid %d)\n", hipGetErrorString(e), grid);
}
```

```cpp
#include <hip/hip_runtime.h>
#include <hip/hip_cooperative_groups.h>
#include <cstdio>
#include <cstdint>
namespace cg = cooperative_groups;

#define LAS __attribute__((address_space(3)))
typedef unsigned short bf16_t;
typedef short bf16x8 __attribute__((ext_vector_type(8)));
typedef float f32x4 __attribute__((ext_vector_type(4)));
typedef float f32x2 __attribute__((ext_vector_type(2)));
typedef unsigned u32x4 __attribute__((ext_vector_type(4)));
typedef unsigned u32x2 __attribute__((ext_vector_type(2)));

constexpr int DM = 2048, MLAT = 16384, MT = 17408;
constexpr int INW = 10752, DFF = 5632, UPW = 11264;
constexpr int OFF_Q = 512, OFF_K = 1536, OFF_V = 2560, OFF_C = 3584, OFF_G = 4608;
constexpr float EPS = 1e-6f;
constexpr size_t MiB = 1u << 20;
constexpr size_t WS_CTL = 0;
constexpr size_t CTL_ZERO_BYTES = 1 * MiB;
constexpr size_t WS_MODS = 4096;
constexpr size_t WS_BAR = 512 * 1024;
constexpr size_t WS_DFTD = 1 * MiB;
constexpr size_t WS_XC = 2 * MiB;
constexpr size_t WS_WIN = 10 * MiB;
constexpr size_t WS_WBR = 52 * MiB;
constexpr size_t WS_WO = 60 * MiB;
constexpr size_t WS_WUP = 68 * MiB;
constexpr size_t WS_WDN = 112 * MiB;
constexpr size_t WS_XN = 134 * MiB;
constexpr size_t WS_BIG = 202 * MiB;
constexpr size_t WS_HMID = 576 * MiB;
constexpr size_t WS_ZBUF = WS_HMID;
constexpr size_t WS_TT = WS_HMID + 32 * MiB;
constexpr size_t WS_MA = WS_HMID + 36 * MiB;
constexpr size_t WS_U = WS_HMID + 64 * MiB;
constexpr size_t WS_VT = WS_HMID + 96 * MiB;
constexpr size_t WS_DFTC = WS_HMID + 128 * MiB;
constexpr size_t WS_PQTC = WS_HMID + 132 * MiB;
constexpr size_t WS_VTC = WS_HMID + 164 * MiB;
constexpr size_t WS_TMP = WS_HMID;
constexpr size_t WS_END = 763 * MiB;
constexpr int LDS_BYTES = 163840, LDS_XST = 163840 - 64;

#define LDS_WAIT() asm volatile("s_waitcnt lgkmcnt(0)" ::: "memory")
__device__ __forceinline__ unsigned cvt_pk_bf16(float lo, float hi) { unsigned r; asm volatile("v_cvt_pk_bf16_f32 %0, %1, %2" : "=v"(r) : "v"(lo), "v"(hi)); return r; }
__device__ __forceinline__ int fresh_lane() { unsigned z; asm volatile("v_mov_b32 %0, 0" : "=v"(z)); return (int)__builtin_amdgcn_mbcnt_hi(~0u, __builtin_amdgcn_mbcnt_lo(~0u, z)); }
__device__ __forceinline__ float bf2f(unsigned short b) { return __uint_as_float((unsigned)b << 16); }
__device__ __forceinline__ float bflo(unsigned w) { return __uint_as_float(w << 16); }
__device__ __forceinline__ float bfhi(unsigned w) { return __uint_as_float(w & 0xffff0000u); }
__device__ __forceinline__ float shx(float v, int o, int lane) { return __int_as_float(__builtin_amdgcn_ds_bpermute((lane ^ o) << 2, __float_as_int(v))); }
__device__ __forceinline__ float wave_sum(float v, int lane) {
#pragma unroll
    for (int o = 1; o < 64; o <<= 1) v += shx(v, o, lane);
    return v;
}
__device__ __forceinline__ float fsigmoid(float x) { return __builtin_amdgcn_rcpf(1.0f + __builtin_amdgcn_exp2f(-1.44269504089f * x)); }
__device__ __forceinline__ float fsilu(float x) { return x * fsigmoid(x); }
__device__ __forceinline__ f32x2 gelu_pk(f32x2 v) {
    const f32x2 av = __builtin_elementwise_abs(v), d = av * 0.2316418882f + 1.0f;
    f32x2 t; t.x = __builtin_amdgcn_rcpf(d.x); t.y = __builtin_amdgcn_rcpf(d.y);
    f32x2 q = t * 0.5307027145f + (-0.7265760135f); q = q * t + 0.7107068705f; q = q * t + (-0.142248368f); q = q * t + 0.127414796f; q = q * t;
    const f32x2 s = (v * v) * (-0.72134752044f);
    f32x2 e; e.x = __builtin_amdgcn_exp2f(s.x); e.y = __builtin_amdgcn_exp2f(s.y);
    const f32x2 m = v * (q * e), r = v - m;
    f32x2 o; o.x = v.x < 0.f ? m.x : r.x; o.y = v.y < 0.f ? m.y : r.y; return o;
}

namespace pg8 {
constexpr int BM = 256, BK = 64, HALF = 128, HTB = HALF * BK * 2, STAGE_BYTES = 8 * HTB, NXCD = 8, WGM = 8;
__host__ __device__ __forceinline__ int lds_byte(int r, int c) { const int st = (r >> 4) * 2 + (c >> 5), rr = r & 15, cc = c & 31, ob = rr * 64 + cc * 2; return st * 1024 + (ob ^ (((ob >> 9) & 1) << 5)); }
__host__ __device__ __forceinline__ void stage_rc(int b, int& R, int& C) { const int st = b / 1024, sb = b % 1024, swz = sb ^ (((sb >> 9) & 1) << 5); R = (st >> 1) * 16 + swz / 64; C = (st & 1) * 32 + (swz % 64) / 2; }
__host__ __device__ __forceinline__ int perm32(int rho) { const int n = rho >> 4, i = rho & 15; return 8 * (i >> 2) + 4 * n + (i & 3); }

struct Unit { const char* A; const char* B; int nt, pm, pn, aux; };

struct StaticOrder {
    int nM, nN, nwg, G, c;
    __device__ void init(int nM_, int nN_, int G_, int c_) { nM = nM_; nN = nN_; nwg = nM * nN; G = G_; c = c_; }
    __device__ bool next(int i, int& pm, int& pn) const {
        const long L = (long)i * G + c; if (L >= nwg) return false;
        int wgid = (int)L; { const int q = nwg / NXCD, r = nwg % NXCD, xcd = wgid % NXCD, off = wgid / NXCD; wgid = (xcd < r ? xcd * (q + 1) : r * (q + 1) + (xcd - r) * q) + off; }
        const int nig = WGM * nN, gid = wgid / nig, fm = gid * WGM, gsz = (nM - fm) < WGM ? (nM - fm) : WGM;
        pm = fm + ((wgid % nig) % gsz); pn = (wgid % nig) / gsz; return true;
    }
};

template <class Epi, class Sched>
__device__ __forceinline__ void gemm_phase(LAS unsigned char* lds, const int tid, const int lda, const int ldb, const Sched& S, const Epi& E) {
    const int wid = __builtin_amdgcn_readfirstlane(tid >> 6), lane = tid & 63, wr = wid >> 2, wc = wid & 3, fr = lane & 15, fq = lane >> 4;
    unsigned voffA[2], voffB[2];
#pragma unroll
    for (int i = 0; i < 2; ++i) { int R, C; stage_rc(tid * 16 + i * 8192, R, C); const int Rb = Epi::PERM ? ((R & ~31) + perm32(R & 31)) : R;
        voffA[i] = (unsigned)(R * lda + C) * 2u; voffB[i] = (unsigned)(Sched::brow(Rb) * ldb + C) * 2u; }
    const size_t kstep = (size_t)(BK * 2);
    const size_t hstepA = (size_t)HALF * lda * 2, hstepB = (size_t)Sched::BH * ldb * 2;
    const unsigned ldsw = (unsigned)wid * 1024u;
    const int aoff = lds_byte(wr * 64 + fr, fq * 8), boff = lds_byte(wc * 32 + fr, fq * 8);
#define PG8_SA(b, h) (((b) * 2 + (h)) * HTB)
#define PG8_SB(b, h) ((4 + (b) * 2 + (h)) * HTB)
#define PG8_STAGE(bufoff, gbase, voff) do { _Pragma("unroll") for (int _i = 0; _i < 2; ++_i) \
        __builtin_amdgcn_global_load_lds((const unsigned*)((const char*)(gbase) + (voff)[_i]), (LAS unsigned*)(lds + (bufoff) + ldsw + _i * 8192), 16, 0, 0); } while (0)
#define PG8_LDA(dst, b, h) do { _Pragma("unroll") for (int m = 0; m < 4; ++m) _Pragma("unroll") for (int k = 0; k < 2; ++k) dst[m][k] = *(const LAS bf16x8*)(lds + PG8_SA(b, h) + aoff + m * 2048 + k * 1024); } while (0)
#define PG8_LDB(dst, b, h) do { _Pragma("unroll") for (int n = 0; n < 2; ++n) _Pragma("unroll") for (int k = 0; k < 2; ++k) dst[n][k] = *(const LAS bf16x8*)(lds + PG8_SB(b, h) + boff + n * 2048 + k * 1024); } while (0)
#define PG8_MMA(ai, bj, At, Bt) do { __builtin_amdgcn_s_setprio(1); _Pragma("unroll") for (int m = 0; m < 4; ++m) _Pragma("unroll") for (int n = 0; n < 2; ++n) _Pragma("unroll") for (int k = 0; k < 2; ++k) \
        acc[ai][bj][m][n] = __builtin_amdgcn_mfma_f32_16x16x32_bf16(Bt[n][k], At[m][k], acc[ai][bj][m][n], 0, 0, 0); __builtin_amdgcn_s_setprio(0); } while (0)
#define PG8_WAIT_V(n) asm volatile("s_waitcnt vmcnt(" #n ")" ::: "memory")
#define PG8_WAIT_L(n) asm volatile("s_waitcnt lgkmcnt(" #n ")" ::: "memory")
#define PG8_BAR __builtin_amdgcn_s_barrier()
#define PG8_SCHED __builtin_amdgcn_sched_barrier(0)
    Unit cur, nxt; int ui = 0;
    if (!S.next(0, cur)) return;
    f32x4 acc[2][2][4][2];
#pragma unroll
    for (int a = 0; a < 2; ++a)
#pragma unroll
        for (int b = 0; b < 2; ++b)
#pragma unroll
            for (int m = 0; m < 4; ++m)
#pragma unroll
                for (int n = 0; n < 2; ++n) acc[a][b][m][n] = (f32x4){0.f, 0.f, 0.f, 0.f};
    bf16x8 At[4][2], B0[2][2], B1[2][2];
    const char* cA = cur.A; const char* cB = cur.B;
    {
        PG8_STAGE(PG8_SB(0, 0), cB, voffB); PG8_STAGE(PG8_SB(0, 1), cB + hstepB, voffB); PG8_STAGE(PG8_SA(0, 0), cA, voffA); PG8_STAGE(PG8_SA(0, 1), cA + hstepA, voffA);
        if (wr == 1) PG8_BAR;
        PG8_WAIT_V(2); PG8_BAR;
        PG8_STAGE(PG8_SB(1, 0), cB + kstep, voffB); PG8_STAGE(PG8_SA(1, 0), cA + kstep, voffA); PG8_STAGE(PG8_SB(1, 1), cB + hstepB + kstep, voffB);
        PG8_WAIT_V(6); PG8_BAR;
    }
    for (;;) {
        const bool has_next = S.next(ui + 1, nxt);
        const char* nA = has_next ? nxt.A : cA; const char* nB = has_next ? nxt.B : cB;
        const int nt = cur.nt;
        for (int t = 0; t < nt; t += 2) {
            const bool last = (t == nt - 2);
            const char* a1 = cA + (size_t)(t + 1) * kstep;
            const char* a2 = last ? nA : cA + (size_t)(t + 2) * kstep; const char* b2 = last ? nB : cB + (size_t)(t + 2) * kstep;
            const char* a3 = a2 + kstep; const char* b3 = b2 + kstep;
            PG8_LDB(B0, 0, 0); PG8_LDB(B1, 0, 1); PG8_SCHED; PG8_LDA(At, 0, 0); PG8_STAGE(PG8_SA(1, 1), a1 + hstepA, voffA);
            PG8_WAIT_V(8); PG8_WAIT_L(0); PG8_BAR; PG8_MMA(0, 0, At, B0); PG8_MMA(0, 1, At, B1); PG8_BAR; PG8_SCHED;
            PG8_LDA(At, 0, 1); PG8_STAGE(PG8_SB(0, 0), b2, voffB); PG8_STAGE(PG8_SB(0, 1), b2 + hstepB, voffB); PG8_STAGE(PG8_SA(0, 0), a2, voffA);
            PG8_WAIT_V(8); PG8_WAIT_L(0); PG8_BAR; PG8_MMA(1, 0, At, B0); PG8_MMA(1, 1, At, B1); PG8_BAR; PG8_SCHED;
            PG8_LDB(B0, 1, 0); PG8_LDB(B1, 1, 1); PG8_SCHED; PG8_LDA(At, 1, 0); PG8_STAGE(PG8_SA(0, 1), a2 + hstepA, voffA);
            PG8_WAIT_V(8); PG8_WAIT_L(0); PG8_BAR; PG8_MMA(0, 0, At, B0); PG8_MMA(0, 1, At, B1); PG8_BAR; PG8_SCHED;
            PG8_LDA(At, 1, 1); PG8_STAGE(PG8_SB(1, 0), b3, voffB); PG8_STAGE(PG8_SB(1, 1), b3 + hstepB, voffB); PG8_STAGE(PG8_SA(1, 0), a3, voffA);
            PG8_WAIT_V(8); PG8_WAIT_L(0); PG8_BAR; PG8_MMA(1, 0, At, B0); PG8_MMA(1, 1, At, B1); PG8_BAR; PG8_SCHED;
        }
        if (wr == 0) PG8_BAR;
        E(acc, cur, wr, wc);
        if (!has_next) break;
        if (!Epi::CHAIN || cur.aux == 2) {
#pragma unroll
        for (int a = 0; a < 2; ++a)
#pragma unroll
            for (int b = 0; b < 2; ++b)
#pragma unroll
                for (int m = 0; m < 4; ++m)
#pragma unroll
                    for (int n = 0; n < 2; ++n) acc[a][b][m][n] = (f32x4){0.f, 0.f, 0.f, 0.f};
        }
        cur = nxt; cA = nA; cB = nB; ++ui;
        if (wr == 1) PG8_BAR;
    }
    PG8_WAIT_V(0);
    PG8_BAR;
#undef PG8_SA
#undef PG8_SB
#undef PG8_STAGE
#undef PG8_LDA
#undef PG8_LDB
#undef PG8_MMA
#undef PG8_WAIT_V
#undef PG8_WAIT_L
#undef PG8_BAR
#undef PG8_SCHED
}
}
using pg8::Unit;
typedef const f32x4 (&AccRef)[2][2][4][2];

struct SchedGrid {
    static __device__ __forceinline__ int brow(int r) { return r; } static constexpr int BH = 128;
    pg8::StaticOrder so; const char* A; const char* B; size_t tsA, tsB; int nt, nextra, ex_pm0, ex_pn0, ex_w, ex_ks;
    __device__ __forceinline__ bool next(int i, Unit& u) const {
        int pm, pn; int kp = 0, ntu = nt, aux = 0;
        if (!so.next(i, pm, pn)) { const long e = (long)i * so.G + so.c - so.nwg; if (e >= nextra) return false; const int te = (int)e / ex_ks; kp = (int)e % ex_ks; ntu = nt / ex_ks; aux = ex_ks > 1 ? 1 : 0;
            pm = ex_pm0 + te / ex_w; pn = ex_pn0 + te % ex_w; }
        u.A = A + (size_t)pm * tsA + (size_t)kp * ntu * 128; u.B = B + (size_t)pn * tsB + (size_t)kp * ntu * 128; u.nt = ntu; u.pm = pm; u.pn = pn; u.aux = aux; return true;
    }
};
struct SchedBranch {
    static __device__ __forceinline__ int brow(int r) { return r; } static constexpr int BH = 128;
    pg8::StaticOrder so; const char* proj; const char* wbr;
    __device__ __forceinline__ bool next(int i, Unit& u) const {
        int pm, pn; if (!so.next(i / 3, pm, pn)) return false;
        const int br = i % 3; const int acol = br == 0 ? 0 : (br == 1 ? OFF_Q : OFF_C), koff = br == 0 ? 0 : (br == 1 ? 512 : 1536);
        u.A = proj + ((size_t)pm * 256 * INW + acol) * 2; u.B = wbr + ((size_t)pn * 256 * DM + koff) * 2; u.nt = br == 1 ? 16 : 8; u.pm = pm; u.pn = pn; u.aux = br; return true;
    }
};
struct SchedF1L {
    static __device__ __forceinline__ int brow(int r) { return (r >> 6) + 64 * (r & 63); } static constexpr int BH = 2;
    const char* dftd; const char* proj; int G, c;
    __device__ __forceinline__ bool next(int i, Unit& u) const {
        const int L = i * G + c; if (L >= 256) return false;
        { const char* ap = dftd; asm volatile("" : "+s"(ap)); u.A = ap; } u.nt = 2; u.pm = 0;
        const int b = L >> 6, g = (L >> 4) & 3, pn = L & 15; u.B = proj + ((size_t)(b * 4096 + 4 * pn) * INW + g * 128) * 2; u.pn = pn; u.aux = b * 4 + g; return true;
    }
};
struct SchedF1 {
    static __device__ __forceinline__ int brow(int r) { return r; } static constexpr int BH = 128;
    const char* dftd; const char* proj; int G, c, nctx;
    __device__ __forceinline__ bool next(int i, Unit& u) const {
        const int e = i * G + c; if (e >= nctx) return false;
        { const char* ap = dftd; asm volatile("" : "+s"(ap)); u.A = ap; } u.nt = 2; u.pm = 0;
        const int b = e >> 2, g = e & 3; u.B = proj + ((size_t)(MLAT + b * 256) * INW + g * 128) * 2; u.pn = 0; u.aux = 16 + b * 4 + g; return true;
    }
};
struct SchedF2 {
    static __device__ __forceinline__ int brow(int r) { return r; } static constexpr int BH = 128;
    const char* dftc; const char* pqtc; int G, c, nctx;
    __device__ __forceinline__ bool next(int i, Unit& u) const {
        const int e = i * G + c; if (e >= nctx) return false;
        const int b = e >> 1, pn = e & 1; { const char* ap = dftc; asm volatile("" : "+s"(ap)); u.A = ap; } u.B = pqtc + (size_t)(b * 512 + pn * 256) * 8192 * 2; u.nt = 8; u.pm = 0; u.pn = pn; u.aux = 4 + b; return true;
    }
};
struct SchedFA {
    static __device__ __forceinline__ int brow(int r) { return r; } static constexpr int BH = 128;
    const char* ma; const char* ub; int G, c;
    __device__ __forceinline__ bool next(int i, Unit& u) const {
        const int L = i * G + c; if (L >= 512) return false;
        { const char* ap = ma; asm volatile("" : "+s"(ap)); u.A = ap; } u.B = ub + (size_t)L * 256 * 128 * 2; u.nt = 2; u.pm = 0; u.pn = L; u.aux = 0; return true;
    }
};
struct SchedFB {
    static __device__ __forceinline__ int brow(int r) { return r; } static constexpr int BH = 128;
    const char* tt; const char* zb; int G, c;
    __device__ __forceinline__ bool next(int i, Unit& u) const {
        const int L = i * G + c; if (L >= 512) return false;
        const int k2 = L >> 3, pn = L & 7; u.A = tt + (size_t)k2 * 256 * 128 * 2; u.B = zb + ((size_t)k2 * 2048 + pn * 256) * 128 * 2; u.nt = 2; u.pm = 0; u.pn = pn; u.aux = k2; return true;
    }
};

struct EpiInProj {
    static constexpr bool PERM = true, CHAIN = false;
    bf16_t* proj; bf16_t* vt; bf16_t* vtc;
    __device__ __forceinline__ void operator()(AccRef acc, const Unit& u, int wr, int wc) const {
        const int ln_ = fresh_lane(), fr = ln_ & 15, fq = ln_ >> 4;
        const int pm = u.pm, pn = u.pn; const int row0 = pm * 256 + wr * 64 + fr, col0 = pn * 256 + wc * 32 + 8 * fq;
        if (pn >= 10 && pn < 14) {
            const int vc0 = col0 - OFF_V;
#pragma unroll
            for (int ai = 0; ai < 2; ++ai)
#pragma unroll
                for (int m = 0; m < 4; ++m) {
                    const int row = row0 + ai * 128 + m * 16; bf16_t* dst; size_t stride;
                    if (pm < 64) { const int b = pm >> 4; dst = vt + (size_t)b * 1024 * 4096 + (row - b * 4096); stride = 4096; }
                    else { const int b = pm - 64; dst = vtc + (size_t)b * 1024 * 256 + (row - MLAT - b * 256); stride = 256; }
#pragma unroll
                    for (int bj = 0; bj < 2; ++bj)
#pragma unroll
                        for (int n = 0; n < 2; ++n) { const f32x4 v = acc[ai][bj][m][n]; const unsigned w0 = cvt_pk_bf16(v[0], v[1]), w1 = cvt_pk_bf16(v[2], v[3]);
                            bf16_t* d = dst + (size_t)(vc0 + bj * 128 + n * 4) * stride;
                            d[0] = (bf16_t)(w0 & 0xffffu); d[stride] = (bf16_t)(w0 >> 16); d[2 * stride] = (bf16_t)(w1 & 0xffffu); d[3 * stride] = (bf16_t)(w1 >> 16); }
                }
            return;
        }
        const int act = pn < 14 ? 0 : (pn < 18 ? 1 : 2); const float sc = (pn >= 2 && pn < 6) ? 0.08838834764831845f : 1.0f;
#pragma unroll
        for (int ai = 0; ai < 2; ++ai)
#pragma unroll
            for (int m = 0; m < 4; ++m) { bf16_t* rowp = proj + (size_t)(row0 + ai * 128 + m * 16) * INW + col0;
#pragma unroll
                for (int bj = 0; bj < 2; ++bj) { f32x4 v0 = acc[ai][bj][m][0], v1 = acc[ai][bj][m][1];
                    if (act == 1) { f32x2 a = gelu_pk((f32x2){v0[0], v0[1]}), b = gelu_pk((f32x2){v0[2], v0[3]}), c = gelu_pk((f32x2){v1[0], v1[1]}), d = gelu_pk((f32x2){v1[2], v1[3]});
                        v0 = (f32x4){a.x, a.y, b.x, b.y}; v1 = (f32x4){c.x, c.y, d.x, d.y}; }
                    else if (act == 2) { v0 = (f32x4){fsigmoid(v0[0]), fsigmoid(v0[1]), fsigmoid(v0[2]), fsigmoid(v0[3])}; v1 = (f32x4){fsigmoid(v1[0]), fsigmoid(v1[1]), fsigmoid(v1[2]), fsigmoid(v1[3])}; }
                    else { v0 = v0 * sc; v1 = v1 * sc; }
                    u32x4 w; w.x = cvt_pk_bf16(v0[0], v0[1]); w.y = cvt_pk_bf16(v0[2], v0[3]); w.z = cvt_pk_bf16(v1[0], v1[1]); w.w = cvt_pk_bf16(v1[2], v1[3]);
                    *(u32x4*)(rowp + bj * 128) = w; } }
    }
};
struct EpiPlain {
    static constexpr bool PERM = true, CHAIN = false;
    bf16_t* out; int ld;
    __device__ __forceinline__ void operator()(AccRef acc, const Unit& u, int wr, int wc) const {
        const int ln_ = fresh_lane(), fr = ln_ & 15, fq = ln_ >> 4;
        const int row0 = u.pm * 256 + wr * 64 + fr, col0 = u.pn * 256 + wc * 32 + 8 * fq;
#pragma unroll
        for (int ai = 0; ai < 2; ++ai)
#pragma unroll
            for (int m = 0; m < 4; ++m) { bf16_t* rowp = out + (size_t)(row0 + ai * 128 + m * 16) * ld + col0;
#pragma unroll
                for (int bj = 0; bj < 2; ++bj) { const f32x4 v0 = acc[ai][bj][m][0], v1 = acc[ai][bj][m][1];
                    u32x4 w; w.x = cvt_pk_bf16(v0[0], v0[1]); w.y = cvt_pk_bf16(v0[2], v0[3]); w.z = cvt_pk_bf16(v1[0], v1[1]); w.w = cvt_pk_bf16(v1[2], v1[3]);
                    *(u32x4*)(rowp + bj * 128) = w; } }
    }
};
struct EpiF1 {
    static constexpr bool PERM = true, CHAIN = false;
    bf16_t* pqt; bf16_t* pqtc;
    __device__ __forceinline__ void operator()(AccRef acc, const Unit& u, int wr, int wc) const {
        const int ln_ = fresh_lane(), fr = ln_ & 15, fq = ln_ >> 4;
        const int aux = u.aux; const bool isc = aux >= 16; const int bg = aux & 15, b = bg >> 2, g = bg & 3;
        bf16_t* base = (isc ? pqtc : pqt) + (size_t)(b * 512 + g * 128) * 8192; const int half = isc ? 256 : 4096;
        const int n0 = u.pn * 256 + wc * 32 + 8 * fq;
#pragma unroll
        for (int ai = 0; ai < 2; ++ai)
#pragma unroll
            for (int m = 0; m < 4; ++m) { bf16_t* rowp = base + (size_t)(wr * 64 + m * 16 + fr) * 8192 + ai * half + n0;
#pragma unroll
                for (int bj = 0; bj < 2; ++bj) { const f32x4 v0 = acc[ai][bj][m][0], v1 = acc[ai][bj][m][1];
                    u32x4 w; w.x = cvt_pk_bf16(v0[0], v0[1]); w.y = cvt_pk_bf16(v0[2], v0[3]); w.z = cvt_pk_bf16(v1[0], v1[1]); w.w = cvt_pk_bf16(v1[2], v1[3]);
                    *(u32x4*)(rowp + bj * 128) = w; } }
    }
};
struct EpiF1L {
    static constexpr bool PERM = true, CHAIN = false;
    bf16_t* ub;
    __device__ __forceinline__ void operator()(AccRef acc, const Unit& u, int wr, int wc) const {
        const int ln_ = fresh_lane(), fr = ln_ & 15, fq = ln_ >> 4;
        const int b = u.aux >> 2, g = u.aux & 3;
#pragma unroll
        for (int ai = 0; ai < 2; ++ai)
#pragma unroll
            for (int m = 0; m < 4; ++m) { const int ch = b * 512 + g * 128 + wr * 64 + m * 16 + fr;
#pragma unroll
                for (int bj = 0; bj < 2; ++bj) { const int n1 = 4 * u.pn + 2 * bj + (wc >> 1), n2 = 32 * (wc & 1) + 8 * fq;
                    const f32x4 v0 = acc[ai][bj][m][0], v1 = acc[ai][bj][m][1];
                    u32x4 w; w.x = cvt_pk_bf16(v0[0], v0[1]); w.y = cvt_pk_bf16(v0[2], v0[3]); w.z = cvt_pk_bf16(v1[0], v1[1]); w.w = cvt_pk_bf16(v1[2], v1[3]);
                    *(u32x4*)(ub + ((size_t)ch * 64 + n1) * 128 + ai * 64 + n2) = w; } }
    }
};
struct EpiFA {
    static constexpr bool PERM = true, CHAIN = false;
    bf16_t* zb;
    __device__ __forceinline__ void operator()(AccRef acc, const Unit& u, int wr, int wc) const {
        if (wr != 0) return;
        const int ln_ = fresh_lane(), fr = ln_ & 15, fq = ln_ >> 4;
#pragma unroll
        for (int ai = 0; ai < 2; ++ai)
#pragma unroll
            for (int m = 0; m < 4; ++m) { const int k2 = m * 16 + fr;
#pragma unroll
                for (int bj = 0; bj < 2; ++bj) { const int bc = u.pn * 4 + 2 * bj + (wc >> 1), n1 = 32 * (wc & 1) + 8 * fq;
                    const f32x4 v0 = acc[ai][bj][m][0], v1 = acc[ai][bj][m][1];
                    u32x4 w; w.x = cvt_pk_bf16(v0[0], v0[1]); w.y = cvt_pk_bf16(v0[2], v0[3]); w.z = cvt_pk_bf16(v1[0], v1[1]); w.w = cvt_pk_bf16(v1[2], v1[3]);
                    *(u32x4*)(zb + ((size_t)k2 * 2048 + bc) * 128 + ai * 64 + n1) = w; } }
    }
};
struct EpiFB {
    static constexpr bool PERM = true, CHAIN = false;
    bf16_t* proj;
    __device__ __forceinline__ void operator()(AccRef acc, const Unit& u, int wr, int wc) const {
        if (wr != 0) return;
        const int ln_ = fresh_lane(), fr = ln_ & 15, fq = ln_ >> 4;
        const float sc = 0.0013810679320049757f; const int k2 = u.aux;
#pragma unroll
        for (int m = 0; m < 4; ++m) { const int k = 64 * (m * 16 + fr) + k2;
#pragma unroll
            for (int bj = 0; bj < 2; ++bj) { const int ncol = u.pn * 256 + 128 * bj + 32 * wc + 8 * fq; const int b = ncol >> 9, ch = ncol & 511;
                const f32x4 v0 = acc[0][bj][m][0] * sc, v1 = acc[0][bj][m][1] * sc;
                u32x4 w; w.x = cvt_pk_bf16(v0[0], v0[1]); w.y = cvt_pk_bf16(v0[2], v0[3]); w.z = cvt_pk_bf16(v1[0], v1[1]); w.w = cvt_pk_bf16(v1[2], v1[3]);
                *(u32x4*)(proj + (size_t)(b * 4096 + k) * INW + ch) = w; } }
    }
};
struct EpiF2 {
    static constexpr bool PERM = true, CHAIN = false;
    bf16_t* proj;
    __device__ __forceinline__ void operator()(AccRef acc, const Unit& u, int wr, int wc) const {
        const int ln_ = fresh_lane(), fr = ln_ & 15, fq = ln_ >> 4;
        const int aux = u.aux; const bool isc = aux >= 4; const int rowbase = isc ? MLAT + (aux - 4) * 256 : aux * 4096;
        const float sc = isc ? 0.005524271728019903f : 0.0013810679320049757f;
        const int row0 = rowbase + u.pm * 256 + wr * 64 + fr, col0 = u.pn * 256 + wc * 32 + 8 * fq;
#pragma unroll
        for (int ai = 0; ai < 2; ++ai)
#pragma unroll
            for (int m = 0; m < 4; ++m) { bf16_t* rowp = proj + (size_t)(row0 + ai * 128 + m * 16) * INW + col0;
#pragma unroll
                for (int bj = 0; bj < 2; ++bj) { const f32x4 v0 = acc[ai][bj][m][0] * sc, v1 = acc[ai][bj][m][1] * sc;
                    u32x4 w; w.x = cvt_pk_bf16(v0[0], v0[1]); w.y = cvt_pk_bf16(v0[2], v0[3]); w.z = cvt_pk_bf16(v1[0], v1[1]); w.w = cvt_pk_bf16(v1[2], v1[3]);
                    *(u32x4*)(rowp + bj * 128) = w; } }
    }
};
typedef f32x4 (&AccMut)[2][2][4][2];
struct EpiBranch {
    static constexpr bool PERM = true, CHAIN = true;
    const bf16_t* proj; bf16_t* merged;
    __device__ __forceinline__ void operator()(AccMut acc, const Unit& u, int wr, int wc) const {
        const int ln_ = fresh_lane(), fr = ln_ & 15, fq = ln_ >> 4;
        const int br = u.aux; const int col0 = u.pn * 256 + wc * 32 + 8 * fq;
#pragma unroll
        for (int ai = 0; ai < 2; ++ai)
#pragma unroll
            for (int m = 0; m < 4; ++m) { const size_t row = (size_t)(u.pm * 256 + ai * 128 + wr * 64 + m * 16 + fr);
#pragma unroll
                for (int bj = 0; bj < 2; ++bj) { const int col = col0 + bj * 128;
                    const bf16_t* gp = proj + row * INW + OFF_G + br * DM + col;
                    const u32x4 gw = *(const u32x4*)gp;
                    const f32x4 g0 = (f32x4){bflo(gw.x), bfhi(gw.x), bflo(gw.y), bfhi(gw.y)}, g1 = (f32x4){bflo(gw.z), bfhi(gw.z), bflo(gw.w), bfhi(gw.w)};
                    if (br < 2) { const u32x4 hw = *(const u32x4*)(gp + DM);
                        const f32x4 r0 = (f32x4){__builtin_amdgcn_rcpf(fmaxf(bflo(hw.x), 1e-30f)), __builtin_amdgcn_rcpf(fmaxf(bfhi(hw.x), 1e-30f)), __builtin_amdgcn_rcpf(fmaxf(bflo(hw.y), 1e-30f)), __builtin_amdgcn_rcpf(fmaxf(bfhi(hw.y), 1e-30f))};
                        const f32x4 r1 = (f32x4){__builtin_amdgcn_rcpf(fmaxf(bflo(hw.z), 1e-30f)), __builtin_amdgcn_rcpf(fmaxf(bfhi(hw.z), 1e-30f)), __builtin_amdgcn_rcpf(fmaxf(bflo(hw.w), 1e-30f)), __builtin_amdgcn_rcpf(fmaxf(bfhi(hw.w), 1e-30f))};
                        acc[ai][bj][m][0] = acc[ai][bj][m][0] * (g0 * r0); acc[ai][bj][m][1] = acc[ai][bj][m][1] * (g1 * r1); }
                    else { const f32x4 v0 = acc[ai][bj][m][0] * g0, v1 = acc[ai][bj][m][1] * g1;
                        u32x4 w; w.x = cvt_pk_bf16(v0[0], v0[1]); w.y = cvt_pk_bf16(v0[2], v0[3]); w.z = cvt_pk_bf16(v1[0], v1[1]); w.w = cvt_pk_bf16(v1[2], v1[3]);
                        *(u32x4*)(merged + row * DM + col) = w; } } }
    }
};
struct EpiResid {
    static constexpr bool PERM = false, CHAIN = false;
    const float* src_lat; const float* src_ctx; float* dst_lat; float* dst_ctx; const float* gate;
    LAS unsigned char* lds;
    __device__ __forceinline__ void operator()(AccRef acc, const Unit& u, int wr, int wc) const {
        const int ln_ = fresh_lane(), fr = ln_ & 15, fq = ln_ >> 4;
        const int pm = u.pm; const int b = pm < 64 ? (pm >> 4) : 4; const float* g = gate + (size_t)b * 12288;
        const float* s0 = pm < 64 ? src_lat + (size_t)pm * 256 * DM : src_ctx + (size_t)(pm - 64) * 256 * DM;
        float* d0 = pm < 64 ? dst_lat + (size_t)pm * 256 * DM : dst_ctx + (size_t)(pm - 64) * 256 * DM;
        if (u.aux) {
            const int col0 = u.pn * 256 + wc * 32 + 4 * fq;
#pragma unroll
            for (int ai = 0; ai < 2; ++ai)
#pragma unroll
                for (int m = 0; m < 4; ++m) { const size_t ro = (size_t)(ai * 128 + wr * 64 + m * 16 + fr) * DM;
#pragma unroll
                    for (int bj = 0; bj < 2; ++bj)
#pragma unroll
                        for (int n = 0; n < 2; ++n) { const int col = col0 + bj * 128 + n * 16; const f32x4 v = *(const f32x4*)(g + col) * acc[ai][bj][m][n]; float* d = d0 + ro + col;
                            unsafeAtomicAdd(d, v[0]); unsafeAtomicAdd(d + 1, v[1]); unsafeAtomicAdd(d + 2, v[2]); unsafeAtomicAdd(d + 3, v[3]); } }
            return;
        }
        LAS float* sc = (LAS float*)(lds + 131072 + (wr * 4 + wc) * 2048);
        const int rrow = ln_ >> 3, rc = (ln_ & 7) * 4;
        f32x4 gr[2];
#pragma unroll
        for (int bj = 0; bj < 2; ++bj) gr[bj] = *(const f32x4*)(g + u.pn * 256 + bj * 128 + wc * 32 + rc);
#pragma unroll
        for (int ai = 0; ai < 2; ++ai)
#pragma unroll
            for (int m = 0; m < 4; ++m)
#pragma unroll
                for (int bj = 0; bj < 2; ++bj) {
                    *(LAS f32x4*)(sc + fr * 32 + 4 * fq) = acc[ai][bj][m][0]; *(LAS f32x4*)(sc + fr * 32 + 16 + 4 * fq) = acc[ai][bj][m][1];
                    asm volatile("s_waitcnt lgkmcnt(0)" ::: "memory");
#pragma unroll
                    for (int i = 0; i < 2; ++i) { const int row = rrow + 8 * i; const f32x4 v = *(const LAS f32x4*)(sc + row * 32 + rc);
                        const size_t off = (size_t)(ai * 128 + wr * 64 + m * 16 + row) * DM + u.pn * 256 + bj * 128 + wc * 32 + rc;
                        *(f32x4*)(d0 + off) = *(const f32x4*)(s0 + off) + gr[bj] * v; }
                    asm volatile("s_waitcnt lgkmcnt(0)" ::: "memory");
                }
    }
};

struct EpiUpConv {
    static constexpr bool PERM = true, CHAIN = false;
    bf16_t* hmid; float* sb; const float* cw; const float* cbias;
    __device__ __forceinline__ void operator()(AccRef acc, const Unit& u, int wr, int wc) const {
        const int ln_ = fresh_lane(), fr = ln_ & 15, fq = ln_ >> 4;
        const int pm = u.pm, ch0 = u.pn * 128 + wc * 32 + 8 * fq;
        f32x4 w0[2], w1[2], w2[2], cb[2];
#pragma unroll
        for (int n = 0; n < 2; ++n) { w0[n] = *(const f32x4*)(cw + ch0 + 4 * n); w1[n] = *(const f32x4*)(cw + DFF + ch0 + 4 * n); w2[n] = *(const f32x4*)(cw + 2 * DFF + ch0 + 4 * n); cb[n] = *(const f32x4*)(cbias + ch0 + 4 * n); }
#pragma unroll
        for (int ai = 0; ai < 2; ++ai) {
            const int blk = pm * 4 + ai * 2 + wr;
            float* sbb = sb + (size_t)blk * 6 * DFF + ch0;
#pragma unroll
            for (int m = 0; m < 4; ++m) {
                f32x4 o[2];
#pragma unroll
                for (int n = 0; n < 2; ++n) {
                    const f32x4 am = acc[ai][0][m][n], gm = acc[ai][1][m][n];
                    const f32x4 z = (f32x4){0.f, 0.f, 0.f, 0.f};
                    const f32x4 ap = (m > 0) ? acc[ai][0][m > 0 ? m - 1 : 0][n] : z, an = (m < 3) ? acc[ai][0][m < 3 ? m + 1 : 3][n] : z;
                    const f32x4 tp = (fr == 15) ? ap : am, tn = (fr == 0) ? an : am;
                    f32x4 pv, nv;
#pragma unroll
                    for (int e = 0; e < 4; ++e) { pv[e] = __int_as_float(__builtin_amdgcn_update_dpp(0, __float_as_int(tp[e]), 0x121, 0xF, 0xF, false));
                        nv[e] = __int_as_float(__builtin_amdgcn_update_dpp(0, __float_as_int(tn[e]), 0x12F, 0xF, 0xF, false)); }
                    const f32x4 y = cb[n] + w0[n] * pv + w1[n] * am + w2[n] * nv;
                    o[n] = (f32x4){fsilu(y[0]) * gm[0], fsilu(y[1]) * gm[1], fsilu(y[2]) * gm[2], fsilu(y[3]) * gm[3]};
                    if (m == 0 && fr == 0) { *(f32x4*)(sbb + 0 * DFF + 4 * n) = y; *(f32x4*)(sbb + 2 * DFF + 4 * n) = gm; *(f32x4*)(sbb + 4 * DFF + 4 * n) = am; }
                    if (m == 3 && fr == 15) { *(f32x4*)(sbb + 1 * DFF + 4 * n) = y; *(f32x4*)(sbb + 3 * DFF + 4 * n) = gm; *(f32x4*)(sbb + 5 * DFF + 4 * n) = am; }
                }
                u32x4 w; w.x = cvt_pk_bf16(o[0][0], o[0][1]); w.y = cvt_pk_bf16(o[0][2], o[0][3]); w.z = cvt_pk_bf16(o[1][0], o[1][1]); w.w = cvt_pk_bf16(o[1][2], o[1][3]);
                *(u32x4*)(hmid + (size_t)(pm * 256 + ai * 128 + wr * 64 + m * 16 + fr) * DFF + ch0) = w;
            }
        }
    }
};
__device__ __forceinline__ void ffn_fix_rows(bf16_t* hmid, const float* sb, const float* cw, int nblk, int gtid, int NT) {
    const int nitems = nblk * 2 * (DFF / 4);
    for (int it = gtid; it < nitems; it += NT) {
        const int c4 = (it % (DFF / 4)) * 4, bw = it / (DFF / 4), which = bw & 1, blk = bw >> 1;
        const int row0 = blk * 64; const int rel = row0 < MLAT ? (row0 & 4095) : ((row0 - MLAT) & 255), seqlen = row0 < MLAT ? 4096 : 256;
        const bool edge = which ? (rel + 64 == seqlen) : (rel == 0);
        const float* s = sb + (size_t)blk * 6 * DFF + c4;
        f32x4 y = *(const f32x4*)(s + which * DFF); const f32x4 g = *(const f32x4*)(s + (2 + which) * DFF);
        if (!edge) { const float* sn = sb + (size_t)(which ? blk + 1 : blk - 1) * 6 * DFF + c4; const f32x4 an = *(const f32x4*)(sn + (which ? 4 : 5) * DFF);
            const f32x4 w = *(const f32x4*)(cw + (which ? 2 * DFF : 0) + c4); y = y + w * an; }
        u32x2 o; o.x = cvt_pk_bf16(fsilu(y[0]) * g[0], fsilu(y[1]) * g[1]); o.y = cvt_pk_bf16(fsilu(y[2]) * g[2], fsilu(y[3]) * g[3]);
        *(u32x2*)(hmid + (size_t)(row0 + (which ? 63 : 0)) * DFF + c4) = o;
    }
}

struct Args { const float* in[22]; float* out; unsigned char* ws; int ph_lo, ph_hi; };

template <bool UPMAP = false>
__device__ __forceinline__ void transpose_item(const float* W, int N, bf16_t* WT, int ldk, int koff, LAS float* scr, int item, int lane) {
    const int nblk = N / 32, kb = item / nblk, nb = item % nblk, k0 = 64 * kb, n0 = 32 * nb;
    const int r0 = UPMAP ? (n0 < DFF ? (n0 >> 7) * 256 + (n0 & 127) : ((n0 - DFF) >> 7) * 256 + 128 + ((n0 - DFF) & 127)) : n0;
#pragma unroll 8
    for (int i = 0; i < 32; ++i) { const int kk = 2 * i + (lane >> 5); scr[kk * 33 + (lane & 31)] = W[(size_t)(k0 + kk) * N + n0 + (lane & 31)]; }
    LDS_WAIT(); asm volatile("" ::: "memory");
    const int c = lane & 7;
#pragma unroll
    for (int j = 0; j < 4; ++j) { const int n = (lane >> 3) + 8 * j; const LAS float* s = scr + (8 * c) * 33 + n;
        u32x4 o; o.x = cvt_pk_bf16(s[0 * 33], s[1 * 33]); o.y = cvt_pk_bf16(s[2 * 33], s[3 * 33]); o.z = cvt_pk_bf16(s[4 * 33], s[5 * 33]); o.w = cvt_pk_bf16(s[6 * 33], s[7 * 33]);
        *(u32x4*)(WT + (size_t)(r0 + n) * ldk + koff + k0 + 8 * c) = o; }
    LDS_WAIT(); asm volatile("" ::: "memory");
}
template <class AR>
__device__ __forceinline__ void convert_weights(const AR& a, int l, LAS float* scr, int gw, int NGW, int lane) {
    unsigned char* ws = a.ws;
    const float* w_in = a.in[8] + (size_t)l * DM * INW; const float* w_f = a.in[13] + (size_t)l * 512 * DM; const float* w_na = a.in[14] + (size_t)l * 1024 * DM;
    const float* w_c = a.in[15] + (size_t)l * 512 * DM; const float* w_o = a.in[16] + (size_t)l * DM * DM; const float* w_up = a.in[17] + (size_t)l * DM * UPW; const float* w_dn = a.in[20] + (size_t)l * DFF * DM;
    constexpr int I_IN = 32 * 336, I_F = 8 * 64, I_NA = 16 * 64, I_C = 8 * 64, I_O = 32 * 64, I_UP = 32 * 352, I_DN = 88 * 64;
    constexpr int NITEMS = I_IN + I_F + I_NA + I_C + I_O + I_UP + I_DN;
    for (int it = gw; it < NITEMS; it += NGW) {
        int r = it;
        if (r < I_IN) { transpose_item(w_in, INW, (bf16_t*)(ws + WS_WIN), DM, 0, scr, r, lane); continue; } r -= I_IN;
        if (r < I_F) { transpose_item(w_f, DM, (bf16_t*)(ws + WS_WBR), DM, 0, scr, r, lane); continue; } r -= I_F;
        if (r < I_NA) { transpose_item(w_na, DM, (bf16_t*)(ws + WS_WBR), DM, 512, scr, r, lane); continue; } r -= I_NA;
        if (r < I_C) { transpose_item(w_c, DM, (bf16_t*)(ws + WS_WBR), DM, 1536, scr, r, lane); continue; } r -= I_C;
        if (r < I_O) { transpose_item(w_o, DM, (bf16_t*)(ws + WS_WO), DM, 0, scr, r, lane); continue; } r -= I_O;
        if (r < I_UP) { transpose_item<true>(w_up, UPW, (bf16_t*)(ws + WS_WUP), DM, 0, scr, r, lane); continue; } r -= I_UP;
        transpose_item(w_dn, DM, (bf16_t*)(ws + WS_WDN), DFF, 0, scr, r, lane);
    }
}
__device__ __forceinline__ void dft_tables(unsigned char* ws, const LAS float* lut, int gw, int NGW, int lane) {
    bf16_t* tt = (bf16_t*)(ws + WS_TT); bf16_t* ma = (bf16_t*)(ws + WS_MA); bf16_t* dftc = (bf16_t*)(ws + WS_DFTC);
    const int half = lane >> 5, x0 = (lane & 31) * 2;
    for (int it = gw; it < 16384 + 256 + 256; it += NGW) {
        if (it < 16384) { const int k2 = it >> 8, k1 = it & 255; float v0 = 0.f, v1 = 0.f;
            if (k1 < 64) { const int k = 64 * k1 + k2, sh = half ? 3072 : 0;
                v0 = lut[(x0 * k + sh) & 4095]; v1 = lut[((x0 + 1) * k + sh) & 4095]; }
            *(unsigned*)(tt + (size_t)it * 128 + half * 64 + x0) = cvt_pk_bf16(v0, v1);
        } else if (it < 16384 + 256) { const int r = it - 16384; float v0 = 0.f, v1 = 0.f;
            if ((r & 64) == 0) { const int k2 = r & 63, im = r >> 7;
                const int sh = im ? (half ? 2048 : 1024) : (half ? 1024 : 0);
                v0 = lut[(((x0 * k2) & 63) * 64 + sh) & 4095]; v1 = lut[((((x0 + 1) * k2) & 63) * 64 + sh) & 4095]; }
            *(unsigned*)(ma + (size_t)r * 128 + half * 64 + x0) = cvt_pk_bf16(v0, v1);
        } else { const int k = it - 16384 - 256; const int n0 = lane * 8; const int nn = n0 & 255, sh = n0 >= 256 ? 1024 : 0; float v[8];
#pragma unroll
            for (int e = 0; e < 8; ++e) v[e] = lut[((((k * (nn + e)) & 255) * 16) + sh) & 4095];
            u32x4 w; w.x = cvt_pk_bf16(v[0], v[1]); w.y = cvt_pk_bf16(v[2], v[3]); w.z = cvt_pk_bf16(v[4], v[5]); w.w = cvt_pk_bf16(v[6], v[7]);
            *(u32x4*)(dftc + (size_t)k * 8192 + n0) = w; }
    }
}
template <class AR>
__device__ __forceinline__ void mods_items(const AR& a, int gw, int NGW, int lane) {
    float* mods = (float*)(a.ws + WS_MODS);
    for (int it = gw; it < 1536; it += NGW) {
        const int l = it / 768, rem = it % 768, cch = rem >> 4, kp = rem & 15; const int col = cch * 256 + lane * 4, k0 = kp * 128;
        float sv[5][2];
#pragma unroll
        for (int r = 0; r < 5; ++r)
#pragma unroll
            for (int i = 0; i < 2; ++i) { const int k = k0 + lane + 64 * i; const float cv = r < 4 ? a.in[1][r * DM + k] : a.in[3][k]; sv[r][i] = fsilu(cv); }
        f32x4 acc[5];
#pragma unroll
        for (int r = 0; r < 5; ++r) acc[r] = (f32x4){0.f, 0.f, 0.f, 0.f};
        const float* wbase = a.in[4] + ((size_t)l * DM + k0) * 12288 + col;
#pragma unroll
        for (int i = 0; i < 2; ++i) {
#pragma unroll 16
            for (int ll = 0; ll < 64; ++ll) { const f32x4 w = *(const f32x4*)(wbase + (size_t)(i * 64 + ll) * 12288);
#pragma unroll
                for (int r = 0; r < 5; ++r) { const float s = __int_as_float(__builtin_amdgcn_readlane(__float_as_int(sv[r][i]), ll)); acc[r] += w * s; } }
        }
        if (kp == 0) { const f32x4 bv = *(const f32x4*)(a.in[5] + (size_t)l * 12288 + col);
#pragma unroll
            for (int r = 0; r < 5; ++r) acc[r] += bv; }
#pragma unroll
        for (int r = 0; r < 5; ++r) { float* d = mods + ((size_t)l * 5 + r) * 12288 + col; unsafeAtomicAdd(d, acc[r][0]); unsafeAtomicAdd(d + 1, acc[r][1]); unsafeAtomicAdd(d + 2, acc[r][2]); unsafeAtomicAdd(d + 3, acc[r][3]); }
    }
}
__device__ __forceinline__ void norm_rows(const float* xlat, const float* xctx, const float* w, const float* mods_l, int shoff, int scoff, bf16_t* XN, int nrows, int gw, int NGW, int lane) {
    for (int row = gw; row < nrows; row += NGW) {
        const float* xr = row < MLAT ? xlat + (size_t)row * DM : xctx + (size_t)(row - MLAT) * DM; const int b = row < MLAT ? (row >> 12) : 4;
        const float* sh = mods_l + (size_t)b * 12288 + shoff; const float* sc = mods_l + (size_t)b * 12288 + scoff;
        f32x4 v[8]; float ss = 0.f;
#pragma unroll
        for (int j = 0; j < 8; ++j) { v[j] = *(const f32x4*)(xr + 4 * lane + 256 * j); ss += (v[j][0] * v[j][0] + v[j][1] * v[j][1]) + (v[j][2] * v[j][2] + v[j][3] * v[j][3]); }
        const float rstd = rsqrtf(wave_sum(ss, lane) * (1.0f / DM) + EPS);
#pragma unroll
        for (int j = 0; j < 8; ++j) { const int col = 4 * lane + 256 * j; const f32x4 wv = *(const f32x4*)(w + col), scv = *(const f32x4*)(sc + col), shv = *(const f32x4*)(sh + col);
            const f32x4 o = (v[j] * rstd * wv) * (scv + 1.0f) + shv; u32x2 pk; pk.x = cvt_pk_bf16(o[0], o[1]); pk.y = cvt_pk_bf16(o[2], o[3]);
            *(u32x2*)(XN + (size_t)row * DM + col) = pk; }
    }
}
__device__ __forceinline__ void final_norm(float* x, const float* w, int gw, int NGW, int lane) {
    for (int row = gw; row < MLAT; row += NGW) { float* xr = x + (size_t)row * DM; f32x4 v[8]; float ss = 0.f;
#pragma unroll
        for (int j = 0; j < 8; ++j) { v[j] = *(const f32x4*)(xr + 4 * lane + 256 * j); ss += (v[j][0] * v[j][0] + v[j][1] * v[j][1]) + (v[j][2] * v[j][2] + v[j][3] * v[j][3]); }
        const float rstd = rsqrtf(wave_sum(ss, lane) * (1.0f / DM) + EPS);
#pragma unroll
        for (int j = 0; j < 8; ++j) { const int col = 4 * lane + 256 * j; *(f32x4*)(xr + col) = v[j] * rstd * *(const f32x4*)(w + col); } }
}
__device__ __forceinline__ void sgu_unit(bf16_t* proj, int row0, int g, const float* nw, const float* wsg, const float* bsg, LAS unsigned char* lds, int tid) {
    LAS bf16_t* vnt = (LAS bf16_t*)lds;
    const int lane = tid & 63, wid = tid >> 6, fr = lane & 15, fq = lane >> 4;
    {
        const int j = tid >> 2, q = tid & 3; const bf16_t* src = proj + (size_t)(row0 + j) * INW + OFF_C + 512 + g * 128 + q * 32;
        float v[32];
#pragma unroll
        for (int i = 0; i < 4; ++i) { const u32x4 w = *(const u32x4*)(src + 8 * i);
            v[8 * i + 0] = bflo(w.x); v[8 * i + 1] = bfhi(w.x); v[8 * i + 2] = bflo(w.y); v[8 * i + 3] = bfhi(w.y); v[8 * i + 4] = bflo(w.z); v[8 * i + 5] = bfhi(w.z); v[8 * i + 6] = bflo(w.w); v[8 * i + 7] = bfhi(w.w); }
        float s = 0.f;
#pragma unroll
        for (int e = 0; e < 32; ++e) s += v[e];
        s += shx(s, 1, lane); s += shx(s, 2, lane); const float mean = s * (1.0f / 128.0f);
        float qv = 0.f;
#pragma unroll
        for (int e = 0; e < 32; ++e) { v[e] -= mean; qv += v[e] * v[e]; }
        qv += shx(qv, 1, lane); qv += shx(qv, 2, lane); const float rstd = rsqrtf(qv * (1.0f / 128.0f) + EPS);
#pragma unroll
        for (int e = 0; e < 32; e += 2) { const int d = q * 32 + e; const unsigned w = cvt_pk_bf16(v[e] * rstd * nw[g * 128 + d], v[e + 1] * rstd * nw[g * 128 + d + 1]);
            vnt[d * 136 + j] = (bf16_t)(w & 0xffffu); vnt[(d + 1) * 136 + j] = (bf16_t)(w >> 16); }
    }
    __syncthreads();
    {
        const int i = 16 * wid + fr;
        bf16x8 wf[4];
#pragma unroll
        for (int ks = 0; ks < 4; ++ks) { const float* wp = wsg + (size_t)i * 128 + 32 * ks + 8 * fq; const f32x4 a = *(const f32x4*)wp, b = *(const f32x4*)(wp + 4);
            u32x4 w; w.x = cvt_pk_bf16(a[0], a[1]); w.y = cvt_pk_bf16(a[2], a[3]); w.z = cvt_pk_bf16(b[0], b[1]); w.w = cvt_pk_bf16(b[2], b[3]); wf[ks] = __builtin_bit_cast(bf16x8, w); }
        const float bias = bsg[i];
        bf16_t* up = proj + (size_t)(row0 + i) * INW + OFF_C + g * 128 + 4 * fq;
#pragma unroll
        for (int nt = 0; nt < 8; ++nt) { f32x4 acc = (f32x4){0.f, 0.f, 0.f, 0.f};
#pragma unroll
            for (int ks = 0; ks < 4; ++ks) { const bf16x8 af = *(const LAS bf16x8*)((const LAS unsigned char*)vnt + (16 * nt + fr) * 272 + (32 * ks + 8 * fq) * 2);
                acc = __builtin_amdgcn_mfma_f32_16x16x32_bf16(af, wf[ks], acc, 0, 0, 0); }
            const u32x2 uw = *(const u32x2*)(up + 16 * nt); u32x2 o;
            o.x = cvt_pk_bf16(bflo(uw.x) * (acc[0] + bias), bfhi(uw.x) * (acc[1] + bias)); o.y = cvt_pk_bf16(bflo(uw.y) * (acc[2] + bias), bfhi(uw.y) * (acc[3] + bias));
            *(u32x2*)(up + 16 * nt) = o; }
    }
    __syncthreads();
}
template <bool LAT>
__device__ __forceinline__ void attn_task(bf16_t* proj, const bf16_t* vt, const float* rpb, int t, int lane, const LAS unsigned char* cl) {
    constexpr int NCH = LAT ? 16 : 8, WCH = LAT ? 8 : 0;
    const int fr = lane & 15, fq = lane >> 4;
    int b, h, r = 0, cgp = 0, qrow;
    if (LAT) { cgp = t & 3; r = (t >> 2) & 63; h = (t >> 8) & 7; b = t >> 11; qrow = b * 4096 + r * 64 + cgp * 16 + fr; }
    else { const int qg = t & 15; h = (t >> 4) & 7; b = t >> 7; qrow = MLAT + b * 256 + qg * 16 + fr; }
    bf16_t* qp = proj + (size_t)qrow * INW + OFF_Q + h * 128;
    bf16x8 qf[4];
#pragma unroll
    for (int ks = 0; ks < 4; ++ks) qf[ks] = *(const bf16x8*)(qp + ks * 32 + fq * 8);
    const int rs = r < 4 ? 0 : (r > 60 ? 56 : r - 4);
    const int cb = cgp == 0 ? 0 : (cgp == 1 ? 8 : (cgp == 2 ? 24 : 32));
    float S[NCH][8];
    const int kap = 8 * (fr >> 2) + (fr & 3);
    const bf16_t* kbase = proj + OFF_K + h * 128 + fq * 8;
    bf16x8 kf[2][8];
#define ATT_LOADK(buf, c) do { _Pragma("unroll") for (int tt = 0; tt < 2; ++tt) { \
        if ((c) < WCH) { const int krow = b * 4096 + (rs + (c)) * 64 + cb + kap + 4 * tt; const bf16_t* kp = kbase + (size_t)krow * INW; \
            _Pragma("unroll") for (int ks = 0; ks < 4; ++ks) kf[buf][tt * 4 + ks] = *(const bf16x8*)(kp + ks * 32); } \
        else { const LAS unsigned char* kp = cl + (32 * ((c) - WCH) + kap + 4 * tt) * 256; \
            _Pragma("unroll") for (int ks = 0; ks < 4; ++ks) kf[buf][tt * 4 + ks] = *(const LAS bf16x8*)(kp + (((ks * 4 + fq) ^ fr) * 16)); } } } while (0)
    ATT_LOADK(0, 0);
#pragma unroll
    for (int c = 0; c < NCH; ++c) {
        if (c + 1 < NCH) ATT_LOADK((c + 1) & 1, c + 1);
        __builtin_amdgcn_sched_barrier(0);
#pragma unroll
        for (int tt = 0; tt < 2; ++tt) {
            f32x4 acc = (f32x4){0.f, 0.f, 0.f, 0.f};
#pragma unroll
            for (int ks = 0; ks < 4; ++ks) acc = __builtin_amdgcn_mfma_f32_16x16x32_bf16(kf[c & 1][tt * 4 + ks], qf[ks], acc, 0, 0, 0);
            S[c][4 * tt + 0] = acc[0]; S[c][4 * tt + 1] = acc[1]; S[c][4 * tt + 2] = acc[2]; S[c][4 * tt + 3] = acc[3];
        }
        __builtin_amdgcn_sched_barrier(0);
    }
#undef ATT_LOADK
    if (LAT) {
        const int qc = cgp * 16 + fr; const int cs = qc < 8 ? 0 : (qc > 56 ? 48 : qc - 8);
#pragma unroll
        for (int c = 0; c < WCH; ++c) { const int dr = rs + c - r + 7; const float* rp = rpb + (h * 15 + dr) * 31;
#pragma unroll
            for (int jj = 0; jj < 8; ++jj) { const int kc = cb + 8 * fq + jj; const bool valid = (kc >= cs) && (kc < cs + 16); int dc = kc - qc + 15; dc = dc < 0 ? 0 : (dc > 30 ? 30 : dc);
                const float bias = rp[dc]; S[c][jj] = valid ? S[c][jj] + bias : -1e30f; } }
    }
    float mx = -3.0e38f;
#pragma unroll
    for (int c = 0; c < NCH; ++c)
#pragma unroll
        for (int jj = 0; jj < 8; ++jj) mx = fmaxf(mx, S[c][jj]);
    mx = fmaxf(mx, shx(mx, 16, lane)); mx = fmaxf(mx, shx(mx, 32, lane));
    float sum = 0.f; bf16x8 pf[NCH];
#pragma unroll
    for (int c = 0; c < NCH; ++c) { float p[8];
#pragma unroll
        for (int jj = 0; jj < 8; ++jj) { p[jj] = __builtin_amdgcn_exp2f((S[c][jj] - mx) * 1.44269504089f); sum += p[jj]; }
        u32x4 w; w.x = cvt_pk_bf16(p[0], p[1]); w.y = cvt_pk_bf16(p[2], p[3]); w.z = cvt_pk_bf16(p[4], p[5]); w.w = cvt_pk_bf16(p[6], p[7]); pf[c] = __builtin_bit_cast(bf16x8, w); }
    sum += shx(sum, 16, lane); sum += shx(sum, 32, lane);
    const float inv = 1.0f / sum;
    const bf16_t* vlat = vt + ((size_t)(b * 1024 + h * 128 + fr)) * 4096 + cb + 8 * fq;
    constexpr int NBH = NCH / 8, NQ = 8 * NBH;
    bf16x8 vf[2][8];
#define ATT_LOADV(buf, q) do { const int dt_ = (q) / NBH, hb_ = (q) % NBH; _Pragma("unroll") for (int i = 0; i < 8; ++i) { const int c_ = hb_ * 8 + i; \
        if (c_ < WCH) vf[buf][i] = *(const bf16x8*)(vlat + (size_t)dt_ * 16 * 4096 + (rs + c_) * 64); \
        else vf[buf][i] = *(const LAS bf16x8*)(cl + 65536 + (dt_ * 16 + fr) * 512 + ((((c_ - WCH) * 4 + fq) ^ fr) * 16)); } } while (0)
    ATT_LOADV(0, 0);
    f32x4 oacc = (f32x4){0.f, 0.f, 0.f, 0.f};
#pragma unroll
    for (int q = 0; q < NQ; ++q) {
        if (q + 1 < NQ) ATT_LOADV((q + 1) & 1, q + 1);
        __builtin_amdgcn_sched_barrier(0);
        const int dt = q / NBH, hb = q % NBH;
        if (hb == 0) oacc = (f32x4){0.f, 0.f, 0.f, 0.f};
#pragma unroll
        for (int i = 0; i < 8; ++i) oacc = __builtin_amdgcn_mfma_f32_16x16x32_bf16(vf[q & 1][i], pf[hb * 8 + i], oacc, 0, 0, 0);
        if (hb == NBH - 1) { u32x2 o; o.x = cvt_pk_bf16(oacc[0] * inv, oacc[1] * inv); o.y = cvt_pk_bf16(oacc[2] * inv, oacc[3] * inv);
            *(u32x2*)(qp + dt * 16 + 4 * fq) = o; }
        __builtin_amdgcn_sched_barrier(0);
    }
#undef ATT_LOADV
}
template <bool LAT>
__device__ __forceinline__ void attn_pass(bf16_t* proj, const bf16_t* vt, const bf16_t* vtc, const float* rpb, int b, int h, int ra, LAS unsigned char* lds, int wave) {
    constexpr int NCH = LAT ? 16 : 8, WCH = LAT ? 8 : 0;
    const int lane = fresh_lane(), fr = lane & 15, fq = lane >> 4, tid = wave * 64 + lane;
    const int r = LAT ? ra + (wave >> 2) : 0, cgp = LAT ? (wave & 3) : 0;
    const int rsa = ra < 4 ? 0 : (ra > 60 ? 56 : ra - 4), rs = r < 4 ? 0 : (r > 60 ? 56 : r - 4), shw = rs - rsa;
    const int rsb = (ra + 1) < 4 ? 0 : ((ra + 1) > 60 ? 56 : ra + 1 - 4), T = 8 + (rsb - rsa);
    const int cb = cgp == 0 ? 0 : (cgp == 1 ? 8 : (cgp == 2 ? 24 : 32));
    const bool active = LAT || wave == 0;
    const int qrow = LAT ? (b * 4096 + r * 64 + cgp * 16 + fr) : (MLAT + b * 256 + ra * 16 + fr);
    bf16_t* qp = proj + (size_t)qrow * INW + OFF_Q + h * 128;
    bf16x8 qf[4];
#pragma unroll
    for (int ks = 0; ks < 4; ++ks) qf[ks] = *(const bf16x8*)(qp + ks * 32 + fq * 8);
    const int kap = 8 * (fr >> 2) + (fr & 3);
    float S[NCH][8];
    if (LAT) {
        __syncthreads();
        { u32x4 v[18];
#pragma unroll
          for (int i = 0; i < 18; ++i) { const int idx = tid + 512 * i, key = idx >> 4, ch = idx & 15;
            if (i < 2 * T) v[i] = *(const u32x4*)(proj + (size_t)(b * 4096 + rsa * 64 + key) * INW + OFF_K + h * 128 + ch * 8); }
#pragma unroll
          for (int i = 0; i < 18; ++i) { const int idx = tid + 512 * i, key = idx >> 4, ch = idx & 15, g = (key & 3) | (((key >> 3) & 3) << 2);
            if (i < 2 * T) *(LAS u32x4*)(lds + key * 256 + ((ch ^ g) * 16)) = v[i]; } }
        __syncthreads();
        const int gw = (fr & 3) | ((((cb >> 3) + (fr >> 2)) & 3) << 2);
#pragma unroll
        for (int c = 0; c < WCH; ++c) {
#pragma unroll
            for (int tt = 0; tt < 2; ++tt) { const LAS unsigned char* kp = lds + ((c + shw) * 64 + cb + kap + 4 * tt) * 256;
                f32x4 acc = (f32x4){0.f, 0.f, 0.f, 0.f};
#pragma unroll
                for (int ks = 0; ks < 4; ++ks) { const bf16x8 kf = *(const LAS bf16x8*)(kp + (((ks * 4 + fq) ^ gw) * 16)); acc = __builtin_amdgcn_mfma_f32_16x16x32_bf16(kf, qf[ks], acc, 0, 0, 0); }
                S[c][4 * tt + 0] = acc[0]; S[c][4 * tt + 1] = acc[1]; S[c][4 * tt + 2] = acc[2]; S[c][4 * tt + 3] = acc[3]; } }
    }
    __syncthreads();
    { u32x4 v[8];
#pragma unroll
      for (int i = 0; i < 8; ++i) { const int idx = tid + 512 * i, key = idx >> 4, ch = idx & 15; v[i] = *(const u32x4*)(proj + (size_t)(MLAT + b * 256 + key) * INW + OFF_K + h * 128 + ch * 8); }
#pragma unroll
      for (int i = 0; i < 8; ++i) { const int idx = tid + 512 * i, key = idx >> 4, ch = idx & 15, g = (key & 3) | (((key >> 3) & 3) << 2); *(LAS u32x4*)(lds + key * 256 + ((ch ^ g) * 16)) = v[i]; } }
    __syncthreads();
    float mx = -3.0e38f, sum = 0.f, inv = 0.f; bf16x8 pf[NCH];
    if (active) {
#pragma unroll
        for (int c = WCH; c < NCH; ++c) {
#pragma unroll
            for (int tt = 0; tt < 2; ++tt) { const LAS unsigned char* kp = lds + (32 * (c - WCH) + kap + 4 * tt) * 256;
                f32x4 acc = (f32x4){0.f, 0.f, 0.f, 0.f};
#pragma unroll
                for (int ks = 0; ks < 4; ++ks) { const bf16x8 kf = *(const LAS bf16x8*)(kp + (((ks * 4 + fq) ^ fr) * 16)); acc = __builtin_amdgcn_mfma_f32_16x16x32_bf16(kf, qf[ks], acc, 0, 0, 0); }
                S[c][4 * tt + 0] = acc[0]; S[c][4 * tt + 1] = acc[1]; S[c][4 * tt + 2] = acc[2]; S[c][4 * tt + 3] = acc[3]; } }
        if (LAT) {
            const int qc = cgp * 16 + fr; const int cs = qc < 8 ? 0 : (qc > 56 ? 48 : qc - 8);
#pragma unroll
            for (int c = 0; c < WCH; ++c) { const int dr = rs + c - r + 7; const float* rp = rpb + (h * 15 + dr) * 31;
#pragma unroll
                for (int jj = 0; jj < 8; ++jj) { const int kc = cb + 8 * fq + jj; const bool valid = (kc >= cs) && (kc < cs + 16); int dc = kc - qc + 15; dc = dc < 0 ? 0 : (dc > 30 ? 30 : dc);
                    const float bias = rp[dc]; S[c][jj] = valid ? S[c][jj] + bias : -1e30f; } }
        }
#pragma unroll
        for (int c = 0; c < NCH; ++c)
#pragma unroll
            for (int jj = 0; jj < 8; ++jj) mx = fmaxf(mx, S[c][jj]);
        mx = fmaxf(mx, shx(mx, 16, lane)); mx = fmaxf(mx, shx(mx, 32, lane));
#pragma unroll
        for (int c = 0; c < NCH; ++c) { float p[8];
#pragma unroll
            for (int jj = 0; jj < 8; ++jj) { p[jj] = __builtin_amdgcn_exp2f((S[c][jj] - mx) * 1.44269504089f); sum += p[jj]; }
            u32x4 w; w.x = cvt_pk_bf16(p[0], p[1]); w.y = cvt_pk_bf16(p[2], p[3]); w.z = cvt_pk_bf16(p[4], p[5]); w.w = cvt_pk_bf16(p[6], p[7]); pf[c] = __builtin_bit_cast(bf16x8, w); }
        sum += shx(sum, 16, lane); sum += shx(sum, 32, lane);
        inv = 1.0f / sum;
    }
    f32x4 oacc[8];
#pragma unroll
    for (int dt = 0; dt < 8; ++dt) oacc[dt] = (f32x4){0.f, 0.f, 0.f, 0.f};
    if (LAT) {
        __syncthreads();
        const int cpr = T * 8;
        { u32x4 v[18];
#pragma unroll
          for (int i = 0; i < 18; ++i) { const int idx = tid + 512 * i, d = idx / cpr, ch = idx - d * cpr;
            if (i < 2 * T) v[i] = *(const u32x4*)(vt + (size_t)(b * 1024 + h * 128 + d) * 4096 + rsa * 64 + ch * 8); }
#pragma unroll
          for (int i = 0; i < 18; ++i) { const int idx = tid + 512 * i, d = idx / cpr, ch = idx - d * cpr;
            if (i < 2 * T) *(LAS u32x4*)(lds + d * 1152 + (((ch & ~7) | ((ch & 7) ^ ((d >> 1) & 7))) * 16)) = v[i]; } }
        __syncthreads();
#pragma unroll
        for (int dt = 0; dt < 8; ++dt)
#pragma unroll
            for (int c = 0; c < WCH; ++c) { const int ch = (c + shw) * 8 + (cb >> 3) + fq;
                const bf16x8 vf = *(const LAS bf16x8*)(lds + (dt * 16 + fr) * 1152 + (((ch & ~7) | ((ch & 7) ^ (fr >> 1))) * 16));
                oacc[dt] = __builtin_amdgcn_mfma_f32_16x16x32_bf16(vf, pf[c], oacc[dt], 0, 0, 0); }
    }
    __syncthreads();
    { u32x4 v[8];
#pragma unroll
      for (int i = 0; i < 8; ++i) { const int idx = tid + 512 * i, d = idx >> 5, ch = idx & 31; v[i] = *(const u32x4*)(vtc + (size_t)(b * 1024 + h * 128 + d) * 256 + ch * 8); }
#pragma unroll
      for (int i = 0; i < 8; ++i) { const int idx = tid + 512 * i, d = idx >> 5, ch = idx & 31; *(LAS u32x4*)(lds + d * 512 + ((ch ^ (d & 15)) * 16)) = v[i]; } }
    __syncthreads();
    if (active) {
#pragma unroll
        for (int dt = 0; dt < 8; ++dt) {
#pragma unroll
            for (int c = WCH; c < NCH; ++c) { const bf16x8 vf = *(const LAS bf16x8*)(lds + (dt * 16 + fr) * 512 + ((((c - WCH) * 4 + fq) ^ fr) * 16));
                oacc[dt] = __builtin_amdgcn_mfma_f32_16x16x32_bf16(vf, pf[c], oacc[dt], 0, 0, 0); }
            u32x2 o; o.x = cvt_pk_bf16(oacc[dt][0] * inv, oacc[dt][1] * inv); o.y = cvt_pk_bf16(oacc[dt][2] * inv, oacc[dt][3] * inv);
            *(u32x2*)(qp + dt * 16 + 4 * fq) = o; }
    }
}
__device__ __forceinline__ void attn_block(bf16_t* proj, const bf16_t* vt, const bf16_t* vtc, const float* rpb, int vcu, int half, bool ctxq, LAS unsigned char* lds, int wave) {
    const int bh = vcu >> 3, b = bh >> 3, h = bh & 7, rb = vcu & 7;
    __syncthreads();
    { const int tid = wave * 64 + fresh_lane();
#pragma unroll
      for (int i = 0; i < 8; ++i) { const int idx = tid + 512 * i, key = idx >> 4, ch = idx & 15, g = (key & 3) | (((key >> 3) & 3) << 2);
          const u32x4 v = *(const u32x4*)(proj + (size_t)(MLAT + b * 256 + key) * INW + OFF_K + h * 128 + ch * 8);
          *(LAS u32x4*)(lds + key * 256 + ((ch ^ g) * 16)) = v; }
#pragma unroll
      for (int i = 0; i < 8; ++i) { const int idx = tid + 512 * i, d = idx >> 5, ch = idx & 31;
          const u32x4 v = *(const u32x4*)(vtc + (size_t)(b * 1024 + h * 128 + d) * 256 + ch * 8);
          *(LAS u32x4*)(lds + 65536 + d * 512 + ((ch ^ (d & 15)) * 16)) = v; } }
    __syncthreads();
    const int lane = fresh_lane();
    for (int round = 0; round < 2; ++round) { const int r = rb * 8 + half * 4 + round * 2 + (wave >> 2), cgp = wave & 3;
        attn_task<true>(proj, vt, rpb, ((bh * 64 + r) << 2) + cgp, lane, lds); }
    if (ctxq && wave == 0) attn_task<false>(proj, vt, rpb, bh * 16 + rb * 2 + half, lane, lds);
}
__device__ __forceinline__ void conv_items(const bf16_t* up, bf16_t* hmid, const float* cw, const float* cbias, int nrows, int gtid, int NT) {
    const int nitems = (nrows / 16) * 704;
    for (int it = gtid; it < nitems; it += NT) {
        const int cg8 = it % 704, rb = it / 704; const int row0 = rb * 16, ch = cg8 * 8;
        const int seqlen = row0 < MLAT ? 4096 : 256; const int ts = (row0 < MLAT ? row0 : row0 - MLAT) & (seqlen - 1);
        float w0[8], w1[8], w2[8], bb[8];
#pragma unroll
        for (int e = 0; e < 8; ++e) { w0[e] = cw[ch + e]; w1[e] = cw[DFF + ch + e]; w2[e] = cw[2 * DFF + ch + e]; bb[e] = cbias[ch + e]; }
        const bf16_t* ap = up + (size_t)row0 * UPW + ch; const bf16_t* gp = ap + DFF; bf16_t* hp = hmid + (size_t)row0 * DFF + ch;
        u32x4 prev = (u32x4){0u, 0u, 0u, 0u}; if (ts > 0) prev = *(const u32x4*)(ap - UPW);
        u32x4 cur = *(const u32x4*)ap;
        for (int i = 0; i < 16; ++i) {
            u32x4 nxt = (u32x4){0u, 0u, 0u, 0u}; if (i < 15 || ts + 16 < seqlen) nxt = *(const u32x4*)(ap + (size_t)(i + 1) * UPW);
            const u32x4 gw = *(const u32x4*)(gp + (size_t)i * UPW);
            float o[8];
#pragma unroll
            for (int e = 0; e < 4; ++e) {
                const float y0 = bb[2 * e] + w0[2 * e] * bflo(prev[e]) + w1[2 * e] * bflo(cur[e]) + w2[2 * e] * bflo(nxt[e]);
                const float y1 = bb[2 * e + 1] + w0[2 * e + 1] * bfhi(prev[e]) + w1[2 * e + 1] * bfhi(cur[e]) + w2[2 * e + 1] * bfhi(nxt[e]);
                o[2 * e] = fsilu(y0) * bflo(gw[e]); o[2 * e + 1] = fsilu(y1) * bfhi(gw[e]); }
            u32x4 w; w.x = cvt_pk_bf16(o[0], o[1]); w.y = cvt_pk_bf16(o[2], o[3]); w.z = cvt_pk_bf16(o[4], o[5]); w.w = cvt_pk_bf16(o[6], o[7]);
            *(u32x4*)(hp + (size_t)i * DFF) = w;
            prev = cur; cur = nxt;
        }
    }
}


#define XB_TMO      128
#define XB_XCNT(j)  (256  + 64 * (j))
#define XB_XSUB(j)  (1280 + 64 * (j))
#define XB_XGEN(j)  (2304 + 64 * (j))
#define XB_TOP      3328
#define XB_TOPGEN   3392
#define XCD_BAR_WORDS 3456
#define XB_SPIN_CAP (1u << 18)
__device__ __forceinline__ unsigned xb_ld(unsigned* p)              { return __hip_atomic_load(p, __ATOMIC_RELAXED, __HIP_MEMORY_SCOPE_AGENT); }
__device__ __forceinline__ unsigned xb_add(unsigned* p, unsigned v) { return __hip_atomic_fetch_add(p, v, __ATOMIC_RELAXED, __HIP_MEMORY_SCOPE_AGENT); }
__device__ __forceinline__ unsigned xb_xcc_id() { return (unsigned)__builtin_amdgcn_s_getreg((3 << 11) | 20) & 0xFu; }
#define XB_SPIN(cond, bar) do { unsigned _sp = 0; while (cond) { __builtin_amdgcn_s_sleep(1); \
    if ((++_sp & 255u) == 0u) { if (xb_ld(&(bar)[XB_TMO])) break; if (_sp > XB_SPIN_CAP) { atomicAdd(&(bar)[XB_TMO], 1u); break; } } } } while (0)
struct XcdBarrier { unsigned* bar; unsigned x; volatile LAS unsigned* st; };
__device__ __forceinline__ XcdBarrier xcd_barrier_post(unsigned* bar, volatile LAS unsigned* st) {
    XcdBarrier b; b.bar = bar; b.x = xb_xcc_id(); b.st = st;
    if (threadIdx.x == 0) (void)xb_add(&bar[XB_XCNT(b.x)], 1u);
    return b;
}
__device__ __forceinline__ void xcd_barrier_complete(unsigned* bar, unsigned x, unsigned& nloc, unsigned& nx) {
    const unsigned G = gridDim.x * gridDim.y * gridDim.z;
    unsigned sum, cnt, mine, sp = 0u;
    for (;;) {
        sum = 0u; cnt = 0u; mine = 0u;
#pragma unroll
        for (unsigned j = 0; j < 16; ++j) { const unsigned c = xb_ld(&bar[XB_XCNT(j)]); sum += c; cnt += (c > 0u) ? 1u : 0u; mine = (j == x) ? c : mine; }
        if (sum == G) break;
        __builtin_amdgcn_s_sleep(1);
        if ((++sp & 255u) == 0u) { if (xb_ld(&bar[XB_TMO])) break; if (sp > XB_SPIN_CAP) { atomicAdd(&bar[XB_TMO], 1u); break; } }
    }
    nloc = mine > 0u ? mine : 1u; nx = cnt > 0u ? cnt : 1u;
}
__device__ __forceinline__ void xcd_barrier(const XcdBarrier& b) {
    asm volatile("s_waitcnt vmcnt(0)" ::: "memory");
    __syncthreads();
    if (threadIdx.x == 0) {
        unsigned* bar = b.bar;
        __builtin_amdgcn_s_waitcnt(0);
        unsigned nloc = b.st[0], nx = b.st[1];
        if (nloc == 0u) { xcd_barrier_complete(bar, b.x, nloc, nx); b.st[0] = nloc; b.st[1] = nx; }
        const unsigned old = xb_add(&bar[XB_XSUB(b.x)], 1u);
        const unsigned gen = old / nloc;
        if (old + 1u == (gen + 1u) * nloc) {
            __builtin_amdgcn_fence(__ATOMIC_RELEASE, "agent");
            asm volatile("s_waitcnt vmcnt(0)" ::: "memory");
            const unsigned og = xb_add(&bar[XB_TOP], 1u);
            const unsigned tg = og / nx;
            if (og + 1u == (tg + 1u) * nx) xb_add(&bar[XB_TOPGEN], 1u);
            else XB_SPIN(xb_ld(&bar[XB_TOPGEN]) == tg, bar);
            __builtin_amdgcn_fence(__ATOMIC_ACQUIRE, "agent");
            xb_add(&bar[XB_XGEN(b.x)], 1u);
            asm volatile("s_waitcnt vmcnt(0)" ::: "memory");
        } else {
            XB_SPIN(xb_ld(&bar[XB_XGEN(b.x)]) == gen, bar);
            __builtin_amdgcn_fence(__ATOMIC_ACQUIRE, "agent");
            asm volatile("s_waitcnt vmcnt(0)" ::: "memory");
        }
    }
    __syncthreads();
}
constexpr int NPHASE = 24;
__global__ void __launch_bounds__(512, 2) mega(Args a_) {
    extern __shared__ __attribute__((aligned(16))) unsigned char lds_raw[];
    LAS unsigned char* lds = (LAS unsigned char*)lds_raw;
    cg::grid_group grid = cg::this_grid();
    const int G = gridDim.x, cu = blockIdx.x, NGW = G * 8, wave = __builtin_amdgcn_readfirstlane((int)threadIdx.x >> 6);

    volatile LAS unsigned* xst = (volatile LAS unsigned*)(lds + LDS_XST);
    if (threadIdx.x < 4) xst[threadIdx.x] = 0u;
    __syncthreads();
    const XcdBarrier xbar = xcd_barrier_post((unsigned*)(a_.ws + WS_BAR), xst);

    const int ph_lo = a_.ph_lo, ph_hi = a_.ph_hi;
    for (int p = ph_lo; p < ph_hi; ++p) {
        if (p > ph_lo) { if (p == 1) grid.sync(); else xcd_barrier(xbar); }
#define PH_IDS const int lane = fresh_lane(); const int tid = wave * 64 + lane, gw = cu * 8 + wave; (void)tid; (void)gw; (void)lane;
        typedef const __attribute__((address_space(4))) Args KArgs;
        KArgs* ap = (KArgs*)__builtin_amdgcn_kernarg_segment_ptr(); asm volatile("" : "+s"(ap));
        KArgs& a = *ap;
        unsigned char* ws = a.ws;
        unsigned* ctl = (unsigned*)(ws + WS_CTL);
        bf16_t* PROJ = (bf16_t*)(ws + WS_BIG); bf16_t* XN = (bf16_t*)(ws + WS_XN); bf16_t* HMID = (bf16_t*)(ws + WS_HMID);
        float* XC = (float*)(ws + WS_XC); float* mods = (float*)(ws + WS_MODS);
        bf16_t* VT = (bf16_t*)(ws + WS_VT); bf16_t* VTC = (bf16_t*)(ws + WS_VTC);
        if (p == 0) { PH_IDS
            LAS float* lut = (LAS float*)(lds + 72 * 1024);
            for (int i = tid; i < 4096; i += 512) lut[i] = cospif((float)i * (1.0f / 2048.0f));
            __syncthreads();
            if (cu == 0) { bf16_t* dd = (bf16_t*)(ws + WS_DFTD);
                for (int e = tid; e < 256 * 128; e += 512) { const int row = e >> 7, d = e & 127, j = row & 127; const float ang = (float)((j * d) & 127) * (1.0f / 64.0f);
                    const float v = row < 128 ? cospif(ang) : sinpif(ang); dd[e] = (bf16_t)(cvt_pk_bf16(v, 0.f) & 0xffffu); } }
            for (int i = cu * 512 + tid; i < 1024 * DM / 4; i += G * 512) ((f32x4*)XC)[i] = ((const f32x4*)a.in[2])[i];
            mods_items(a, gw, NGW, lane);
            convert_weights(a, 0, (LAS float*)(lds + wave * 8704), gw, NGW, lane);
            dft_tables(ws, lut, gw, NGW, lane);
            continue;
        }
        if (p == NPHASE - 1) { PH_IDS final_norm(a.out, a.in[21], gw, NGW, lane); continue; }
        const int l = (p - 1) / 11, s = (p - 1) % 11;
        const float* mods_l = mods + (size_t)l * 5 * 12288;
        const float* xlat = (l == 0) ? a.in[0] : a.out; const float* xctx = (l == 0) ? a.in[2] : XC;
        const int nMall = (l == 0) ? 68 : 64;
        switch (s) {
        case 0: { PH_IDS
            if (l == 1) { LAS float* lut = (LAS float*)(lds + 72 * 1024);
                for (int i = tid; i < 4096; i += 512) lut[i] = cospif((float)i * (1.0f / 2048.0f));
                __syncthreads();
                convert_weights(a, 1, (LAS float*)(lds + wave * 8704), gw, NGW, lane);
                dft_tables(ws, lut, gw, NGW, lane); }
            norm_rows(xlat, xctx, a.in[6] + (size_t)l * DM, mods_l, 0, 2048, XN, MT, gw, NGW, lane);
        } break;
        case 1: { PH_IDS
            SchedGrid S; S.so.init(nMall, 42, G, cu); S.A = (const char*)XN; S.B = (const char*)(ws + WS_WIN); S.tsA = (size_t)256 * DM * 2; S.tsB = (size_t)256 * DM * 2; S.nt = 32;
            S.nextra = (l == 0) ? 0 : 32; S.ex_pm0 = 64; S.ex_pn0 = 6; S.ex_w = 8; S.ex_ks = 1;
            EpiInProj E{PROJ, VT, VTC};
            pg8::gemm_phase<EpiInProj, SchedGrid>(lds, tid, DM, DM, S, E);
        } break;
        case 2: { PH_IDS
            const int nun = 512 + ((l == 0) ? 32 : 0);
            for (int u = cu; u < nun; u += G) { int row0, g;
                if (u < 512) { const int b = u >> 7, ch = (u >> 2) & 31; g = u & 3; row0 = b * 4096 + ch * 128; }
                else { const int e = u - 512; const int b = e >> 3, ch = (e >> 2) & 1; g = e & 3; row0 = MLAT + b * 256 + ch * 128; }
                sgu_unit(PROJ, row0, g, a.in[10] + (size_t)l * 512, a.in[11] + ((size_t)l * 4 + g) * 128 * 128, a.in[12] + ((size_t)l * 4 + g) * 128, lds, tid); }
            __syncthreads();
            { SchedF1L S{(const char*)(ws + WS_DFTD), (const char*)PROJ, G, cu}; EpiF1L E{(bf16_t*)(ws + WS_U)};
              pg8::gemm_phase<EpiF1L, SchedF1L>(lds, wave * 64 + fresh_lane(), 128, INW, S, E); }
            if (l == 0) { SchedF1 S{(const char*)(ws + WS_DFTD), (const char*)PROJ, G, (cu + 128) % G, 16}; EpiF1 E{nullptr, (bf16_t*)(ws + WS_PQTC)};
              pg8::gemm_phase<EpiF1, SchedF1>(lds, wave * 64 + fresh_lane(), 128, INW, S, E); }
        } break;
        case 3: { PH_IDS
            { SchedFA S{(const char*)(ws + WS_MA), (const char*)(ws + WS_U), G, cu}; EpiFA E{(bf16_t*)(ws + WS_ZBUF)};
              pg8::gemm_phase<EpiFA, SchedFA>(lds, tid, 128, 128, S, E); }
            if (l == 0) { SchedF2 S{(const char*)(ws + WS_DFTC), (const char*)(ws + WS_PQTC), G, (cu + 128) % G, 8}; EpiF2 E{PROJ};
              pg8::gemm_phase<EpiF2, SchedF2>(lds, wave * 64 + fresh_lane(), 8192, 8192, S, E); }
            for (int vcu = cu; vcu < 256; vcu += G) { const int bh = vcu >> 3, rb = vcu & 7; const float* rpb = a.in[9] + (size_t)l * 8 * 15 * 31;
#pragma unroll 1
                for (int pp = 0; pp < 2; ++pp) attn_pass<true>(PROJ, VT, VTC, rpb, bh >> 3, bh & 7, rb * 8 + 0 * 4 + pp * 2, lds, wave);
                if (l == 0) attn_pass<false>(PROJ, VT, VTC, rpb, bh >> 3, bh & 7, rb * 2 + 0, lds, wave); }
        } break;
        case 4: { PH_IDS
            { SchedFB S{(const char*)(ws + WS_TT), (const char*)(ws + WS_ZBUF), G, cu}; EpiFB E{PROJ};
              pg8::gemm_phase<EpiFB, SchedFB>(lds, tid, 128, 128, S, E); }
            for (int vcu = cu; vcu < 256; vcu += G) { const int bh = vcu >> 3, rb = vcu & 7; const float* rpb = a.in[9] + (size_t)l * 8 * 15 * 31;
#pragma unroll 1
                for (int pp = 0; pp < 2; ++pp) attn_pass<true>(PROJ, VT, VTC, rpb, bh >> 3, bh & 7, rb * 8 + 1 * 4 + pp * 2, lds, wave);
                if (l == 0) attn_pass<false>(PROJ, VT, VTC, rpb, bh >> 3, bh & 7, rb * 2 + 1, lds, wave); }
        } break;
        case 5: { PH_IDS
            SchedBranch S; S.so.init(nMall, 8, G, cu); S.proj = (const char*)PROJ; S.wbr = (const char*)(ws + WS_WBR);
            EpiBranch E{PROJ, XN};
            pg8::gemm_phase<EpiBranch, SchedBranch>(lds, tid, INW, DM, S, E);
        } break;
        case 6: { PH_IDS
            SchedGrid S; S.so.init(64, 8, G, cu); S.A = (const char*)XN; S.B = (const char*)(ws + WS_WO); S.tsA = (size_t)256 * DM * 2; S.tsB = (size_t)256 * DM * 2; S.nt = 32;
            S.nextra = (l == 0) ? 32 * 8 : 0; S.ex_pm0 = 64; S.ex_pn0 = 0; S.ex_w = 8; S.ex_ks = 8;
            EpiResid E{xlat, XC, a.out, XC, mods_l + 4096, lds};
            pg8::gemm_phase<EpiResid, SchedGrid>(lds, tid, DM, DM, S, E);
        } break;
        case 7: { PH_IDS
            norm_rows(a.out, XC, a.in[7] + (size_t)l * DM, mods_l, 6144, 8192, XN, nMall * 256, gw, NGW, lane);
        } break;
        case 8: { PH_IDS
            SchedGrid S; S.so.init(nMall, 44, G, cu); S.A = (const char*)XN; S.B = (const char*)(ws + WS_WUP); S.tsA = (size_t)256 * DM * 2; S.tsB = (size_t)256 * DM * 2; S.nt = 32; S.nextra = 0; S.ex_pm0 = 0; S.ex_pn0 = 0; S.ex_w = 1; S.ex_ks = 1;
            EpiUpConv E{HMID, (float*)(ws + WS_BIG), a.in[18] + (size_t)l * 3 * DFF, a.in[19] + (size_t)l * DFF};
            pg8::gemm_phase<EpiUpConv, SchedGrid>(lds, tid, DM, DM, S, E);
        } break;
        case 9: { PH_IDS
            ffn_fix_rows(HMID, (const float*)(ws + WS_BIG), a.in[18] + (size_t)l * 3 * DFF, nMall * 4, cu * 512 + tid, G * 512);
        } break;
        case 10: { PH_IDS
            SchedGrid S; S.so.init(64, 8, G, cu); S.A = (const char*)HMID; S.B = (const char*)(ws + WS_WDN); S.tsA = (size_t)256 * DFF * 2; S.tsB = (size_t)256 * DFF * 2; S.nt = 88;
            S.nextra = (l == 0) ? 32 * 4 : 0; S.ex_pm0 = 64; S.ex_pn0 = 0; S.ex_w = 8; S.ex_ks = 4;
            EpiResid E{a.out, XC, a.out, XC, mods_l + 10240, lds};
            pg8::gemm_phase<EpiResid, SchedGrid>(lds, tid, DFF, DFF, S, E);
        } break;
        }
    }
}

extern "C" void kernel_launch(void* const* d_in, const int* in_sizes, int n_in, void* d_out, int out_size, void* d_ws, size_t ws_size, hipStream_t stream) {
    static int grid = 0;
    if (grid == 0) {
        if (n_in != 22 || ws_size < WS_END) { fprintf(stderr, "kernel_launch: unexpected n_in %d / ws_size %zu (need %zu)\n", n_in, ws_size, (size_t)WS_END); grid = -1; return; }
        int dev = 0, cus = 0, per_cu = 0;
        hipGetDevice(&dev); hipDeviceGetAttribute(&cus, hipDeviceAttributeMultiprocessorCount, dev);
        if (hipFuncSetAttribute((const void*)mega, hipFuncAttributeMaxDynamicSharedMemorySize, LDS_BYTES) != hipSuccess) { fprintf(stderr, "kernel_launch: hipFuncSetAttribute failed\n"); grid = -1; return; }
        hipOccupancyMaxActiveBlocksPerMultiprocessor(&per_cu, (const void*)mega, 512, LDS_BYTES);
        (void)hipGetLastError();
        if (per_cu < 1) fprintf(stderr, "kernel_launch: occupancy query says %d blocks/CU\n", per_cu);
        grid = cus > 0 ? cus : 256;
    }
    if (grid < 0) return;
    hipMemsetAsync((char*)d_ws + WS_CTL, 0, CTL_ZERO_BYTES, stream);
    Args a{};
    for (int i = 0; i < 22; ++i) a.in[i] = (const float*)d_in[i];
    a.out = (float*)d_out; a.ws = (unsigned char*)d_ws; a.ph_lo = 0; a.ph_hi = NPHASE;
    void* args[] = {&a};
    hipError_t e = hipLaunchCooperativeKernel((const void*)mega, dim3(grid), dim3(512), args, LDS_BYTES, stream);
    if (e != hipSuccess) fprintf(stderr, "kernel_launch: cooperative launch failed: %s (grid %d)\n", hipGetErrorString(e), grid);
}
```

```cpp
#include <hip/hip_runtime.h>
#include <hip/hip_cooperative_groups.h>
#include <cstdio>
#include <cstdint>
namespace cg = cooperative_groups;

#define LAS __attribute__((address_space(3)))
typedef unsigned short bf16_t;
typedef short bf16x8 __attribute__((ext_vector_type(8)));
typedef float f32x4 __attribute__((ext_vector_type(4)));
typedef float f32x2 __attribute__((ext_vector_type(2)));
typedef unsigned u32x4 __attribute__((ext_vector_type(4)));
typedef unsigned u32x2 __attribute__((ext_vector_type(2)));

constexpr int DM = 2048, MLAT = 16384, MT = 17408;
constexpr int INW = 10752, DFF = 5632, UPW = 11264;
constexpr int OFF_Q = 512, OFF_K = 1536, OFF_V = 2560, OFF_C = 3584, OFF_G = 4608;
constexpr float EPS = 1e-6f;
constexpr size_t MiB = 1u << 20;
constexpr size_t WS_CTL = 0;
constexpr size_t CTL_ZERO_BYTES = 1 * MiB;
constexpr size_t WS_MODS = 4096;
constexpr size_t WS_BAR = 512 * 1024;
constexpr size_t WS_DFTD = 1 * MiB;
constexpr size_t WS_XC = 2 * MiB;
constexpr size_t WS_WIN = 10 * MiB;
constexpr size_t WS_WBR = 52 * MiB;
constexpr size_t WS_WO = 60 * MiB;
constexpr size_t WS_WUP = 68 * MiB;
constexpr size_t WS_WDN = 112 * MiB;
constexpr size_t WS_XN = 134 * MiB;
constexpr size_t WS_BIG = 202 * MiB;
constexpr size_t WS_HMID = 576 * MiB;
constexpr size_t WS_ZBUF = WS_HMID;
constexpr size_t WS_TT = WS_HMID + 32 * MiB;
constexpr size_t WS_MA = WS_HMID + 36 * MiB;
constexpr size_t WS_U = WS_HMID + 64 * MiB;
constexpr size_t WS_VT = WS_HMID + 96 * MiB;
constexpr size_t WS_DFTC = WS_HMID + 128 * MiB;
constexpr size_t WS_PQTC = WS_HMID + 132 * MiB;
constexpr size_t WS_VTC = WS_HMID + 164 * MiB;
constexpr size_t WS_TMP = WS_HMID;
constexpr size_t WS_END = 763 * MiB;
constexpr int LDS_BYTES = 163840, LDS_XST = 163840 - 64;

#define LDS_WAIT() asm volatile("s_waitcnt lgkmcnt(0)" ::: "memory")
__device__ __forceinline__ unsigned cvt_pk_bf16(float lo, float hi) { unsigned r; asm volatile("v_cvt_pk_bf16_f32 %0, %1, %2" : "=v"(r) : "v"(lo), "v"(hi)); return r; }
__device__ __forceinline__ int fresh_lane() { unsigned z; asm volatile("v_mov_b32 %0, 0" : "=v"(z)); return (int)__builtin_amdgcn_mbcnt_hi(~0u, __builtin_amdgcn_mbcnt_lo(~0u, z)); }
__device__ __forceinline__ float bf2f(unsigned short b) { return __uint_as_float((unsigned)b << 16); }
__device__ __forceinline__ float bflo(unsigned w) { return __uint_as_float(w << 16); }
__device__ __forceinline__ float bfhi(unsigned w) { return __uint_as_float(w & 0xffff0000u); }
__device__ __forceinline__ float shx(float v, int o, int lane) { return __int_as_float(__builtin_amdgcn_ds_bpermute((lane ^ o) << 2, __float_as_int(v))); }
__device__ __forceinline__ float wave_sum(float v, int lane) {
#pragma unroll
    for (int o = 1; o < 64; o <<= 1) v += shx(v, o, lane);
    return v;
}
__device__ __forceinline__ float fsigmoid(float x) { return __builtin_amdgcn_rcpf(1.0f + __builtin_amdgcn_exp2f(-1.44269504089f * x)); }
__device__ __forceinline__ float fsilu(float x) { return x * fsigmoid(x); }
__device__ __forceinline__ f32x2 gelu_pk(f32x2 v) {
    const f32x2 av = __builtin_elementwise_abs(v), d = av * 0.2316418882f + 1.0f;
    f32x2 t; t.x = __builtin_amdgcn_rcpf(d.x); t.y = __builtin_amdgcn_rcpf(d.y);
    f32x2 q = t * 0.5307027145f + (-0.7265760135f); q = q * t + 0.7107068705f; q = q * t + (-0.142248368f); q = q * t + 0.127414796f; q = q * t;
    const f32x2 s = (v * v) * (-0.72134752044f);
    f32x2 e; e.x = __builtin_amdgcn_exp2f(s.x); e.y = __builtin_amdgcn_exp2f(s.y);
    const f32x2 m = v * (q * e), r = v - m;
    f32x2 o; o.x = v.x < 0.f ? m.x : r.x; o.y = v.y < 0.f ? m.y : r.y; return o;
}

namespace pg8 {
constexpr int BM = 256, BK = 64, HALF = 128, HTB = HALF * BK * 2, STAGE_BYTES = 8 * HTB, NXCD = 8, WGM = 8;
__host__ __device__ __forceinline__ int lds_byte(int r, int c) { const int st = (r >> 4) * 2 + (c >> 5), rr = r & 15, cc = c & 31, ob = rr * 64 + cc * 2; return st * 1024 + (ob ^ (((ob >> 9) & 1) << 5)); }
__host__ __device__ __forceinline__ void stage_rc(int b, int& R, int& C) { const int st = b / 1024, sb = b % 1024, swz = sb ^ (((sb >> 9) & 1) << 5); R = (st >> 1) * 16 + swz / 64; C = (st & 1) * 32 + (swz % 64) / 2; }
__host__ __device__ __forceinline__ int perm32(int rho) { const int n = rho >> 4, i = rho & 15; return 8 * (i >> 2) + 4 * n + (i & 3); }

struct Unit { const char* A; const char* B; int nt, pm, pn, aux; };

struct StaticOrder {
    int nM, nN, nwg, G, c;
    __device__ void init(int nM_, int nN_, int G_, int c_) { nM = nM_; nN = nN_; nwg = nM * nN; G = G_; c = c_; }
    __device__ bool next(int i, int& pm, int& pn) const {
        const long L = (long)i * G + c; if (L >= nwg) return false;
        int wgid = (int)L; { const int q = nwg / NXCD, r = nwg % NXCD, xcd = wgid % NXCD, off = wgid / NXCD; wgid = (xcd < r ? xcd * (q + 1) : r * (q + 1) + (xcd - r) * q) + off; }
        const int nig = WGM * nN, gid = wgid / nig, fm = gid * WGM, gsz = (nM - fm) < WGM ? (nM - fm) : WGM;
        pm = fm + ((wgid % nig) % gsz); pn = (wgid % nig) / gsz; return true;
    }
};

template <class Epi, class Sched>
__device__ __forceinline__ void gemm_phase(LAS unsigned char* lds, const int tid, const int lda, const int ldb, const Sched& S, const Epi& E) {
    const int wid = __builtin_amdgcn_readfirstlane(tid >> 6), lane = tid & 63, wr = wid >> 2, wc = wid & 3, fr = lane & 15, fq = lane >> 4;
    unsigned voffA[2], voffB[2];
#pragma unroll
    for (int i = 0; i < 2; ++i) { int R, C; stage_rc(tid * 16 + i * 8192, R, C); const int Rb = Epi::PERM ? ((R & ~31) + perm32(R & 31)) : R;
        voffA[i] = (unsigned)(R * lda + C) * 2u; voffB[i] = (unsigned)(Sched::brow(Rb) * ldb + C) * 2u; }
    const size_t kstep = (size_t)(BK * 2);
    const size_t hstepA = (size_t)HALF * lda * 2, hstepB = (size_t)Sched::BH * ldb * 2;
    const unsigned ldsw = (unsigned)wid * 1024u;
    const int aoff = lds_byte(wr * 64 + fr, fq * 8), boff = lds_byte(wc * 32 + fr, fq * 8);
#define PG8_SA(b, h) (((b) * 2 + (h)) * HTB)
#define PG8_SB(b, h) ((4 + (b) * 2 + (h)) * HTB)
#define PG8_STAGE(bufoff, gbase, voff) do { _Pragma("unroll") for (int _i = 0; _i < 2; ++_i) \
        __builtin_amdgcn_global_load_lds((const unsigned*)((const char*)(gbase) + (voff)[_i]), (LAS unsigned*)(lds + (bufoff) + ldsw + _i * 8192), 16, 0, 0); } while (0)
#define PG8_LDA(dst, b, h) do { _Pragma("unroll") for (int m = 0; m < 4; ++m) _Pragma("unroll") for (int k = 0; k < 2; ++k) dst[m][k] = *(const LAS bf16x8*)(lds + PG8_SA(b, h) + aoff + m * 2048 + k * 1024); } while (0)
#define PG8_LDB(dst, b, h) do { _Pragma("unroll") for (int n = 0; n < 2; ++n) _Pragma("unroll") for (int k = 0; k < 2; ++k) dst[n][k] = *(const LAS bf16x8*)(lds + PG8_SB(b, h) + boff + n * 2048 + k * 1024); } while (0)
#define PG8_MMA(ai, bj, At, Bt) do { __builtin_amdgcn_s_setprio(1); _Pragma("unroll") for (int m = 0; m < 4; ++m) _Pragma("unroll") for (int n = 0; n < 2; ++n) _Pragma("unroll") for (int k = 0; k < 2; ++k) \
        acc[ai][bj][m][n] = __builtin_amdgcn_mfma_f32_16x16x32_bf16(Bt[n][k], At[m][k], acc[ai][bj][m][n], 0, 0, 0); __builtin_amdgcn_s_setprio(0); } while (0)
#define PG8_WAIT_V(n) asm volatile("s_waitcnt vmcnt(" #n ")" ::: "memory")
#define PG8_WAIT_L(n) asm volatile("s_waitcnt lgkmcnt(" #n ")" ::: "memory")
#define PG8_BAR __builtin_amdgcn_s_barrier()
#define PG8_SCHED __builtin_amdgcn_sched_barrier(0)
    Unit cur, nxt; int ui = 0;
    if (!S.next(0, cur)) return;
    f32x4 acc[2][2][4][2];
#pragma unroll
    for (int a = 0; a < 2; ++a)
#pragma unroll
        for (int b = 0; b < 2; ++b)
#pragma unroll
            for (int m = 0; m < 4; ++m)
#pragma unroll
                for (int n = 0; n < 2; ++n) acc[a][b][m][n] = (f32x4){0.f, 0.f, 0.f, 0.f};
    bf16x8 At[4][2], B0[2][2], B1[2][2];
    const char* cA = cur.A; const char* cB = cur.B;
    {
        PG8_STAGE(PG8_SB(0, 0), cB, voffB); PG8_STAGE(PG8_SB(0, 1), cB + hstepB, voffB); PG8_STAGE(PG8_SA(0, 0), cA, voffA); PG8_STAGE(PG8_SA(0, 1), cA + hstepA, voffA);
        if (wr == 1) PG8_BAR;
        PG8_WAIT_V(2); PG8_BAR;
        PG8_STAGE(PG8_SB(1, 0), cB + kstep, voffB); PG8_STAGE(PG8_SA(1, 0), cA + kstep, voffA); PG8_STAGE(PG8_SB(1, 1), cB + hstepB + kstep, voffB);
        PG8_WAIT_V(6); PG8_BAR;
    }
    for (;;) {
        const bool has_next = S.next(ui + 1, nxt);
        const char* nA = has_next ? nxt.A : cA; const char* nB = has_next ? nxt.B : cB;
        const int nt = cur.nt;
        for (int t = 0; t < nt; t += 2) {
            const bool last = (t == nt - 2);
            const char* a1 = cA + (size_t)(t + 1) * kstep;
            const char* a2 = last ? nA : cA + (size_t)(t + 2) * kstep; const char* b2 = last ? nB : cB + (size_t)(t + 2) * kstep;
            const char* a3 = a2 + kstep; const char* b3 = b2 + kstep;
            PG8_LDB(B0, 0, 0); PG8_LDB(B1, 0, 1); PG8_SCHED; PG8_LDA(At, 0, 0); PG8_STAGE(PG8_SA(1, 1), a1 + hstepA, voffA);
            PG8_WAIT_V(8); PG8_WAIT_L(0); PG8_BAR; PG8_MMA(0, 0, At, B0); PG8_MMA(0, 1, At, B1); PG8_BAR; PG8_SCHED;
            PG8_LDA(At, 0, 1); PG8_STAGE(PG8_SB(0, 0), b2, voffB); PG8_STAGE(PG8_SB(0, 1), b2 + hstepB, voffB); PG8_STAGE(PG8_SA(0, 0), a2, voffA);
            PG8_WAIT_V(8); PG8_WAIT_L(0); PG8_BAR; PG8_MMA(1, 0, At, B0); PG8_MMA(1, 1, At, B1); PG8_BAR; PG8_SCHED;
            PG8_LDB(B0, 1, 0); PG8_LDB(B1, 1, 1); PG8_SCHED; PG8_LDA(At, 1, 0); PG8_STAGE(PG8_SA(0, 1), a2 + hstepA, voffA);
            PG8_WAIT_V(8); PG8_WAIT_L(0); PG8_BAR; PG8_MMA(0, 0, At, B0); PG8_MMA(0, 1, At, B1); PG8_BAR; PG8_SCHED;
            PG8_LDA(At, 1, 1); PG8_STAGE(PG8_SB(1, 0), b3, voffB); PG8_STAGE(PG8_SB(1, 1), b3 + hstepB, voffB); PG8_STAGE(PG8_SA(1, 0), a3, voffA);
            PG8_WAIT_V(8); PG8_WAIT_L(0); PG8_BAR; PG8_MMA(1, 0, At, B0); PG8_MMA(1, 1, At, B1); PG8_BAR; PG8_SCHED;
        }
        if (wr == 0) PG8_BAR;
        E(acc, cur, wr, wc);
        if (!has_next) break;
        if (!Epi::CHAIN || cur.aux == 2) {
#pragma unroll
        for (int a = 0; a < 2; ++a)
#pragma unroll
            for (int b = 0; b < 2; ++b)
#pragma unroll
                for (int m = 0; m < 4; ++m)
#pragma unroll
                    for (int n = 0; n < 2; ++n) acc[a][b][m][n] = (f32x4){0.f, 0.f, 0.f, 0.f};
        }
        cur = nxt; cA = nA; cB = nB; ++ui;
        if (wr == 1) PG8_BAR;
    }
    PG8_WAIT_V(0);
    PG8_BAR;
#undef PG8_SA
#undef PG8_SB
#undef PG8_STAGE
#undef PG8_LDA
#undef PG8_LDB
#undef PG8_MMA
#undef PG8_WAIT_V
#undef PG8_WAIT_L
#undef PG8_BAR
#undef PG8_SCHED
}
}
using pg8::Unit;
typedef const f32x4 (&AccRef)[2][2][4][2];

struct SchedGrid {
    static __device__ __forceinline__ int brow(int r) { return r; } static constexpr int BH = 128;
    pg8::StaticOrder so; const char* A; const char* B; size_t tsA, tsB; int nt, nextra, ex_pm0, ex_pn0, ex_w, ex_ks;
    __device__ __forceinline__ bool next(int i, Unit& u) const {
        int pm, pn; int kp = 0, ntu = nt, aux = 0;
        if (!so.next(i, pm, pn)) { const long e = (long)i * so.G + so.c - so.nwg; if (e >= nextra) return false; const int te = (int)e / ex_ks; kp = (int)e % ex_ks; ntu = nt / ex_ks; aux = ex_ks > 1 ? 1 : 0;
            pm = ex_pm0 + te / ex_w; pn = ex_pn0 + te % ex_w; }
        u.A = A + (size_t)pm * tsA + (size_t)kp * ntu * 128; u.B = B + (size_t)pn * tsB + (size_t)kp * ntu * 128; u.nt = ntu; u.pm = pm; u.pn = pn; u.aux = aux; return true;
    }
};
struct SchedBranch {
    static __device__ __forceinline__ int brow(int r) { return r; } static constexpr int BH = 128;
    pg8::StaticOrder so; const char* proj; const char* wbr;
    __device__ __forceinline__ bool next(int i, Unit& u) const {
        int pm, pn; if (!so.next(i / 3, pm, pn)) return false;
        const int br = i % 3; const int acol = br == 0 ? 0 : (br == 1 ? OFF_Q : OFF_C), koff = br == 0 ? 0 : (br == 1 ? 512 : 1536);
        u.A = proj + ((size_t)pm * 256 * INW + acol) * 2; u.B = wbr + ((size_t)pn * 256 * DM + koff) * 2; u.nt = br == 1 ? 16 : 8; u.pm = pm; u.pn = pn; u.aux = br; return true;
    }
};
struct SchedF1L {
    static __device__ __forceinline__ int brow(int r) { return (r >> 6) + 64 * (r & 63); } static constexpr int BH = 2;
    const char* dftd; const char* proj; int G, c;
    __device__ __forceinline__ bool next(int i, Unit& u) const {
        const int L = i * G + c; if (L >= 256) return false;
        { const char* ap = dftd; asm volatile("" : "+s"(ap)); u.A = ap; } u.nt = 2; u.pm = 0;
        const int b = L >> 6, g = (L >> 4) & 3, pn = L & 15; u.B = proj + ((size_t)(b * 4096 + 4 * pn) * INW + g * 128) * 2; u.pn = pn; u.aux = b * 4 + g; return true;
    }
};
struct SchedF1 {
    static __device__ __forceinline__ int brow(int r) { return r; } static constexpr int BH = 128;
    const char* dftd; const char* proj; int G, c, nctx;
    __device__ __forceinline__ bool next(int i, Unit& u) const {
        const int e = i * G + c; if (e >= nctx) return false;
        { const char* ap = dftd; asm volatile("" : "+s"(ap)); u.A = ap; } u.nt = 2; u.pm = 0;
        const int b = e >> 2, g = e & 3; u.B = proj + ((size_t)(MLAT + b * 256) * INW + g * 128) * 2; u.pn = 0; u.aux = 16 + b * 4 + g; return true;
    }
};
struct SchedF2 {
    static __device__ __forceinline__ int brow(int r) { return r; } static constexpr int BH = 128;
    const char* dftc; const char* pqtc; int G, c, nctx;
    __device__ __forceinline__ bool next(int i, Unit& u) const {
        const int e = i * G + c; if (e >= nctx) return false;
        const int b = e >> 1, pn = e & 1; { const char* ap = dftc; asm volatile("" : "+s"(ap)); u.A = ap; } u.B = pqtc + (size_t)(b * 512 + pn * 256) * 8192 * 2; u.nt = 8; u.pm = 0; u.pn = pn; u.aux = 4 + b; return true;
    }
};
struct SchedFA {
    static __device__ __forceinline__ int brow(int r) { return r; } static constexpr int BH = 128;
    const char* ma; const char* ub; int G, c;
    __device__ __forceinline__ bool next(int i, Unit& u) const {
        const int L = i * G + c; if (L >= 512) return false;
        { const char* ap = ma; asm volatile("" : "+s"(ap)); u.A = ap; } u.B = ub + (size_t)L * 256 * 128 * 2; u.nt = 2; u.pm = 0; u.pn = L; u.aux = 0; return true;
    }
};
struct SchedFB {
    static __device__ __forceinline__ int brow(int r) { return r; } static constexpr int BH = 128;
    const char* tt; const char* zb; int G, c;
    __device__ __forceinline__ bool next(int i, Unit& u) const {
        const int L = i * G + c; if (L >= 512) return false;
        const int k2 = L >> 3, pn = L & 7; u.A = tt + (size_t)k2 * 256 * 128 * 2; u.B = zb + ((size_t)k2 * 2048 + pn * 256) * 128 * 2; u.nt = 2; u.pm = 0; u.pn = pn; u.aux = k2; return true;
    }
};

struct EpiInProj {
    static constexpr bool PERM = true, CHAIN = false;
    bf16_t* proj; bf16_t* vt; bf16_t* vtc;
    __device__ __forceinline__ void operator()(AccRef acc, const Unit& u, int wr, int wc) const {
        const int ln_ = fresh_lane(), fr = ln_ & 15, fq = ln_ >> 4;
        const int pm = u.pm, pn = u.pn; const int row0 = pm * 256 + wr * 64 + fr, col0 = pn * 256 + wc * 32 + 8 * fq;
        if (pn >= 10 && pn < 14) {
            const int vc0 = col0 - OFF_V;
#pragma unroll
            for (int ai = 0; ai < 2; ++ai)
#pragma unroll
                for (int m = 0; m < 4; ++m) {
                    const int row = row0 + ai * 128 + m * 16; bf16_t* dst; size_t stride;
                    if (pm < 64) { const int b = pm >> 4; dst = vt + (size_t)b * 1024 * 4096 + (row - b * 4096); stride = 4096; }
                    else { const int b = pm - 64; dst = vtc + (size_t)b * 1024 * 256 + (row - MLAT - b * 256); stride = 256; }
#pragma unroll
                    for (int bj = 0; bj < 2; ++bj)
#pragma unroll
                        for (int n = 0; n < 2; ++n) { const f32x4 v = acc[ai][bj][m][n]; const unsigned w0 = cvt_pk_bf16(v[0], v[1]), w1 = cvt_pk_bf16(v[2], v[3]);
                            bf16_t* d = dst + (size_t)(vc0 + bj * 128 + n * 4) * stride;
                            d[0] = (bf16_t)(w0 & 0xffffu); d[stride] = (bf16_t)(w0 >> 16); d[2 * stride] = (bf16_t)(w1 & 0xffffu); d[3 * stride] = (bf16_t)(w1 >> 16); }
                }
            return;
        }
        const int act = pn < 14 ? 0 : (pn < 18 ? 1 : 2); const float sc = (pn >= 2 && pn < 6) ? 0.08838834764831845f : 1.0f;
#pragma unroll
        for (int ai = 0; ai < 2; ++ai)
#pragma unroll
            for (int m = 0; m < 4; ++m) { bf16_t* rowp = proj + (size_t)(row0 + ai * 128 + m * 16) * INW + col0;
#pragma unroll
                for (int bj = 0; bj < 2; ++bj) { f32x4 v0 = acc[ai][bj][m][0], v1 = acc[ai][bj][m][1];
                    if (act == 1) { f32x2 a = gelu_pk((f32x2){v0[0], v0[1]}), b = gelu_pk((f32x2){v0[2], v0[3]}), c = gelu_pk((f32x2){v1[0], v1[1]}), d = gelu_pk((f32x2){v1[2], v1[3]});
                        v0 = (f32x4){a.x, a.y, b.x, b.y}; v1 = (f32x4){c.x, c.y, d.x, d.y}; }
                    else if (act == 2) { v0 = (f32x4){fsigmoid(v0[0]), fsigmoid(v0[1]), fsigmoid(v0[2]), fsigmoid(v0[3])}; v1 = (f32x4){fsigmoid(v1[0]), fsigmoid(v1[1]), fsigmoid(v1[2]), fsigmoid(v1[3])}; }
                    else { v0 = v0 * sc; v1 = v1 * sc; }
                    u32x4 w; w.x = cvt_pk_bf16(v0[0], v0[1]); w.y = cvt_pk_bf16(v0[2], v0[3]); w.z = cvt_pk_bf16(v1[0], v1[1]); w.w = cvt_pk_bf16(v1[2], v1[3]);
                    *(u32x4*)(rowp + bj * 128) = w; } }
    }
};
struct EpiPlain {
    static constexpr bool PERM = true, CHAIN = false;
    bf16_t* out; int ld;
    __device__ __forceinline__ void operator()(AccRef acc, const Unit& u, int wr, int wc) const {
        const int ln_ = fresh_lane(), fr = ln_ & 15, fq = ln_ >> 4;
        const int row0 = u.pm * 256 + wr * 64 + fr, col0 = u.pn * 256 + wc * 32 + 8 * fq;
#pragma unroll
        for (int ai = 0; ai < 2; ++ai)
#pragma unroll
            for (int m = 0; m < 4; ++m) { bf16_t* rowp = out + (size_t)(row0 + ai * 128 + m * 16) * ld + col0;
#pragma unroll
                for (int bj = 0; bj < 2; ++bj) { const f32x4 v0 = acc[ai][bj][m][0], v1 = acc[ai][bj][m][1];
                    u32x4 w; w.x = cvt_pk_bf16(v0[0], v0[1]); w.y = cvt_pk_bf16(v0[2], v0[3]); w.z = cvt_pk_bf16(v1[0], v1[1]); w.w = cvt_pk_bf16(v1[2], v1[3]);
                    *(u32x4*)(rowp + bj * 128) = w; } }
    }
};
struct EpiF1 {
    static constexpr bool PERM = true, CHAIN = false;
    bf16_t* pqt; bf16_t* pqtc;
    __device__ __forceinline__ void operator()(AccRef acc, const Unit& u, int wr, int wc) const {
        const int ln_ = fresh_lane(), fr = ln_ & 15, fq = ln_ >> 4;
        const int aux = u.aux; const bool isc = aux >= 16; const int bg = aux & 15, b = bg >> 2, g = bg & 3;
        bf16_t* base = (isc ? pqtc : pqt) + (size_t)(b * 512 + g * 128) * 8192; const int half = isc ? 256 : 4096;
        const int n0 = u.pn * 256 + wc * 32 + 8 * fq;
#pragma unroll
        for (int ai = 0; ai < 2; ++ai)
#pragma unroll
            for (int m = 0; m < 4; ++m) { bf16_t* rowp = base + (size_t)(wr * 64 + m * 16 + fr) * 8192 + ai * half + n0;
#pragma unroll
                for (int bj = 0; bj < 2; ++bj) { const f32x4 v0 = acc[ai][bj][m][0], v1 = acc[ai][bj][m][1];
                    u32x4 w; w.x = cvt_pk_bf16(v0[0], v0[1]); w.y = cvt_pk_bf16(v0[2], v0[3]); w.z = cvt_pk_bf16(v1[0], v1[1]); w.w = cvt_pk_bf16(v1[2], v1[3]);
                    *(u32x4*)(rowp + bj * 128) = w; } }
    }
};
struct EpiF1L {
    static constexpr bool PERM = true, CHAIN = false;
    bf16_t* ub;
    __device__ __forceinline__ void operator()(AccRef acc, const Unit& u, int wr, int wc) const {
        const int ln_ = fresh_lane(), fr = ln_ & 15, fq = ln_ >> 4;
        const int b = u.aux >> 2, g = u.aux & 3;
#pragma unroll
        for (int ai = 0; ai < 2; ++ai)
#pragma unroll
            for (int m = 0; m < 4; ++m) { const int ch = b * 512 + g * 128 + wr * 64 + m * 16 + fr;
#pragma unroll
                for (int bj = 0; bj < 2; ++bj) { const int n1 = 4 * u.pn + 2 * bj + (wc >> 1), n2 = 32 * (wc & 1) + 8 * fq;
                    const f32x4 v0 = acc[ai][bj][m][0], v1 = acc[ai][bj][m][1];
                    u32x4 w; w.x = cvt_pk_bf16(v0[0], v0[1]); w.y = cvt_pk_bf16(v0[2], v0[3]); w.z = cvt_pk_bf16(v1[0], v1[1]); w.w = cvt_pk_bf16(v1[2], v1[3]);
                    *(u32x4*)(ub + ((size_t)ch * 64 + n1) * 128 + ai * 64 + n2) = w; } }
    }
};
struct EpiFA {
    static constexpr bool PERM = true, CHAIN = false;
    bf16_t* zb;
    __device__ __forceinline__ void operator()(AccRef acc, const Unit& u, int wr, int wc) const {
        if (wr != 0) return;
        const int ln_ = fresh_lane(), fr = ln_ & 15, fq = ln_ >> 4;
#pragma unroll
        for (int ai = 0; ai < 2; ++ai)
#pragma unroll
            for (int m = 0; m < 4; ++m) { const int k2 = m * 16 + fr;
#pragma unroll
                for (int bj = 0; bj < 2; ++bj) { const int bc = u.pn * 4 + 2 * bj + (wc >> 1), n1 = 32 * (wc & 1) + 8 * fq;
                    const f32x4 v0 = acc[ai][bj][m][0], v1 = acc[ai][bj][m][1];
                    u32x4 w; w.x = cvt_pk_bf16(v0[0], v0[1]); w.y = cvt_pk_bf16(v0[2], v0[3]); w.z = cvt_pk_bf16(v1[0], v1[1]); w.w = cvt_pk_bf16(v1[2], v1[3]);
                    *(u32x4*)(zb + ((size_t)k2 * 2048 + bc) * 128 + ai * 64 + n1) = w; } }
    }
};
struct EpiFB {
    static constexpr bool PERM = true, CHAIN = false;
    bf16_t* proj;
    __device__ __forceinline__ void operator()(AccRef acc, const Unit& u, int wr, int wc) const {
        if (wr != 0) return;
        const int ln_ = fresh_lane(), fr = ln_ & 15, fq = ln_ >> 4;
        const float sc = 0.0013810679320049757f; const int k2 = u.aux;
#pragma unroll
        for (int m = 0; m < 4; ++m) { const int k = 64 * (m * 16 + fr) + k2;
#pragma unroll
            for (int bj = 0; bj < 2; ++bj) { const int ncol = u.pn * 256 + 128 * bj + 32 * wc + 8 * fq; const int b = ncol >> 9, ch = ncol & 511;
                const f32x4 v0 = acc[0][bj][m][0] * sc, v1 = acc[0][bj][m][1] * sc;
                u32x4 w; w.x = cvt_pk_bf16(v0[0], v0[1]); w.y = cvt_pk_bf16(v0[2], v0[3]); w.z = cvt_pk_bf16(v1[0], v1[1]); w.w = cvt_pk_bf16(v1[2], v1[3]);
                *(u32x4*)(proj + (size_t)(b * 4096 + k) * INW + ch) = w; } }
    }
};
struct EpiF2 {
    static constexpr bool PERM = true, CHAIN = false;
    bf16_t* proj;
    __device__ __forceinline__ void operator()(AccRef acc, const Unit& u, int wr, int wc) const {
        const int ln_ = fresh_lane(), fr = ln_ & 15, fq = ln_ >> 4;
        const int aux = u.aux; const bool isc = aux >= 4; const int rowbase = isc ? MLAT + (aux - 4) * 256 : aux * 4096;
        const float sc = isc ? 0.005524271728019903f : 0.0013810679320049757f;
        const int row0 = rowbase + u.pm * 256 + wr * 64 + fr, col0 = u.pn * 256 + wc * 32 + 8 * fq;
#pragma unroll
        for (int ai = 0; ai < 2; ++ai)
#pragma unroll
            for (int m = 0; m < 4; ++m) { bf16_t* rowp = proj + (size_t)(row0 + ai * 128 + m * 16) * INW + col0;
#pragma unroll
                for (int bj = 0; bj < 2; ++bj) { const f32x4 v0 = acc[ai][bj][m][0] * sc, v1 = acc[ai][bj][m][1] * sc;
                    u32x4 w; w.x = cvt_pk_bf16(v0[0], v0[1]); w.y = cvt_pk_bf16(v0[2], v0[3]); w.z = cvt_pk_bf16(v1[0], v1[1]); w.w = cvt_pk_bf16(v1[2], v1[3]);
                    *(u32x4*)(rowp + bj * 128) = w; } }
    }
};
typedef f32x4 (&AccMut)[2][2][4][2];
struct EpiBranch {
    static constexpr bool PERM = true, CHAIN = true;
    const bf16_t* proj; bf16_t* merged;
    __device__ __forceinline__ void operator()(AccMut acc, const Unit& u, int wr, int wc) const {
        const int ln_ = fresh_lane(), fr = ln_ & 15, fq = ln_ >> 4;
        const int br = u.aux; const int col0 = u.pn * 256 + wc * 32 + 8 * fq;
#pragma unroll
        for (int ai = 0; ai < 2; ++ai)
#pragma unroll
            for (int m = 0; m < 4; ++m) { const size_t row = (size_t)(u.pm * 256 + ai * 128 + wr * 64 + m * 16 + fr);
#pragma unroll
                for (int bj = 0; bj < 2; ++bj) { const int col = col0 + bj * 128;
                    const bf16_t* gp = proj + row * INW + OFF_G + br * DM + col;
                    const u32x4 gw = *(const u32x4*)gp;
                    const f32x4 g0 = (f32x4){bflo(gw.x), bfhi(gw.x), bflo(gw.y), bfhi(gw.y)}, g1 = (f32x4){bflo(gw.z), bfhi(gw.z), bflo(gw.w), bfhi(gw.w)};
                    if (br < 2) { const u32x4 hw = *(const u32x4*)(gp + DM);
                        const f32x4 r0 = (f32x4){__builtin_amdgcn_rcpf(fmaxf(bflo(hw.x), 1e-30f)), __builtin_amdgcn_rcpf(fmaxf(bfhi(hw.x), 1e-30f)), __builtin_amdgcn_rcpf(fmaxf(bflo(hw.y), 1e-30f)), __builtin_amdgcn_rcpf(fmaxf(bfhi(hw.y), 1e-30f))};
                        const f32x4 r1 = (f32x4){__builtin_amdgcn_rcpf(fmaxf(bflo(hw.z), 1e-30f)), __builtin_amdgcn_rcpf(fmaxf(bfhi(hw.z), 1e-30f)), __builtin_amdgcn_rcpf(fmaxf(bflo(hw.w), 1e-30f)), __builtin_amdgcn_rcpf(fmaxf(bfhi(hw.w), 1e-30f))};
                        acc[ai][bj][m][0] = acc[ai][bj][m][0] * (g0 * r0); acc[ai][bj][m][1] = acc[ai][bj][m][1] * (g1 * r1); }
                    else { const f32x4 v0 = acc[ai][bj][m][0] * g0, v1 = acc[ai][bj][m][1] * g1;
                        u32x4 w; w.x = cvt_pk_bf16(v0[0], v0[1]); w.y = cvt_pk_bf16(v0[2], v0[3]); w.z = cvt_pk_bf16(v1[0], v1[1]); w.w = cvt_pk_bf16(v1[2], v1[3]);
                        *(u32x4*)(merged + row * DM + col) = w; } } }
    }
};
struct EpiResid {
    static constexpr bool PERM = false, CHAIN = false;
    const float* src_lat; const float* src_ctx; float* dst_lat; float* dst_ctx; const float* gate;
    LAS unsigned char* lds;
    __device__ __forceinline__ void operator()(AccRef acc, const Unit& u, int wr, int wc) const {
        const int ln_ = fresh_lane(), fr = ln_ & 15, fq = ln_ >> 4;
        const int pm = u.pm; const int b = pm < 64 ? (pm >> 4) : 4; const float* g = gate + (size_t)b * 12288;
        const float* s0 = pm < 64 ? src_lat + (size_t)pm * 256 * DM : src_ctx + (size_t)(pm - 64) * 256 * DM;
        float* d0 = pm < 64 ? dst_lat + (size_t)pm * 256 * DM : dst_ctx + (size_t)(pm - 64) * 256 * DM;
        LAS float* sc = (LAS float*)(lds + 131072 + (wr * 4 + wc) * 2048);
        const int rrow = ln_ >> 3, rc = (ln_ & 7) * 4;
        if (u.aux) {
            const int arow = ln_ >> 5, ac = ln_ & 31; float ga[2];
#pragma unroll
            for (int bj = 0; bj < 2; ++bj) ga[bj] = g[u.pn * 256 + bj * 128 + wc * 32 + ac];
#pragma unroll
            for (int ai = 0; ai < 2; ++ai)
#pragma unroll
                for (int m = 0; m < 4; ++m)
#pragma unroll
                    for (int bj = 0; bj < 2; ++bj) {
                        *(LAS f32x4*)(sc + fr * 32 + 4 * fq) = acc[ai][bj][m][0]; *(LAS f32x4*)(sc + fr * 32 + 16 + 4 * fq) = acc[ai][bj][m][1];
                        asm volatile("s_waitcnt lgkmcnt(0)" ::: "memory");
#pragma unroll
                        for (int i = 0; i < 8; ++i) { const int row = arow + 2 * i; const float v = sc[row * 32 + ac] * ga[bj];
                            unsafeAtomicAdd(d0 + (size_t)(ai * 128 + wr * 64 + m * 16 + row) * DM + u.pn * 256 + bj * 128 + wc * 32 + ac, v); }
                        asm volatile("s_waitcnt lgkmcnt(0)" ::: "memory");
                    }
            return;
        }
        f32x4 gr[2];
#pragma unroll
        for (int bj = 0; bj < 2; ++bj) gr[bj] = *(const f32x4*)(g + u.pn * 256 + bj * 128 + wc * 32 + rc);
#pragma unroll
        for (int ai = 0; ai < 2; ++ai)
#pragma unroll
            for (int m = 0; m < 4; ++m)
#pragma unroll
                for (int bj = 0; bj < 2; ++bj) {
                    *(LAS f32x4*)(sc + fr * 32 + 4 * fq) = acc[ai][bj][m][0]; *(LAS f32x4*)(sc + fr * 32 + 16 + 4 * fq) = acc[ai][bj][m][1];
                    asm volatile("s_waitcnt lgkmcnt(0)" ::: "memory");
#pragma unroll
                    for (int i = 0; i < 2; ++i) { const int row = rrow + 8 * i; const f32x4 v = *(const LAS f32x4*)(sc + row * 32 + rc);
                        const size_t off = (size_t)(ai * 128 + wr * 64 + m * 16 + row) * DM + u.pn * 256 + bj * 128 + wc * 32 + rc;
                        *(f32x4*)(d0 + off) = *(const f32x4*)(s0 + off) + gr[bj] * v; }
                    asm volatile("s_waitcnt lgkmcnt(0)" ::: "memory");
                }
    }
};

struct EpiUpConv {
    static constexpr bool PERM = true, CHAIN = false;
    bf16_t* hmid; float* sb; const float* cw; const float* cbias;
    __device__ __forceinline__ void operator()(AccRef acc, const Unit& u, int wr, int wc) const {
        const int ln_ = fresh_lane(), fr = ln_ & 15, fq = ln_ >> 4;
        const int pm = u.pm, ch0 = u.pn * 128 + wc * 32 + 8 * fq;
        f32x4 w0[2], w1[2], w2[2], cb[2];
#pragma unroll
        for (int n = 0; n < 2; ++n) { w0[n] = *(const f32x4*)(cw + ch0 + 4 * n); w1[n] = *(const f32x4*)(cw + DFF + ch0 + 4 * n); w2[n] = *(const f32x4*)(cw + 2 * DFF + ch0 + 4 * n); cb[n] = *(const f32x4*)(cbias + ch0 + 4 * n); }
#pragma unroll
        for (int ai = 0; ai < 2; ++ai) {
            const int blk = pm * 4 + ai * 2 + wr;
            float* sbb = sb + (size_t)blk * 6 * DFF + ch0;
#pragma unroll
            for (int m = 0; m < 4; ++m) {
                f32x4 o[2];
#pragma unroll
                for (int n = 0; n < 2; ++n) {
                    const f32x4 am = acc[ai][0][m][n], gm = acc[ai][1][m][n];
                    const f32x4 z = (f32x4){0.f, 0.f, 0.f, 0.f};
                    const f32x4 ap = (m > 0) ? acc[ai][0][m > 0 ? m - 1 : 0][n] : z, an = (m < 3) ? acc[ai][0][m < 3 ? m + 1 : 3][n] : z;
                    const f32x4 tp = (fr == 15) ? ap : am, tn = (fr == 0) ? an : am;
                    f32x4 pv, nv;
#pragma unroll
                    for (int e = 0; e < 4; ++e) { pv[e] = __int_as_float(__builtin_amdgcn_update_dpp(0, __float_as_int(tp[e]), 0x121, 0xF, 0xF, false));
                        nv[e] = __int_as_float(__builtin_amdgcn_update_dpp(0, __float_as_int(tn[e]), 0x12F, 0xF, 0xF, false)); }
                    const f32x4 y = cb[n] + w0[n] * pv + w1[n] * am + w2[n] * nv;
                    o[n] = (f32x4){fsilu(y[0]) * gm[0], fsilu(y[1]) * gm[1], fsilu(y[2]) * gm[2], fsilu(y[3]) * gm[3]};
                    if (m == 0 && fr == 0) { *(f32x4*)(sbb + 0 * DFF + 4 * n) = y; *(f32x4*)(sbb + 2 * DFF + 4 * n) = gm; *(f32x4*)(sbb + 4 * DFF + 4 * n) = am; }
                    if (m == 3 && fr == 15) { *(f32x4*)(sbb + 1 * DFF + 4 * n) = y; *(f32x4*)(sbb + 3 * DFF + 4 * n) = gm; *(f32x4*)(sbb + 5 * DFF + 4 * n) = am; }
                }
                u32x4 w; w.x = cvt_pk_bf16(o[0][0], o[0][1]); w.y = cvt_pk_bf16(o[0][2], o[0][3]); w.z = cvt_pk_bf16(o[1][0], o[1][1]); w.w = cvt_pk_bf16(o[1][2], o[1][3]);
                *(u32x4*)(hmid + (size_t)(pm * 256 + ai * 128 + wr * 64 + m * 16 + fr) * DFF + ch0) = w;
            }
        }
    }
};
__device__ __forceinline__ void ffn_fix_rows(bf16_t* hmid, const float* sb, const float* cw, int nblk, int gtid, int NT) {
    const int nitems = nblk * 2 * (DFF / 4);
    for (int it = gtid; it < nitems; it += NT) {
        const int c4 = (it % (DFF / 4)) * 4, bw = it / (DFF / 4), which = bw & 1, blk = bw >> 1;
        const int row0 = blk * 64; const int rel = row0 < MLAT ? (row0 & 4095) : ((row0 - MLAT) & 255), seqlen = row0 < MLAT ? 4096 : 256;
        const bool edge = which ? (rel + 64 == seqlen) : (rel == 0);
        const float* s = sb + (size_t)blk * 6 * DFF + c4;
        f32x4 y = *(const f32x4*)(s + which * DFF); const f32x4 g = *(const f32x4*)(s + (2 + which) * DFF);
        if (!edge) { const float* sn = sb + (size_t)(which ? blk + 1 : blk - 1) * 6 * DFF + c4; const f32x4 an = *(const f32x4*)(sn + (which ? 4 : 5) * DFF);
            const f32x4 w = *(const f32x4*)(cw + (which ? 2 * DFF : 0) + c4); y = y + w * an; }
        u32x2 o; o.x = cvt_pk_bf16(fsilu(y[0]) * g[0], fsilu(y[1]) * g[1]); o.y = cvt_pk_bf16(fsilu(y[2]) * g[2], fsilu(y[3]) * g[3]);
        *(u32x2*)(hmid + (size_t)(row0 + (which ? 63 : 0)) * DFF + c4) = o;
    }
}

struct Args { const float* in[22]; float* out; unsigned char* ws; int ph_lo, ph_hi; };

template <bool UPMAP = false>
__device__ __forceinline__ void transpose_item(const float* W, int N, bf16_t* WT, int ldk, int koff, LAS float* scr, int item, int lane) {
    const int nblk = N / 32, kb = item / nblk, nb = item % nblk, k0 = 64 * kb, n0 = 32 * nb;
    const int r0 = UPMAP ? (n0 < DFF ? (n0 >> 7) * 256 + (n0 & 127) : ((n0 - DFF) >> 7) * 256 + 128 + ((n0 - DFF) & 127)) : n0;
#pragma unroll 8
    for (int i = 0; i < 32; ++i) { const int kk = 2 * i + (lane >> 5); scr[kk * 33 + (lane & 31)] = W[(size_t)(k0 + kk) * N + n0 + (lane & 31)]; }
    LDS_WAIT(); asm volatile("" ::: "memory");
    const int c = lane & 7;
#pragma unroll
    for (int j = 0; j < 4; ++j) { const int n = (lane >> 3) + 8 * j; const LAS float* s = scr + (8 * c) * 33 + n;
        u32x4 o; o.x = cvt_pk_bf16(s[0 * 33], s[1 * 33]); o.y = cvt_pk_bf16(s[2 * 33], s[3 * 33]); o.z = cvt_pk_bf16(s[4 * 33], s[5 * 33]); o.w = cvt_pk_bf16(s[6 * 33], s[7 * 33]);
        *(u32x4*)(WT + (size_t)(r0 + n) * ldk + koff + k0 + 8 * c) = o; }
    LDS_WAIT(); asm volatile("" ::: "memory");
}
template <class AR>
__device__ __forceinline__ void convert_weights(const AR& a, int l, LAS float* scr, int gw, int NGW, int lane) {
    unsigned char* ws = a.ws;
    const float* w_in = a.in[8] + (size_t)l * DM * INW; const float* w_f = a.in[13] + (size_t)l * 512 * DM; const float* w_na = a.in[14] + (size_t)l * 1024 * DM;
    const float* w_c = a.in[15] + (size_t)l * 512 * DM; const float* w_o = a.in[16] + (size_t)l * DM * DM; const float* w_up = a.in[17] + (size_t)l * DM * UPW; const float* w_dn = a.in[20] + (size_t)l * DFF * DM;
    constexpr int I_IN = 32 * 336, I_F = 8 * 64, I_NA = 16 * 64, I_C = 8 * 64, I_O = 32 * 64, I_UP = 32 * 352, I_DN = 88 * 64;
    constexpr int NITEMS = I_IN + I_F + I_NA + I_C + I_O + I_UP + I_DN;
    for (int it = gw; it < NITEMS; it += NGW) {
        int r = it;
        if (r < I_IN) { transpose_item(w_in, INW, (bf16_t*)(ws + WS_WIN), DM, 0, scr, r, lane); continue; } r -= I_IN;
        if (r < I_F) { transpose_item(w_f, DM, (bf16_t*)(ws + WS_WBR), DM, 0, scr, r, lane); continue; } r -= I_F;
        if (r < I_NA) { transpose_item(w_na, DM, (bf16_t*)(ws + WS_WBR), DM, 512, scr, r, lane); continue; } r -= I_NA;
        if (r < I_C) { transpose_item(w_c, DM, (bf16_t*)(ws + WS_WBR), DM, 1536, scr, r, lane); continue; } r -= I_C;
        if (r < I_O) { transpose_item(w_o, DM, (bf16_t*)(ws + WS_WO), DM, 0, scr, r, lane); continue; } r -= I_O;
        if (r < I_UP) { transpose_item<true>(w_up, UPW, (bf16_t*)(ws + WS_WUP), DM, 0, scr, r, lane); continue; } r -= I_UP;
        transpose_item(w_dn, DM, (bf16_t*)(ws + WS_WDN), DFF, 0, scr, r, lane);
    }
}
__device__ __forceinline__ void dft_tables(unsigned char* ws, const LAS float* lut, int gw, int NGW, int lane) {
    bf16_t* tt = (bf16_t*)(ws + WS_TT); bf16_t* ma = (bf16_t*)(ws + WS_MA); bf16_t* dftc = (bf16_t*)(ws + WS_DFTC);
    const int half = lane >> 5, x0 = (lane & 31) * 2;
    for (int it = gw; it < 16384 + 256 + 256; it += NGW) {
        if (it < 16384) { const int k2 = it >> 8, k1 = it & 255; float v0 = 0.f, v1 = 0.f;
            if (k1 < 64) { const int k = 64 * k1 + k2, sh = half ? 3072 : 0;
                v0 = lut[(x0 * k + sh) & 4095]; v1 = lut[((x0 + 1) * k + sh) & 4095]; }
            *(unsigned*)(tt + (size_t)it * 128 + half * 64 + x0) = cvt_pk_bf16(v0, v1);
        } else if (it < 16384 + 256) { const int r = it - 16384; float v0 = 0.f, v1 = 0.f;
            if ((r & 64) == 0) { const int k2 = r & 63, im = r >> 7;
                const int sh = im ? (half ? 2048 : 1024) : (half ? 1024 : 0);
                v0 = lut[(((x0 * k2) & 63) * 64 + sh) & 4095]; v1 = lut[((((x0 + 1) * k2) & 63) * 64 + sh) & 4095]; }
            *(unsigned*)(ma + (size_t)r * 128 + half * 64 + x0) = cvt_pk_bf16(v0, v1);
        } else { const int k = it - 16384 - 256; const int n0 = lane * 8; const int nn = n0 & 255, sh = n0 >= 256 ? 1024 : 0; float v[8];
#pragma unroll
            for (int e = 0; e < 8; ++e) v[e] = lut[((((k * (nn + e)) & 255) * 16) + sh) & 4095];
            u32x4 w; w.x = cvt_pk_bf16(v[0], v[1]); w.y = cvt_pk_bf16(v[2], v[3]); w.z = cvt_pk_bf16(v[4], v[5]); w.w = cvt_pk_bf16(v[6], v[7]);
            *(u32x4*)(dftc + (size_t)k * 8192 + n0) = w; }
    }
}
template <class AR>
__device__ __forceinline__ void mods_items(const AR& a, int gw, int NGW, int lane) {
    float* mods = (float*)(a.ws + WS_MODS);
    for (int it = gw; it < 1536; it += NGW) {
        const int l = it / 768, rem = it % 768, cch = rem >> 4, kp = rem & 15; const int col = cch * 256 + lane * 4, k0 = kp * 128;
        float sv[5][2];
#pragma unroll
        for (int r = 0; r < 5; ++r)
#pragma unroll
            for (int i = 0; i < 2; ++i) { const int k = k0 + lane + 64 * i; const float cv = r < 4 ? a.in[1][r * DM + k] : a.in[3][k]; sv[r][i] = fsilu(cv); }
        f32x4 acc[5];
#pragma unroll
        for (int r = 0; r < 5; ++r) acc[r] = (f32x4){0.f, 0.f, 0.f, 0.f};
        const float* wbase = a.in[4] + ((size_t)l * DM + k0) * 12288 + col;
#pragma unroll
        for (int i = 0; i < 2; ++i) {
#pragma unroll 16
            for (int ll = 0; ll < 64; ++ll) { const f32x4 w = *(const f32x4*)(wbase + (size_t)(i * 64 + ll) * 12288);
#pragma unroll
                for (int r = 0; r < 5; ++r) { const float s = __int_as_float(__builtin_amdgcn_readlane(__float_as_int(sv[r][i]), ll)); acc[r] += w * s; } }
        }
        if (kp == 0) { const f32x4 bv = *(const f32x4*)(a.in[5] + (size_t)l * 12288 + col);
#pragma unroll
            for (int r = 0; r < 5; ++r) acc[r] += bv; }
#pragma unroll
        for (int r = 0; r < 5; ++r) { float* d = mods + ((size_t)l * 5 + r) * 12288 + col; unsafeAtomicAdd(d, acc[r][0]); unsafeAtomicAdd(d + 1, acc[r][1]); unsafeAtomicAdd(d + 2, acc[r][2]); unsafeAtomicAdd(d + 3, acc[r][3]); }
    }
}
__device__ __forceinline__ void norm_rows(const float* xlat, const float* xctx, const float* w, const float* mods_l, int shoff, int scoff, bf16_t* XN, int nrows, int gw, int NGW, int lane) {
    for (int row = gw; row < nrows; row += NGW) {
        const float* xr = row < MLAT ? xlat + (size_t)row * DM : xctx + (size_t)(row - MLAT) * DM; const int b = row < MLAT ? (row >> 12) : 4;
        const float* sh = mods_l + (size_t)b * 12288 + shoff; const float* sc = mods_l + (size_t)b * 12288 + scoff;
        f32x4 v[8]; float ss = 0.f;
#pragma unroll
        for (int j = 0; j < 8; ++j) { v[j] = *(const f32x4*)(xr + 4 * lane + 256 * j); ss += (v[j][0] * v[j][0] + v[j][1] * v[j][1]) + (v[j][2] * v[j][2] + v[j][3] * v[j][3]); }
        const float rstd = rsqrtf(wave_sum(ss, lane) * (1.0f / DM) + EPS);
#pragma unroll
        for (int j = 0; j < 8; ++j) { const int col = 4 * lane + 256 * j; const f32x4 wv = *(const f32x4*)(w + col), scv = *(const f32x4*)(sc + col), shv = *(const f32x4*)(sh + col);
            const f32x4 o = (v[j] * rstd * wv) * (scv + 1.0f) + shv; u32x2 pk; pk.x = cvt_pk_bf16(o[0], o[1]); pk.y = cvt_pk_bf16(o[2], o[3]);
            *(u32x2*)(XN + (size_t)row * DM + col) = pk; }
    }
}
__device__ __forceinline__ void final_norm(float* x, const float* w, int gw, int NGW, int lane) {
    for (int row = gw; row < MLAT; row += NGW) { float* xr = x + (size_t)row * DM; f32x4 v[8]; float ss = 0.f;
#pragma unroll
        for (int j = 0; j < 8; ++j) { v[j] = *(const f32x4*)(xr + 4 * lane + 256 * j); ss += (v[j][0] * v[j][0] + v[j][1] * v[j][1]) + (v[j][2] * v[j][2] + v[j][3] * v[j][3]); }
        const float rstd = rsqrtf(wave_sum(ss, lane) * (1.0f / DM) + EPS);
#pragma unroll
        for (int j = 0; j < 8; ++j) { const int col = 4 * lane + 256 * j; *(f32x4*)(xr + col) = v[j] * rstd * *(const f32x4*)(w + col); } }
}
__device__ __forceinline__ void sgu_unit(bf16_t* proj, int row0, int g, const float* nw, const float* wsg, const float* bsg, LAS unsigned char* lds, int tid) {
    LAS bf16_t* vnt = (LAS bf16_t*)lds;
    const int lane = tid & 63, wid = tid >> 6, fr = lane & 15, fq = lane >> 4;
    {
        const int j = tid >> 2, q = tid & 3; const bf16_t* src = proj + (size_t)(row0 + j) * INW + OFF_C + 512 + g * 128 + q * 32;
        float v[32];
#pragma unroll
        for (int i = 0; i < 4; ++i) { const u32x4 w = *(const u32x4*)(src + 8 * i);
            v[8 * i + 0] = bflo(w.x); v[8 * i + 1] = bfhi(w.x); v[8 * i + 2] = bflo(w.y); v[8 * i + 3] = bfhi(w.y); v[8 * i + 4] = bflo(w.z); v[8 * i + 5] = bfhi(w.z); v[8 * i + 6] = bflo(w.w); v[8 * i + 7] = bfhi(w.w); }
        float s = 0.f;
#pragma unroll
        for (int e = 0; e < 32; ++e) s += v[e];
        s += shx(s, 1, lane); s += shx(s, 2, lane); const float mean = s * (1.0f / 128.0f);
        float qv = 0.f;
#pragma unroll
        for (int e = 0; e < 32; ++e) { v[e] -= mean; qv += v[e] * v[e]; }
        qv += shx(qv, 1, lane); qv += shx(qv, 2, lane); const float rstd = rsqrtf(qv * (1.0f / 128.0f) + EPS);
#pragma unroll
        for (int e = 0; e < 32; e += 2) { const int d = q * 32 + e; const unsigned w = cvt_pk_bf16(v[e] * rstd * nw[g * 128 + d], v[e + 1] * rstd * nw[g * 128 + d + 1]);
            vnt[d * 136 + j] = (bf16_t)(w & 0xffffu); vnt[(d + 1) * 136 + j] = (bf16_t)(w >> 16); }
    }
    __syncthreads();
    {
        const int i = 16 * wid + fr;
        bf16x8 wf[4];
#pragma unroll
        for (int ks = 0; ks < 4; ++ks) { const float* wp = wsg + (size_t)i * 128 + 32 * ks + 8 * fq; const f32x4 a = *(const f32x4*)wp, b = *(const f32x4*)(wp + 4);
            u32x4 w; w.x = cvt_pk_bf16(a[0], a[1]); w.y = cvt_pk_bf16(a[2], a[3]); w.z = cvt_pk_bf16(b[0], b[1]); w.w = cvt_pk_bf16(b[2], b[3]); wf[ks] = __builtin_bit_cast(bf16x8, w); }
        const float bias = bsg[i];
        bf16_t* up = proj + (size_t)(row0 + i) * INW + OFF_C + g * 128 + 4 * fq;
#pragma unroll
        for (int nt = 0; nt < 8; ++nt) { f32x4 acc = (f32x4){0.f, 0.f, 0.f, 0.f};
#pragma unroll
            for (int ks = 0; ks < 4; ++ks) { const bf16x8 af = *(const LAS bf16x8*)((const LAS unsigned char*)vnt + (16 * nt + fr) * 272 + (32 * ks + 8 * fq) * 2);
                acc = __builtin_amdgcn_mfma_f32_16x16x32_bf16(af, wf[ks], acc, 0, 0, 0); }
            const u32x2 uw = *(const u32x2*)(up + 16 * nt); u32x2 o;
            o.x = cvt_pk_bf16(bflo(uw.x) * (acc[0] + bias), bfhi(uw.x) * (acc[1] + bias)); o.y = cvt_pk_bf16(bflo(uw.y) * (acc[2] + bias), bfhi(uw.y) * (acc[3] + bias));
            *(u32x2*)(up + 16 * nt) = o; }
    }
    __syncthreads();
}
template <bool LAT>
__device__ __forceinline__ void attn_task(bf16_t* proj, const bf16_t* vt, const float* rpb, int t, int lane, const LAS unsigned char* cl) {
    constexpr int NCH = LAT ? 16 : 8, WCH = LAT ? 8 : 0;
    const int fr = lane & 15, fq = lane >> 4;
    int b, h, r = 0, cgp = 0, qrow;
    if (LAT) { cgp = t & 3; r = (t >> 2) & 63; h = (t >> 8) & 7; b = t >> 11; qrow = b * 4096 + r * 64 + cgp * 16 + fr; }
    else { const int qg = t & 15; h = (t >> 4) & 7; b = t >> 7; qrow = MLAT + b * 256 + qg * 16 + fr; }
    bf16_t* qp = proj + (size_t)qrow * INW + OFF_Q + h * 128;
    bf16x8 qf[4];
#pragma unroll
    for (int ks = 0; ks < 4; ++ks) qf[ks] = *(const bf16x8*)(qp + ks * 32 + fq * 8);
    const int rs = r < 4 ? 0 : (r > 60 ? 56 : r - 4);
    const int cb = cgp == 0 ? 0 : (cgp == 1 ? 8 : (cgp == 2 ? 24 : 32));
    float S[NCH][8];
    const int kap = 8 * (fr >> 2) + (fr & 3);
    const bf16_t* kbase = proj + OFF_K + h * 128 + fq * 8;
    bf16x8 kf[2][8];
#define ATT_LOADK(buf, c) do { _Pragma("unroll") for (int tt = 0; tt < 2; ++tt) { \
        if ((c) < WCH) { const int krow = b * 4096 + (rs + (c)) * 64 + cb + kap + 4 * tt; const bf16_t* kp = kbase + (size_t)krow * INW; \
            _Pragma("unroll") for (int ks = 0; ks < 4; ++ks) kf[buf][tt * 4 + ks] = *(const bf16x8*)(kp + ks * 32); } \
        else { const LAS unsigned char* kp = cl + (32 * ((c) - WCH) + kap + 4 * tt) * 256; \
            _Pragma("unroll") for (int ks = 0; ks < 4; ++ks) kf[buf][tt * 4 + ks] = *(const LAS bf16x8*)(kp + (((ks * 4 + fq) ^ fr) * 16)); } } } while (0)
    ATT_LOADK(0, 0);
#pragma unroll
    for (int c = 0; c < NCH; ++c) {
        if (c + 1 < NCH) ATT_LOADK((c + 1) & 1, c + 1);
        __builtin_amdgcn_sched_barrier(0);
#pragma unroll
        for (int tt = 0; tt < 2; ++tt) {
            f32x4 acc = (f32x4){0.f, 0.f, 0.f, 0.f};
#pragma unroll
            for (int ks = 0; ks < 4; ++ks) acc = __builtin_amdgcn_mfma_f32_16x16x32_bf16(kf[c & 1][tt * 4 + ks], qf[ks], acc, 0, 0, 0);
            S[c][4 * tt + 0] = acc[0]; S[c][4 * tt + 1] = acc[1]; S[c][4 * tt + 2] = acc[2]; S[c][4 * tt + 3] = acc[3];
        }
        __builtin_amdgcn_sched_barrier(0);
    }
#undef ATT_LOADK
    if (LAT) {
        const int qc = cgp * 16 + fr; const int cs = qc < 8 ? 0 : (qc > 56 ? 48 : qc - 8);
#pragma unroll
        for (int c = 0; c < WCH; ++c) { const int dr = rs + c - r + 7; const float* rp = rpb + (h * 15 + dr) * 31;
#pragma unroll
            for (int jj = 0; jj < 8; ++jj) { const int kc = cb + 8 * fq + jj; const bool valid = (kc >= cs) && (kc < cs + 16); int dc = kc - qc + 15; dc = dc < 0 ? 0 : (dc > 30 ? 30 : dc);
                const float bias = rp[dc]; S[c][jj] = valid ? S[c][jj] + bias : -1e30f; } }
    }
    float mx = -3.0e38f;
#pragma unroll
    for (int c = 0; c < NCH; ++c)
#pragma unroll
        for (int jj = 0; jj < 8; ++jj) mx = fmaxf(mx, S[c][jj]);
    mx = fmaxf(mx, shx(mx, 16, lane)); mx = fmaxf(mx, shx(mx, 32, lane));
    float sum = 0.f; bf16x8 pf[NCH];
#pragma unroll
    for (int c = 0; c < NCH; ++c) { float p[8];
#pragma unroll
        for (int jj = 0; jj < 8; ++jj) { p[jj] = __builtin_amdgcn_exp2f((S[c][jj] - mx) * 1.44269504089f); sum += p[jj]; }
        u32x4 w; w.x = cvt_pk_bf16(p[0], p[1]); w.y = cvt_pk_bf16(p[2], p[3]); w.z = cvt_pk_bf16(p[4], p[5]); w.w = cvt_pk_bf16(p[6], p[7]); pf[c] = __builtin_bit_cast(bf16x8, w); }
    sum += shx(sum, 16, lane); sum += shx(sum, 32, lane);
    const float inv = 1.0f / sum;
    const bf16_t* vlat = vt + ((size_t)(b * 1024 + h * 128 + fr)) * 4096 + cb + 8 * fq;
    constexpr int NBH = NCH / 8, NQ = 8 * NBH;
    bf16x8 vf[2][8];
#define ATT_LOADV(buf, q) do { const int dt_ = (q) / NBH, hb_ = (q) % NBH; _Pragma("unroll") for (int i = 0; i < 8; ++i) { const int c_ = hb_ * 8 + i; \
        if (c_ < WCH) vf[buf][i] = *(const bf16x8*)(vlat + (size_t)dt_ * 16 * 4096 + (rs + c_) * 64); \
        else vf[buf][i] = *(const LAS bf16x8*)(cl + 65536 + (dt_ * 16 + fr) * 512 + ((((c_ - WCH) * 4 + fq) ^ fr) * 16)); } } while (0)
    ATT_LOADV(0, 0);
    f32x4 oacc = (f32x4){0.f, 0.f, 0.f, 0.f};
#pragma unroll
    for (int q = 0; q < NQ; ++q) {
        if (q + 1 < NQ) ATT_LOADV((q + 1) & 1, q + 1);
        __builtin_amdgcn_sched_barrier(0);
        const int dt = q / NBH, hb = q % NBH;
        if (hb == 0) oacc = (f32x4){0.f, 0.f, 0.f, 0.f};
#pragma unroll
        for (int i = 0; i < 8; ++i) oacc = __builtin_amdgcn_mfma_f32_16x16x32_bf16(vf[q & 1][i], pf[hb * 8 + i], oacc, 0, 0, 0);
        if (hb == NBH - 1) { u32x2 o; o.x = cvt_pk_bf16(oacc[0] * inv, oacc[1] * inv); o.y = cvt_pk_bf16(oacc[2] * inv, oacc[3] * inv);
            *(u32x2*)(qp + dt * 16 + 4 * fq) = o; }
        __builtin_amdgcn_sched_barrier(0);
    }
#undef ATT_LOADV
}
template <bool LAT>
__device__ __forceinline__ void attn_pass(bf16_t* proj, const bf16_t* vt, const bf16_t* vtc, const float* rpb, int b, int h, int ra, LAS unsigned char* lds, int wave) {
    constexpr int NCH = LAT ? 16 : 8, WCH = LAT ? 8 : 0;
    const int lane = fresh_lane(), fr = lane & 15, fq = lane >> 4, tid = wave * 64 + lane;
    const int r = LAT ? ra + (wave >> 2) : 0, cgp = LAT ? (wave & 3) : 0;
    const int rsa = ra < 4 ? 0 : (ra > 60 ? 56 : ra - 4), rs = r < 4 ? 0 : (r > 60 ? 56 : r - 4), shw = rs - rsa;
    const int rsb = (ra + 1) < 4 ? 0 : ((ra + 1) > 60 ? 56 : ra + 1 - 4), T = 8 + (rsb - rsa);
    const int cb = cgp == 0 ? 0 : (cgp == 1 ? 8 : (cgp == 2 ? 24 : 32));
    const bool active = LAT || wave == 0;
    const int qrow = LAT ? (b * 4096 + r * 64 + cgp * 16 + fr) : (MLAT + b * 256 + ra * 16 + fr);
    bf16_t* qp = proj + (size_t)qrow * INW + OFF_Q + h * 128;
    bf16x8 qf[4];
#pragma unroll
    for (int ks = 0; ks < 4; ++ks) qf[ks] = *(const bf16x8*)(qp + ks * 32 + fq * 8);
    const int kap = 8 * (fr >> 2) + (fr & 3);
    float S[NCH][8];
    if (LAT) {
        __syncthreads();
        { u32x4 v[18];
#pragma unroll
          for (int i = 0; i < 18; ++i) { const int idx = tid + 512 * i, key = idx >> 4, ch = idx & 15;
            if (i < 2 * T) v[i] = *(const u32x4*)(proj + (size_t)(b * 4096 + rsa * 64 + key) * INW + OFF_K + h * 128 + ch * 8); }
#pragma unroll
          for (int i = 0; i < 18; ++i) { const int idx = tid + 512 * i, key = idx >> 4, ch = idx & 15, g = (key & 3) | (((key >> 3) & 3) << 2);
            if (i < 2 * T) *(LAS u32x4*)(lds + key * 256 + ((ch ^ g) * 16)) = v[i]; } }
        __syncthreads();
        const int gw = (fr & 3) | ((((cb >> 3) + (fr >> 2)) & 3) << 2);
#pragma unroll
        for (int c = 0; c < WCH; ++c) {
#pragma unroll
            for (int tt = 0; tt < 2; ++tt) { const LAS unsigned char* kp = lds + ((c + shw) * 64 + cb + kap + 4 * tt) * 256;
                f32x4 acc = (f32x4){0.f, 0.f, 0.f, 0.f};
#pragma unroll
                for (int ks = 0; ks < 4; ++ks) { const bf16x8 kf = *(const LAS bf16x8*)(kp + (((ks * 4 + fq) ^ gw) * 16)); acc = __builtin_amdgcn_mfma_f32_16x16x32_bf16(kf, qf[ks], acc, 0, 0, 0); }
                S[c][4 * tt + 0] = acc[0]; S[c][4 * tt + 1] = acc[1]; S[c][4 * tt + 2] = acc[2]; S[c][4 * tt + 3] = acc[3]; } }
    }
    __syncthreads();
    { u32x4 v[8];
#pragma unroll
      for (int i = 0; i < 8; ++i) { const int idx = tid + 512 * i, key = idx >> 4, ch = idx & 15; v[i] = *(const u32x4*)(proj + (size_t)(MLAT + b * 256 + key) * INW + OFF_K + h * 128 + ch * 8); }
#pragma unroll
      for (int i = 0; i < 8; ++i) { const int idx = tid + 512 * i, key = idx >> 4, ch = idx & 15, g = (key & 3) | (((key >> 3) & 3) << 2); *(LAS u32x4*)(lds + key * 256 + ((ch ^ g) * 16)) = v[i]; } }
    __syncthreads();
    float mx = -3.0e38f, sum = 0.f, inv = 0.f; bf16x8 pf[NCH];
    if (active) {
#pragma unroll
        for (int c = WCH; c < NCH; ++c) {
#pragma unroll
            for (int tt = 0; tt < 2; ++tt) { const LAS unsigned char* kp = lds + (32 * (c - WCH) + kap + 4 * tt) * 256;
                f32x4 acc = (f32x4){0.f, 0.f, 0.f, 0.f};
#pragma unroll
                for (int ks = 0; ks < 4; ++ks) { const bf16x8 kf = *(const LAS bf16x8*)(kp + (((ks * 4 + fq) ^ fr) * 16)); acc = __builtin_amdgcn_mfma_f32_16x16x32_bf16(kf, qf[ks], acc, 0, 0, 0); }
                S[c][4 * tt + 0] = acc[0]; S[c][4 * tt + 1] = acc[1]; S[c][4 * tt + 2] = acc[2]; S[c][4 * tt + 3] = acc[3]; } }
        if (LAT) {
            const int qc = cgp * 16 + fr; const int cs = qc < 8 ? 0 : (qc > 56 ? 48 : qc - 8);
#pragma unroll
            for (int c = 0; c < WCH; ++c) { const int dr = rs + c - r + 7; const float* rp = rpb + (h * 15 + dr) * 31;
#pragma unroll
                for (int jj = 0; jj < 8; ++jj) { const int kc = cb + 8 * fq + jj; const bool valid = (kc >= cs) && (kc < cs + 16); int dc = kc - qc + 15; dc = dc < 0 ? 0 : (dc > 30 ? 30 : dc);
                    const float bias = rp[dc]; S[c][jj] = valid ? S[c][jj] + bias : -1e30f; } }
        }
#pragma unroll
        for (int c = 0; c < NCH; ++c)
#pragma unroll
            for (int jj = 0; jj < 8; ++jj) mx = fmaxf(mx, S[c][jj]);
        mx = fmaxf(mx, shx(mx, 16, lane)); mx = fmaxf(mx, shx(mx, 32, lane));
#pragma unroll
        for (int c = 0; c < NCH; ++c) { float p[8];
#pragma unroll
            for (int jj = 0; jj < 8; ++jj) { p[jj] = __builtin_amdgcn_exp2f((S[c][jj] - mx) * 1.44269504089f); sum += p[jj]; }
            u32x4 w; w.x = cvt_pk_bf16(p[0], p[1]); w.y = cvt_pk_bf16(p[2], p[3]); w.z = cvt_pk_bf16(p[4], p[5]); w.w = cvt_pk_bf16(p[6], p[7]); pf[c] = __builtin_bit_cast(bf16x8, w); }
        sum += shx(sum, 16, lane); sum += shx(sum, 32, lane);
        inv = 1.0f / sum;
    }
    f32x4 oacc[8];
#pragma unroll
    for (int dt = 0; dt < 8; ++dt) oacc[dt] = (f32x4){0.f, 0.f, 0.f, 0.f};
    if (LAT) {
        __syncthreads();
        const int cpr = T * 8;
        { u32x4 v[18];
#pragma unroll
          for (int i = 0; i < 18; ++i) { const int idx = tid + 512 * i, d = idx / cpr, ch = idx - d * cpr;
            if (i < 2 * T) v[i] = *(const u32x4*)(vt + (size_t)(b * 1024 + h * 128 + d) * 4096 + rsa * 64 + ch * 8); }
#pragma unroll
          for (int i = 0; i < 18; ++i) { const int idx = tid + 512 * i, d = idx / cpr, ch = idx - d * cpr;
            if (i < 2 * T) *(LAS u32x4*)(lds + d * 1152 + (((ch & ~7) | ((ch & 7) ^ ((d >> 1) & 7))) * 16)) = v[i]; } }
        __syncthreads();
#pragma unroll
        for (int dt = 0; dt < 8; ++dt)
#pragma unroll
            for (int c = 0; c < WCH; ++c) { const int ch = (c + shw) * 8 + (cb >> 3) + fq;
                const bf16x8 vf = *(const LAS bf16x8*)(lds + (dt * 16 + fr) * 1152 + (((ch & ~7) | ((ch & 7) ^ (fr >> 1))) * 16));
                oacc[dt] = __builtin_amdgcn_mfma_f32_16x16x32_bf16(vf, pf[c], oacc[dt], 0, 0, 0); }
    }
    __syncthreads();
    { u32x4 v[8];
#pragma unroll
      for (int i = 0; i < 8; ++i) { const int idx = tid + 512 * i, d = idx >> 5, ch = idx & 31; v[i] = *(const u32x4*)(vtc + (size_t)(b * 1024 + h * 128 + d) * 256 + ch * 8); }
#pragma unroll
      for (int i = 0; i < 8; ++i) { const int idx = tid + 512 * i, d = idx >> 5, ch = idx & 31; *(LAS u32x4*)(lds + d * 512 + ((ch ^ (d & 15)) * 16)) = v[i]; } }
    __syncthreads();
    if (active) {
#pragma unroll
        for (int dt = 0; dt < 8; ++dt) {
#pragma unroll
            for (int c = WCH; c < NCH; ++c) { const bf16x8 vf = *(const LAS bf16x8*)(lds + (dt * 16 + fr) * 512 + ((((c - WCH) * 4 + fq) ^ fr) * 16));
                oacc[dt] = __builtin_amdgcn_mfma_f32_16x16x32_bf16(vf, pf[c], oacc[dt], 0, 0, 0); }
            u32x2 o; o.x = cvt_pk_bf16(oacc[dt][0] * inv, oacc[dt][1] * inv); o.y = cvt_pk_bf16(oacc[dt][2] * inv, oacc[dt][3] * inv);
            *(u32x2*)(qp + dt * 16 + 4 * fq) = o; }
    }
}
__device__ __forceinline__ void attn_block(bf16_t* proj, const bf16_t* vt, const bf16_t* vtc, const float* rpb, int vcu, int half, bool ctxq, LAS unsigned char* lds, int wave) {
    const int bh = vcu >> 3, b = bh >> 3, h = bh & 7, rb = vcu & 7;
    __syncthreads();
    { const int tid = wave * 64 + fresh_lane();
#pragma unroll
      for (int i = 0; i < 8; ++i) { const int idx = tid + 512 * i, key = idx >> 4, ch = idx & 15, g = (key & 3) | (((key >> 3) & 3) << 2);
          const u32x4 v = *(const u32x4*)(proj + (size_t)(MLAT + b * 256 + key) * INW + OFF_K + h * 128 + ch * 8);
          *(LAS u32x4*)(lds + key * 256 + ((ch ^ g) * 16)) = v; }
#pragma unroll
      for (int i = 0; i < 8; ++i) { const int idx = tid + 512 * i, d = idx >> 5, ch = idx & 31;
          const u32x4 v = *(const u32x4*)(vtc + (size_t)(b * 1024 + h * 128 + d) * 256 + ch * 8);
          *(LAS u32x4*)(lds + 65536 + d * 512 + ((ch ^ (d & 15)) * 16)) = v; } }
    __syncthreads();
    const int lane = fresh_lane();
    for (int round = 0; round < 2; ++round) { const int r = rb * 8 + half * 4 + round * 2 + (wave >> 2), cgp = wave & 3;
        attn_task<true>(proj, vt, rpb, ((bh * 64 + r) << 2) + cgp, lane, lds); }
    if (ctxq && wave == 0) attn_task<false>(proj, vt, rpb, bh * 16 + rb * 2 + half, lane, lds);
}
__device__ __forceinline__ void conv_items(const bf16_t* up, bf16_t* hmid, const float* cw, const float* cbias, int nrows, int gtid, int NT) {
    const int nitems = (nrows / 16) * 704;
    for (int it = gtid; it < nitems; it += NT) {
        const int cg8 = it % 704, rb = it / 704; const int row0 = rb * 16, ch = cg8 * 8;
        const int seqlen = row0 < MLAT ? 4096 : 256; const int ts = (row0 < MLAT ? row0 : row0 - MLAT) & (seqlen - 1);
        float w0[8], w1[8], w2[8], bb[8];
#pragma unroll
        for (int e = 0; e < 8; ++e) { w0[e] = cw[ch + e]; w1[e] = cw[DFF + ch + e]; w2[e] = cw[2 * DFF + ch + e]; bb[e] = cbias[ch + e]; }
        const bf16_t* ap = up + (size_t)row0 * UPW + ch; const bf16_t* gp = ap + DFF; bf16_t* hp = hmid + (size_t)row0 * DFF + ch;
        u32x4 prev = (u32x4){0u, 0u, 0u, 0u}; if (ts > 0) prev = *(const u32x4*)(ap - UPW);
        u32x4 cur = *(const u32x4*)ap;
        for (int i = 0; i < 16; ++i) {
            u32x4 nxt = (u32x4){0u, 0u, 0u, 0u}; if (i < 15 || ts + 16 < seqlen) nxt = *(const u32x4*)(ap + (size_t)(i + 1) * UPW);
            const u32x4 gw = *(const u32x4*)(gp + (size_t)i * UPW);
            float o[8];
#pragma unroll
            for (int e = 0; e < 4; ++e) {
                const float y0 = bb[2 * e] + w0[2 * e] * bflo(prev[e]) + w1[2 * e] * bflo(cur[e]) + w2[2 * e] * bflo(nxt[e]);
                const float y1 = bb[2 * e + 1] + w0[2 * e + 1] * bfhi(prev[e]) + w1[2 * e + 1] * bfhi(cur[e]) + w2[2 * e + 1] * bfhi(nxt[e]);
                o[2 * e] = fsilu(y0) * bflo(gw[e]); o[2 * e + 1] = fsilu(y1) * bfhi(gw[e]); }
            u32x4 w; w.x = cvt_pk_bf16(o[0], o[1]); w.y = cvt_pk_bf16(o[2], o[3]); w.z = cvt_pk_bf16(o[4], o[5]); w.w = cvt_pk_bf16(o[6], o[7]);
            *(u32x4*)(hp + (size_t)i * DFF) = w;
            prev = cur; cur = nxt;
        }
    }
}


#define XB_TMO      128
#define XB_XCNT(j)  (256  + 64 * (j))
#define XB_XSUB(j)  (1280 + 64 * (j))
#define XB_XGEN(j)  (2304 + 64 * (j))
#define XB_TOP      3328
#define XB_TOPGEN   3392
#define XCD_BAR_WORDS 3456
#define XB_SPIN_CAP (1u << 18)
__device__ __forceinline__ unsigned xb_ld(unsigned* p)              { return __hip_atomic_load(p, __ATOMIC_RELAXED, __HIP_MEMORY_SCOPE_AGENT); }
__device__ __forceinline__ unsigned xb_add(unsigned* p, unsigned v) { return __hip_atomic_fetch_add(p, v, __ATOMIC_RELAXED, __HIP_MEMORY_SCOPE_AGENT); }
__device__ __forceinline__ unsigned xb_xcc_id() { return (unsigned)__builtin_amdgcn_s_getreg((3 << 11) | 20) & 0xFu; }
#define XB_SPIN(cond, bar) do { unsigned _sp = 0; while (cond) { __builtin_amdgcn_s_sleep(1); \
    if ((++_sp & 255u) == 0u) { if (xb_ld(&(bar)[XB_TMO])) break; if (_sp > XB_SPIN_CAP) { atomicAdd(&(bar)[XB_TMO], 1u); break; } } } } while (0)
struct XcdBarrier { unsigned* bar; unsigned x; volatile LAS unsigned* st; };
__device__ __forceinline__ XcdBarrier xcd_barrier_post(unsigned* bar, volatile LAS unsigned* st) {
    XcdBarrier b; b.bar = bar; b.x = xb_xcc_id(); b.st = st;
    if (threadIdx.x == 0) (void)xb_add(&bar[XB_XCNT(b.x)], 1u);
    return b;
}
__device__ __forceinline__ void xcd_barrier_complete(unsigned* bar, unsigned x, unsigned& nloc, unsigned& nx) {
    const unsigned G = gridDim.x * gridDim.y * gridDim.z;
    unsigned sum, cnt, mine, sp = 0u;
    for (;;) {
        sum = 0u; cnt = 0u; mine = 0u;
#pragma unroll
        for (unsigned j = 0; j < 16; ++j) { const unsigned c = xb_ld(&bar[XB_XCNT(j)]); sum += c; cnt += (c > 0u) ? 1u : 0u; mine = (j == x) ? c : mine; }
        if (sum == G) break;
        __builtin_amdgcn_s_sleep(1);
        if ((++sp & 255u) == 0u) { if (xb_ld(&bar[XB_TMO])) break; if (sp > XB_SPIN_CAP) { atomicAdd(&bar[XB_TMO], 1u); break; } }
    }
    nloc = mine > 0u ? mine : 1u; nx = cnt > 0u ? cnt : 1u;
}
__device__ __forceinline__ void xcd_barrier(const XcdBarrier& b) {
    asm volatile("s_waitcnt vmcnt(0)" ::: "memory");
    __syncthreads();
    if (threadIdx.x == 0) {
        unsigned* bar = b.bar;
        __builtin_amdgcn_s_waitcnt(0);
        unsigned nloc = b.st[0], nx = b.st[1];
        if (nloc == 0u) { xcd_barrier_complete(bar, b.x, nloc, nx); b.st[0] = nloc; b.st[1] = nx; }
        const unsigned old = xb_add(&bar[XB_XSUB(b.x)], 1u);
        const unsigned gen = old / nloc;
        if (old + 1u == (gen + 1u) * nloc) {
            __builtin_amdgcn_fence(__ATOMIC_RELEASE, "agent");
            asm volatile("s_waitcnt vmcnt(0)" ::: "memory");
            const unsigned og = xb_add(&bar[XB_TOP], 1u);
            const unsigned tg = og / nx;
            if (og + 1u == (tg + 1u) * nx) xb_add(&bar[XB_TOPGEN], 1u);
            else XB_SPIN(xb_ld(&bar[XB_TOPGEN]) == tg, bar);
            __builtin_amdgcn_fence(__ATOMIC_ACQUIRE, "agent");
            xb_add(&bar[XB_XGEN(b.x)], 1u);
            asm volatile("s_waitcnt vmcnt(0)" ::: "memory");
        } else {
            XB_SPIN(xb_ld(&bar[XB_XGEN(b.x)]) == gen, bar);
            __builtin_amdgcn_fence(__ATOMIC_ACQUIRE, "agent");
            asm volatile("s_waitcnt vmcnt(0)" ::: "memory");
        }
    }
    __syncthreads();
}
constexpr int NPHASE = 24;
__global__ void __launch_bounds__(512, 2) mega(Args a_) {
    extern __shared__ __attribute__((aligned(16))) unsigned char lds_raw[];
    LAS unsigned char* lds = (LAS unsigned char*)lds_raw;
    cg::grid_group grid = cg::this_grid();
    const int G = gridDim.x, cu = blockIdx.x, NGW = G * 8, wave = __builtin_amdgcn_readfirstlane((int)threadIdx.x >> 6);

    volatile LAS unsigned* xst = (volatile LAS unsigned*)(lds + LDS_XST);
    if (threadIdx.x < 4) xst[threadIdx.x] = 0u;
    __syncthreads();
    const XcdBarrier xbar = xcd_barrier_post((unsigned*)(a_.ws + WS_BAR), xst);

    const int ph_lo = a_.ph_lo, ph_hi = a_.ph_hi;
    for (int p = ph_lo; p < ph_hi; ++p) {
        if (p > ph_lo) { if (p == 1) grid.sync(); else xcd_barrier(xbar); }
#define PH_IDS const int lane = fresh_lane(); const int tid = wave * 64 + lane, gw = cu * 8 + wave; (void)tid; (void)gw; (void)lane;
        typedef const __attribute__((address_space(4))) Args KArgs;
        KArgs* ap = (KArgs*)__builtin_amdgcn_kernarg_segment_ptr(); asm volatile("" : "+s"(ap));
        KArgs& a = *ap;
        unsigned char* ws = a.ws;
        unsigned* ctl = (unsigned*)(ws + WS_CTL);
        bf16_t* PROJ = (bf16_t*)(ws + WS_BIG); bf16_t* XN = (bf16_t*)(ws + WS_XN); bf16_t* HMID = (bf16_t*)(ws + WS_HMID);
        float* XC = (float*)(ws + WS_XC); float* mods = (float*)(ws + WS_MODS);
        bf16_t* VT = (bf16_t*)(ws + WS_VT); bf16_t* VTC = (bf16_t*)(ws + WS_VTC);
        if (p == 0) { PH_IDS
            LAS float* lut = (LAS float*)(lds + 72 * 1024);
            for (int i = tid; i < 4096; i += 512) lut[i] = cospif((float)i * (1.0f / 2048.0f));
            __syncthreads();
            if (cu == 0) { bf16_t* dd = (bf16_t*)(ws + WS_DFTD);
                for (int e = tid; e < 256 * 128; e += 512) { const int row = e >> 7, d = e & 127, j = row & 127; const float ang = (float)((j * d) & 127) * (1.0f / 64.0f);
                    const float v = row < 128 ? cospif(ang) : sinpif(ang); dd[e] = (bf16_t)(cvt_pk_bf16(v, 0.f) & 0xffffu); } }
            for (int i = cu * 512 + tid; i < 1024 * DM / 4; i += G * 512) ((f32x4*)XC)[i] = ((const f32x4*)a.in[2])[i];
            mods_items(a, gw, NGW, lane);
            convert_weights(a, 0, (LAS float*)(lds + wave * 8704), gw, NGW, lane);
            dft_tables(ws, lut, gw, NGW, lane);
            continue;
        }
        if (p == NPHASE - 1) { PH_IDS final_norm(a.out, a.in[21], gw, NGW, lane); continue; }
        const int l = (p - 1) / 11, s = (p - 1) % 11;
        const float* mods_l = mods + (size_t)l * 5 * 12288;
        const float* xlat = (l == 0) ? a.in[0] : a.out; const float* xctx = (l == 0) ? a.in[2] : XC;
        const int nMall = (l == 0) ? 68 : 64;
        switch (s) {
        case 0: { PH_IDS
            if (l == 1) { LAS float* lut = (LAS float*)(lds + 72 * 1024);
                for (int i = tid; i < 4096; i += 512) lut[i] = cospif((float)i * (1.0f / 2048.0f));
                __syncthreads();
                convert_weights(a, 1, (LAS float*)(lds + wave * 8704), gw, NGW, lane);
                dft_tables(ws, lut, gw, NGW, lane); }
            norm_rows(xlat, xctx, a.in[6] + (size_t)l * DM, mods_l, 0, 2048, XN, MT, gw, NGW, lane);
        } break;
        case 1: { PH_IDS
            SchedGrid S; S.so.init(nMall, 42, G, cu); S.A = (const char*)XN; S.B = (const char*)(ws + WS_WIN); S.tsA = (size_t)256 * DM * 2; S.tsB = (size_t)256 * DM * 2; S.nt = 32;
            S.nextra = (l == 0) ? 0 : 32; S.ex_pm0 = 64; S.ex_pn0 = 6; S.ex_w = 8; S.ex_ks = 1;
            EpiInProj E{PROJ, VT, VTC};
            pg8::gemm_phase<EpiInProj, SchedGrid>(lds, tid, DM, DM, S, E);
        } break;
        case 2: { PH_IDS
            const int nun = 512 + ((l == 0) ? 32 : 0);
            for (int u = cu; u < nun; u += G) { int row0, g;
                if (u < 512) { const int b = u >> 7, ch = (u >> 2) & 31; g = u & 3; row0 = b * 4096 + ch * 128; }
                else { const int e = u - 512; const int b = e >> 3, ch = (e >> 2) & 1; g = e & 3; row0 = MLAT + b * 256 + ch * 128; }
                sgu_unit(PROJ, row0, g, a.in[10] + (size_t)l * 512, a.in[11] + ((size_t)l * 4 + g) * 128 * 128, a.in[12] + ((size_t)l * 4 + g) * 128, lds, tid); }
            __syncthreads();
            { SchedF1L S{(const char*)(ws + WS_DFTD), (const char*)PROJ, G, cu}; EpiF1L E{(bf16_t*)(ws + WS_U)};
              pg8::gemm_phase<EpiF1L, SchedF1L>(lds, wave * 64 + fresh_lane(), 128, INW, S, E); }
            if (l == 0) { SchedF1 S{(const char*)(ws + WS_DFTD), (const char*)PROJ, G, (cu + 128) % G, 16}; EpiF1 E{nullptr, (bf16_t*)(ws + WS_PQTC)};
              pg8::gemm_phase<EpiF1, SchedF1>(lds, wave * 64 + fresh_lane(), 128, INW, S, E); }
        } break;
        case 3: { PH_IDS
            { SchedFA S{(const char*)(ws + WS_MA), (const char*)(ws + WS_U), G, cu}; EpiFA E{(bf16_t*)(ws + WS_ZBUF)};
              pg8::gemm_phase<EpiFA, SchedFA>(lds, tid, 128, 128, S, E); }
            if (l == 0) { SchedF2 S{(const char*)(ws + WS_DFTC), (const char*)(ws + WS_PQTC), G, (cu + 128) % G, 8}; EpiF2 E{PROJ};
              pg8::gemm_phase<EpiF2, SchedF2>(lds, wave * 64 + fresh_lane(), 8192, 8192, S, E); }
            for (int vcu = cu; vcu < 256; vcu += G) { const int bh = vcu >> 3, rb = vcu & 7; const float* rpb = a.in[9] + (size_t)l * 8 * 15 * 31;
#pragma unroll 1
                for (int pp = 0; pp < 2; ++pp) attn_pass<true>(PROJ, VT, VTC, rpb, bh >> 3, bh & 7, rb * 8 + 0 * 4 + pp * 2, lds, wave);
                if (l == 0) attn_pass<false>(PROJ, VT, VTC, rpb, bh >> 3, bh & 7, rb * 2 + 0, lds, wave); }
        } break;
        case 4: { PH_IDS
            { SchedFB S{(const char*)(ws + WS_TT), (const char*)(ws + WS_ZBUF), G, cu}; EpiFB E{PROJ};
              pg8::gemm_phase<EpiFB, SchedFB>(lds, tid, 128, 128, S, E); }
            for (int vcu = cu; vcu < 256; vcu += G) { const int bh = vcu >> 3, rb = vcu & 7; const float* rpb = a.in[9] + (size_t)l * 8 * 15 * 31;
#pragma unroll 1
                for (int pp = 0; pp < 2; ++pp) attn_pass<true>(PROJ, VT, VTC, rpb, bh >> 3, bh & 7, rb * 8 + 1 * 4 + pp * 2, lds, wave);
                if (l == 0) attn_pass<false>(PROJ, VT, VTC, rpb, bh >> 3, bh & 7, rb * 2 + 1, lds, wave); }
        } break;
        case 5: { PH_IDS
            SchedBranch S; S.so.init(nMall, 8, G, cu); S.proj = (const char*)PROJ; S.wbr = (const char*)(ws + WS_WBR);
            EpiBranch E{PROJ, XN};
            pg8::gemm_phase<EpiBranch, SchedBranch>(lds, tid, INW, DM, S, E);
        } break;
        case 6: { PH_IDS
            SchedGrid S; S.so.init(64, 8, G, cu); S.A = (const char*)XN; S.B = (const char*)(ws + WS_WO); S.tsA = (size_t)256 * DM * 2; S.tsB = (size_t)256 * DM * 2; S.nt = 32;
            S.nextra = (l == 0) ? 32 * 2 : 0; S.ex_pm0 = 64; S.ex_pn0 = 0; S.ex_w = 8; S.ex_ks = 2;
            EpiResid E{xlat, XC, a.out, XC, mods_l + 4096, lds};
            pg8::gemm_phase<EpiResid, SchedGrid>(lds, tid, DM, DM, S, E);
        } break;
        case 7: { PH_IDS
            norm_rows(a.out, XC, a.in[7] + (size_t)l * DM, mods_l, 6144, 8192, XN, nMall * 256, gw, NGW, lane);
        } break;
        case 8: { PH_IDS
            SchedGrid S; S.so.init(nMall, 44, G, cu); S.A = (const char*)XN; S.B = (const char*)(ws + WS_WUP); S.tsA = (size_t)256 * DM * 2; S.tsB = (size_t)256 * DM * 2; S.nt = 32; S.nextra = 0; S.ex_pm0 = 0; S.ex_pn0 = 0; S.ex_w = 1; S.ex_ks = 1;
            EpiUpConv E{HMID, (float*)(ws + WS_BIG), a.in[18] + (size_t)l * 3 * DFF, a.in[19] + (size_t)l * DFF};
            pg8::gemm_phase<EpiUpConv, SchedGrid>(lds, tid, DM, DM, S, E);
        } break;
        case 9: { PH_IDS
            ffn_fix_rows(HMID, (const float*)(ws + WS_BIG), a.in[18] + (size_t)l * 3 * DFF, nMall * 4, cu * 512 + tid, G * 512);
        } break;
        case 10: { PH_IDS
            SchedGrid S; S.so.init(64, 8, G, cu); S.A = (const char*)HMID; S.B = (const char*)(ws + WS_WDN); S.tsA = (size_t)256 * DFF * 2; S.tsB = (size_t)256 * DFF * 2; S.nt = 88;
            S.nextra = (l == 0) ? 32 * 4 : 0; S.ex_pm0 = 64; S.ex_pn0 = 0; S.ex_w = 8; S.ex_ks = 4;
            EpiResid E{a.out, XC, a.out, XC, mods_l + 10240, lds};
            pg8::gemm_phase<EpiResid, SchedGrid>(lds, tid, DFF, DFF, S, E);
        } break;
        }
    }
}

extern "C" void kernel_launch(void* const* d_in, const int* in_sizes, int n_in, void* d_out, int out_size, void* d_ws, size_t ws_size, hipStream_t stream) {
    static int grid = 0;
    if (grid == 0) {
        if (n_in != 22 || ws_size < WS_END) { fprintf(stderr, "kernel_launch: unexpected n_in %d / ws_size %zu (need %zu)\n", n_in, ws_size, (size_t)WS_END); grid = -1; return; }
        int dev = 0, cus = 0, per_cu = 0;
        hipGetDevice(&dev); hipDeviceGetAttribute(&cus, hipDeviceAttributeMultiprocessorCount, dev);
        if (hipFuncSetAttribute((const void*)mega, hipFuncAttributeMaxDynamicSharedMemorySize, LDS_BYTES) != hipSuccess) { fprintf(stderr, "kernel_launch: hipFuncSetAttribute failed\n"); grid = -1; return; }
        hipOccupancyMaxActiveBlocksPerMultiprocessor(&per_cu, (const void*)mega, 512, LDS_BYTES);
        (void)hipGetLastError();
        if (per_cu < 1) fprintf(stderr, "kernel_launch: occupancy query says %d blocks/CU\n", per_cu);
        grid = cus > 0 ? cus : 256;
    }
    if (grid < 0) return;
    hipMemsetAsync((char*)d_ws + WS_CTL, 0, CTL_ZERO_BYTES, stream);
    Args a{};
    for (int i = 0; i < 22; ++i) a.in[i] = (const float*)d_in[i];
    a.out = (float*)d_out; a.ws = (unsigned char*)d_ws; a.ph_lo = 0; a.ph_hi = NPHASE;
    void* args[] = {&a};
    hipError_t e = hipLaunchCooperativeKernel((const void*)mega, dim3(grid), dim3(512), args, LDS_BYTES, stream);
    if (e != hipSuccess) fprintf(stderr, "kernel_launch: cooperative launch failed: %s (grid %d)\n", hipGetErrorString(e), grid);
}
```

```cpp
#include <hip/hip_runtime.h>
#include <hip/hip_cooperative_groups.h>
#include <cstdio>
#include <cstdint>
namespace cg = cooperative_groups;

#define LAS __attribute__((address_space(3)))
typedef unsigned short bf16_t;
typedef short bf16x8 __attribute__((ext_vector_type(8)));
typedef float f32x4 __attribute__((ext_vector_type(4)));
typedef float f32x2 __attribute__((ext_vector_type(2)));
typedef unsigned u32x4 __attribute__((ext_vector_type(4)));
typedef unsigned u32x2 __attribute__((ext_vector_type(2)));

constexpr int DM = 2048, MLAT = 16384, MT = 17408;
constexpr int INW = 10752, DFF = 5632, UPW = 11264;
constexpr int OFF_Q = 512, OFF_K = 1536, OFF_V = 2560, OFF_C = 3584, OFF_G = 4608;
constexpr float EPS = 1e-6f;
constexpr size_t MiB = 1u << 20;
constexpr size_t WS_CTL = 0;
constexpr size_t CTL_ZERO_BYTES = 1 * MiB;
constexpr size_t WS_MODS = 4096;
constexpr size_t WS_BAR = 512 * 1024;
constexpr size_t WS_DFTD = 1 * MiB;
constexpr size_t WS_XC = 2 * MiB;
constexpr size_t WS_WIN = 10 * MiB;
constexpr size_t WS_WBR = 52 * MiB;
constexpr size_t WS_WO = 60 * MiB;
constexpr size_t WS_WUP = 68 * MiB;
constexpr size_t WS_WDN = 112 * MiB;
constexpr size_t WS_XN = 134 * MiB;
constexpr size_t WS_BIG = 202 * MiB;
constexpr size_t WS_HMID = 576 * MiB;
constexpr size_t WS_ZBUF = WS_HMID;
constexpr size_t WS_TT = WS_HMID + 32 * MiB;
constexpr size_t WS_MA = WS_HMID + 36 * MiB;
constexpr size_t WS_U = WS_HMID + 64 * MiB;
constexpr size_t WS_VT = WS_HMID + 96 * MiB;
constexpr size_t WS_DFTC = WS_HMID + 128 * MiB;
constexpr size_t WS_PQTC = WS_HMID + 132 * MiB;
constexpr size_t WS_VTC = WS_HMID + 164 * MiB;
constexpr size_t WS_TMP = WS_HMID;
constexpr size_t WS_END = 763 * MiB;
constexpr int LDS_BYTES = 163840, LDS_XST = 163840 - 64;

#define LDS_WAIT() asm volatile("s_waitcnt lgkmcnt(0)" ::: "memory")
__device__ __forceinline__ unsigned cvt_pk_bf16(float lo, float hi) { unsigned r; asm volatile("v_cvt_pk_bf16_f32 %0, %1, %2" : "=v"(r) : "v"(lo), "v"(hi)); return r; }
__device__ __forceinline__ int fresh_lane() { unsigned z; asm volatile("v_mov_b32 %0, 0" : "=v"(z)); return (int)__builtin_amdgcn_mbcnt_hi(~0u, __builtin_amdgcn_mbcnt_lo(~0u, z)); }
__device__ __forceinline__ float bf2f(unsigned short b) { return __uint_as_float((unsigned)b << 16); }
__device__ __forceinline__ float bflo(unsigned w) { return __uint_as_float(w << 16); }
__device__ __forceinline__ float bfhi(unsigned w) { return __uint_as_float(w & 0xffff0000u); }
__device__ __forceinline__ float shx(float v, int o, int lane) { return __int_as_float(__builtin_amdgcn_ds_bpermute((lane ^ o) << 2, __float_as_int(v))); }
__device__ __forceinline__ float wave_sum(float v, int lane) {
#pragma unroll
    for (int o = 1; o < 64; o <<= 1) v += shx(v, o, lane);
    return v;
}
__device__ __forceinline__ float fsigmoid(float x) { return __builtin_amdgcn_rcpf(1.0f + __builtin_amdgcn_exp2f(-1.44269504089f * x)); }
__device__ __forceinline__ float fsilu(float x) { return x * fsigmoid(x); }
__device__ __forceinline__ f32x2 gelu_pk(f32x2 v) {
    const f32x2 av = __builtin_elementwise_abs(v), d = av * 0.2316418882f + 1.0f;
    f32x2 t; t.x = __builtin_amdgcn_rcpf(d.x); t.y = __builtin_amdgcn_rcpf(d.y);
    f32x2 q = t * 0.5307027145f + (-0.7265760135f); q = q * t + 0.7107068705f; q = q * t + (-0.142248368f); q = q * t + 0.127414796f; q = q * t;
    const f32x2 s = (v * v) * (-0.72134752044f);
    f32x2 e; e.x = __builtin_amdgcn_exp2f(s.x); e.y = __builtin_amdgcn_exp2f(s.y);
    const f32x2 m = v * (q * e), r = v - m;
    f32x2 o; o.x = v.x < 0.f ? m.x : r.x; o.y = v.y < 0.f ? m.y : r.y; return o;
}

namespace pg8 {
constexpr int BM = 256, BK = 64, HALF = 128, HTB = HALF * BK * 2, STAGE_BYTES = 8 * HTB, NXCD = 8, WGM = 8;
__host__ __device__ __forceinline__ int lds_byte(int r, int c) { const int st = (r >> 4) * 2 + (c >> 5), rr = r & 15, cc = c & 31, ob = rr * 64 + cc * 2; return st * 1024 + (ob ^ (((ob >> 9) & 1) << 5)); }
__host__ __device__ __forceinline__ void stage_rc(int b, int& R, int& C) { const int st = b / 1024, sb = b % 1024, swz = sb ^ (((sb >> 9) & 1) << 5); R = (st >> 1) * 16 + swz / 64; C = (st & 1) * 32 + (swz % 64) / 2; }
__host__ __device__ __forceinline__ int perm32(int rho) { const int n = rho >> 4, i = rho & 15; return 8 * (i >> 2) + 4 * n + (i & 3); }

struct Unit { const char* A; const char* B; int nt, pm, pn, aux; };

struct StaticOrder {
    int nM, nN, nwg, G, c;
    __device__ void init(int nM_, int nN_, int G_, int c_) { nM = nM_; nN = nN_; nwg = nM * nN; G = G_; c = c_; }
    __device__ bool next(int i, int& pm, int& pn) const {
        const long L = (long)i * G + c; if (L >= nwg) return false;
        int wgid = (int)L; { const int q = nwg / NXCD, r = nwg % NXCD, xcd = wgid % NXCD, off = wgid / NXCD; wgid = (xcd < r ? xcd * (q + 1) : r * (q + 1) + (xcd - r) * q) + off; }
        const int nig = WGM * nN, gid = wgid / nig, fm = gid * WGM, gsz = (nM - fm) < WGM ? (nM - fm) : WGM;
        pm = fm + ((wgid % nig) % gsz); pn = (wgid % nig) / gsz; return true;
    }
};

template <class Epi, class Sched>
__device__ __forceinline__ void gemm_phase(LAS unsigned char* lds, const int tid, const int lda, const int ldb, const Sched& S, const Epi& E) {
    const int wid = __builtin_amdgcn_readfirstlane(tid >> 6), lane = tid & 63, wr = wid >> 2, wc = wid & 3, fr = lane & 15, fq = lane >> 4;
    unsigned voffA[2], voffB[2];
#pragma unroll
    for (int i = 0; i < 2; ++i) { int R, C; stage_rc(tid * 16 + i * 8192, R, C); const int Rb = Epi::PERM ? ((R & ~31) + perm32(R & 31)) : R;
        voffA[i] = (unsigned)(R * lda + C) * 2u; voffB[i] = (unsigned)(Sched::brow(Rb) * ldb + C) * 2u; }
    const size_t kstep = (size_t)(BK * 2);
    const size_t hstepA = (size_t)HALF * lda * 2, hstepB = (size_t)Sched::BH * ldb * 2;
    const unsigned ldsw = (unsigned)wid * 1024u;
    const int aoff = lds_byte(wr * 64 + fr, fq * 8), boff = lds_byte(wc * 32 + fr, fq * 8);
#define PG8_SA(b, h) (((b) * 2 + (h)) * HTB)
#define PG8_SB(b, h) ((4 + (b) * 2 + (h)) * HTB)
#define PG8_STAGE(bufoff, gbase, voff) do { _Pragma("unroll") for (int _i = 0; _i < 2; ++_i) \
        __builtin_amdgcn_global_load_lds((const unsigned*)((const char*)(gbase) + (voff)[_i]), (LAS unsigned*)(lds + (bufoff) + ldsw + _i * 8192), 16, 0, 0); } while (0)
#define PG8_LDA(dst, b, h) do { _Pragma("unroll") for (int m = 0; m < 4; ++m) _Pragma("unroll") for (int k = 0; k < 2; ++k) dst[m][k] = *(const LAS bf16x8*)(lds + PG8_SA(b, h) + aoff + m * 2048 + k * 1024); } while (0)
#define PG8_LDB(dst, b, h) do { _Pragma("unroll") for (int n = 0; n < 2; ++n) _Pragma("unroll") for (int k = 0; k < 2; ++k) dst[n][k] = *(const LAS bf16x8*)(lds + PG8_SB(b, h) + boff + n * 2048 + k * 1024); } while (0)
#define PG8_MMA(ai, bj, At, Bt) do { __builtin_amdgcn_s_setprio(1); _Pragma("unroll") for (int m = 0; m < 4; ++m) _Pragma("unroll") for (int n = 0; n < 2; ++n) _Pragma("unroll") for (int k = 0; k < 2; ++k) \
        acc[ai][bj][m][n] = __builtin_amdgcn_mfma_f32_16x16x32_bf16(Bt[n][k], At[m][k], acc[ai][bj][m][n], 0, 0, 0); __builtin_amdgcn_s_setprio(0); } while (0)
#define PG8_WAIT_V(n) asm volatile("s_waitcnt vmcnt(" #n ")" ::: "memory")
#define PG8_WAIT_L(n) asm volatile("s_waitcnt lgkmcnt(" #n ")" ::: "memory")
#define PG8_BAR __builtin_amdgcn_s_barrier()
#define PG8_SCHED __builtin_amdgcn_sched_barrier(0)
    Unit cur, nxt; int ui = 0;
    if (!S.next(0, cur)) return;
    f32x4 acc[2][2][4][2];
#pragma unroll
    for (int a = 0; a < 2; ++a)
#pragma unroll
        for (int b = 0; b < 2; ++b)
#pragma unroll
            for (int m = 0; m < 4; ++m)
#pragma unroll
                for (int n = 0; n < 2; ++n) acc[a][b][m][n] = (f32x4){0.f, 0.f, 0.f, 0.f};
    bf16x8 At[4][2], B0[2][2], B1[2][2];
    const char* cA = cur.A; const char* cB = cur.B;
    {
        PG8_STAGE(PG8_SB(0, 0), cB, voffB); PG8_STAGE(PG8_SB(0, 1), cB + hstepB, voffB); PG8_STAGE(PG8_SA(0, 0), cA, voffA); PG8_STAGE(PG8_SA(0, 1), cA + hstepA, voffA);
        if (wr == 1) PG8_BAR;
        PG8_WAIT_V(2); PG8_BAR;
        PG8_STAGE(PG8_SB(1, 0), cB + kstep, voffB); PG8_STAGE(PG8_SA(1, 0), cA + kstep, voffA); PG8_STAGE(PG8_SB(1, 1), cB + hstepB + kstep, voffB);
        PG8_WAIT_V(6); PG8_BAR;
    }
    for (;;) {
        const bool has_next = S.next(ui + 1, nxt);
        const char* nA = has_next ? nxt.A : cA; const char* nB = has_next ? nxt.B : cB;
        const int nt = cur.nt;
        for (int t = 0; t < nt; t += 2) {
            const bool last = (t == nt - 2);
            const char* a1 = cA + (size_t)(t + 1) * kstep;
            const char* a2 = last ? nA : cA + (size_t)(t + 2) * kstep; const char* b2 = last ? nB : cB + (size_t)(t + 2) * kstep;
            const char* a3 = a2 + kstep; const char* b3 = b2 + kstep;
            PG8_LDB(B0, 0, 0); PG8_LDB(B1, 0, 1); PG8_SCHED; PG8_LDA(At, 0, 0); PG8_STAGE(PG8_SA(1, 1), a1 + hstepA, voffA);
            PG8_WAIT_V(8); PG8_WAIT_L(0); PG8_BAR; PG8_MMA(0, 0, At, B0); PG8_MMA(0, 1, At, B1); PG8_BAR; PG8_SCHED;
            PG8_LDA(At, 0, 1); PG8_STAGE(PG8_SB(0, 0), b2, voffB); PG8_STAGE(PG8_SB(0, 1), b2 + hstepB, voffB); PG8_STAGE(PG8_SA(0, 0), a2, voffA);
            PG8_WAIT_V(8); PG8_WAIT_L(0); PG8_BAR; PG8_MMA(1, 0, At, B0); PG8_MMA(1, 1, At, B1); PG8_BAR; PG8_SCHED;
            PG8_LDB(B0, 1, 0); PG8_LDB(B1, 1, 1); PG8_SCHED; PG8_LDA(At, 1, 0); PG8_STAGE(PG8_SA(0, 1), a2 + hstepA, voffA);
            PG8_WAIT_V(8); PG8_WAIT_L(0); PG8_BAR; PG8_MMA(0, 0, At, B0); PG8_MMA(0, 1, At, B1); PG8_BAR; PG8_SCHED;
            PG8_LDA(At, 1, 1); PG8_STAGE(PG8_SB(1, 0), b3, voffB); PG8_STAGE(PG8_SB(1, 1), b3 + hstepB, voffB); PG8_STAGE(PG8_SA(1, 0), a3, voffA);
            PG8_WAIT_V(8); PG8_WAIT_L(0); PG8_BAR; PG8_MMA(1, 0, At, B0); PG8_MMA(1, 1, At, B1); PG8_BAR; PG8_SCHED;
        }
        if (wr == 0) PG8_BAR;
        E(acc, cur, wr, wc);
        if (!has_next) break;
        if (!Epi::CHAIN || cur.aux == 2) {
#pragma unroll
        for (int a = 0; a < 2; ++a)
#pragma unroll
            for (int b = 0; b < 2; ++b)
#pragma unroll
                for (int m = 0; m < 4; ++m)
#pragma unroll
                    for (int n = 0; n < 2; ++n) acc[a][b][m][n] = (f32x4){0.f, 0.f, 0.f, 0.f};
        }
        cur = nxt; cA = nA; cB = nB; ++ui;
        if (wr == 1) PG8_BAR;
    }
    PG8_WAIT_V(0);
    PG8_BAR;
#undef PG8_SA
#undef PG8_SB
#undef PG8_STAGE
#undef PG8_LDA
#undef PG8_LDB
#undef PG8_MMA
#undef PG8_WAIT_V
#undef PG8_WAIT_L
#undef PG8_BAR
#undef PG8_SCHED
}
}
using pg8::Unit;
typedef const f32x4 (&AccRef)[2][2][4][2];

struct SchedGrid {
    static __device__ __forceinline__ int brow(int r) { return r; } static constexpr int BH = 128;
    pg8::StaticOrder so; const char* A; const char* B; size_t tsA, tsB; int nt, nextra, ex_pm0, ex_pn0, ex_w, ex_ks;
    __device__ __forceinline__ bool next(int i, Unit& u) const {
        int pm, pn; int kp = 0, ntu = nt, aux = 0;
        if (!so.next(i, pm, pn)) { const long e = (long)i * so.G + so.c - so.nwg; if (e >= nextra) return false; const int te = (int)e / ex_ks; kp = (int)e % ex_ks; ntu = nt / ex_ks; aux = ex_ks > 1 ? 1 : 0;
            pm = ex_pm0 + te / ex_w; pn = ex_pn0 + te % ex_w; }
        u.A = A + (size_t)pm * tsA + (size_t)kp * ntu * 128; u.B = B + (size_t)pn * tsB + (size_t)kp * ntu * 128; u.nt = ntu; u.pm = pm; u.pn = pn; u.aux = aux; return true;
    }
};
struct SchedBranch {
    static __device__ __forceinline__ int brow(int r) { return r; } static constexpr int BH = 128;
    pg8::StaticOrder so; const char* proj; const char* wbr;
    __device__ __forceinline__ bool next(int i, Unit& u) const {
        int pm, pn; if (!so.next(i / 3, pm, pn)) return false;
        const int br = i % 3; const int acol = br == 0 ? 0 : (br == 1 ? OFF_Q : OFF_C), koff = br == 0 ? 0 : (br == 1 ? 512 : 1536);
        u.A = proj + ((size_t)pm * 256 * INW + acol) * 2; u.B = wbr + ((size_t)pn * 256 * DM + koff) * 2; u.nt = br == 1 ? 16 : 8; u.pm = pm; u.pn = pn; u.aux = br; return true;
    }
};
struct SchedF1L {
    static __device__ __forceinline__ int brow(int r) { return (r >> 6) + 64 * (r & 63); } static constexpr int BH = 2;
    const char* dftd; const char* proj; int G, c;
    __device__ __forceinline__ bool next(int i, Unit& u) const {
        const int L = i * G + c; if (L >= 256) return false;
        { const char* ap = dftd; asm volatile("" : "+s"(ap)); u.A = ap; } u.nt = 2; u.pm = 0;
        const int b = L >> 6, g = (L >> 4) & 3, pn = L & 15; u.B = proj + ((size_t)(b * 4096 + 4 * pn) * INW + g * 128) * 2; u.pn = pn; u.aux = b * 4 + g; return true;
    }
};
struct SchedF1 {
    static __device__ __forceinline__ int brow(int r) { return r; } static constexpr int BH = 128;
    const char* dftd; const char* proj; int G, c, nctx;
    __device__ __forceinline__ bool next(int i, Unit& u) const {
        const int e = i * G + c; if (e >= nctx) return false;
        { const char* ap = dftd; asm volatile("" : "+s"(ap)); u.A = ap; } u.nt = 2; u.pm = 0;
        const int b = e >> 2, g = e & 3; u.B = proj + ((size_t)(MLAT + b * 256) * INW + g * 128) * 2; u.pn = 0; u.aux = 16 + b * 4 + g; return true;
    }
};
struct SchedF2 {
    static __device__ __forceinline__ int brow(int r) { return r; } static constexpr int BH = 128;
    const char* dftc; const char* pqtc; int G, c, nctx;
    __device__ __forceinline__ bool next(int i, Unit& u) const {
        const int e = i * G + c; if (e >= nctx) return false;
        const int b = e >> 1, pn = e & 1; { const char* ap = dftc; asm volatile("" : "+s"(ap)); u.A = ap; } u.B = pqtc + (size_t)(b * 512 + pn * 256) * 8192 * 2; u.nt = 8; u.pm = 0; u.pn = pn; u.aux = 4 + b; return true;
    }
};
struct SchedFA {
    static __device__ __forceinline__ int brow(int r) { return r; } static constexpr int BH = 128;
    const char* ma; const char* ub; int G, c;
    __device__ __forceinline__ bool next(int i, Unit& u) const {
        const int L = i * G + c; if (L >= 512) return false;
        { const char* ap = ma; asm volatile("" : "+s"(ap)); u.A = ap; } u.B = ub + (size_t)L * 256 * 128 * 2; u.nt = 2; u.pm = 0; u.pn = L; u.aux = 0; return true;
    }
};
struct SchedFB {
    static __device__ __forceinline__ int brow(int r) { return r; } static constexpr int BH = 128;
    const char* tt; const char* zb; int G, c;
    __device__ __forceinline__ bool next(int i, Unit& u) const {
        const int L = i * G + c; if (L >= 512) return false;
        const int k2 = L >> 3, pn = L & 7; u.A = tt + (size_t)k2 * 256 * 128 * 2; u.B = zb + ((size_t)k2 * 2048 + pn * 256) * 128 * 2; u.nt = 2; u.pm = 0; u.pn = pn; u.aux = k2; return true;
    }
};

struct EpiInProj {
    static constexpr bool PERM = true, CHAIN = false;
    bf16_t* proj; bf16_t* vt; bf16_t* vtc;
    __device__ __forceinline__ void operator()(AccRef acc, const Unit& u, int wr, int wc) const {
        const int ln_ = fresh_lane(), fr = ln_ & 15, fq = ln_ >> 4;
        const int pm = u.pm, pn = u.pn; const int row0 = pm * 256 + wr * 64 + fr, col0 = pn * 256 + wc * 32 + 8 * fq;
        if (pn >= 10 && pn < 14) {
            const int vc0 = col0 - OFF_V;
#pragma unroll
            for (int ai = 0; ai < 2; ++ai)
#pragma unroll
                for (int m = 0; m < 4; ++m) {
                    const int row = row0 + ai * 128 + m * 16; bf16_t* dst; size_t stride;
                    if (pm < 64) { const int b = pm >> 4; dst = vt + (size_t)b * 1024 * 4096 + (row - b * 4096); stride = 4096; }
                    else { const int b = pm - 64; dst = vtc + (size_t)b * 1024 * 256 + (row - MLAT - b * 256); stride = 256; }
#pragma unroll
                    for (int bj = 0; bj < 2; ++bj)
#pragma unroll
                        for (int n = 0; n < 2; ++n) { const f32x4 v = acc[ai][bj][m][n]; const unsigned w0 = cvt_pk_bf16(v[0], v[1]), w1 = cvt_pk_bf16(v[2], v[3]);
                            bf16_t* d = dst + (size_t)(vc0 + bj * 128 + n * 4) * stride;
                            d[0] = (bf16_t)(w0 & 0xffffu); d[stride] = (bf16_t)(w0 >> 16); d[2 * stride] = (bf16_t)(w1 & 0xffffu); d[3 * stride] = (bf16_t)(w1 >> 16); }
                }
            return;
        }
        const int act = pn < 14 ? 0 : (pn < 18 ? 1 : 2); const float sc = (pn >= 2 && pn < 6) ? 0.08838834764831845f : 1.0f;
#pragma unroll
        for (int ai = 0; ai < 2; ++ai)
#pragma unroll
            for (int m = 0; m < 4; ++m) { bf16_t* rowp = proj + (size_t)(row0 + ai * 128 + m * 16) * INW + col0;
#pragma unroll
                for (int bj = 0; bj < 2; ++bj) { f32x4 v0 = acc[ai][bj][m][0], v1 = acc[ai][bj][m][1];
                    if (act == 1) { f32x2 a = gelu_pk((f32x2){v0[0], v0[1]}), b = gelu_pk((f32x2){v0[2], v0[3]}), c = gelu_pk((f32x2){v1[0], v1[1]}), d = gelu_pk((f32x2){v1[2], v1[3]});
                        v0 = (f32x4){a.x, a.y, b.x, b.y}; v1 = (f32x4){c.x, c.y, d.x, d.y}; }
                    else if (act == 2) { v0 = (f32x4){fsigmoid(v0[0]), fsigmoid(v0[1]), fsigmoid(v0[2]), fsigmoid(v0[3])}; v1 = (f32x4){fsigmoid(v1[0]), fsigmoid(v1[1]), fsigmoid(v1[2]), fsigmoid(v1[3])}; }
                    else { v0 = v0 * sc; v1 = v1 * sc; }
                    u32x4 w; w.x = cvt_pk_bf16(v0[0], v0[1]); w.y = cvt_pk_bf16(v0[2], v0[3]); w.z = cvt_pk_bf16(v1[0], v1[1]); w.w = cvt_pk_bf16(v1[2], v1[3]);
                    *(u32x4*)(rowp + bj * 128) = w; } }
    }
};
struct EpiPlain {
    static constexpr bool PERM = true, CHAIN = false;
    bf16_t* out; int ld;
    __device__ __forceinline__ void operator()(AccRef acc, const Unit& u, int wr, int wc) const {
        const int ln_ = fresh_lane(), fr = ln_ & 15, fq = ln_ >> 4;
        const int row0 = u.pm * 256 + wr * 64 + fr, col0 = u.pn * 256 + wc * 32 + 8 * fq;
#pragma unroll
        for (int ai = 0; ai < 2; ++ai)
#pragma unroll
            for (int m = 0; m < 4; ++m) { bf16_t* rowp = out + (size_t)(row0 + ai * 128 + m * 16) * ld + col0;
#pragma unroll
                for (int bj = 0; bj < 2; ++bj) { const f32x4 v0 = acc[ai][bj][m][0], v1 = acc[ai][bj][m][1];
                    u32x4 w; w.x = cvt_pk_bf16(v0[0], v0[1]); w.y = cvt_pk_bf16(v0[2], v0[3]); w.z = cvt_pk_bf16(v1[0], v1[1]); w.w = cvt_pk_bf16(v1[2], v1[3]);
                    *(u32x4*)(rowp + bj * 128) = w; } }
    }
};
struct EpiF1 {
    static constexpr bool PERM = true, CHAIN = false;
    bf16_t* pqt; bf16_t* pqtc;
    __device__ __forceinline__ void operator()(AccRef acc, const Unit& u, int wr, int wc) const {
        const int ln_ = fresh_lane(), fr = ln_ & 15, fq = ln_ >> 4;
        const int aux = u.aux; const bool isc = aux >= 16; const int bg = aux & 15, b = bg >> 2, g = bg & 3;
        bf16_t* base = (isc ? pqtc : pqt) + (size_t)(b * 512 + g * 128) * 8192; const int half = isc ? 256 : 4096;
        const int n0 = u.pn * 256 + wc * 32 + 8 * fq;
#pragma unroll
        for (int ai = 0; ai < 2; ++ai)
#pragma unroll
            for (int m = 0; m < 4; ++m) { bf16_t* rowp = base + (size_t)(wr * 64 + m * 16 + fr) * 8192 + ai * half + n0;
#pragma unroll
                for (int bj = 0; bj < 2; ++bj) { const f32x4 v0 = acc[ai][bj][m][0], v1 = acc[ai][bj][m][1];
                    u32x4 w; w.x = cvt_pk_bf16(v0[0], v0[1]); w.y = cvt_pk_bf16(v0[2], v0[3]); w.z = cvt_pk_bf16(v1[0], v1[1]); w.w = cvt_pk_bf16(v1[2], v1[3]);
                    *(u32x4*)(rowp + bj * 128) = w; } }
    }
};
struct EpiF1L {
    static constexpr bool PERM = true, CHAIN = false;
    bf16_t* ub;
    __device__ __forceinline__ void operator()(AccRef acc, const Unit& u, int wr, int wc) const {
        const int ln_ = fresh_lane(), fr = ln_ & 15, fq = ln_ >> 4;
        const int b = u.aux >> 2, g = u.aux & 3;
#pragma unroll
        for (int ai = 0; ai < 2; ++ai)
#pragma unroll
            for (int m = 0; m < 4; ++m) { const int ch = b * 512 + g * 128 + wr * 64 + m * 16 + fr;
#pragma unroll
                for (int bj = 0; bj < 2; ++bj) { const int n1 = 4 * u.pn + 2 * bj + (wc >> 1), n2 = 32 * (wc & 1) + 8 * fq;
                    const f32x4 v0 = acc[ai][bj][m][0], v1 = acc[ai][bj][m][1];
                    u32x4 w; w.x = cvt_pk_bf16(v0[0], v0[1]); w.y = cvt_pk_bf16(v0[2], v0[3]); w.z = cvt_pk_bf16(v1[0], v1[1]); w.w = cvt_pk_bf16(v1[2], v1[3]);
                    *(u32x4*)(ub + ((size_t)ch * 64 + n1) * 128 + ai * 64 + n2) = w; } }
    }
};
struct EpiFA {
    static constexpr bool PERM = true, CHAIN = false;
    bf16_t* zb;
    __device__ __forceinline__ void operator()(AccRef acc, const Unit& u, int wr, int wc) const {
        if (wr != 0) return;
        const int ln_ = fresh_lane(), fr = ln_ & 15, fq = ln_ >> 4;
#pragma unroll
        for (int ai = 0; ai < 2; ++ai)
#pragma unroll
            for (int m = 0; m < 4; ++m) { const int k2 = m * 16 + fr;
#pragma unroll
                for (int bj = 0; bj < 2; ++bj) { const int bc = u.pn * 4 + 2 * bj + (wc >> 1), n1 = 32 * (wc & 1) + 8 * fq;
                    const f32x4 v0 = acc[ai][bj][m][0], v1 = acc[ai][bj][m][1];
                    u32x4 w; w.x = cvt_pk_bf16(v0[0], v0[1]); w.y = cvt_pk_bf16(v0[2], v0[3]); w.z = cvt_pk_bf16(v1[0], v1[1]); w.w = cvt_pk_bf16(v1[2], v1[3]);
                    *(u32x4*)(zb + ((size_t)k2 * 2048 + bc) * 128 + ai * 64 + n1) = w; } }
    }
};
struct EpiFB {
    static constexpr bool PERM = true, CHAIN = false;
    bf16_t* proj;
    __device__ __forceinline__ void operator()(AccRef acc, const Unit& u, int wr, int wc) const {
        if (wr != 0) return;
        const int ln_ = fresh_lane(), fr = ln_ & 15, fq = ln_ >> 4;
        const float sc = 0.0013810679320049757f; const int k2 = u.aux;
#pragma unroll
        for (int m = 0; m < 4; ++m) { const int k = 64 * (m * 16 + fr) + k2;
#pragma unroll
            for (int bj = 0; bj < 2; ++bj) { const int ncol = u.pn * 256 + 128 * bj + 32 * wc + 8 * fq; const int b = ncol >> 9, ch = ncol & 511;
                const f32x4 v0 = acc[0][bj][m][0] * sc, v1 = acc[0][bj][m][1] * sc;
                u32x4 w; w.x = cvt_pk_bf16(v0[0], v0[1]); w.y = cvt_pk_bf16(v0[2], v0[3]); w.z = cvt_pk_bf16(v1[0], v1[1]); w.w = cvt_pk_bf16(v1[2], v1[3]);
                *(u32x4*)(proj + (size_t)(b * 4096 + k) * INW + ch) = w; } }
    }
};
struct EpiF2 {
    static constexpr bool PERM = true, CHAIN = false;
    bf16_t* proj;
    __device__ __forceinline__ void operator()(AccRef acc, const Unit& u, int wr, int wc) const {
        const int ln_ = fresh_lane(), fr = ln_ & 15, fq = ln_ >> 4;
        const int aux = u.aux; const bool isc = aux >= 4; const int rowbase = isc ? MLAT + (aux - 4) * 256 : aux * 4096;
        const float sc = isc ? 0.005524271728019903f : 0.0013810679320049757f;
        const int row0 = rowbase + u.pm * 256 + wr * 64 + fr, col0 = u.pn * 256 + wc * 32 + 8 * fq;
#pragma unroll
        for (int ai = 0; ai < 2; ++ai)
#pragma unroll
            for (int m = 0; m < 4; ++m) { bf16_t* rowp = proj + (size_t)(row0 + ai * 128 + m * 16) * INW + col0;
#pragma unroll
                for (int bj = 0; bj < 2; ++bj) { const f32x4 v0 = acc[ai][bj][m][0] * sc, v1 = acc[ai][bj][m][1] * sc;
                    u32x4 w; w.x = cvt_pk_bf16(v0[0], v0[1]); w.y = cvt_pk_bf16(v0[2], v0[3]); w.z = cvt_pk_bf16(v1[0], v1[1]); w.w = cvt_pk_bf16(v1[2], v1[3]);
                    *(u32x4*)(rowp + bj * 128) = w; } }
    }
};
typedef f32x4 (&AccMut)[2][2][4][2];
struct EpiBranch {
    static constexpr bool PERM = true, CHAIN = true;
    const bf16_t* proj; bf16_t* merged;
    __device__ __forceinline__ void operator()(AccMut acc, const Unit& u, int wr, int wc) const {
        const int ln_ = fresh_lane(), fr = ln_ & 15, fq = ln_ >> 4;
        const int br = u.aux; const int col0 = u.pn * 256 + wc * 32 + 8 * fq;
#pragma unroll
        for (int ai = 0; ai < 2; ++ai)
#pragma unroll
            for (int m = 0; m < 4; ++m) { const size_t row = (size_t)(u.pm * 256 + ai * 128 + wr * 64 + m * 16 + fr);
#pragma unroll
                for (int bj = 0; bj < 2; ++bj) { const int col = col0 + bj * 128;
                    const bf16_t* gp = proj + row * INW + OFF_G + br * DM + col;
                    const u32x4 gw = *(const u32x4*)gp;
                    const f32x4 g0 = (f32x4){bflo(gw.x), bfhi(gw.x), bflo(gw.y), bfhi(gw.y)}, g1 = (f32x4){bflo(gw.z), bfhi(gw.z), bflo(gw.w), bfhi(gw.w)};
                    if (br < 2) { const u32x4 hw = *(const u32x4*)(gp + DM);
                        const f32x4 r0 = (f32x4){__builtin_amdgcn_rcpf(fmaxf(bflo(hw.x), 1e-30f)), __builtin_amdgcn_rcpf(fmaxf(bfhi(hw.x), 1e-30f)), __builtin_amdgcn_rcpf(fmaxf(bflo(hw.y), 1e-30f)), __builtin_amdgcn_rcpf(fmaxf(bfhi(hw.y), 1e-30f))};
                        const f32x4 r1 = (f32x4){__builtin_amdgcn_rcpf(fmaxf(bflo(hw.z), 1e-30f)), __builtin_amdgcn_rcpf(fmaxf(bfhi(hw.z), 1e-30f)), __builtin_amdgcn_rcpf(fmaxf(bflo(hw.w), 1e-30f)), __builtin_amdgcn_rcpf(fmaxf(bfhi(hw.w), 1e-30f))};
                        acc[ai][bj][m][0] = acc[ai][bj][m][0] * (g0 * r0); acc[ai][bj][m][1] = acc[ai][bj][m][1] * (g1 * r1); }
                    else { const f32x4 v0 = acc[ai][bj][m][0] * g0, v1 = acc[ai][bj][m][1] * g1;
                        u32x4 w; w.x = cvt_pk_bf16(v0[0], v0[1]); w.y = cvt_pk_bf16(v0[2], v0[3]); w.z = cvt_pk_bf16(v1[0], v1[1]); w.w = cvt_pk_bf16(v1[2], v1[3]);
                        *(u32x4*)(merged + row * DM + col) = w; } } }
    }
};
struct EpiResid {
    static constexpr bool PERM = false, CHAIN = false;
    const float* src_lat; const float* src_ctx; float* dst_lat; float* dst_ctx; const float* gate;
    LAS unsigned char* lds;
    __device__ __forceinline__ void operator()(AccRef acc, const Unit& u, int wr, int wc) const {
        const int ln_ = fresh_lane(), fr = ln_ & 15, fq = ln_ >> 4;
        const int pm = u.pm; const int b = pm < 64 ? (pm >> 4) : 4; const float* g = gate + (size_t)b * 12288;
        const float* s0 = pm < 64 ? src_lat + (size_t)pm * 256 * DM : src_ctx + (size_t)(pm - 64) * 256 * DM;
        float* d0 = pm < 64 ? dst_lat + (size_t)pm * 256 * DM : dst_ctx + (size_t)(pm - 64) * 256 * DM;
        LAS float* sc = (LAS float*)(lds + 131072 + (wr * 4 + wc) * 2048);
        const int rrow = ln_ >> 3, rc = (ln_ & 7) * 4;
        if (u.aux) {
            const int arow = ln_ >> 5, ac = ln_ & 31; float ga[2];
#pragma unroll
            for (int bj = 0; bj < 2; ++bj) ga[bj] = g[u.pn * 256 + bj * 128 + wc * 32 + ac];
#pragma unroll
            for (int ai = 0; ai < 2; ++ai)
#pragma unroll
                for (int m = 0; m < 4; ++m)
#pragma unroll
                    for (int bj = 0; bj < 2; ++bj) {
                        *(LAS f32x4*)(sc + fr * 32 + 4 * fq) = acc[ai][bj][m][0]; *(LAS f32x4*)(sc + fr * 32 + 16 + 4 * fq) = acc[ai][bj][m][1];
                        asm volatile("s_waitcnt lgkmcnt(0)" ::: "memory");
#pragma unroll
                        for (int i = 0; i < 8; ++i) { const int row = arow + 2 * i; const float v = sc[row * 32 + ac] * ga[bj];
                            unsafeAtomicAdd(d0 + (size_t)(ai * 128 + wr * 64 + m * 16 + row) * DM + u.pn * 256 + bj * 128 + wc * 32 + ac, v); }
                        asm volatile("s_waitcnt lgkmcnt(0)" ::: "memory");
                    }
            return;
        }
        f32x4 gr[2];
#pragma unroll
        for (int bj = 0; bj < 2; ++bj) gr[bj] = *(const f32x4*)(g + u.pn * 256 + bj * 128 + wc * 32 + rc);
#pragma unroll
        for (int ai = 0; ai < 2; ++ai)
#pragma unroll
            for (int m = 0; m < 4; ++m)
#pragma unroll
                for (int bj = 0; bj < 2; ++bj) {
                    *(LAS f32x4*)(sc + fr * 32 + 4 * fq) = acc[ai][bj][m][0]; *(LAS f32x4*)(sc + fr * 32 + 16 + 4 * fq) = acc[ai][bj][m][1];
                    asm volatile("s_waitcnt lgkmcnt(0)" ::: "memory");
#pragma unroll
                    for (int i = 0; i < 2; ++i) { const int row = rrow + 8 * i; const f32x4 v = *(const LAS f32x4*)(sc + row * 32 + rc);
                        const size_t off = (size_t)(ai * 128 + wr * 64 + m * 16 + row) * DM + u.pn * 256 + bj * 128 + wc * 32 + rc;
                        *(f32x4*)(d0 + off) = *(const f32x4*)(s0 + off) + gr[bj] * v; }
                    asm volatile("s_waitcnt lgkmcnt(0)" ::: "memory");
                }
    }
};

struct EpiUpConv {
    static constexpr bool PERM = true, CHAIN = false;
    bf16_t* hmid; float* sb; const float* cw; const float* cbias;
    __device__ __forceinline__ void operator()(AccRef acc, const Unit& u, int wr, int wc) const {
        const int ln_ = fresh_lane(), fr = ln_ & 15, fq = ln_ >> 4;
        const int pm = u.pm, ch0 = u.pn * 128 + wc * 32 + 8 * fq;
        f32x4 w0[2], w1[2], w2[2], cb[2];
#pragma unroll
        for (int n = 0; n < 2; ++n) { w0[n] = *(const f32x4*)(cw + ch0 + 4 * n); w1[n] = *(const f32x4*)(cw + DFF + ch0 + 4 * n); w2[n] = *(const f32x4*)(cw + 2 * DFF + ch0 + 4 * n); cb[n] = *(const f32x4*)(cbias + ch0 + 4 * n); }
#pragma unroll
        for (int ai = 0; ai < 2; ++ai) {
            const int blk = pm * 4 + ai * 2 + wr;
            float* sbb = sb + (size_t)blk * 6 * DFF + ch0;
#pragma unroll
            for (int m = 0; m < 4; ++m) {
                f32x4 o[2];
#pragma unroll
                for (int n = 0; n < 2; ++n) {
                    const f32x4 am = acc[ai][0][m][n], gm = acc[ai][1][m][n];
                    const f32x4 z = (f32x4){0.f, 0.f, 0.f, 0.f};
                    const f32x4 ap = (m > 0) ? acc[ai][0][m > 0 ? m - 1 : 0][n] : z, an = (m < 3) ? acc[ai][0][m < 3 ? m + 1 : 3][n] : z;
                    const f32x4 tp = (fr == 15) ? ap : am, tn = (fr == 0) ? an : am;
                    f32x4 pv, nv;
#pragma unroll
                    for (int e = 0; e < 4; ++e) { pv[e] = __int_as_float(__builtin_amdgcn_update_dpp(0, __float_as_int(tp[e]), 0x121, 0xF, 0xF, false));
                        nv[e] = __int_as_float(__builtin_amdgcn_update_dpp(0, __float_as_int(tn[e]), 0x12F, 0xF, 0xF, false)); }
                    const f32x4 y = cb[n] + w0[n] * pv + w1[n] * am + w2[n] * nv;
                    o[n] = (f32x4){fsilu(y[0]) * gm[0], fsilu(y[1]) * gm[1], fsilu(y[2]) * gm[2], fsilu(y[3]) * gm[3]};
                    if (m == 0 && fr == 0) { *(f32x4*)(sbb + 0 * DFF + 4 * n) = y; *(f32x4*)(sbb + 2 * DFF + 4 * n) = gm; *(f32x4*)(sbb + 4 * DFF + 4 * n) = am; }
                    if (m == 3 && fr == 15) { *(f32x4*)(sbb + 1 * DFF + 4 * n) = y; *(f32x4*)(sbb + 3 * DFF + 4 * n) = gm; *(f32x4*)(sbb + 5 * DFF + 4 * n) = am; }
                }
                u32x4 w; w.x = cvt_pk_bf16(o[0][0], o[0][1]); w.y = cvt_pk_bf16(o[0][2], o[0][3]); w.z = cvt_pk_bf16(o[1][0], o[1][1]); w.w = cvt_pk_bf16(o[1][2], o[1][3]);
                *(u32x4*)(hmid + (size_t)(pm * 256 + ai * 128 + wr * 64 + m * 16 + fr) * DFF + ch0) = w;
            }
        }
    }
};
__device__ __forceinline__ void ffn_fix_rows(bf16_t* hmid, const float* sb, const float* cw, int nblk, int gtid, int NT) {
    const int nitems = nblk * 2 * (DFF / 4);
    for (int it = gtid; it < nitems; it += NT) {
        const int c4 = (it % (DFF / 4)) * 4, bw = it / (DFF / 4), which = bw & 1, blk = bw >> 1;
        const int row0 = blk * 64; const int rel = row0 < MLAT ? (row0 & 4095) : ((row0 - MLAT) & 255), seqlen = row0 < MLAT ? 4096 : 256;
        const bool edge = which ? (rel + 64 == seqlen) : (rel == 0);
        const float* s = sb + (size_t)blk * 6 * DFF + c4;
        f32x4 y = *(const f32x4*)(s + which * DFF); const f32x4 g = *(const f32x4*)(s + (2 + which) * DFF);
        if (!edge) { const float* sn = sb + (size_t)(which ? blk + 1 : blk - 1) * 6 * DFF + c4; const f32x4 an = *(const f32x4*)(sn + (which ? 4 : 5) * DFF);
            const f32x4 w = *(const f32x4*)(cw + (which ? 2 * DFF : 0) + c4); y = y + w * an; }
        u32x2 o; o.x = cvt_pk_bf16(fsilu(y[0]) * g[0], fsilu(y[1]) * g[1]); o.y = cvt_pk_bf16(fsilu(y[2]) * g[2], fsilu(y[3]) * g[3]);
        *(u32x2*)(hmid + (size_t)(row0 + (which ? 63 : 0)) * DFF + c4) = o;
    }
}

struct Args { const float* in[22]; float* out; unsigned char* ws; int ph_lo, ph_hi; };

template <bool UPMAP = false>
__device__ __forceinline__ void transpose_item(const float* W, int N, bf16_t* WT, int ldk, int koff, LAS float* scr, int item, int lane) {
    const int nblk = N / 32, kb = item / nblk, nb = item % nblk, k0 = 64 * kb, n0 = 32 * nb;
    const int r0 = UPMAP ? (n0 < DFF ? (n0 >> 7) * 256 + (n0 & 127) : ((n0 - DFF) >> 7) * 256 + 128 + ((n0 - DFF) & 127)) : n0;
#pragma unroll 8
    for (int i = 0; i < 32; ++i) { const int kk = 2 * i + (lane >> 5); scr[kk * 33 + (lane & 31)] = W[(size_t)(k0 + kk) * N + n0 + (lane & 31)]; }
    LDS_WAIT(); asm volatile("" ::: "memory");
    const int c = lane & 7;
#pragma unroll
    for (int j = 0; j < 4; ++j) { const int n = (lane >> 3) + 8 * j; const LAS float* s = scr + (8 * c) * 33 + n;
        u32x4 o; o.x = cvt_pk_bf16(s[0 * 33], s[1 * 33]); o.y = cvt_pk_bf16(s[2 * 33], s[3 * 33]); o.z = cvt_pk_bf16(s[4 * 33], s[5 * 33]); o.w = cvt_pk_bf16(s[6 * 33], s[7 * 33]);
        *(u32x4*)(WT + (size_t)(r0 + n) * ldk + koff + k0 + 8 * c) = o; }
    LDS_WAIT(); asm volatile("" ::: "memory");
}
template <class AR>
__device__ __forceinline__ void convert_weights(const AR& a, int l, LAS float* scr, int gw, int NGW, int lane) {
    unsigned char* ws = a.ws;
    const float* w_in = a.in[8] + (size_t)l * DM * INW; const float* w_f = a.in[13] + (size_t)l * 512 * DM; const float* w_na = a.in[14] + (size_t)l * 1024 * DM;
    const float* w_c = a.in[15] + (size_t)l * 512 * DM; const float* w_o = a.in[16] + (size_t)l * DM * DM; const float* w_up = a.in[17] + (size_t)l * DM * UPW; const float* w_dn = a.in[20] + (size_t)l * DFF * DM;
    constexpr int I_IN = 32 * 336, I_F = 8 * 64, I_NA = 16 * 64, I_C = 8 * 64, I_O = 32 * 64, I_UP = 32 * 352, I_DN = 88 * 64;
    constexpr int NITEMS = I_IN + I_F + I_NA + I_C + I_O + I_UP + I_DN;
    for (int it = gw; it < NITEMS; it += NGW) {
        int r = it;
        if (r < I_IN) { transpose_item(w_in, INW, (bf16_t*)(ws + WS_WIN), DM, 0, scr, r, lane); continue; } r -= I_IN;
        if (r < I_F) { transpose_item(w_f, DM, (bf16_t*)(ws + WS_WBR), DM, 0, scr, r, lane); continue; } r -= I_F;
        if (r < I_NA) { transpose_item(w_na, DM, (bf16_t*)(ws + WS_WBR), DM, 512, scr, r, lane); continue; } r -= I_NA;
        if (r < I_C) { transpose_item(w_c, DM, (bf16_t*)(ws + WS_WBR), DM, 1536, scr, r, lane); continue; } r -= I_C;
        if (r < I_O) { transpose_item(w_o, DM, (bf16_t*)(ws + WS_WO), DM, 0, scr, r, lane); continue; } r -= I_O;
        if (r < I_UP) { transpose_item<true>(w_up, UPW, (bf16_t*)(ws + WS_WUP), DM, 0, scr, r, lane); continue; } r -= I_UP;
        transpose_item(w_dn, DM, (bf16_t*)(ws + WS_WDN), DFF, 0, scr, r, lane);
    }
}
__device__ __forceinline__ void dft_tables(unsigned char* ws, const LAS float* lut, int gw, int NGW, int lane) {
    bf16_t* tt = (bf16_t*)(ws + WS_TT); bf16_t* ma = (bf16_t*)(ws + WS_MA); bf16_t* dftc = (bf16_t*)(ws + WS_DFTC);
    const int half = lane >> 5, x0 = (lane & 31) * 2;
    for (int it = gw; it < 16384 + 256 + 256; it += NGW) {
        if (it < 16384) { const int k2 = it >> 8, k1 = it & 255; float v0 = 0.f, v1 = 0.f;
            if (k1 < 64) { const int k = 64 * k1 + k2, sh = half ? 3072 : 0;
                v0 = lut[(x0 * k + sh) & 4095]; v1 = lut[((x0 + 1) * k + sh) & 4095]; }
            *(unsigned*)(tt + (size_t)it * 128 + half * 64 + x0) = cvt_pk_bf16(v0, v1);
        } else if (it < 16384 + 256) { const int r = it - 16384; float v0 = 0.f, v1 = 0.f;
            if ((r & 64) == 0) { const int k2 = r & 63, im = r >> 7;
                const int sh = im ? (half ? 2048 : 1024) : (half ? 1024 : 0);
                v0 = lut[(((x0 * k2) & 63) * 64 + sh) & 4095]; v1 = lut[((((x0 + 1) * k2) & 63) * 64 + sh) & 4095]; }
            *(unsigned*)(ma + (size_t)r * 128 + half * 64 + x0) = cvt_pk_bf16(v0, v1);
        } else { const int k = it - 16384 - 256; const int n0 = lane * 8; const int nn = n0 & 255, sh = n0 >= 256 ? 1024 : 0; float v[8];
#pragma unroll
            for (int e = 0; e < 8; ++e) v[e] = lut[((((k * (nn + e)) & 255) * 16) + sh) & 4095];
            u32x4 w; w.x = cvt_pk_bf16(v[0], v[1]); w.y = cvt_pk_bf16(v[2], v[3]); w.z = cvt_pk_bf16(v[4], v[5]); w.w = cvt_pk_bf16(v[6], v[7]);
            *(u32x4*)(dftc + (size_t)k * 8192 + n0) = w; }
    }
}
template <class AR>
__device__ __forceinline__ void mods_items(const AR& a, int gw, int NGW, int lane) {
    float* mods = (float*)(a.ws + WS_MODS);
    for (int it = gw; it < 1536; it += NGW) {
        const int l = it / 768, rem = it % 768, cch = rem >> 4, kp = rem & 15; const int col = cch * 256 + lane * 4, k0 = kp * 128;
        float sv[5][2];
#pragma unroll
        for (int r = 0; r < 5; ++r)
#pragma unroll
            for (int i = 0; i < 2; ++i) { const int k = k0 + lane + 64 * i; const float cv = r < 4 ? a.in[1][r * DM + k] : a.in[3][k]; sv[r][i] = fsilu(cv); }
        f32x4 acc[5];
#pragma unroll
        for (int r = 0; r < 5; ++r) acc[r] = (f32x4){0.f, 0.f, 0.f, 0.f};
        const float* wbase = a.in[4] + ((size_t)l * DM + k0) * 12288 + col;
#pragma unroll
        for (int i = 0; i < 2; ++i) {
#pragma unroll 16
            for (int ll = 0; ll < 64; ++ll) { const f32x4 w = *(const f32x4*)(wbase + (size_t)(i * 64 + ll) * 12288);
#pragma unroll
                for (int r = 0; r < 5; ++r) { const float s = __int_as_float(__builtin_amdgcn_readlane(__float_as_int(sv[r][i]), ll)); acc[r] += w * s; } }
        }
        if (kp == 0) { const f32x4 bv = *(const f32x4*)(a.in[5] + (size_t)l * 12288 + col);
#pragma unroll
            for (int r = 0; r < 5; ++r) acc[r] += bv; }
#pragma unroll
        for (int r = 0; r < 5; ++r) { float* d = mods + ((size_t)l * 5 + r) * 12288 + col; unsafeAtomicAdd(d, acc[r][0]); unsafeAtomicAdd(d + 1, acc[r][1]); unsafeAtomicAdd(d + 2, acc[r][2]); unsafeAtomicAdd(d + 3, acc[r][3]); }
    }
}
__device__ __forceinline__ void norm_rows(const float* xlat, const float* xctx, const float* w, const float* mods_l, int shoff, int scoff, bf16_t* XN, int nrows, int gw, int NGW, int lane) {
    for (int row = gw; row < nrows; row += NGW) {
        const float* xr = row < MLAT ? xlat + (size_t)row * DM : xctx + (size_t)(row - MLAT) * DM; const int b = row < MLAT ? (row >> 12) : 4;
        const float* sh = mods_l + (size_t)b * 12288 + shoff; const float* sc = mods_l + (size_t)b * 12288 + scoff;
        f32x4 v[8]; float ss = 0.f;
#pragma unroll
        for (int j = 0; j < 8; ++j) { v[j] = *(const f32x4*)(xr + 4 * lane + 256 * j); ss += (v[j][0] * v[j][0] + v[j][1] * v[j][1]) + (v[j][2] * v[j][2] + v[j][3] * v[j][3]); }
        const float rstd = rsqrtf(wave_sum(ss, lane) * (1.0f / DM) + EPS);
#pragma unroll
        for (int j = 0; j < 8; ++j) { const int col = 4 * lane + 256 * j; const f32x4 wv = *(const f32x4*)(w + col), scv = *(const f32x4*)(sc + col), shv = *(const f32x4*)(sh + col);
            const f32x4 o = (v[j] * rstd * wv) * (scv + 1.0f) + shv; u32x2 pk; pk.x = cvt_pk_bf16(o[0], o[1]); pk.y = cvt_pk_bf16(o[2], o[3]);
            *(u32x2*)(XN + (size_t)row * DM + col) = pk; }
    }
}
__device__ __forceinline__ void final_norm(float* x, const float* w, int gw, int NGW, int lane) {
    for (int row = gw; row < MLAT; row += NGW) { float* xr = x + (size_t)row * DM; f32x4 v[8]; float ss = 0.f;
#pragma unroll
        for (int j = 0; j < 8; ++j) { v[j] = *(const f32x4*)(xr + 4 * lane + 256 * j); ss += (v[j][0] * v[j][0] + v[j][1] * v[j][1]) + (v[j][2] * v[j][2] + v[j][3] * v[j][3]); }
        const float rstd = rsqrtf(wave_sum(ss, lane) * (1.0f / DM) + EPS);
#pragma unroll
        for (int j = 0; j < 8; ++j) { const int col = 4 * lane + 256 * j; *(f32x4*)(xr + col) = v[j] * rstd * *(const f32x4*)(w + col); } }
}
__device__ __forceinline__ void sgu_unit(bf16_t* proj, int row0, int g, const float* nw, const float* wsg, const float* bsg, LAS unsigned char* lds, int tid) {
    LAS bf16_t* vnt = (LAS bf16_t*)lds;
    const int lane = tid & 63, wid = tid >> 6, fr = lane & 15, fq = lane >> 4;
    {
        const int j = tid >> 2, q = tid & 3; const bf16_t* src = proj + (size_t)(row0 + j) * INW + OFF_C + 512 + g * 128 + q * 32;
        float v[32];
#pragma unroll
        for (int i = 0; i < 4; ++i) { const u32x4 w = *(const u32x4*)(src + 8 * i);
            v[8 * i + 0] = bflo(w.x); v[8 * i + 1] = bfhi(w.x); v[8 * i + 2] = bflo(w.y); v[8 * i + 3] = bfhi(w.y); v[8 * i + 4] = bflo(w.z); v[8 * i + 5] = bfhi(w.z); v[8 * i + 6] = bflo(w.w); v[8 * i + 7] = bfhi(w.w); }
        float s = 0.f;
#pragma unroll
        for (int e = 0; e < 32; ++e) s += v[e];
        s += shx(s, 1, lane); s += shx(s, 2, lane); const float mean = s * (1.0f / 128.0f);
        float qv = 0.f;
#pragma unroll
        for (int e = 0; e < 32; ++e) { v[e] -= mean; qv += v[e] * v[e]; }
        qv += shx(qv, 1, lane); qv += shx(qv, 2, lane); const float rstd = rsqrtf(qv * (1.0f / 128.0f) + EPS);
#pragma unroll
        for (int e = 0; e < 32; e += 2) { const int d = q * 32 + e; const unsigned w = cvt_pk_bf16(v[e] * rstd * nw[g * 128 + d], v[e + 1] * rstd * nw[g * 128 + d + 1]);
            vnt[d * 136 + j] = (bf16_t)(w & 0xffffu); vnt[(d + 1) * 136 + j] = (bf16_t)(w >> 16); }
    }
    __syncthreads();
    {
        const int i = 16 * wid + fr;
        bf16x8 wf[4];
#pragma unroll
        for (int ks = 0; ks < 4; ++ks) { const float* wp = wsg + (size_t)i * 128 + 32 * ks + 8 * fq; const f32x4 a = *(const f32x4*)wp, b = *(const f32x4*)(wp + 4);
            u32x4 w; w.x = cvt_pk_bf16(a[0], a[1]); w.y = cvt_pk_bf16(a[2], a[3]); w.z = cvt_pk_bf16(b[0], b[1]); w.w = cvt_pk_bf16(b[2], b[3]); wf[ks] = __builtin_bit_cast(bf16x8, w); }
        const float bias = bsg[i];
        bf16_t* up = proj + (size_t)(row0 + i) * INW + OFF_C + g * 128 + 4 * fq;
#pragma unroll
        for (int nt = 0; nt < 8; ++nt) { f32x4 acc = (f32x4){0.f, 0.f, 0.f, 0.f};
#pragma unroll
            for (int ks = 0; ks < 4; ++ks) { const bf16x8 af = *(const LAS bf16x8*)((const LAS unsigned char*)vnt + (16 * nt + fr) * 272 + (32 * ks + 8 * fq) * 2);
                acc = __builtin_amdgcn_mfma_f32_16x16x32_bf16(af, wf[ks], acc, 0, 0, 0); }
            const u32x2 uw = *(const u32x2*)(up + 16 * nt); u32x2 o;
            o.x = cvt_pk_bf16(bflo(uw.x) * (acc[0] + bias), bfhi(uw.x) * (acc[1] + bias)); o.y = cvt_pk_bf16(bflo(uw.y) * (acc[2] + bias), bfhi(uw.y) * (acc[3] + bias));
            *(u32x2*)(up + 16 * nt) = o; }
    }
    __syncthreads();
}
template <bool LAT>
__device__ __forceinline__ void attn_task(bf16_t* proj, const bf16_t* vt, const float* rpb, int t, int lane, const LAS unsigned char* cl) {
    constexpr int NCH = LAT ? 16 : 8, WCH = LAT ? 8 : 0;
    const int fr = lane & 15, fq = lane >> 4;
    int b, h, r = 0, cgp = 0, qrow;
    if (LAT) { cgp = t & 3; r = (t >> 2) & 63; h = (t >> 8) & 7; b = t >> 11; qrow = b * 4096 + r * 64 + cgp * 16 + fr; }
    else { const int qg = t & 15; h = (t >> 4) & 7; b = t >> 7; qrow = MLAT + b * 256 + qg * 16 + fr; }
    bf16_t* qp = proj + (size_t)qrow * INW + OFF_Q + h * 128;
    bf16x8 qf[4];
#pragma unroll
    for (int ks = 0; ks < 4; ++ks) qf[ks] = *(const bf16x8*)(qp + ks * 32 + fq * 8);
    const int rs = r < 4 ? 0 : (r > 60 ? 56 : r - 4);
    const int cb = cgp == 0 ? 0 : (cgp == 1 ? 8 : (cgp == 2 ? 24 : 32));
    float S[NCH][8];
    const int kap = 8 * (fr >> 2) + (fr & 3);
    const bf16_t* kbase = proj + OFF_K + h * 128 + fq * 8;
    bf16x8 kf[2][8];
#define ATT_LOADK(buf, c) do { _Pragma("unroll") for (int tt = 0; tt < 2; ++tt) { \
        if ((c) < WCH) { const int krow = b * 4096 + (rs + (c)) * 64 + cb + kap + 4 * tt; const bf16_t* kp = kbase + (size_t)krow * INW; \
            _Pragma("unroll") for (int ks = 0; ks < 4; ++ks) kf[buf][tt * 4 + ks] = *(const bf16x8*)(kp + ks * 32); } \
        else { const LAS unsigned char* kp = cl + (32 * ((c) - WCH) + kap + 4 * tt) * 256; \
            _Pragma("unroll") for (int ks = 0; ks < 4; ++ks) kf[buf][tt * 4 + ks] = *(const LAS bf16x8*)(kp + (((ks * 4 + fq) ^ fr) * 16)); } } } while (0)
    ATT_LOADK(0, 0);
#pragma unroll
    for (int c = 0; c < NCH; ++c) {
        if (c + 1 < NCH) ATT_LOADK((c + 1) & 1, c + 1);
        __builtin_amdgcn_sched_barrier(0);
#pragma unroll
        for (int tt = 0; tt < 2; ++tt) {
            f32x4 acc = (f32x4){0.f, 0.f, 0.f, 0.f};
#pragma unroll
            for (int ks = 0; ks < 4; ++ks) acc = __builtin_amdgcn_mfma_f32_16x16x32_bf16(kf[c & 1][tt * 4 + ks], qf[ks], acc, 0, 0, 0);
            S[c][4 * tt + 0] = acc[0]; S[c][4 * tt + 1] = acc[1]; S[c][4 * tt + 2] = acc[2]; S[c][4 * tt + 3] = acc[3];
        }
        __builtin_amdgcn_sched_barrier(0);
    }
#undef ATT_LOADK
    if (LAT) {
        const int qc = cgp * 16 + fr; const int cs = qc < 8 ? 0 : (qc > 56 ? 48 : qc - 8);
#pragma unroll
        for (int c = 0; c < WCH; ++c) { const int dr = rs + c - r + 7; const float* rp = rpb + (h * 15 + dr) * 31;
#pragma unroll
            for (int jj = 0; jj < 8; ++jj) { const int kc = cb + 8 * fq + jj; const bool valid = (kc >= cs) && (kc < cs + 16); int dc = kc - qc + 15; dc = dc < 0 ? 0 : (dc > 30 ? 30 : dc);
                const float bias = rp[dc]; S[c][jj] = valid ? S[c][jj] + bias : -1e30f; } }
    }
    float mx = -3.0e38f;
#pragma unroll
    for (int c = 0; c < NCH; ++c)
#pragma unroll
        for (int jj = 0; jj < 8; ++jj) mx = fmaxf(mx, S[c][jj]);
    mx = fmaxf(mx, shx(mx, 16, lane)); mx = fmaxf(mx, shx(mx, 32, lane));
    float sum = 0.f; bf16x8 pf[NCH];
#pragma unroll
    for (int c = 0; c < NCH; ++c) { float p[8];
#pragma unroll
        for (int jj = 0; jj < 8; ++jj) { p[jj] = __builtin_amdgcn_exp2f((S[c][jj] - mx) * 1.44269504089f); sum += p[jj]; }
        u32x4 w; w.x = cvt_pk_bf16(p[0], p[1]); w.y = cvt_pk_bf16(p[2], p[3]); w.z = cvt_pk_bf16(p[4], p[5]); w.w = cvt_pk_bf16(p[6], p[7]); pf[c] = __builtin_bit_cast(bf16x8, w); }
    sum += shx(sum, 16, lane); sum += shx(sum, 32, lane);
    const float inv = 1.0f / sum;
    const bf16_t* vlat = vt + ((size_t)(b * 1024 + h * 128 + fr)) * 4096 + cb + 8 * fq;
    constexpr int NBH = NCH / 8, NQ = 8 * NBH;
    bf16x8 vf[2][8];
#define ATT_LOADV(buf, q) do { const int dt_ = (q) / NBH, hb_ = (q) % NBH; _Pragma("unroll") for (int i = 0; i < 8; ++i) { const int c_ = hb_ * 8 + i; \
        if (c_ < WCH) vf[buf][i] = *(const bf16x8*)(vlat + (size_t)dt_ * 16 * 4096 + (rs + c_) * 64); \
        else vf[buf][i] = *(const LAS bf16x8*)(cl + 65536 + (dt_ * 16 + fr) * 512 + ((((c_ - WCH) * 4 + fq) ^ fr) * 16)); } } while (0)
    ATT_LOADV(0, 0);
    f32x4 oacc = (f32x4){0.f, 0.f, 0.f, 0.f};
#pragma unroll
    for (int q = 0; q < NQ; ++q) {
        if (q + 1 < NQ) ATT_LOADV((q + 1) & 1, q + 1);
        __builtin_amdgcn_sched_barrier(0);
        const int dt = q / NBH, hb = q % NBH;
        if (hb == 0) oacc = (f32x4){0.f, 0.f, 0.f, 0.f};
#pragma unroll
        for (int i = 0; i < 8; ++i) oacc = __builtin_amdgcn_mfma_f32_16x16x32_bf16(vf[q & 1][i], pf[hb * 8 + i], oacc, 0, 0, 0);
        if (hb == NBH - 1) { u32x2 o; o.x = cvt_pk_bf16(oacc[0] * inv, oacc[1] * inv); o.y = cvt_pk_bf16(oacc[2] * inv, oacc[3] * inv);
            *(u32x2*)(qp + dt * 16 + 4 * fq) = o; }
        __builtin_amdgcn_sched_barrier(0);
    }
#undef ATT_LOADV
}
template <bool LAT>
__device__ __forceinline__ void attn_pass(bf16_t* proj, const bf16_t* vt, const bf16_t* vtc, const float* rpb, int b, int h, int ra, LAS unsigned char* lds, int wave) {
    constexpr int NCH = LAT ? 16 : 8, WCH = LAT ? 8 : 0;
    const int lane = fresh_lane(), fr = lane & 15, fq = lane >> 4, tid = wave * 64 + lane;
    const int r = LAT ? ra + (wave >> 2) : 0, cgp = LAT ? (wave & 3) : 0;
    const int rsa = ra < 4 ? 0 : (ra > 60 ? 56 : ra - 4), rs = r < 4 ? 0 : (r > 60 ? 56 : r - 4), shw = rs - rsa;
    const int rsb = (ra + 1) < 4 ? 0 : ((ra + 1) > 60 ? 56 : ra + 1 - 4), T = 8 + (rsb - rsa);
    const int cb = cgp == 0 ? 0 : (cgp == 1 ? 8 : (cgp == 2 ? 24 : 32));
    const bool active = LAT || wave == 0;
    const int qrow = LAT ? (b * 4096 + r * 64 + cgp * 16 + fr) : (MLAT + b * 256 + ra * 16 + fr);
    bf16_t* qp = proj + (size_t)qrow * INW + OFF_Q + h * 128;
    bf16x8 qf[4];
#pragma unroll
    for (int ks = 0; ks < 4; ++ks) qf[ks] = *(const bf16x8*)(qp + ks * 32 + fq * 8);
    const int kap = 8 * (fr >> 2) + (fr & 3);
    float S[NCH][8];
    if (LAT) {
        __syncthreads();
        { u32x4 v[18];
#pragma unroll
          for (int i = 0; i < 18; ++i) { const int idx = tid + 512 * i, key = idx >> 4, ch = idx & 15;
            if (i < 2 * T) v[i] = *(const u32x4*)(proj + (size_t)(b * 4096 + rsa * 64 + key) * INW + OFF_K + h * 128 + ch * 8); }
#pragma unroll
          for (int i = 0; i < 18; ++i) { const int idx = tid + 512 * i, key = idx >> 4, ch = idx & 15, g = (key & 3) | (((key >> 3) & 3) << 2);
            if (i < 2 * T) *(LAS u32x4*)(lds + key * 256 + ((ch ^ g) * 16)) = v[i]; } }
        __syncthreads();
        const int gw = (fr & 3) | ((((cb >> 3) + (fr >> 2)) & 3) << 2);
#pragma unroll
        for (int c = 0; c < WCH; ++c) {
#pragma unroll
            for (int tt = 0; tt < 2; ++tt) { const LAS unsigned char* kp = lds + ((c + shw) * 64 + cb + kap + 4 * tt) * 256;
                f32x4 acc = (f32x4){0.f, 0.f, 0.f, 0.f};
#pragma unroll
                for (int ks = 0; ks < 4; ++ks) { const bf16x8 kf = *(const LAS bf16x8*)(kp + (((ks * 4 + fq) ^ gw) * 16)); acc = __builtin_amdgcn_mfma_f32_16x16x32_bf16(kf, qf[ks], acc, 0, 0, 0); }
                S[c][4 * tt + 0] = acc[0]; S[c][4 * tt + 1] = acc[1]; S[c][4 * tt + 2] = acc[2]; S[c][4 * tt + 3] = acc[3]; } }
    }
    __syncthreads();
    { u32x4 v[8];
#pragma unroll
      for (int i = 0; i < 8; ++i) { const int idx = tid + 512 * i, key = idx >> 4, ch = idx & 15; v[i] = *(const u32x4*)(proj + (size_t)(MLAT + b * 256 + key) * INW + OFF_K + h * 128 + ch * 8); }
#pragma unroll
      for (int i = 0; i < 8; ++i) { const int idx = tid + 512 * i, key = idx >> 4, ch = idx & 15, g = (key & 3) | (((key >> 3) & 3) << 2); *(LAS u32x4*)(lds + key * 256 + ((ch ^ g) * 16)) = v[i]; } }
    __syncthreads();
    float mx = -3.0e38f, sum = 0.f, inv = 0.f; bf16x8 pf[NCH];
    if (active) {
#pragma unroll
        for (int c = WCH; c < NCH; ++c) {
#pragma unroll
            for (int tt = 0; tt < 2; ++tt) { const LAS unsigned char* kp = lds + (32 * (c - WCH) + kap + 4 * tt) * 256;
                f32x4 acc = (f32x4){0.f, 0.f, 0.f, 0.f};
#pragma unroll
                for (int ks = 0; ks < 4; ++ks) { const bf16x8 kf = *(const LAS bf16x8*)(kp + (((ks * 4 + fq) ^ fr) * 16)); acc = __builtin_amdgcn_mfma_f32_16x16x32_bf16(kf, qf[ks], acc, 0, 0, 0); }
                S[c][4 * tt + 0] = acc[0]; S[c][4 * tt + 1] = acc[1]; S[c][4 * tt + 2] = acc[2]; S[c][4 * tt + 3] = acc[3]; } }
        if (LAT) {
            const int qc = cgp * 16 + fr; const int cs = qc < 8 ? 0 : (qc > 56 ? 48 : qc - 8);
#pragma unroll
            for (int c = 0; c < WCH; ++c) { const int dr = rs + c - r + 7; const float* rp = rpb + (h * 15 + dr) * 31;
#pragma unroll
                for (int jj = 0; jj < 8; ++jj) { const int kc = cb + 8 * fq + jj; const bool valid = (kc >= cs) && (kc < cs + 16); int dc = kc - qc + 15; dc = dc < 0 ? 0 : (dc > 30 ? 30 : dc);
                    const float bias = rp[dc]; S[c][jj] = valid ? S[c][jj] + bias : -1e30f; } }
        }
#pragma unroll
        for (int c = 0; c < NCH; ++c)
#pragma unroll
            for (int jj = 0; jj < 8; ++jj) mx = fmaxf(mx, S[c][jj]);
        mx = fmaxf(mx, shx(mx, 16, lane)); mx = fmaxf(mx, shx(mx, 32, lane));
#pragma unroll
        for (int c = 0; c < NCH; ++c) { float p[8];
#pragma unroll
            for (int jj = 0; jj < 8; ++jj) { p[jj] = __builtin_amdgcn_exp2f((S[c][jj] - mx) * 1.44269504089f); sum += p[jj]; }
            u32x4 w; w.x = cvt_pk_bf16(p[0], p[1]); w.y = cvt_pk_bf16(p[2], p[3]); w.z = cvt_pk_bf16(p[4], p[5]); w.w = cvt_pk_bf16(p[6], p[7]); pf[c] = __builtin_bit_cast(bf16x8, w); }
        sum += shx(sum, 16, lane); sum += shx(sum, 32, lane);
        inv = 1.0f / sum;
    }
    f32x4 oacc[8];
#pragma unroll
    for (int dt = 0; dt < 8; ++dt) oacc[dt] = (f32x4){0.f, 0.f, 0.f, 0.f};
    if (LAT) {
        __syncthreads();
        const int cpr = T * 8;
        { u32x4 v[18];
#pragma unroll
          for (int i = 0; i < 18; ++i) { const int idx = tid + 512 * i, d = idx / cpr, ch = idx - d * cpr;
            if (i < 2 * T) v[i] = *(const u32x4*)(vt + (size_t)(b * 1024 + h * 128 + d) * 4096 + rsa * 64 + ch * 8); }
#pragma unroll
          for (int i = 0; i < 18; ++i) { const int idx = tid + 512 * i, d = idx / cpr, ch = idx - d * cpr;
            if (i < 2 * T) *(LAS u32x4*)(lds + d * 1152 + (((ch & ~7) | ((ch & 7) ^ ((d >> 1) & 7))) * 16)) = v[i]; } }
        __syncthreads();
#pragma unroll
        for (int dt = 0; dt < 8; ++dt)
#pragma unroll
            for (int c = 0; c < WCH; ++c) { const int ch = (c + shw) * 8 + (cb >> 3) + fq;
                const bf16x8 vf = *(const LAS bf16x8*)(lds + (dt * 16 + fr) * 1152 + (((ch & ~7) | ((ch & 7) ^ (fr >> 1))) * 16));
                oacc[dt] = __builtin_amdgcn_mfma_f32_16x16x32_bf16(vf, pf[c], oacc[dt], 0, 0, 0); }
    }
    __syncthreads();
    { u32x4 v[8];
#pragma unroll
      for (int i = 0; i < 8; ++i) { const int idx = tid + 512 * i, d = idx >> 5, ch = idx & 31; v[i] = *(const u32x4*)(vtc + (size_t)(b * 1024 + h * 128 + d) * 256 + ch * 8); }
#pragma unroll
      for (int i = 0; i < 8; ++i) { const int idx = tid + 512 * i, d = idx >> 5, ch = idx & 31; *(LAS u32x4*)(lds + d * 512 + ((ch ^ (d & 15)) * 16)) = v[i]; } }
    __syncthreads();
    if (active) {
#pragma unroll
        for (int dt = 0; dt < 8; ++dt) {
#pragma unroll
            for (int c = WCH; c < NCH; ++c) { const bf16x8 vf = *(const LAS bf16x8*)(lds + (dt * 16 + fr) * 512 + ((((c - WCH) * 4 + fq) ^ fr) * 16));
                oacc[dt] = __builtin_amdgcn_mfma_f32_16x16x32_bf16(vf, pf[c], oacc[dt], 0, 0, 0); }
            u32x2 o; o.x = cvt_pk_bf16(oacc[dt][0] * inv, oacc[dt][1] * inv); o.y = cvt_pk_bf16(oacc[dt][2] * inv, oacc[dt][3] * inv);
            *(u32x2*)(qp + dt * 16 + 4 * fq) = o; }
    }
}
__device__ __forceinline__ void attn_block(bf16_t* proj, const bf16_t* vt, const bf16_t* vtc, const float* rpb, int vcu, int half, bool ctxq, LAS unsigned char* lds, int wave) {
    const int bh = vcu >> 3, b = bh >> 3, h = bh & 7, rb = vcu & 7;
    __syncthreads();
    { const int tid = wave * 64 + fresh_lane();
#pragma unroll
      for (int i = 0; i < 8; ++i) { const int idx = tid + 512 * i, key = idx >> 4, ch = idx & 15, g = (key & 3) | (((key >> 3) & 3) << 2);
          const u32x4 v = *(const u32x4*)(proj + (size_t)(MLAT + b * 256 + key) * INW + OFF_K + h * 128 + ch * 8);
          *(LAS u32x4*)(lds + key * 256 + ((ch ^ g) * 16)) = v; }
#pragma unroll
      for (int i = 0; i < 8; ++i) { const int idx = tid + 512 * i, d = idx >> 5, ch = idx & 31;
          const u32x4 v = *(const u32x4*)(vtc + (size_t)(b * 1024 + h * 128 + d) * 256 + ch * 8);
          *(LAS u32x4*)(lds + 65536 + d * 512 + ((ch ^ (d & 15)) * 16)) = v; } }
    __syncthreads();
    const int lane = fresh_lane();
    for (int round = 0; round < 2; ++round) { const int r = rb * 8 + half * 4 + round * 2 + (wave >> 2), cgp = wave & 3;
        attn_task<true>(proj, vt, rpb, ((bh * 64 + r) << 2) + cgp, lane, lds); }
    if (ctxq && wave == 0) attn_task<false>(proj, vt, rpb, bh * 16 + rb * 2 + half, lane, lds);
}
__device__ __forceinline__ void conv_items(const bf16_t* up, bf16_t* hmid, const float* cw, const float* cbias, int nrows, int gtid, int NT) {
    const int nitems = (nrows / 16) * 704;
    for (int it = gtid; it < nitems; it += NT) {
        const int cg8 = it % 704, rb = it / 704; const int row0 = rb * 16, ch = cg8 * 8;
        const int seqlen = row0 < MLAT ? 4096 : 256; const int ts = (row0 < MLAT ? row0 : row0 - MLAT) & (seqlen - 1);
        float w0[8], w1[8], w2[8], bb[8];
#pragma unroll
        for (int e = 0; e < 8; ++e) { w0[e] = cw[ch + e]; w1[e] = cw[DFF + ch + e]; w2[e] = cw[2 * DFF + ch + e]; bb[e] = cbias[ch + e]; }
        const bf16_t* ap = up + (size_t)row0 * UPW + ch; const bf16_t* gp = ap + DFF; bf16_t* hp = hmid + (size_t)row0 * DFF + ch;
        u32x4 prev = (u32x4){0u, 0u, 0u, 0u}; if (ts > 0) prev = *(const u32x4*)(ap - UPW);
        u32x4 cur = *(const u32x4*)ap;
        for (int i = 0; i < 16; ++i) {
            u32x4 nxt = (u32x4){0u, 0u, 0u, 0u}; if (i < 15 || ts + 16 < seqlen) nxt = *(const u32x4*)(ap + (size_t)(i + 1) * UPW);
            const u32x4 gw = *(const u32x4*)(gp + (size_t)i * UPW);
            float o[8];
#pragma unroll
            for (int e = 0; e < 4; ++e) {
                const float y0 = bb[2 * e] + w0[2 * e] * bflo(prev[e]) + w1[2 * e] * bflo(cur[e]) + w2[2 * e] * bflo(nxt[e]);
                const float y1 = bb[2 * e + 1] + w0[2 * e + 1] * bfhi(prev[e]) + w1[2 * e + 1] * bfhi(cur[e]) + w2[2 * e + 1] * bfhi(nxt[e]);
                o[2 * e] = fsilu(y0) * bflo(gw[e]); o[2 * e + 1] = fsilu(y1) * bfhi(gw[e]); }
            u32x4 w; w.x = cvt_pk_bf16(o[0], o[1]); w.y = cvt_pk_bf16(o[2], o[3]); w.z = cvt_pk_bf16(o[4], o[5]); w.w = cvt_pk_bf16(o[6], o[7]);
            *(u32x4*)(hp + (size_t)i * DFF) = w;
            prev = cur; cur = nxt;
        }
    }
}


#define XB_TMO      128
#define XB_XCNT(j)  (256  + 64 * (j))
#define XB_XSUB(j)  (1280 + 64 * (j))
#define XB_XGEN(j)  (2304 + 64 * (j))
#define XB_TOP      3328
#define XB_TOPGEN   3392
#define XCD_BAR_WORDS 3456
#define XB_SPIN_CAP (1u << 18)
__device__ __forceinline__ unsigned xb_ld(unsigned* p)              { return __hip_atomic_load(p, __ATOMIC_RELAXED, __HIP_MEMORY_SCOPE_AGENT); }
__device__ __forceinline__ unsigned xb_add(unsigned* p, unsigned v) { return __hip_atomic_fetch_add(p, v, __ATOMIC_RELAXED, __HIP_MEMORY_SCOPE_AGENT); }
__device__ __forceinline__ unsigned xb_xcc_id() { return (unsigned)__builtin_amdgcn_s_getreg((3 << 11) | 20) & 0xFu; }
#define XB_SPIN(cond, bar) do { unsigned _sp = 0; while (cond) { __builtin_amdgcn_s_sleep(1); \
    if ((++_sp & 255u) == 0u) { if (xb_ld(&(bar)[XB_TMO])) break; if (_sp > XB_SPIN_CAP) { atomicAdd(&(bar)[XB_TMO], 1u); break; } } } } while (0)
struct XcdBarrier { unsigned* bar; unsigned x; volatile LAS unsigned* st; };
__device__ __forceinline__ XcdBarrier xcd_barrier_post(unsigned* bar, volatile LAS unsigned* st) {
    XcdBarrier b; b.bar = bar; b.x = xb_xcc_id(); b.st = st;
    if (threadIdx.x == 0) (void)xb_add(&bar[XB_XCNT(b.x)], 1u);
    return b;
}
__device__ __forceinline__ void xcd_barrier_complete(unsigned* bar, unsigned x, unsigned& nloc, unsigned& nx) {
    const unsigned G = gridDim.x * gridDim.y * gridDim.z;
    unsigned sum, cnt, mine, sp = 0u;
    for (;;) {
        sum = 0u; cnt = 0u; mine = 0u;
#pragma unroll
        for (unsigned j = 0; j < 16; ++j) { const unsigned c = xb_ld(&bar[XB_XCNT(j)]); sum += c; cnt += (c > 0u) ? 1u : 0u; mine = (j == x) ? c : mine; }
        if (sum == G) break;
        __builtin_amdgcn_s_sleep(1);
        if ((++sp & 255u) == 0u) { if (xb_ld(&bar[XB_TMO])) break; if (sp > XB_SPIN_CAP) { atomicAdd(&bar[XB_TMO], 1u); break; } }
    }
    nloc = mine > 0u ? mine : 1u; nx = cnt > 0u ? cnt : 1u;
}
__device__ __forceinline__ void xcd_barrier(const XcdBarrier& b) {
    asm volatile("s_waitcnt vmcnt(0)" ::: "memory");
    __syncthreads();
    if (threadIdx.x == 0) {
        unsigned* bar = b.bar;
        __builtin_amdgcn_s_waitcnt(0);
        unsigned nloc = b.st[0], nx = b.st[1];
        if (nloc == 0u) { xcd_barrier_complete(bar, b.x, nloc, nx); b.st[0] = nloc; b.st[1] = nx; }
        const unsigned old = xb_add(&bar[XB_XSUB(b.x)], 1u);
        const unsigned gen = old / nloc;
        if (old + 1u == (gen + 1u) * nloc) {
            __builtin_amdgcn_fence(__ATOMIC_RELEASE, "agent");
            asm volatile("s_waitcnt vmcnt(0)" ::: "memory");
            const unsigned og = xb_add(&bar[XB_TOP], 1u);
            const unsigned tg = og / nx;
            if (og + 1u == (tg + 1u) * nx) xb_add(&bar[XB_TOPGEN], 1u);
            else XB_SPIN(xb_ld(&bar[XB_TOPGEN]) == tg, bar);
            __builtin_amdgcn_fence(__ATOMIC_ACQUIRE, "agent");
            xb_add(&bar[XB_XGEN(b.x)], 1u);
            asm volatile("s_waitcnt vmcnt(0)" ::: "memory");
        } else {
            XB_SPIN(xb_ld(&bar[XB_XGEN(b.x)]) == gen, bar);
            __builtin_amdgcn_fence(__ATOMIC_ACQUIRE, "agent");
            asm volatile("s_waitcnt vmcnt(0)" ::: "memory");
        }
    }
    __syncthreads();
}
constexpr int NPHASE = 24;
__global__ void __launch_bounds__(512, 2) mega(Args a_) {
    extern __shared__ __attribute__((aligned(16))) unsigned char lds_raw[];
    LAS unsigned char* lds = (LAS unsigned char*)lds_raw;
    cg::grid_group grid = cg::this_grid();
    const int G = gridDim.x, cu = blockIdx.x, NGW = G * 8, wave = __builtin_amdgcn_readfirstlane((int)threadIdx.x >> 6);

    volatile LAS unsigned* xst = (volatile LAS unsigned*)(lds + LDS_XST);
    if (threadIdx.x < 4) xst[threadIdx.x] = 0u;
    __syncthreads();
    const XcdBarrier xbar = xcd_barrier_post((unsigned*)(a_.ws + WS_BAR), xst);

    const int ph_lo = a_.ph_lo, ph_hi = a_.ph_hi;
    for (int p = ph_lo; p < ph_hi; ++p) {
        if (p > ph_lo) { if (p == 1) grid.sync(); else xcd_barrier(xbar); }
#define PH_IDS const int lane = fresh_lane(); const int tid = wave * 64 + lane, gw = cu * 8 + wave; (void)tid; (void)gw; (void)lane;
        typedef const __attribute__((address_space(4))) Args KArgs;
        KArgs* ap = (KArgs*)__builtin_amdgcn_kernarg_segment_ptr(); asm volatile("" : "+s"(ap));
        KArgs& a = *ap;
        unsigned char* ws = a.ws;
        unsigned* ctl = (unsigned*)(ws + WS_CTL);
        bf16_t* PROJ = (bf16_t*)(ws + WS_BIG); bf16_t* XN = (bf16_t*)(ws + WS_XN); bf16_t* HMID = (bf16_t*)(ws + WS_HMID);
        float* XC = (float*)(ws + WS_XC); float* mods = (float*)(ws + WS_MODS);
        bf16_t* VT = (bf16_t*)(ws + WS_VT); bf16_t* VTC = (bf16_t*)(ws + WS_VTC);
        if (p == 0) { PH_IDS
            LAS float* lut = (LAS float*)(lds + 72 * 1024);
            for (int i = tid; i < 4096; i += 512) lut[i] = cospif((float)i * (1.0f / 2048.0f));
            __syncthreads();
            if (cu == 0) { bf16_t* dd = (bf16_t*)(ws + WS_DFTD);
                for (int e = tid; e < 256 * 128; e += 512) { const int row = e >> 7, d = e & 127, j = row & 127; const float ang = (float)((j * d) & 127) * (1.0f / 64.0f);
                    const float v = row < 128 ? cospif(ang) : sinpif(ang); dd[e] = (bf16_t)(cvt_pk_bf16(v, 0.f) & 0xffffu); } }
            for (int i = cu * 512 + tid; i < 1024 * DM / 4; i += G * 512) ((f32x4*)XC)[i] = ((const f32x4*)a.in[2])[i];
            mods_items(a, gw, NGW, lane);
            convert_weights(a, 0, (LAS float*)(lds + wave * 8704), gw, NGW, lane);
            dft_tables(ws, lut, gw, NGW, lane);
            continue;
        }
        if (p == NPHASE - 1) { PH_IDS final_norm(a.out, a.in[21], gw, NGW, lane); continue; }
        const int l = (p - 1) / 11, s = (p - 1) % 11;
        const float* mods_l = mods + (size_t)l * 5 * 12288;
        const float* xlat = (l == 0) ? a.in[0] : a.out; const float* xctx = (l == 0) ? a.in[2] : XC;
        const int nMall = (l == 0) ? 68 : 64;
        switch (s) {
        case 0: { PH_IDS
            if (l == 1) { LAS float* lut = (LAS float*)(lds + 72 * 1024);
                for (int i = tid; i < 4096; i += 512) lut[i] = cospif((float)i * (1.0f / 2048.0f));
                __syncthreads();
                convert_weights(a, 1, (LAS float*)(lds + wave * 8704), gw, NGW, lane);
                dft_tables(ws, lut, gw, NGW, lane); }
            norm_rows(xlat, xctx, a.in[6] + (size_t)l * DM, mods_l, 0, 2048, XN, MT, gw, NGW, lane);
        } break;
        case 1: { PH_IDS
            SchedGrid S; S.so.init(nMall, 42, G, cu); S.A = (const char*)XN; S.B = (const char*)(ws + WS_WIN); S.tsA = (size_t)256 * DM * 2; S.tsB = (size_t)256 * DM * 2; S.nt = 32;
            S.nextra = (l == 0) ? 0 : 32; S.ex_pm0 = 64; S.ex_pn0 = 6; S.ex_w = 8; S.ex_ks = 1;
            EpiInProj E{PROJ, VT, VTC};
            pg8::gemm_phase<EpiInProj, SchedGrid>(lds, tid, DM, DM, S, E);
        } break;
        case 2: { PH_IDS
            const int nun = 512 + ((l == 0) ? 32 : 0);
            for (int u = cu; u < nun; u += G) { int row0, g;
                if (u < 512) { const int b = u >> 7, ch = (u >> 2) & 31; g = u & 3; row0 = b * 4096 + ch * 128; }
                else { const int e = u - 512; const int b = e >> 3, ch = (e >> 2) & 1; g = e & 3; row0 = MLAT + b * 256 + ch * 128; }
                sgu_unit(PROJ, row0, g, a.in[10] + (size_t)l * 512, a.in[11] + ((size_t)l * 4 + g) * 128 * 128, a.in[12] + ((size_t)l * 4 + g) * 128, lds, tid); }
            __syncthreads();
            { SchedF1L S{(const char*)(ws + WS_DFTD), (const char*)PROJ, G, cu}; EpiF1L E{(bf16_t*)(ws + WS_U)};
              pg8::gemm_phase<EpiF1L, SchedF1L>(lds, wave * 64 + fresh_lane(), 128, INW, S, E); }
            if (l == 0) { SchedF1 S{(const char*)(ws + WS_DFTD), (const char*)PROJ, G, (cu + 128) % G, 16}; EpiF1 E{nullptr, (bf16_t*)(ws + WS_PQTC)};
              pg8::gemm_phase<EpiF1, SchedF1>(lds, wave * 64 + fresh_lane(), 128, INW, S, E); }
        } break;
        case 3: { PH_IDS
            { SchedFA S{(const char*)(ws + WS_MA), (const char*)(ws + WS_U), G, cu}; EpiFA E{(bf16_t*)(ws + WS_ZBUF)};
              pg8::gemm_phase<EpiFA, SchedFA>(lds, tid, 128, 128, S, E); }
            if (l == 0) { SchedF2 S{(const char*)(ws + WS_DFTC), (const char*)(ws + WS_PQTC), G, (cu + 128) % G, 8}; EpiF2 E{PROJ};
              pg8::gemm_phase<EpiF2, SchedF2>(lds, wave * 64 + fresh_lane(), 8192, 8192, S, E); }
            for (int vcu = cu; vcu < 256; vcu += G) { const int bh = vcu >> 3, rb = vcu & 7; const float* rpb = a.in[9] + (size_t)l * 8 * 15 * 31;
#pragma unroll 1
                for (int pp = 0; pp < 2; ++pp) attn_pass<true>(PROJ, VT, VTC, rpb, bh >> 3, bh & 7, rb * 8 + 0 * 4 + pp * 2, lds, wave);
                if (l == 0) attn_pass<false>(PROJ, VT, VTC, rpb, bh >> 3, bh & 7, rb * 2 + 0, lds, wave); }
        } break;
        case 4: { PH_IDS
            { SchedFB S{(const char*)(ws + WS_TT), (const char*)(ws + WS_ZBUF), G, cu}; EpiFB E{PROJ};
              pg8::gemm_phase<EpiFB, SchedFB>(lds, tid, 128, 128, S, E); }
            for (int vcu = cu; vcu < 256; vcu += G) { const int bh = vcu >> 3, rb = vcu & 7; const float* rpb = a.in[9] + (size_t)l * 8 * 15 * 31;
#pragma unroll 1
                for (int pp = 0; pp < 2; ++pp) attn_pass<true>(PROJ, VT, VTC, rpb, bh >> 3, bh & 7, rb * 8 + 1 * 4 + pp * 2, lds, wave);
                if (l == 0) attn_pass<false>(PROJ, VT, VTC, rpb, bh >> 3, bh & 7, rb * 2 + 1, lds, wave); }
        } break;
        case 5: { PH_IDS
            SchedBranch S; S.so.init(nMall, 8, G, cu); S.proj = (const char*)PROJ; S.wbr = (const char*)(ws + WS_WBR);
            EpiBranch E{PROJ, XN};
            pg8::gemm_phase<EpiBranch, SchedBranch>(lds, tid, INW, DM, S, E);
        } break;
        case 6: { PH_IDS
            SchedGrid S; S.so.init(64, 8, G, cu); S.A = (const char*)XN; S.B = (const char*)(ws + WS_WO); S.tsA = (size_t)256 * DM * 2; S.tsB = (size_t)256 * DM * 2; S.nt = 32;
            S.nextra = (l == 0) ? 32 * 4 : 0; S.ex_pm0 = 64; S.ex_pn0 = 0; S.ex_w = 8; S.ex_ks = 4;
            EpiResid E{xlat, XC, a.out, XC, mods_l + 4096, lds};
            pg8::gemm_phase<EpiResid, SchedGrid>(lds, tid, DM, DM, S, E);
        } break;
        case 7: { PH_IDS
            norm_rows(a.out, XC, a.in[7] + (size_t)l * DM, mods_l, 6144, 8192, XN, nMall * 256, gw, NGW, lane);
        } break;
        case 8: { PH_IDS
            SchedGrid S; S.so.init(nMall, 44, G, cu); S.A = (const char*)XN; S.B = (const char*)(ws + WS_WUP); S.tsA = (size_t)256 * DM * 2; S.tsB = (size_t)256 * DM * 2; S.nt = 32; S.nextra = 0; S.ex_pm0 = 0; S.ex_pn0 = 0; S.ex_w = 1; S.ex_ks = 1;
            EpiUpConv E{HMID, (float*)(ws + WS_BIG), a.in[18] + (size_t)l * 3 * DFF, a.in[19] + (size_t)l * DFF};
            pg8::gemm_phase<EpiUpConv, SchedGrid>(lds, tid, DM, DM, S, E);
        } break;
        case 9: { PH_IDS
            ffn_fix_rows(HMID, (const float*)(ws + WS_BIG), a.in[18] + (size_t)l * 3 * DFF, nMall * 4, cu * 512 + tid, G * 512);
        } break;
        case 10: { PH_IDS
            SchedGrid S; S.so.init(64, 8, G, cu); S.A = (const char*)HMID; S.B = (const char*)(ws + WS_WDN); S.tsA = (size_t)256 * DFF * 2; S.tsB = (size_t)256 * DFF * 2; S.nt = 88;
            S.nextra = (l == 0) ? 32 * 4 : 0; S.ex_pm0 = 64; S.ex_pn0 = 0; S.ex_w = 8; S.ex_ks = 4;
            EpiResid E{a.out, XC, a.out, XC, mods_l + 10240, lds};
            pg8::gemm_phase<EpiResid, SchedGrid>(lds, tid, DFF, DFF, S, E);
        } break;
        }
    }
}

extern "C" void kernel_launch(void* const* d_in, const int* in_sizes, int n_in, void* d_out, int out_size, void* d_ws, size_t ws_size, hipStream_t stream) {
    static int grid = 0;
    if (grid == 0) {
        if (n_in != 22 || ws_size < WS_END) { fprintf(stderr, "kernel_launch: unexpected n_in %d / ws_size %zu (need %zu)\n", n_in, ws_size, (size_t)WS_END); grid = -1; return; }
        int dev = 0, cus = 0, per_cu = 0;
        hipGetDevice(&dev); hipDeviceGetAttribute(&cus, hipDeviceAttributeMultiprocessorCount, dev);
        if (hipFuncSetAttribute((const void*)mega, hipFuncAttributeMaxDynamicSharedMemorySize, LDS_BYTES) != hipSuccess) { fprintf(stderr, "kernel_launch: hipFuncSetAttribute failed\n"); grid = -1; return; }
        hipOccupancyMaxActiveBlocksPerMultiprocessor(&per_cu, (const void*)mega, 512, LDS_BYTES);
        (void)hipGetLastError();
        if (per_cu < 1) fprintf(stderr, "kernel_launch: occupancy query says %d blocks/CU\n", per_cu);
        grid = cus > 0 ? cus : 256;
    }
    if (grid < 0) return;
    hipMemsetAsync((char*)d_ws + WS_CTL, 0, CTL_ZERO_BYTES, stream);
    Args a{};
    for (int i = 0; i < 22; ++i) a.in[i] = (const float*)d_in[i];
    a.out = (float*)d_out; a.ws = (unsigned char*)d_ws; a.ph_lo = 0; a.ph_hi = NPHASE;
    void* args[] = {&a};
    hipError_t e = hipLaunchCooperativeKernel((const void*)mega, dim3(grid), dim3(512), args, LDS_BYTES, stream);
    if (e != hipSuccess) fprintf(stderr, "kernel_launch: cooperative launch failed: %s (grid %d)\n", hipGetErrorString(e), grid);
}
```
